# Optimizing an MI355X kernel written in HIP

```python
import jax, jax.numpy as jnp
from jax import lax
import numpy as np

D_MODEL = 1024
BATCH = 8
SEQ = 8192
DEPTH = 1
DEC_BATCH = 32
DEC_SEQ = 32
PAST_LEN = 1024

CHUNK = 64
MIX_WIDTH = D_MODEL
POOL_WIDTH = MIX_WIDTH // 2
POOL_WINDOWS = (2, 4, 8, 16)
POOL_GROUPS = len(POOL_WINDOWS)
POOL_GROUP_WIDTH = POOL_WIDTH // POOL_GROUPS
POOL_HIST = max(POOL_WINDOWS) - 1
MLSTM_WIDTH = MIX_WIDTH - POOL_WIDTH
MLSTM_HEADS = 4
HEAD_DIM = MLSTM_WIDTH // MLSTM_HEADS
D_FF = -(-8 * D_MODEL // (3 * 256)) * 256
IN_COLS = POOL_WIDTH + 4 * MLSTM_WIDTH + 2 * MLSTM_HEADS
SPLITS = [int(s) for s in np.cumsum([POOL_WIDTH, MLSTM_WIDTH, MLSTM_WIDTH, MLSTM_WIDTH, MLSTM_WIDTH, MLSTM_HEADS])]
ALPHA = (2.0 * DEPTH) ** 0.25
BETA = (8.0 * DEPTH) ** -0.25
LN_EPS = 1e-5

kernel_name = 'hymba_pool_mlstm_stream_step'


def layer_norm(x, g, b):
    xf = x.astype(jnp.float32)
    mu = jnp.mean(xf, axis=-1, keepdims=True)
    var = jnp.mean(jnp.square(xf - mu), axis=-1, keepdims=True)
    y = (xf - mu) * lax.rsqrt(var + LN_EPS) * g.astype(jnp.float32) + b.astype(jnp.float32)
    return y.astype(x.dtype)


def pool_mixer(u, hist, pos0, w_pool, pool_scale):
    T = u.shape[1]
    ext = jnp.concatenate([hist.astype(u.dtype), u], axis=1)
    extf = ext.astype(jnp.float32)
    cs = jnp.pad(jnp.cumsum(extf, axis=1), ((0, 0), (1, 0), (0, 0)))
    end = cs[:, POOL_HIST + 1:POOL_HIST + 1 + T]
    idx = pos0 + jnp.arange(T) + 1
    outs = []
    for g, w in enumerate(POOL_WINDOWS):
        ch = slice(g * POOL_GROUP_WIDTH, (g + 1) * POOL_GROUP_WIDTH)
        start = cs[:, POOL_HIST + 1 - w:POOL_HIST + 1 - w + T, ch]
        cnt = jnp.minimum(idx, w).astype(jnp.float32)[None, :, None]
        outs.append((end[..., ch] - start) / cnt - extf[:, POOL_HIST:, ch])
    d = jnp.stack(outs, axis=2)
    p = jnp.einsum('btgc,gcd->btgd', d, w_pool.astype(jnp.float32)).reshape(u.shape)
    p = p * pool_scale.astype(jnp.float32)
    return p.astype(u.dtype), ext[:, -POOL_HIST:]


def mlstm_chunk(carry, inp):
    C, n, m = carry
    q, k, v, ig, logf = inp
    L = q.shape[2]
    b = jnp.cumsum(logf, axis=-1)
    m_t = b + jnp.maximum(m[..., None], lax.cummax(ig - b, axis=2))
    dec = jnp.exp(b + m[..., None] - m_t)
    causal = jnp.tril(jnp.ones((L, L), dtype=bool))
    log_d = b[..., :, None] - b[..., None, :] + ig[..., None, :] - m_t[..., :, None]
    dmat = jnp.exp(jnp.where(causal, log_d, -jnp.inf))
    s = jnp.einsum('bhtd,bhsd->bhts', q, k) * dmat
    num = dec[..., None] * jnp.einsum('bhtk,bhkv->bhtv', q, C) + jnp.einsum('bhts,bhsv->bhtv', s, v)
    den = dec * jnp.einsum('bhtk,bhk->bht', q, n) + jnp.sum(s, axis=-1)
    h = num / jnp.maximum(jnp.abs(den), jnp.exp(-m_t))[..., None]
    m_new = m_t[..., -1]
    w_state = jnp.exp(b[..., -1] + m - m_new)
    w_row = jnp.exp(b[..., -1:] - b + ig - m_new[..., None])
    C_new = w_state[..., None, None] * C + jnp.einsum('bhs,bhsk,bhsv->bhkv', w_row, k, v)
    n_new = w_state[..., None] * n + jnp.einsum('bhs,bhsk->bhk', w_row, k)
    return (C_new, n_new, m_new), h


def mlstm_mixer(q, k, v, o, ig, fg, C0, n0, m0, norm_g):
    B, T, _ = q.shape
    L = min(T, CHUNK)
    nc = T // L
    f32 = jnp.float32

    def heads(a):
        return a.reshape(B, nc, L, MLSTM_HEADS, HEAD_DIM).transpose(1, 0, 3, 2, 4).astype(f32)

    def gates(a):
        return a.reshape(B, nc, L, MLSTM_HEADS).transpose(1, 0, 3, 2).astype(f32)

    xs = (heads(q), heads(k) * (HEAD_DIM ** -0.5), heads(v), gates(ig), jax.nn.log_sigmoid(gates(fg)))
    carry, hs = lax.scan(mlstm_chunk, (C0.astype(f32), n0.astype(f32), m0.astype(f32)), xs)
    h = hs.transpose(1, 0, 3, 2, 4).reshape(B, T, MLSTM_HEADS, HEAD_DIM)
    mu = jnp.mean(h, axis=-1, keepdims=True)
    var = jnp.mean(jnp.square(h - mu), axis=-1, keepdims=True)
    h = ((h - mu) * lax.rsqrt(var + LN_EPS)).reshape(B, T, MLSTM_WIDTH)
    h = h * norm_g.astype(f32) * jax.nn.sigmoid(o.astype(f32))
    return h.astype(q.dtype), carry


def trunk_layer(x, pool_hist, C0, n0, m0, pos0, w_in, b_in, w_pool, pool_scale, mlstm_norm_g, w_out,
                ln1_g, ln1_b, w_gate, w_up, w_down, ln2_g, ln2_b):
    proj = x @ w_in + b_in
    u, q, k, v, o, ig, fg = jnp.split(proj, SPLITS, axis=-1)
    p_out, pool_new = pool_mixer(u, pool_hist, pos0, w_pool, pool_scale)
    m_out, (C, n, m) = mlstm_mixer(q, k, v, o, ig, fg, C0, n0, m0, mlstm_norm_g)
    mix = jnp.concatenate([p_out, m_out], axis=-1) @ w_out
    h = layer_norm(ALPHA * x + mix, ln1_g, ln1_b)
    ff = (jax.nn.silu(h @ w_gate) * (h @ w_up)) @ w_down
    y = layer_norm(ALPHA * h + ff, ln2_g, ln2_b)
    dt = x.dtype
    return y, (pool_new.astype(dt), C.astype(dt), n.astype(dt), m.astype(dt))


def setup_inputs(seed: int = 0) -> dict:
    key = jax.random.key(seed)
    ks = jax.random.split(key, 24)
    f32 = jnp.float32

    def nrm(k, shape, s):
        return jax.random.normal(k, shape, f32) * s

    x_prompt = nrm(ks[0], (BATCH, SEQ, D_MODEL), 1.0)
    x_sample = nrm(ks[1], (DEC_BATCH, DEC_SEQ, D_MODEL), 1.0)
    state_pool = nrm(ks[2], (DEPTH, DEC_BATCH, POOL_HIST, POOL_WIDTH), 1.0)
    state_mlstm_C = nrm(ks[3], (DEPTH, DEC_BATCH, MLSTM_HEADS, HEAD_DIM, HEAD_DIM), 0.3)
    state_mlstm_n = nrm(ks[4], (DEPTH, DEC_BATCH, MLSTM_HEADS, HEAD_DIM), 0.3)
    state_mlstm_m = nrm(ks[5], (DEPTH, DEC_BATCH, MLSTM_HEADS), 1.0)
    ln_in_g = 1.0 + nrm(ks[6], (D_MODEL,), 0.02)
    ln_in_b = nrm(ks[7], (D_MODEL,), 0.01)
    col_scale = jnp.ones((IN_COLS,), f32).at[SPLITS[2]:SPLITS[3]].set(BETA)
    w_in = nrm(ks[8], (DEPTH, D_MODEL, IN_COLS), D_MODEL ** -0.5) * col_scale
    f_bias = jnp.concatenate([jnp.zeros((IN_COLS - MLSTM_HEADS,), f32), jnp.linspace(3.0, 6.0, MLSTM_HEADS)])
    b_in = nrm(ks[9], (DEPTH, IN_COLS), 0.01) + f_bias
    w_pool = nrm(ks[10], (DEPTH, POOL_GROUPS, POOL_GROUP_WIDTH, POOL_GROUP_WIDTH), POOL_GROUP_WIDTH ** -0.5)
    pool_scale = 1.0 + nrm(ks[11], (DEPTH, POOL_WIDTH), 0.02)
    mlstm_norm_g = 1.0 + nrm(ks[12], (DEPTH, MLSTM_WIDTH), 0.02)
    w_out = nrm(ks[13], (DEPTH, MIX_WIDTH, D_MODEL), BETA * MIX_WIDTH ** -0.5)
    ln1_g = 1.0 + nrm(ks[14], (DEPTH, D_MODEL), 0.02)
    ln1_b = nrm(ks[15], (DEPTH, D_MODEL), 0.01)
    w_gate = nrm(ks[16], (DEPTH, D_MODEL, D_FF), D_MODEL ** -0.5)
    w_up = nrm(ks[17], (DEPTH, D_MODEL, D_FF), D_MODEL ** -0.5)
    w_down = nrm(ks[18], (DEPTH, D_FF, D_MODEL), BETA * D_FF ** -0.5)
    ln2_g = 1.0 + nrm(ks[19], (DEPTH, D_MODEL), 0.02)
    ln2_b = nrm(ks[20], (DEPTH, D_MODEL), 0.01)
    return {'x_prompt': x_prompt, 'x_sample': x_sample, 'state_pool': state_pool,
            'state_mlstm_C': state_mlstm_C, 'state_mlstm_n': state_mlstm_n, 'state_mlstm_m': state_mlstm_m,
            'ln_in_g': ln_in_g, 'ln_in_b': ln_in_b, 'w_in': w_in, 'b_in': b_in, 'w_pool': w_pool,
            'pool_scale': pool_scale, 'mlstm_norm_g': mlstm_norm_g, 'w_out': w_out,
            'ln1_g': ln1_g, 'ln1_b': ln1_b, 'w_gate': w_gate, 'w_up': w_up, 'w_down': w_down,
            'ln2_g': ln2_g, 'ln2_b': ln2_b}


def reference(x_prompt, x_sample, state_pool, state_mlstm_C, state_mlstm_n, state_mlstm_m,
              ln_in_g, ln_in_b, w_in, b_in, w_pool, pool_scale, mlstm_norm_g, w_out,
              ln1_g, ln1_b, w_gate, w_up, w_down, ln2_g, ln2_b):
    dt = x_prompt.dtype
    bp = x_prompt.shape[0]
    hp = layer_norm(x_prompt, ln_in_g, ln_in_b)
    hs = layer_norm(x_sample, ln_in_g, ln_in_b)
    zero_pool = jnp.zeros((bp, POOL_HIST, POOL_WIDTH), dt)
    zero_C = jnp.zeros((bp, MLSTM_HEADS, HEAD_DIM, HEAD_DIM), dt)
    zero_n = jnp.zeros((bp, MLSTM_HEADS, HEAD_DIM), dt)
    zero_m = jnp.zeros((bp, MLSTM_HEADS), dt)
    acc_p = [[], [], [], []]
    acc_s = [[], [], [], []]
    for l in range(DEPTH):
        params = (w_in[l], b_in[l], w_pool[l], pool_scale[l], mlstm_norm_g[l], w_out[l],
                  ln1_g[l], ln1_b[l], w_gate[l], w_up[l], w_down[l], ln2_g[l], ln2_b[l])
        hp, st_p = trunk_layer(hp, zero_pool, zero_C, zero_n, zero_m, 0, *params)
        hs, st_s = trunk_layer(hs, state_pool[l], state_mlstm_C[l], state_mlstm_n[l], state_mlstm_m[l],
                               PAST_LEN, *params)
        for a, s in zip(acc_p, st_p):
            a.append(s)
        for a, s in zip(acc_s, st_s):
            a.append(s)
    pool_p, C_p, n_p, m_p = [jnp.stack(a) for a in acc_p]
    pool_s, C_s, n_s, m_s = [jnp.stack(a) for a in acc_s]
    return (hp, hs, pool_p, C_p, n_p, m_p, pool_s, C_s, n_s, m_s)
```

```cpp
#include <hip/hip_runtime.h>
#include <hip/hip_cooperative_groups.h>
#include <cstdio>
namespace cg = cooperative_groups;
namespace pg8 {
#define PG8_LAS __attribute__((address_space(3)))
typedef unsigned short bf16_t;
typedef short bf16x8 __attribute__((ext_vector_type(8)));
typedef float f32x4 __attribute__((ext_vector_type(4)));
typedef unsigned u32x4 __attribute__((ext_vector_type(4)));
constexpr int BM = 256, BK = 64, HALF = 128, HTB = HALF * BK * 2  , STAGE_BYTES = 8 * HTB, NXCD = 8, WGM = 8;

__host__ __device__ __forceinline__ int lds_byte(int r, int c) { const int st = (r >> 4) * 2 + (c >> 5), rr = r & 15, cc = c & 31, ob = rr * 64 + cc * 2; return st * 1024 + (ob ^ (((ob >> 9) & 1) << 5)); }
__host__ __device__ __forceinline__ void stage_rc(int b, int& R, int& C) { const int st = b / 1024, sb = b % 1024, swz = sb ^ (((sb >> 9) & 1) << 5); R = (st >> 1) * 16 + swz / 64; C = (st & 1) * 32 + (swz % 64) / 2; }
__host__ __device__ __forceinline__ int perm32(int rho) { const int n = rho >> 4, i = rho & 15; return 8 * (i >> 2) + 4 * n + (i & 3); }

struct Unit { int pm, pn; };
struct Gemm { const bf16_t* A; const bf16_t* Bt; int M, N, K; };
struct StaticOrder {
    int nM, nN, nwg, G, c;
    __host__ __device__ void init(int M, int N, int G_, int c_) { nM = M / BM; nN = N / BM; nwg = nM * nN; G = G_; c = c_; }
    __host__ __device__ bool next(int i, Unit& u) const {
        const long L = (long)i * G + c; if (L >= nwg) return false;
        int wgid = (int)L; { const int q = nwg / NXCD, r = nwg % NXCD, xcd = wgid % NXCD, off = wgid / NXCD; wgid = (xcd < r ? xcd * (q + 1) : r * (q + 1) + (xcd - r) * q) + off; }
        const int nig = WGM * nN, gid = wgid / nig, fm = gid * WGM, gsz = (nM - fm) < WGM ? (nM - fm) : WGM;
        u.pm = fm + ((wgid % nig) % gsz); u.pn = (wgid % nig) / gsz; return true;
    }
    __device__ __forceinline__ void a_ready(const Unit&) const {}
    __device__ __forceinline__ void done(const Unit&) const {}
};
__device__ __forceinline__ unsigned cvt_pk_bf16(float lo, float hi) { unsigned r; asm volatile("v_cvt_pk_bf16_f32 %0, %1, %2" : "=v"(r) : "v"(lo), "v"(hi)); return r; }
template <class Epi, class Sched>
__device__ __forceinline__ void gemm_phase(PG8_LAS unsigned char* lds, const Gemm g, const Sched& S, const Epi& E) {
    int tid_ = threadIdx.x; asm volatile("" : "+v"(tid_)); const int tid = tid_, wid = __builtin_amdgcn_readfirstlane(tid >> 6), lane = tid & 63, wr = wid >> 2, wc = wid & 3, fr = lane & 15, fq = lane >> 4;
    const int K = g.K, nt = K / BK;
    unsigned voffA[2], voffB[2];
#pragma unroll
    for (int i = 0; i < 2; ++i) { int R, C; stage_rc(tid * 16 + i * 8192, R, C); const int Rb = Epi::PERM ? ((R & ~31) + perm32(R & 31)) : R;
        voffA[i] = (unsigned)(R * K + C) * 2u; voffB[i] = (unsigned)(Rb * K + C) * 2u; }
    const size_t kstep = (size_t)(BK * 2);
    const size_t hstep = (size_t)HALF * K * 2;
    const size_t tstep = 2 * hstep;
    const unsigned ldsw = (unsigned)wid * 1024u;
    const int aoff = lds_byte(wr * 64 + fr, fq * 8), boff = lds_byte(wc * 32 + fr, fq * 8);
#define PG8_SA(b, h) (((b) * 2 + (h)) * HTB)
#define PG8_SB(b, h) ((4 + (b) * 2 + (h)) * HTB)
#define PG8_STAGE(bufoff, gbase, voff) do { _Pragma("unroll") for (int _i = 0; _i < 2; ++_i) \
        __builtin_amdgcn_global_load_lds((const unsigned*)((const char*)(gbase) + (voff)[_i]), (PG8_LAS unsigned*)(lds + (bufoff) + ldsw + _i * 8192), 16, 0, 0); } while (0)
#define PG8_LDA(dst, b, h) do { _Pragma("unroll") for (int m = 0; m < 4; ++m) _Pragma("unroll") for (int k = 0; k < 2; ++k) dst[m][k] = *(const PG8_LAS bf16x8*)(lds + PG8_SA(b, h) + aoff + m * 2048 + k * 1024); } while (0)
#define PG8_LDB(dst, b, h) do { _Pragma("unroll") for (int n = 0; n < 2; ++n) _Pragma("unroll") for (int k = 0; k < 2; ++k) dst[n][k] = *(const PG8_LAS bf16x8*)(lds + PG8_SB(b, h) + boff + n * 2048 + k * 1024); } while (0)
#define PG8_MMA(ai, bj, At, Bt) do { __builtin_amdgcn_s_setprio(1); _Pragma("unroll") for (int m = 0; m < 4; ++m) _Pragma("unroll") for (int n = 0; n < 2; ++n) _Pragma("unroll") for (int k = 0; k < 2; ++k) \
        acc[ai][bj][m][n] = __builtin_amdgcn_mfma_f32_16x16x32_bf16(Bt[n][k], At[m][k], acc[ai][bj][m][n], 0, 0, 0); __builtin_amdgcn_s_setprio(0); } while (0)
#define PG8_WAIT_V(n) asm volatile("s_waitcnt vmcnt(" #n ")" ::: "memory")
#define PG8_WAIT_L(n) asm volatile("s_waitcnt lgkmcnt(" #n ")" ::: "memory")
#define PG8_BAR __builtin_amdgcn_s_barrier()
#define PG8_SCHED __builtin_amdgcn_sched_barrier(0)
    Unit cur, nxt; int ui = 0;
    if (!S.next(0, cur)) return;
    f32x4 acc[2][2][4][2];
#pragma unroll
    for (int a = 0; a < 2; ++a)
#pragma unroll
        for (int b = 0; b < 2; ++b)
#pragma unroll
            for (int m = 0; m < 4; ++m)
#pragma unroll
                for (int n = 0; n < 2; ++n) acc[a][b][m][n] = (f32x4){0.f, 0.f, 0.f, 0.f};
    bf16x8 At[4][2], B0[2][2], B1[2][2];
    const char* cA = (const char*)g.A + (size_t)cur.pm * tstep; const char* cB = (const char*)g.Bt + (size_t)cur.pn * tstep;
    S.a_ready(cur);
    PG8_STAGE(PG8_SB(0, 0), cB, voffB); PG8_STAGE(PG8_SA(0, 0), cA, voffA); PG8_STAGE(PG8_SB(0, 1), cB + hstep, voffB); PG8_STAGE(PG8_SA(0, 1), cA + hstep, voffA);
    if (wr == 1) PG8_BAR;
    PG8_WAIT_V(4); PG8_BAR;
    PG8_STAGE(PG8_SB(1, 0), cB + kstep, voffB); PG8_STAGE(PG8_SA(1, 0), cA + kstep, voffA); PG8_STAGE(PG8_SB(1, 1), cB + hstep + kstep, voffB);
    PG8_WAIT_V(6); PG8_BAR;
    for (;;) {
        const bool has_next = S.next(ui + 1, nxt);
        const char* nA = has_next ? (const char*)g.A + (size_t)nxt.pm * tstep : cA; const char* nB = has_next ? (const char*)g.Bt + (size_t)nxt.pn * tstep : cB;
        for (int t = 0; t < nt; t += 2) {
            const bool last = (t == nt - 2);
            const char* a1 = cA + (size_t)(t + 1) * kstep;
            const char* a2 = last ? nA : cA + (size_t)(t + 2) * kstep; const char* b2 = last ? nB : cB + (size_t)(t + 2) * kstep;
            const char* a3 = a2 + kstep; const char* b3 = b2 + kstep;
            if (last && has_next) S.a_ready(nxt);
            PG8_LDB(B0, 0, 0); PG8_SCHED; PG8_LDA(At, 0, 0); PG8_STAGE(PG8_SA(1, 1), a1 + hstep, voffA);
            PG8_WAIT_L(8); PG8_BAR; PG8_WAIT_L(0); PG8_MMA(0, 0, At, B0); PG8_BAR; PG8_SCHED;
            PG8_LDB(B1, 0, 1); PG8_STAGE(PG8_SB(0, 0), b2, voffB);
            PG8_BAR; PG8_WAIT_L(0); PG8_MMA(0, 1, At, B1); PG8_BAR;
            PG8_LDA(At, 0, 1); PG8_STAGE(PG8_SA(0, 0), a2, voffA);
            PG8_BAR; PG8_WAIT_L(0); PG8_MMA(1, 0, At, B0); PG8_BAR; PG8_SCHED;
            PG8_STAGE(PG8_SB(0, 1), b2 + hstep, voffB);
            PG8_WAIT_V(6); PG8_BAR; PG8_MMA(1, 1, At, B1); PG8_BAR;
            PG8_LDB(B0, 1, 0); PG8_SCHED; PG8_LDA(At, 1, 0); PG8_STAGE(PG8_SA(0, 1), a2 + hstep, voffA);
            PG8_WAIT_L(8); PG8_BAR; PG8_WAIT_L(0); PG8_MMA(0, 0, At, B0); PG8_BAR; PG8_SCHED;
            PG8_LDB(B1, 1, 1); PG8_STAGE(PG8_SB(1, 0), b3, voffB);
            PG8_BAR; PG8_WAIT_L(0); PG8_MMA(0, 1, At, B1); PG8_BAR;
            PG8_LDA(At, 1, 1); PG8_STAGE(PG8_SA(1, 0), a3, voffA);
            PG8_BAR; PG8_WAIT_L(0); PG8_MMA(1, 0, At, B0); PG8_BAR; PG8_SCHED;
            PG8_STAGE(PG8_SB(1, 1), b3 + hstep, voffB);
            PG8_WAIT_V(6); PG8_BAR; PG8_MMA(1, 1, At, B1); PG8_BAR;
        }
        if constexpr (!Epi::AFTER_DRAIN) { E(acc, cur, wr, wc, fr, fq); S.done(cur); }
        if (!has_next) break;
#pragma unroll
        for (int a = 0; a < 2; ++a)
#pragma unroll
            for (int b = 0; b < 2; ++b)
#pragma unroll
                for (int m = 0; m < 4; ++m)
#pragma unroll
                    for (int n = 0; n < 2; ++n) acc[a][b][m][n] = (f32x4){0.f, 0.f, 0.f, 0.f};
        cur = nxt; cA = nA; cB = nB; ++ui;
    }
    PG8_WAIT_V(0);
    if (wr == 0) PG8_BAR;
    PG8_BAR;
    if constexpr (Epi::AFTER_DRAIN) { E.fused(acc, cur, wr, wc, fr, fq, lds, wid, lane); S.done(cur); }
#undef PG8_SA
#undef PG8_SB
#undef PG8_STAGE
#undef PG8_LDA
#undef PG8_LDB
#undef PG8_MMA
#undef PG8_WAIT_V
#undef PG8_WAIT_L
#undef PG8_BAR
#undef PG8_SCHED
}
}

using pg8::bf16_t; using pg8::bf16x8; using pg8::f32x4; using pg8::u32x4;
#define LAS __attribute__((address_space(3)))
typedef unsigned u32x2 __attribute__((ext_vector_type(2)));

constexpr int DM = 1024, NB = 8, SEQ = 8192, DB = 32, DS = 32;
constexpr int MP = NB * SEQ, MS = DB * DS, MT = MP + MS;
constexpr int NPROJ = 2560, INCOLS = 2568, DFF = 2816;
constexpr int SCN = 16;
constexpr float ALPHA = 1.189207115002721f, KSCALE = 0.08838834764831845f, LN_EPS = 1e-5f;

constexpr size_t al256(size_t x) { return (x + 255) & ~(size_t)255; }
constexpr size_t WS_WIN = 0;
constexpr size_t WS_WOUT = WS_WIN + al256((size_t)NPROJ * DM * 2);
constexpr size_t WS_WGU = WS_WOUT + al256((size_t)DM * DM * 2);
constexpr size_t WS_WDN = WS_WGU + al256((size_t)2 * DFF * DM * 2);
constexpr size_t WS_WPOOL = WS_WDN + al256((size_t)DM * DFF * 2);
constexpr size_t WS_BIAS = WS_WPOOL + al256((size_t)4 * 128 * 128 * 2);
constexpr size_t WS_GATES = WS_BIAS + al256((size_t)NPROJ * 4);
constexpr size_t WS_MTAB = WS_GATES + al256((size_t)MT * 8 * 4);
constexpr size_t WS_BTAB = WS_MTAB + al256((size_t)32 * 132 * 4);
constexpr size_t WS_DST = WS_BTAB + al256((size_t)32 * 128 * 4);
constexpr size_t WS_DN = WS_DST + al256((size_t)224 * 16384 * 4);
constexpr size_t WS_H0 = WS_DN + al256((size_t)224 * 128 * 4);
constexpr size_t WS_PROJ = WS_H0 + al256((size_t)MT * DM * 2);
constexpr size_t WS_MIX = WS_PROJ + al256((size_t)MT * NPROJ * 2);
constexpr size_t WS_END = WS_MIX + al256((size_t)MT * DM * 2);
constexpr size_t WS_ACT = WS_PROJ;
static_assert((size_t)MT * DFF * 2 <= WS_END - WS_PROJ, "act does not fit");

constexpr size_t O_Y = 0;
constexpr size_t O_POOLP = (size_t)MT * DM;
constexpr size_t O_CP = O_POOLP + (size_t)NB * 15 * 512;
constexpr size_t O_NP = O_CP + (size_t)NB * 4 * 16384;
constexpr size_t O_MP = O_NP + (size_t)NB * 4 * 128;
constexpr size_t O_POOLS = O_MP + (size_t)NB * 4;
constexpr size_t O_CS = O_POOLS + (size_t)DB * 15 * 512;
constexpr size_t O_NS = O_CS + (size_t)DB * 4 * 16384;
constexpr size_t O_MS = O_NS + (size_t)DB * 4 * 128;
constexpr size_t O_END = O_MS + (size_t)DB * 4;

struct Params { const float* in[21]; float* out; unsigned char* ws; };

__device__ __forceinline__ int fresh_tid() { int t = threadIdx.x; asm volatile("" : "+v"(t)); return t; }
__device__ __forceinline__ float bf2f(unsigned x) { return __uint_as_float(x << 16); }
__device__ __forceinline__ float bflo(unsigned w) { return __uint_as_float(w << 16); }
__device__ __forceinline__ float bfhi(unsigned w) { return __uint_as_float(w & 0xffff0000u); }
__device__ __forceinline__ unsigned pk2(float lo, float hi) { return pg8::cvt_pk_bf16(lo, hi); }
__device__ __forceinline__ float wave_sum(float v) {
#pragma unroll
    for (int o = 32; o; o >>= 1) v += __shfl_xor(v, o);
    return v; }
__device__ __forceinline__ float wave_max(float v) {
#pragma unroll
    for (int o = 32; o; o >>= 1) v = fmaxf(v, __shfl_xor(v, o));
    return v; }
__device__ __forceinline__ float scan_sum(float x, int lane) {
#pragma unroll
    for (int o = 1; o < 64; o <<= 1) { const float y = __shfl_up(x, o); if (lane >= o) x += y; }
    return x; }
__device__ __forceinline__ float scan_max(float x, int lane) {
#pragma unroll
    for (int o = 1; o < 64; o <<= 1) { const float y = __shfl_up(x, o); if (lane >= o) x = fmaxf(x, y); }
    return x; }
__device__ __forceinline__ float logsigmoid(float x) { return fminf(x, 0.f) - log1pf(expf(-fabsf(x))); }
__device__ __forceinline__ bf16x8 ldfrag(LAS const unsigned char* base, int row, int strideB, int kbyte) { return *(LAS const bf16x8*)(base + row * strideB + kbyte); }
#define MFMA16(a, b, c) __builtin_amdgcn_mfma_f32_16x16x32_bf16((a), (b), (c), 0, 0, 0)

struct EpiBf16B {
    static constexpr bool PERM = true, AFTER_DRAIN = false;
    bf16_t* O; int ldc; const float* bias;
    __device__ __forceinline__ void operator()(const f32x4 (&acc)[2][2][4][2], const pg8::Unit& u, int wr, int wc, int fr, int fq) const {
        const int row0 = u.pm * 256 + wr * 64 + fr, col0 = u.pn * 256 + wc * 32 + 8 * fq;
        f32x4 bv[2][2];
#pragma unroll
        for (int bj = 0; bj < 2; ++bj)
#pragma unroll
            for (int n = 0; n < 2; ++n) bv[bj][n] = *(const f32x4*)(bias + col0 + bj * 128 + 4 * n);
#pragma unroll
        for (int ai = 0; ai < 2; ++ai)
#pragma unroll
            for (int m = 0; m < 4; ++m) { bf16_t* rowp = O + (size_t)(row0 + ai * 128 + m * 16) * ldc + col0;
#pragma unroll
                for (int bj = 0; bj < 2; ++bj) { const f32x4 v0 = acc[ai][bj][m][0] + bv[bj][0], v1 = acc[ai][bj][m][1] + bv[bj][1];
                    u32x4 w; w.x = pk2(v0[0], v0[1]); w.y = pk2(v0[2], v0[3]); w.z = pk2(v1[0], v1[1]); w.w = pk2(v1[2], v1[3]);
                    *(u32x4*)(rowp + bj * 128) = w; } }
    }
};
struct EpiRes {
    static constexpr bool PERM = false, AFTER_DRAIN = false;
    const bf16_t* base; float* out;
    __device__ __forceinline__ void operator()(const f32x4 (&acc)[2][2][4][2], const pg8::Unit& u, int wr, int wc, int fr, int fq) const {
        const int row0 = u.pm * 256 + wr * 64 + fr, col0 = u.pn * 256 + wc * 32 + 4 * fq;
#pragma unroll
        for (int ai = 0; ai < 2; ++ai)
#pragma unroll
            for (int m = 0; m < 4; ++m) { const size_t off = (size_t)(row0 + ai * 128 + m * 16) * DM + col0;
#pragma unroll
                for (int bj = 0; bj < 2; ++bj)
#pragma unroll
                    for (int n = 0; n < 2; ++n) { const u32x2 b = *(const u32x2*)(base + off + bj * 128 + n * 16);
                        f32x4 o; o[0] = ALPHA * bflo(b.x) + acc[ai][bj][m][n][0]; o[1] = ALPHA * bfhi(b.x) + acc[ai][bj][m][n][1];
                        o[2] = ALPHA * bflo(b.y) + acc[ai][bj][m][n][2]; o[3] = ALPHA * bfhi(b.y) + acc[ai][bj][m][n][3];
                        *(f32x4*)(out + off + bj * 128 + n * 16) = o; } }
    }
};
__device__ __forceinline__ float swiglu(float g, float u) { return g * u / (1.0f + __expf(-g)); }
struct EpiSwiglu {
    static constexpr bool PERM = true, AFTER_DRAIN = false;
    bf16_t* O;
    __device__ __forceinline__ void operator()(const f32x4 (&acc)[2][2][4][2], const pg8::Unit& u, int wr, int wc, int fr, int fq) const {
        const int row0 = u.pm * 256 + wr * 64 + fr, col0 = u.pn * 128 + wc * 32 + 8 * fq;
#pragma unroll
        for (int ai = 0; ai < 2; ++ai)
#pragma unroll
            for (int m = 0; m < 4; ++m) { bf16_t* rowp = O + (size_t)(row0 + ai * 128 + m * 16) * DFF + col0;
                const f32x4 g0 = acc[ai][0][m][0], g1 = acc[ai][0][m][1], u0 = acc[ai][1][m][0], u1 = acc[ai][1][m][1];
                u32x4 w; w.x = pk2(swiglu(g0[0], u0[0]), swiglu(g0[1], u0[1])); w.y = pk2(swiglu(g0[2], u0[2]), swiglu(g0[3], u0[3]));
                w.z = pk2(swiglu(g1[0], u1[0]), swiglu(g1[1], u1[1])); w.w = pk2(swiglu(g1[2], u1[2]), swiglu(g1[3], u1[3]));
                *(u32x4*)rowp = w; }
    }
};

__device__ __forceinline__ void tr_job(LAS float* T, const float* src, int ld, int K, int NC, bf16_t* dst, int mode, int vb, int nvb) {
    const int tid = fresh_tid(); const int nkt = K / 64, ntile = nkt * (NC / 64);
    for (int t = vb; t < ntile; t += nvb) {
        const int k0 = (t % nkt) * 64, n0 = (t / nkt) * 64;
        { const int r = tid >> 3, cs = (tid & 7) * 8; const float* s = src + (size_t)(k0 + r) * ld + n0 + cs;
          const float4 a = *(const float4*)s, b = *(const float4*)(s + 4); LAS float* d = T + r * 65 + cs;
          d[0] = a.x; d[1] = a.y; d[2] = a.z; d[3] = a.w; d[4] = b.x; d[5] = b.y; d[6] = b.z; d[7] = b.w; }
        __syncthreads();
        { const int n = tid >> 3, ks = (tid & 7) * 8, gn = n0 + n; float v[8];
#pragma unroll
          for (int i = 0; i < 8; ++i) v[i] = T[(ks + i) * 65 + n];
          const float sc = (mode == 3 && gn >= 1024 && gn < 1536) ? KSCALE : 1.0f;
          const int drow = (mode == 1) ? 256 * (gn >> 7) + (gn & 127) : (mode == 2) ? 256 * (gn >> 7) + 128 + (gn & 127) : gn;
          u32x4 w; w.x = pk2(v[0] * sc, v[1] * sc); w.y = pk2(v[2] * sc, v[3] * sc); w.z = pk2(v[4] * sc, v[5] * sc); w.w = pk2(v[6] * sc, v[7] * sc);
          *(u32x4*)(dst + (size_t)drow * K + k0 + ks) = w; }
        __syncthreads();
    }
}

__device__ __forceinline__ void phase0(const Params& p, LAS unsigned char* lds) {
    const int tid = fresh_tid(), lane = tid & 63, wave = tid >> 6, G = gridDim.x, bx = blockIdx.x;
    unsigned char* ws = p.ws;
    LAS float* T = (LAS float*)lds;
    int off = 0;
    tr_job(T, p.in[8], INCOLS, DM, NPROJ, (bf16_t*)(ws + WS_WIN), 3, (bx + off) % G, G); off += 640;
    tr_job(T, p.in[13], DM, DM, DM, (bf16_t*)(ws + WS_WOUT), 0, (bx + G - off % G) % G, G); off += 256;
    tr_job(T, p.in[16], DFF, DM, DFF, (bf16_t*)(ws + WS_WGU), 1, (bx + G - off % G) % G, G); off += 704;
    tr_job(T, p.in[17], DFF, DM, DFF, (bf16_t*)(ws + WS_WGU), 2, (bx + G - off % G) % G, G); off += 704;
    tr_job(T, p.in[18], DM, DFF, DM, (bf16_t*)(ws + WS_WDN), 0, (bx + G - off % G) % G, G); off += 704;
#pragma unroll 1
    for (int g = 0; g < 4; ++g) { tr_job(T, p.in[10] + g * 16384, 128, 128, 128, (bf16_t*)(ws + WS_WPOOL) + g * 16384, 0, (bx + G - off % G) % G, G); off += 4; }
    { float* bs = (float*)(ws + WS_BIAS); const float* b_in = p.in[9];
      for (int i = bx * 512 + tid; i < NPROJ; i += G * 512) bs[i] = b_in[i] * ((i >= 1024 && i < 1536) ? KSCALE : 1.0f); }
    LAS float* wg = (LAS float*)lds;
    { const float* w_in = p.in[8]; for (int i = tid; i < 8192; i += 512) { const int g = i >> 10, k = i & 1023; wg[i] = w_in[(size_t)k * INCOLS + NPROJ + g]; } }
    __syncthreads();
    const float* lg = p.in[6]; const float* lb = p.in[7]; const float* b_in = p.in[9];
    bf16_t* h0 = (bf16_t*)(ws + WS_H0); float* gates = (float*)(ws + WS_GATES);
    for (int row = bx * 8 + wave; row < MT; row += G * 8) {
        const float* x = row < MP ? p.in[0] + (size_t)row * DM : p.in[1] + (size_t)(row - MP) * DM;
        float4 v[4];
#pragma unroll
        for (int i = 0; i < 4; ++i) v[i] = *(const float4*)(x + i * 256 + lane * 4);
        float s = 0.f;
#pragma unroll
        for (int i = 0; i < 4; ++i) s += (v[i].x + v[i].y) + (v[i].z + v[i].w);
        const float mu = wave_sum(s) * (1.0f / DM);
        float q = 0.f;
#pragma unroll
        for (int i = 0; i < 4; ++i) { v[i].x -= mu; v[i].y -= mu; v[i].z -= mu; v[i].w -= mu; q += (v[i].x * v[i].x + v[i].y * v[i].y) + (v[i].z * v[i].z + v[i].w * v[i].w); }
        const float rstd = rsqrtf(wave_sum(q) * (1.0f / DM) + LN_EPS);
        float ga[8];
#pragma unroll
        for (int g = 0; g < 8; ++g) ga[g] = 0.f;
#pragma unroll
        for (int i = 0; i < 4; ++i) { const int c = i * 256 + lane * 4; const float4 gg = *(const float4*)(lg + c), bb = *(const float4*)(lb + c);
            float4 y; y.x = v[i].x * rstd * gg.x + bb.x; y.y = v[i].y * rstd * gg.y + bb.y; y.z = v[i].z * rstd * gg.z + bb.z; y.w = v[i].w * rstd * gg.w + bb.w;
            u32x2 w; w.x = pk2(y.x, y.y); w.y = pk2(y.z, y.w); *(u32x2*)(h0 + (size_t)row * DM + c) = w;
#pragma unroll
            for (int g = 0; g < 8; ++g) { const f32x4 wv = *(LAS const f32x4*)(wg + g * 1024 + c); ga[g] += (y.x * wv[0] + y.y * wv[1]) + (y.z * wv[2] + y.w * wv[3]); } }
#pragma unroll
        for (int g = 0; g < 8; ++g) ga[g] = wave_sum(ga[g]);
        float r = ga[0];
#pragma unroll
        for (int g = 1; g < 8; ++g) r = (lane == g) ? ga[g] : r;
        if (lane < 8) gates[(size_t)row * 8 + lane] = r + b_in[NPROJ + lane];
    }
}

__device__ __forceinline__ void gate_scan(const Params& p, LAS unsigned char* lds) {
    const int tid = fresh_tid(), lane = tid & 63, wave = tid >> 6;
    const float* gates = (const float*)(p.ws + WS_GATES); float* mtab = (float*)(p.ws + WS_MTAB); float* btab = (float*)(p.ws + WS_BTAB);
    LAS float* sA = (LAS float*)lds; LAS float* sB = sA + 128;
    for (int chain = blockIdx.x; chain < 32; chain += gridDim.x) {
        const int batch = chain >> 2, head = chain & 3;
        for (int c = wave; c < 128; c += 8) {
            const size_t row = (size_t)batch * SEQ + c * 64 + lane;
            const float ig = gates[row * 8 + head], fg = gates[row * 8 + 4 + head];
            const float b = scan_sum(logsigmoid(fg), lane); const float A = wave_max(ig - b); const float bl = __shfl(b, 63);
            if (lane == 0) { sA[c] = A; sB[c] = bl; }
        }
        __syncthreads();
        if (tid == 0) { float m = 0.f; mtab[chain * 132] = 0.f;
            for (int c = 0; c < 128; ++c) { m = sB[c] + fmaxf(m, sA[c]); mtab[chain * 132 + c + 1] = m; btab[chain * 128 + c] = sB[c]; }
            p.out[O_MP + chain] = m; }
        __syncthreads();
    }
}

constexpr int L_Q = 0, L_K = 17408, L_KT = 34816, L_VT = 53248, L_CT = 71680, L_S = 106496, L_G = 115712;

template <bool FULL>
__device__ __forceinline__ void mlstm_run(const Params& p, LAS unsigned char* lds, f32x4 (&accC)[2][4], float& nreg,
                                          int row0, int head, int nch, int L, const float* mtabp, float m0, float* m_out) {
    const int tid = fresh_tid(), lane = tid & 63, wave = __builtin_amdgcn_readfirstlane(tid >> 6), l15 = lane & 15, l4 = lane >> 4, st = wave & 3, tp = wave >> 2;
    const bf16_t* proj = (const bf16_t*)(p.ws + WS_PROJ); const float* gates = (const float*)(p.ws + WS_GATES);
    bf16_t* mix = (bf16_t*)(p.ws + WS_MIX); const float* norm_g = p.in[12];
    LAS unsigned short* sQ = (LAS unsigned short*)(lds + L_Q); LAS unsigned short* sK = (LAS unsigned short*)(lds + L_K);
    LAS unsigned short* sKT = (LAS unsigned short*)(lds + L_KT); LAS unsigned short* sVT = (LAS unsigned short*)(lds + L_VT);
    LAS unsigned short* sS = (LAS unsigned short*)(lds + L_S); LAS float* sH = (LAS float*)(lds + L_Q);
    LAS float* gA = (LAS float*)(lds + L_G); LAS float* gM = gA + 64; LAS float* gDec = gA + 128; LAS float* gEinv = gA + 192; LAS float* gW = gA + 256;
    LAS float* gQn = gA + 320; LAS float* gDi = gA + 384; LAS float* gN = gA + 448; LAS float* scal = gA + 576;
#pragma unroll 1
    for (int c = 0; c < nch; ++c) {
        const int r0 = row0 + c * 64;
        const float m_prev = mtabp ? mtabp[c] : m0;
        uint4 kq[2], kk[2], kv[2];
#pragma unroll
        for (int i = 0; i < 2; ++i) { const int piece = tid + 512 * i, tok = piece >> 4, dsg = piece & 15; const bool valid = tok < L;
            const bf16_t* src = proj + (size_t)(r0 + tok) * NPROJ + head * 128 + dsg * 8; const uint4 z = make_uint4(0, 0, 0, 0);
            kk[i] = valid ? *(const uint4*)(src + 1024) : z; kv[i] = valid ? *(const uint4*)(src + 1536) : z;
            if (FULL) kq[i] = valid ? *(const uint4*)(src + 512) : z; else kq[i] = z; }
        if (wave == 0) {
            const bool valid = lane < L; float ig = 0.f, fg = 0.f;
            if (valid) { const float* gp = gates + (size_t)(r0 + lane) * 8 + head; ig = gp[0]; fg = gp[4]; }
            const float b = scan_sum(valid ? logsigmoid(fg) : 0.f, lane);
            const float a = valid ? ig - b : -1e30f;
            const float M = fmaxf(m_prev, scan_max(a, lane));
            const float Ml = __shfl(M, L - 1), bl = __shfl(b, L - 1);
            gA[lane] = a; gM[lane] = M; gDec[lane] = expf(m_prev - M); gEinv[lane] = expf(-(b + M)); gW[lane] = valid ? expf(a - Ml) : 0.f;
            if (lane == 0) { scal[0] = expf(m_prev - Ml); scal[1] = bl + Ml; if (m_out) *m_out = bl + Ml; }
        }
        if (FULL) {
#pragma unroll
            for (int i = 0; i < 2; ++i)
#pragma unroll
                for (int n = 0; n < 4; ++n) { u32x2 w; w.x = pk2(accC[i][n][0], accC[i][n][1]); w.y = pk2(accC[i][n][2], accC[i][n][3]);
                    *(LAS u32x2*)(lds + L_CT + (64 * tp + 16 * n + l15) * 272 + (32 * st + 16 * i + 4 * l4) * 2) = w; }
            if (tid < 128) gN[tid] = nreg;
        }
#pragma unroll
        for (int i = 0; i < 2; ++i) { const int piece = tid + 512 * i, tok = piece >> 4, dsg = piece & 15;
            if (FULL) { *(LAS u32x4*)(sQ + tok * 136 + dsg * 8) = (u32x4){kq[i].x, kq[i].y, kq[i].z, kq[i].w}; *(LAS u32x4*)(sK + tok * 136 + dsg * 8) = (u32x4){kk[i].x, kk[i].y, kk[i].z, kk[i].w}; }
            const unsigned vw[4] = {kv[i].x, kv[i].y, kv[i].z, kv[i].w};
#pragma unroll
            for (int e = 0; e < 4; ++e) { sVT[(dsg * 8 + 2 * e) * 72 + tok] = (unsigned short)(vw[e] & 0xffffu); sVT[(dsg * 8 + 2 * e + 1) * 72 + tok] = (unsigned short)(vw[e] >> 16); } }
        __syncthreads();
#pragma unroll
        for (int i = 0; i < 2; ++i) { const int piece = tid + 512 * i, tok = piece >> 4, dsg = piece & 15; const float w = gW[tok];
            const unsigned kw[4] = {kk[i].x, kk[i].y, kk[i].z, kk[i].w};
#pragma unroll
            for (int e = 0; e < 4; ++e) { const unsigned pkd = pk2(bflo(kw[e]) * w, bfhi(kw[e]) * w);
                sKT[(dsg * 8 + 2 * e) * 72 + tok] = (unsigned short)(pkd & 0xffffu); sKT[(dsg * 8 + 2 * e + 1) * 72 + tok] = (unsigned short)(pkd >> 16); } }
        f32x4 nacc[4];
#pragma unroll
        for (int n = 0; n < 4; ++n) nacc[n] = (f32x4){0.f, 0.f, 0.f, 0.f};
        if (FULL) {
            f32x4 sacc[2]; sacc[0] = (f32x4){0.f, 0.f, 0.f, 0.f}; sacc[1] = sacc[0];
#pragma unroll
            for (int ks = 0; ks < 4; ++ks) { const int kb = (32 * ks + 8 * l4) * 2;
                const bf16x8 a = ldfrag(lds + L_K, 16 * st + l15, 272, kb);
#pragma unroll
                for (int tt = 0; tt < 2; ++tt) { const bf16x8 b = ldfrag(lds + L_Q, 16 * (2 * tp + tt) + l15, 272, kb); sacc[tt] = MFMA16(a, b, sacc[tt]); } }
#pragma unroll
            for (int tt = 0; tt < 2; ++tt) { const int t = 16 * (2 * tp + tt) + l15; const float Mt = gM[t]; float dv[4];
#pragma unroll
                for (int j = 0; j < 4; ++j) { const int s = 16 * st + 4 * l4 + j; dv[j] = (s <= t) ? sacc[tt][j] * expf(gA[s] - Mt) : 0.f; }
                u32x2 w; w.x = pk2(dv[0], dv[1]); w.y = pk2(dv[2], dv[3]); *(LAS u32x2*)(lds + L_S + t * 144 + (16 * st + 4 * l4) * 2) = w; }
#pragma unroll
            for (int ks = 0; ks < 4; ++ks) { const int kb = (32 * ks + 8 * l4) * 2;
                const bf16x8 a = ldfrag(lds + L_Q, 16 * st + l15, 272, kb);
#pragma unroll
                for (int n = 0; n < 4; ++n) { const bf16x8 b = ldfrag(lds + L_CT, 64 * tp + 16 * n + l15, 272, kb); nacc[n] = MFMA16(a, b, nacc[n]); } }
#pragma unroll
            for (int j = 0; j < 4; ++j) { const float dj = gDec[16 * st + 4 * l4 + j];
#pragma unroll
                for (int n = 0; n < 4; ++n) nacc[n][j] *= dj; }
            { const int row = tid >> 3, seg = tid & 7; float s = 0.f;
              const u32x4 q0 = *(LAS const u32x4*)(sQ + row * 136 + seg * 16), q1 = *(LAS const u32x4*)(sQ + row * 136 + seg * 16 + 8);
              const unsigned qw[8] = {q0.x, q0.y, q0.z, q0.w, q1.x, q1.y, q1.z, q1.w};
#pragma unroll
              for (int e = 0; e < 8; ++e) s += bflo(qw[e]) * gN[seg * 16 + 2 * e] + bfhi(qw[e]) * gN[seg * 16 + 2 * e + 1];
              s += __shfl_xor(s, 1); s += __shfl_xor(s, 2); s += __shfl_xor(s, 4);
              if (seg == 0) gQn[row] = s; }
        }
        __syncthreads();
        if (FULL) { const int row = tid >> 3, seg = tid & 7; const u32x4 s0 = *(LAS const u32x4*)(sS + row * 72 + seg * 8);
            float s = (bflo(s0.x) + bfhi(s0.x)) + (bflo(s0.y) + bfhi(s0.y)) + (bflo(s0.z) + bfhi(s0.z)) + (bflo(s0.w) + bfhi(s0.w));
            s += __shfl_xor(s, 1); s += __shfl_xor(s, 2); s += __shfl_xor(s, 4);
            if (seg == 0) { const float den = gDec[row] * gQn[row] + s; gDi[row] = 1.0f / fmaxf(fabsf(den), gEinv[row]); } }
        const float wsv = scal[0];
#pragma unroll
        for (int i = 0; i < 2; ++i)
#pragma unroll
            for (int n = 0; n < 4; ++n) accC[i][n] *= wsv;
#pragma unroll
        for (int ks = 0; ks < 2; ++ks) { const int kb = (32 * ks + 8 * l4) * 2; bf16x8 bv[4];
#pragma unroll
            for (int n = 0; n < 4; ++n) bv[n] = ldfrag(lds + L_VT, 64 * tp + 16 * n + l15, 144, kb);
            if (FULL) { const bf16x8 a = ldfrag(lds + L_S, 16 * st + l15, 144, kb);
#pragma unroll
                for (int n = 0; n < 4; ++n) nacc[n] = MFMA16(a, bv[n], nacc[n]); }
#pragma unroll
            for (int i = 0; i < 2; ++i) { const bf16x8 a = ldfrag(lds + L_KT, 32 * st + 16 * i + l15, 144, kb);
#pragma unroll
                for (int n = 0; n < 4; ++n) accC[i][n] = MFMA16(a, bv[n], accC[i][n]); } }
        if (tid < 128) { float s = 0.f;
#pragma unroll
            for (int e = 0; e < 8; ++e) { const u32x4 k4 = *(LAS const u32x4*)(sKT + tid * 72 + e * 8);
                s += (bflo(k4.x) + bfhi(k4.x)) + (bflo(k4.y) + bfhi(k4.y)) + (bflo(k4.z) + bfhi(k4.z)) + (bflo(k4.w) + bfhi(k4.w)); }
            nreg = wsv * nreg + s; }
        __syncthreads();
        if (FULL) {
#pragma unroll
            for (int j = 0; j < 4; ++j) { const int t = 16 * st + 4 * l4 + j; const float di = gDi[t];
#pragma unroll
                for (int n = 0; n < 4; ++n) sH[t * 132 + 64 * tp + 16 * n + l15] = nacc[n][j] * di; }
            __syncthreads();
#pragma unroll 1
            for (int rr = 0; rr < 8; ++rr) { const int t = wave * 8 + rr;
                if (t < L) { const float x0 = sH[t * 132 + 2 * lane], x1 = sH[t * 132 + 2 * lane + 1];
                    const float mean = wave_sum(x0 + x1) * (1.0f / 128.0f); const float d0 = x0 - mean, d1 = x1 - mean;
                    const float rstd = rsqrtf(wave_sum(d0 * d0 + d1 * d1) * (1.0f / 128.0f) + LN_EPS);
                    const unsigned ow = *(const unsigned*)(proj + (size_t)(r0 + t) * NPROJ + 2048 + head * 128 + 2 * lane);
                    const float2 g = *(const float2*)(norm_g + head * 128 + 2 * lane);
                    const float y0 = d0 * rstd * g.x / (1.0f + __expf(-bflo(ow))), y1 = d1 * rstd * g.y / (1.0f + __expf(-bfhi(ow)));
                    *(unsigned*)(mix + (size_t)(r0 + t) * DM + 512 + head * 128 + 2 * lane) = pk2(y0, y1); } }
            __syncthreads();
        }
    }
}

constexpr int L_PW = 34816, L_PU = 69632;
template <int W>
__device__ __forceinline__ void pool_diff(LAS unsigned char* lds, bool sample, int tilepos0) {
    const int tid = fresh_tid(), co = tid & 15, t0 = (tid >> 4) * 4;
#pragma unroll 1
    for (int tt = 0; tt < 4; ++tt) {
        const int t = t0 + tt; const int sgi = sample ? (t >> 5) : 0, lt = sample ? (t & 31) : t;
        const int rowbase = sample ? sgi * 47 + 15 + lt : 15 + t;
        const int cnt = sample ? W : min(tilepos0 + t + 1, W);
        float sum[8];
#pragma unroll
        for (int e = 0; e < 8; ++e) sum[e] = 0.f;
        u32x4 x0 = (u32x4){0u, 0u, 0u, 0u};
#pragma unroll
        for (int j = 0; j < W; ++j) { const u32x4 r = *(LAS const u32x4*)(lds + L_PU + (rowbase - j) * 272 + co * 16); if (j == 0) x0 = r;
            sum[0] += bflo(r.x); sum[1] += bfhi(r.x); sum[2] += bflo(r.y); sum[3] += bfhi(r.y); sum[4] += bflo(r.z); sum[5] += bfhi(r.z); sum[6] += bflo(r.w); sum[7] += bfhi(r.w); }
        const float inv = 1.0f / (float)cnt;
        u32x4 w; w.x = pk2(sum[0] * inv - bflo(x0.x), sum[1] * inv - bfhi(x0.x)); w.y = pk2(sum[2] * inv - bflo(x0.y), sum[3] * inv - bfhi(x0.y));
        w.z = pk2(sum[4] * inv - bflo(x0.z), sum[5] * inv - bfhi(x0.z)); w.w = pk2(sum[6] * inv - bflo(x0.w), sum[7] * inv - bfhi(x0.w));
        *(LAS u32x4*)(lds + t * 272 + co * 16) = w; }
}

__device__ __forceinline__ void pool_item(const Params& p, LAS unsigned char* lds, int item) {
    const int tid = fresh_tid(), lane = tid & 63, wave = __builtin_amdgcn_readfirstlane(tid >> 6), l15 = lane & 15, l4 = lane >> 4, st = wave & 3, tp = wave >> 2;
    const int g = item & 3, R0 = (item >> 2) * 128;
    const bf16_t* proj = (const bf16_t*)(p.ws + WS_PROJ); const float* hist = p.in[2];
    const bf16_t* Wp = (const bf16_t*)(p.ws + WS_WPOOL) + g * 16384; bf16_t* mix = (bf16_t*)(p.ws + WS_MIX); const float* pscale = p.in[11];
    const bool sample = R0 >= MP; const int seqrow0 = sample ? 0 : (R0 / SEQ) * SEQ, tilepos0 = sample ? 0 : R0 - seqrow0;
#pragma unroll
    for (int i = 0; i < 4; ++i) { const int piece = tid + 512 * i, row = piece >> 4, seg = piece & 15;
        *(LAS u32x4*)(lds + L_PW + row * 272 + seg * 16) = *(const u32x4*)(Wp + row * 128 + seg * 8); }
    const int nrows = sample ? 188 : 143;
    for (int piece = tid; piece < nrows * 16; piece += 512) { const int e = piece >> 4, seg = piece & 15; u32x4 val = (u32x4){0u, 0u, 0u, 0u};
        if (!sample) { const int pos = tilepos0 - 15 + e; if (pos >= 0) val = *(const u32x4*)(proj + (size_t)(seqrow0 + pos) * NPROJ + g * 128 + seg * 8); }
        else { const int sgi = e / 47, le = e - sgi * 47, b = ((R0 - MP) >> 5) + sgi;
            if (le < 15) { const float* hp = hist + ((size_t)b * 15 + le) * 512 + g * 128 + seg * 8; const float4 a = *(const float4*)hp, c4 = *(const float4*)(hp + 4);
                val.x = pk2(a.x, a.y); val.y = pk2(a.z, a.w); val.z = pk2(c4.x, c4.y); val.w = pk2(c4.z, c4.w); }
            else val = *(const u32x4*)(proj + (size_t)(MP + b * 32 + le - 15) * NPROJ + g * 128 + seg * 8); }
        *(LAS u32x4*)(lds + L_PU + e * 272 + seg * 16) = val; }
    __syncthreads();
    if (g == 0) pool_diff<2>(lds, sample, tilepos0); else if (g == 1) pool_diff<4>(lds, sample, tilepos0); else if (g == 2) pool_diff<8>(lds, sample, tilepos0); else pool_diff<16>(lds, sample, tilepos0);
    __syncthreads();
    f32x4 acc[2][4];
#pragma unroll
    for (int i = 0; i < 2; ++i)
#pragma unroll
        for (int n = 0; n < 4; ++n) acc[i][n] = (f32x4){0.f, 0.f, 0.f, 0.f};
#pragma unroll
    for (int ks = 0; ks < 4; ++ks) { const int kb = (32 * ks + 8 * l4) * 2; bf16x8 bv[4];
#pragma unroll
        for (int n = 0; n < 4; ++n) bv[n] = ldfrag(lds, 64 * tp + 16 * n + l15, 272, kb);
#pragma unroll
        for (int i = 0; i < 2; ++i) { const bf16x8 a = ldfrag(lds + L_PW, 32 * st + 16 * i + l15, 272, kb);
#pragma unroll
            for (int n = 0; n < 4; ++n) acc[i][n] = MFMA16(a, bv[n], acc[i][n]); } }
#pragma unroll
    for (int i = 0; i < 2; ++i) { const int d0 = 32 * st + 16 * i + 4 * l4; const float4 ps = *(const float4*)(pscale + g * 128 + d0);
#pragma unroll
        for (int n = 0; n < 4; ++n) { const int t = 64 * tp + 16 * n + l15;
            u32x2 w; w.x = pk2(acc[i][n][0] * ps.x, acc[i][n][1] * ps.y); w.y = pk2(acc[i][n][2] * ps.z, acc[i][n][3] * ps.w);
            *(u32x2*)(mix + (size_t)(R0 + t) * DM + g * 128 + d0) = w; } }
    __syncthreads();
}

constexpr int N_S2 = 224, N_SMP = 128, N_POOL = (MT / 128) * 4;

__device__ __forceinline__ void phase2(const Params& p, LAS unsigned char* lds) {
    const int tid = fresh_tid(), lane = tid & 63, wave = tid >> 6, l15 = lane & 15, l4 = lane >> 4, st = wave & 3, tp = wave >> 2;
    float* Dst = (float*)(p.ws + WS_DST); float* Dn = (float*)(p.ws + WS_DN); const float* mtab = (const float*)(p.ws + WS_MTAB);
    for (int it = blockIdx.x; it < N_S2 + N_SMP + N_POOL; it += gridDim.x) {
        if (it < N_S2) {
            const int chain = it / 7, sc = it % 7, batch = chain >> 2, head = chain & 3;
            f32x4 accC[2][4]; float nreg = 0.f;
#pragma unroll
            for (int i = 0; i < 2; ++i)
#pragma unroll
                for (int n = 0; n < 4; ++n) accC[i][n] = (f32x4){0.f, 0.f, 0.f, 0.f};
            mlstm_run<false>(p, lds, accC, nreg, batch * SEQ + sc * SCN * 64, head, SCN, 64, mtab + chain * 132 + sc * SCN, 0.f, nullptr);
#pragma unroll
            for (int i = 0; i < 2; ++i)
#pragma unroll
                for (int n = 0; n < 4; ++n)
#pragma unroll
                    for (int j = 0; j < 4; ++j) Dst[((size_t)it * 32 + (i * 4 + n) * 4 + j) * 512 + tid] = accC[i][n][j];
            if (tid < 128) Dn[it * 128 + tid] = nreg;
        } else if (it < N_S2 + N_SMP) {
            const int s = it - N_S2, b = s >> 2, head = s & 3;
            const float* C0 = p.in[3] + (size_t)s * 16384; f32x4 accC[2][4];
#pragma unroll
            for (int i = 0; i < 2; ++i)
#pragma unroll
                for (int n = 0; n < 4; ++n)
#pragma unroll
                    for (int j = 0; j < 4; ++j) accC[i][n][j] = C0[(32 * st + 16 * i + 4 * l4 + j) * 128 + 64 * tp + 16 * n + l15];
            float nreg = tid < 128 ? p.in[4][s * 128 + tid] : 0.f;
            mlstm_run<true>(p, lds, accC, nreg, MP + b * 32, head, 1, 32, nullptr, p.in[5][s], p.out + O_MS + s);
            float* Co = p.out + O_CS + (size_t)s * 16384;
#pragma unroll
            for (int i = 0; i < 2; ++i)
#pragma unroll
                for (int n = 0; n < 4; ++n)
#pragma unroll
                    for (int j = 0; j < 4; ++j) Co[(32 * st + 16 * i + 4 * l4 + j) * 128 + 64 * tp + 16 * n + l15] = accC[i][n][j];
            if (tid < 128) p.out[O_NS + s * 128 + tid] = nreg;
        } else {
            pool_item(p, lds, it - N_S2 - N_SMP);
        }
    }
    const bf16_t* proj = (const bf16_t*)(p.ws + WS_PROJ);
    for (int idx = blockIdx.x * 512 + tid; idx < (NB + DB) * 15 * 512; idx += gridDim.x * 512) {
        if (idx < NB * 7680) { const int b = idx / 7680, rem = idx % 7680, i = rem >> 9, c = rem & 511;
            p.out[O_POOLP + idx] = bf2f(proj[(size_t)(b * SEQ + SEQ - 15 + i) * NPROJ + c]); }
        else { const int id2 = idx - NB * 7680, b = id2 / 7680, rem = id2 % 7680, i = rem >> 9, c = rem & 511;
            p.out[O_POOLS + id2] = bf2f(proj[(size_t)(MP + b * 32 + 17 + i) * NPROJ + c]); }
    }
}

__device__ __forceinline__ void phase3(const Params& p, LAS unsigned char* lds) {
    const int tid = fresh_tid(), lane = tid & 63, wave = tid >> 6, l15 = lane & 15, l4 = lane >> 4, st = wave & 3, tp = wave >> 2;
    const float* Dst = (const float*)(p.ws + WS_DST); const float* Dn = (const float*)(p.ws + WS_DN);
    const float* mtab = (const float*)(p.ws + WS_MTAB); const float* btab = (const float*)(p.ws + WS_BTAB);
    for (int it = blockIdx.x; it < 256; it += gridDim.x) {
        const int chain = it >> 3, sc = it & 7, batch = chain >> 2, head = chain & 3;
        f32x4 accC[2][4]; float nreg = 0.f;
#pragma unroll
        for (int i = 0; i < 2; ++i)
#pragma unroll
            for (int n = 0; n < 4; ++n) accC[i][n] = (f32x4){0.f, 0.f, 0.f, 0.f};
#pragma unroll 1
        for (int j = 0; j < sc; ++j) {
            float Bs = 0.f;
            for (int c = 0; c < SCN; ++c) Bs += btab[chain * 128 + j * SCN + c];
            const float Wj = expf(Bs + mtab[chain * 132 + j * SCN] - mtab[chain * 132 + (j + 1) * SCN]);
            const int item = chain * 7 + j;
#pragma unroll
            for (int i = 0; i < 2; ++i)
#pragma unroll
                for (int n = 0; n < 4; ++n)
#pragma unroll
                    for (int q = 0; q < 4; ++q) accC[i][n][q] = Wj * accC[i][n][q] + Dst[((size_t)item * 32 + (i * 4 + n) * 4 + q) * 512 + tid];
            if (tid < 128) nreg = Wj * nreg + Dn[item * 128 + tid];
        }
        mlstm_run<true>(p, lds, accC, nreg, batch * SEQ + sc * SCN * 64, head, SCN, 64, mtab + chain * 132 + sc * SCN, 0.f, nullptr);
        if (sc == 7) {
            float* Co = p.out + O_CP + (size_t)chain * 16384;
#pragma unroll
            for (int i = 0; i < 2; ++i)
#pragma unroll
                for (int n = 0; n < 4; ++n)
#pragma unroll
                    for (int j = 0; j < 4; ++j) Co[(32 * st + 16 * i + 4 * l4 + j) * 128 + 64 * tp + 16 * n + l15] = accC[i][n][j];
            if (tid < 128) p.out[O_NP + chain * 128 + tid] = nreg;
        }
    }
}

template <bool TO_BF16>
__device__ __forceinline__ void ln_rows(const float* src, const float* gam, const float* bet, bf16_t* ob, float* of) {
    const int tid = fresh_tid(), lane = tid & 63, wave = tid >> 6;
    for (int row = blockIdx.x * 8 + wave; row < MT; row += gridDim.x * 8) {
        const float* x = src + (size_t)row * DM; float4 v[4];
#pragma unroll
        for (int i = 0; i < 4; ++i) v[i] = *(const float4*)(x + i * 256 + lane * 4);
        float s = 0.f;
#pragma unroll
        for (int i = 0; i < 4; ++i) s += (v[i].x + v[i].y) + (v[i].z + v[i].w);
        const float mu = wave_sum(s) * (1.0f / DM); float q = 0.f;
#pragma unroll
        for (int i = 0; i < 4; ++i) { v[i].x -= mu; v[i].y -= mu; v[i].z -= mu; v[i].w -= mu; q += (v[i].x * v[i].x + v[i].y * v[i].y) + (v[i].z * v[i].z + v[i].w * v[i].w); }
        const float rstd = rsqrtf(wave_sum(q) * (1.0f / DM) + LN_EPS);
#pragma unroll
        for (int i = 0; i < 4; ++i) { const int c = i * 256 + lane * 4; const float4 gg = *(const float4*)(gam + c), bb = *(const float4*)(bet + c);
            float4 y; y.x = v[i].x * rstd * gg.x + bb.x; y.y = v[i].y * rstd * gg.y + bb.y; y.z = v[i].z * rstd * gg.z + bb.z; y.w = v[i].w * rstd * gg.w + bb.w;
            if (TO_BF16) { u32x2 w; w.x = pk2(y.x, y.y); w.y = pk2(y.z, y.w); *(u32x2*)(ob + (size_t)row * DM + c) = w; }
            else *(float4*)(of + (size_t)row * DM + c) = y; }
    }
}

__global__ void __launch_bounds__(512) fwd_mega(Params p) {
    extern __shared__ __attribute__((aligned(16))) unsigned char smem[];
    LAS unsigned char* lds = (LAS unsigned char*)smem;
    cg::grid_group grid = cg::this_grid();
    unsigned char* ws = p.ws;
    bf16_t* h0 = (bf16_t*)(ws + WS_H0); bf16_t* proj = (bf16_t*)(ws + WS_PROJ); bf16_t* mix = (bf16_t*)(ws + WS_MIX); bf16_t* act = (bf16_t*)(ws + WS_ACT);
    const int G = gridDim.x, bx = blockIdx.x;

#ifndef PH
#define PH 0x1ff
#endif
    if (PH & 1) phase0(p, lds);
    grid.sync();
    if (PH & 2) { gate_scan(p, lds);
      pg8::Gemm g{h0, (const bf16_t*)(ws + WS_WIN), MT, NPROJ, DM}; pg8::StaticOrder S; S.init(MT, NPROJ, G, bx);
      EpiBf16B e{proj, NPROJ, (const float*)(ws + WS_BIAS)}; pg8::gemm_phase(lds, g, S, e); }
    grid.sync();
    if (PH & 4) phase2(p, lds);
    grid.sync();
    if (PH & 8) phase3(p, lds);
    grid.sync();
    if (PH & 16) { pg8::Gemm g{mix, (const bf16_t*)(ws + WS_WOUT), MT, DM, DM}; pg8::StaticOrder S; S.init(MT, DM, G, bx);
      EpiRes e{h0, p.out + O_Y}; pg8::gemm_phase(lds, g, S, e); }
    grid.sync();
    if (PH & 32) ln_rows<true>(p.out + O_Y, p.in[14], p.in[15], h0, nullptr);
    grid.sync();
    if (PH & 64) { pg8::Gemm g{h0, (const bf16_t*)(ws + WS_WGU), MT, 2 * DFF, DM}; pg8::StaticOrder S; S.init(MT, 2 * DFF, G, bx);
      EpiSwiglu e{act}; pg8::gemm_phase(lds, g, S, e); }
    grid.sync();
    if (PH & 128) { pg8::Gemm g{act, (const bf16_t*)(ws + WS_WDN), MT, DM, DFF}; pg8::StaticOrder S; S.init(MT, DM, G, bx);
      EpiRes e{h0, p.out + O_Y}; pg8::gemm_phase(lds, g, S, e); }
    grid.sync();
    if (PH & 256) ln_rows<false>(p.out + O_Y, p.in[19], p.in[20], nullptr, p.out + O_Y);
}

extern "C" void kernel_launch(void* const* d_in, const int* in_sizes, int n_in, void* d_out, int out_size, void* d_ws, size_t ws_size, hipStream_t stream) {
    constexpr size_t kDynLds = 131072;
    static int grid_blocks = 0;
    if (!grid_blocks) {
        if (n_in != 21 || (size_t)out_size != O_END || ws_size < WS_END) { fprintf(stderr, "kernel_launch: unexpected shapes: n_in %d out %d ws %zu (need %zu)\n", n_in, out_size, ws_size, (size_t)WS_END); grid_blocks = -1; return; }
        int dev = 0, cus = 0, per_cu = 0;
        hipGetDevice(&dev);
        hipDeviceGetAttribute(&cus, hipDeviceAttributeMultiprocessorCount, dev);
        if (hipFuncSetAttribute((const void*)fwd_mega, hipFuncAttributeMaxDynamicSharedMemorySize, (int)kDynLds) != hipSuccess) { fprintf(stderr, "kernel_launch: hipFuncSetAttribute failed\n"); grid_blocks = -1; return; }
        if (hipOccupancyMaxActiveBlocksPerMultiprocessor(&per_cu, (const void*)fwd_mega, 512, kDynLds) != hipSuccess || per_cu < 1) { fprintf(stderr, "kernel_launch: occupancy query failed (%d)\n", per_cu); grid_blocks = -1; return; }
        if (per_cu > 1) per_cu = 1;
        grid_blocks = cus * per_cu;
    }
    if (grid_blocks < 0) return;
    Params p{};
    for (int i = 0; i < 21; ++i) p.in[i] = (const float*)d_in[i];
    p.out = (float*)d_out; p.ws = (unsigned char*)d_ws;
    void* args[] = {&p};
    hipError_t e = hipLaunchCooperativeKernel((const void*)fwd_mega, dim3(grid_blocks), dim3(512), args, kDynLds, stream);
    if (e != hipSuccess) fprintf(stderr, "cooperative launch failed: %s (grid %d)\n", hipGetErrorString(e), grid_blocks);
}
```

```cpp
#include <hip/hip_runtime.h>
#include <hip/hip_cooperative_groups.h>
#include <cstdio>
namespace cg = cooperative_groups;
namespace pg8 {
#define PG8_LAS __attribute__((address_space(3)))
typedef unsigned short bf16_t;
typedef short bf16x8 __attribute__((ext_vector_type(8)));
typedef float f32x4 __attribute__((ext_vector_type(4)));
typedef unsigned u32x4 __attribute__((ext_vector_type(4)));
constexpr int BM = 256, BK = 64, HALF = 128, HTB = HALF * BK * 2  , STAGE_BYTES = 8 * HTB, NXCD = 8, WGM = 8;

__host__ __device__ __forceinline__ int lds_byte(int r, int c) { const int st = (r >> 4) * 2 + (c >> 5), rr = r & 15, cc = c & 31, ob = rr * 64 + cc * 2; return st * 1024 + (ob ^ (((ob >> 9) & 1) << 5)); }
__host__ __device__ __forceinline__ void stage_rc(int b, int& R, int& C) { const int st = b / 1024, sb = b % 1024, swz = sb ^ (((sb >> 9) & 1) << 5); R = (st >> 1) * 16 + swz / 64; C = (st & 1) * 32 + (swz % 64) / 2; }
__host__ __device__ __forceinline__ int perm32(int rho) { const int n = rho >> 4, i = rho & 15; return 8 * (i >> 2) + 4 * n + (i & 3); }

struct Unit { int pm, pn; };
struct Gemm { const bf16_t* A; const bf16_t* Bt; int M, N, K; };
struct StaticOrder {
    int nM, nN, nwg, G, c;
    __host__ __device__ void init(int M, int N, int G_, int c_) { nM = M / BM; nN = N / BM; nwg = nM * nN; G = G_; c = c_; }
    __host__ __device__ bool next(int i, Unit& u) const {
        const long L = (long)i * G + c; if (L >= nwg) return false;
        int wgid = (int)L; { const int q = nwg / NXCD, r = nwg % NXCD, xcd = wgid % NXCD, off = wgid / NXCD; wgid = (xcd < r ? xcd * (q + 1) : r * (q + 1) + (xcd - r) * q) + off; }
        const int nig = WGM * nN, gid = wgid / nig, fm = gid * WGM, gsz = (nM - fm) < WGM ? (nM - fm) : WGM;
        u.pm = fm + ((wgid % nig) % gsz); u.pn = (wgid % nig) / gsz; return true;
    }
    __device__ __forceinline__ void a_ready(const Unit&) const {}
    __device__ __forceinline__ void done(const Unit&) const {}
};
__device__ __forceinline__ unsigned cvt_pk_bf16(float lo, float hi) { unsigned r; asm volatile("v_cvt_pk_bf16_f32 %0, %1, %2" : "=v"(r) : "v"(lo), "v"(hi)); return r; }
template <class Epi, class Sched>
__device__ __forceinline__ void gemm_phase(PG8_LAS unsigned char* lds, const Gemm g, const Sched& S, const Epi& E) {
    int tid_ = threadIdx.x; asm volatile("" : "+v"(tid_)); const int tid = tid_, wid = __builtin_amdgcn_readfirstlane(tid >> 6), lane = tid & 63, wr = wid >> 2, wc = wid & 3, fr = lane & 15, fq = lane >> 4;
    const int K = g.K, nt = K / BK;
    unsigned voffA[2], voffB[2];
#pragma unroll
    for (int i = 0; i < 2; ++i) { int R, C; stage_rc(tid * 16 + i * 8192, R, C); const int Rb = Epi::PERM ? ((R & ~31) + perm32(R & 31)) : R;
        voffA[i] = (unsigned)(R * K + C) * 2u; voffB[i] = (unsigned)(Rb * K + C) * 2u; }
    const size_t kstep = (size_t)(BK * 2);
    const size_t hstep = (size_t)HALF * K * 2;
    const size_t tstep = 2 * hstep;
    const unsigned ldsw = (unsigned)wid * 1024u;
    const int aoff = lds_byte(wr * 64 + fr, fq * 8), boff = lds_byte(wc * 32 + fr, fq * 8);
#define PG8_SA(b, h) (((b) * 2 + (h)) * HTB)
#define PG8_SB(b, h) ((4 + (b) * 2 + (h)) * HTB)
#define PG8_STAGE(bufoff, gbase, voff) do { _Pragma("unroll") for (int _i = 0; _i < 2; ++_i) \
        __builtin_amdgcn_global_load_lds((const unsigned*)((const char*)(gbase) + (voff)[_i]), (PG8_LAS unsigned*)(lds + (bufoff) + ldsw + _i * 8192), 16, 0, 0); } while (0)
#define PG8_LDA(dst, b, h) do { _Pragma("unroll") for (int m = 0; m < 4; ++m) _Pragma("unroll") for (int k = 0; k < 2; ++k) dst[m][k] = *(const PG8_LAS bf16x8*)(lds + PG8_SA(b, h) + aoff + m * 2048 + k * 1024); } while (0)
#define PG8_LDB(dst, b, h) do { _Pragma("unroll") for (int n = 0; n < 2; ++n) _Pragma("unroll") for (int k = 0; k < 2; ++k) dst[n][k] = *(const PG8_LAS bf16x8*)(lds + PG8_SB(b, h) + boff + n * 2048 + k * 1024); } while (0)
#define PG8_MMA(ai, bj, At, Bt) do { __builtin_amdgcn_s_setprio(1); _Pragma("unroll") for (int m = 0; m < 4; ++m) _Pragma("unroll") for (int n = 0; n < 2; ++n) _Pragma("unroll") for (int k = 0; k < 2; ++k) \
        acc[ai][bj][m][n] = __builtin_amdgcn_mfma_f32_16x16x32_bf16(Bt[n][k], At[m][k], acc[ai][bj][m][n], 0, 0, 0); __builtin_amdgcn_s_setprio(0); } while (0)
#define PG8_WAIT_V(n) asm volatile("s_waitcnt vmcnt(" #n ")" ::: "memory")
#define PG8_WAIT_L(n) asm volatile("s_waitcnt lgkmcnt(" #n ")" ::: "memory")
#define PG8_BAR __builtin_amdgcn_s_barrier()
#define PG8_SCHED __builtin_amdgcn_sched_barrier(0)
    Unit cur, nxt; int ui = 0;
    if (!S.next(0, cur)) return;
    f32x4 acc[2][2][4][2];
#pragma unroll
    for (int a = 0; a < 2; ++a)
#pragma unroll
        for (int b = 0; b < 2; ++b)
#pragma unroll
            for (int m = 0; m < 4; ++m)
#pragma unroll
                for (int n = 0; n < 2; ++n) acc[a][b][m][n] = (f32x4){0.f, 0.f, 0.f, 0.f};
    bf16x8 At[4][2], B0[2][2], B1[2][2];
    const char* cA = (const char*)g.A + (size_t)cur.pm * tstep; const char* cB = (const char*)g.Bt + (size_t)cur.pn * tstep;
    S.a_ready(cur);
    PG8_STAGE(PG8_SB(0, 0), cB, voffB); PG8_STAGE(PG8_SA(0, 0), cA, voffA); PG8_STAGE(PG8_SB(0, 1), cB + hstep, voffB); PG8_STAGE(PG8_SA(0, 1), cA + hstep, voffA);
    if (wr == 1) PG8_BAR;
    PG8_WAIT_V(4); PG8_BAR;
    PG8_STAGE(PG8_SB(1, 0), cB + kstep, voffB); PG8_STAGE(PG8_SA(1, 0), cA + kstep, voffA); PG8_STAGE(PG8_SB(1, 1), cB + hstep + kstep, voffB);
    PG8_WAIT_V(6); PG8_BAR;
    for (;;) {
        const bool has_next = S.next(ui + 1, nxt);
        const char* nA = has_next ? (const char*)g.A + (size_t)nxt.pm * tstep : cA; const char* nB = has_next ? (const char*)g.Bt + (size_t)nxt.pn * tstep : cB;
        for (int t = 0; t < nt; t += 2) {
            const bool last = (t == nt - 2);
            const char* a1 = cA + (size_t)(t + 1) * kstep;
            const char* a2 = last ? nA : cA + (size_t)(t + 2) * kstep; const char* b2 = last ? nB : cB + (size_t)(t + 2) * kstep;
            const char* a3 = a2 + kstep; const char* b3 = b2 + kstep;
            if (last && has_next) S.a_ready(nxt);
            PG8_LDB(B0, 0, 0); PG8_SCHED; PG8_LDA(At, 0, 0); PG8_STAGE(PG8_SA(1, 1), a1 + hstep, voffA);
            PG8_WAIT_L(8); PG8_BAR; PG8_WAIT_L(0); PG8_MMA(0, 0, At, B0); PG8_BAR; PG8_SCHED;
            PG8_LDB(B1, 0, 1); PG8_STAGE(PG8_SB(0, 0), b2, voffB);
            PG8_BAR; PG8_WAIT_L(0); PG8_MMA(0, 1, At, B1); PG8_BAR;
            PG8_LDA(At, 0, 1); PG8_STAGE(PG8_SA(0, 0), a2, voffA);
            PG8_BAR; PG8_WAIT_L(0); PG8_MMA(1, 0, At, B0); PG8_BAR; PG8_SCHED;
            PG8_STAGE(PG8_SB(0, 1), b2 + hstep, voffB);
            PG8_WAIT_V(6); PG8_BAR; PG8_MMA(1, 1, At, B1); PG8_BAR;
            PG8_LDB(B0, 1, 0); PG8_SCHED; PG8_LDA(At, 1, 0); PG8_STAGE(PG8_SA(0, 1), a2 + hstep, voffA);
            PG8_WAIT_L(8); PG8_BAR; PG8_WAIT_L(0); PG8_MMA(0, 0, At, B0); PG8_BAR; PG8_SCHED;
            PG8_LDB(B1, 1, 1); PG8_STAGE(PG8_SB(1, 0), b3, voffB);
            PG8_BAR; PG8_WAIT_L(0); PG8_MMA(0, 1, At, B1); PG8_BAR;
            PG8_LDA(At, 1, 1); PG8_STAGE(PG8_SA(1, 0), a3, voffA);
            PG8_BAR; PG8_WAIT_L(0); PG8_MMA(1, 0, At, B0); PG8_BAR; PG8_SCHED;
            PG8_STAGE(PG8_SB(1, 1), b3 + hstep, voffB);
            PG8_WAIT_V(6); PG8_BAR; PG8_MMA(1, 1, At, B1); PG8_BAR;
        }
        if constexpr (!Epi::AFTER_DRAIN) { E(acc, cur, wr, wc, fr, fq); S.done(cur); }
        if (!has_next) break;
#pragma unroll
        for (int a = 0; a < 2; ++a)
#pragma unroll
            for (int b = 0; b < 2; ++b)
#pragma unroll
                for (int m = 0; m < 4; ++m)
#pragma unroll
                    for (int n = 0; n < 2; ++n) acc[a][b][m][n] = (f32x4){0.f, 0.f, 0.f, 0.f};
        cur = nxt; cA = nA; cB = nB; ++ui;
    }
    PG8_WAIT_V(0);
    if (wr == 0) PG8_BAR;
    PG8_BAR;
    if constexpr (Epi::AFTER_DRAIN) { E.fused(acc, cur, wr, wc, fr, fq, lds, wid, lane); S.done(cur); }
#undef PG8_SA
#undef PG8_SB
#undef PG8_STAGE
#undef PG8_LDA
#undef PG8_LDB
#undef PG8_MMA
#undef PG8_WAIT_V
#undef PG8_WAIT_L
#undef PG8_BAR
#undef PG8_SCHED
}
}

using pg8::bf16_t; using pg8::bf16x8; using pg8::f32x4; using pg8::u32x4;
#define LAS __attribute__((address_space(3)))
typedef unsigned u32x2 __attribute__((ext_vector_type(2)));

constexpr int DM = 1024, NB = 8, SEQ = 8192, DB = 32, DS = 32;
constexpr int MP = NB * SEQ, MS = DB * DS, MT = MP + MS;
constexpr int NPROJ = 2560, INCOLS = 2568, DFF = 2816;
constexpr int SCN = 16;
constexpr float ALPHA = 1.189207115002721f, KSCALE = 0.08838834764831845f, LN_EPS = 1e-5f;

constexpr size_t al256(size_t x) { return (x + 255) & ~(size_t)255; }
constexpr size_t WS_BAR = 0;
constexpr size_t WS_WIN = 16384;
constexpr size_t WS_WOUT = WS_WIN + al256((size_t)NPROJ * DM * 2);
constexpr size_t WS_WGU = WS_WOUT + al256((size_t)DM * DM * 2);
constexpr size_t WS_WDN = WS_WGU + al256((size_t)2 * DFF * DM * 2);
constexpr size_t WS_WPOOL = WS_WDN + al256((size_t)DM * DFF * 2);
constexpr size_t WS_BIAS = WS_WPOOL + al256((size_t)4 * 128 * 128 * 2);
constexpr size_t WS_GATES = WS_BIAS + al256((size_t)NPROJ * 4);
constexpr size_t WS_MTAB = WS_GATES + al256((size_t)MT * 8 * 4);
constexpr size_t WS_BTAB = WS_MTAB + al256((size_t)32 * 132 * 4);
constexpr size_t WS_GTAB = WS_BTAB + al256((size_t)32 * 128 * 4);
constexpr size_t WS_DST = WS_GTAB + al256((size_t)MT * 4 * 16);
constexpr size_t WS_DN = WS_DST + al256((size_t)224 * 16384 * 4);
constexpr size_t WS_H0 = WS_DN + al256((size_t)224 * 128 * 4);
constexpr size_t WS_PROJ = WS_H0 + al256((size_t)MT * DM * 2);
constexpr size_t WS_MIX = WS_PROJ + al256((size_t)MT * NPROJ * 2);
constexpr size_t WS_END = WS_MIX + al256((size_t)MT * DM * 2);
constexpr size_t WS_ACT = WS_PROJ;
static_assert((size_t)MT * DFF * 2 <= WS_END - WS_PROJ, "act does not fit");

constexpr size_t O_Y = 0;
constexpr size_t O_POOLP = (size_t)MT * DM;
constexpr size_t O_CP = O_POOLP + (size_t)NB * 15 * 512;
constexpr size_t O_NP = O_CP + (size_t)NB * 4 * 16384;
constexpr size_t O_MP = O_NP + (size_t)NB * 4 * 128;
constexpr size_t O_POOLS = O_MP + (size_t)NB * 4;
constexpr size_t O_CS = O_POOLS + (size_t)DB * 15 * 512;
constexpr size_t O_NS = O_CS + (size_t)DB * 4 * 16384;
constexpr size_t O_MS = O_NS + (size_t)DB * 4 * 128;
constexpr size_t O_END = O_MS + (size_t)DB * 4;

struct Params { const float* in[21]; float* out; unsigned char* ws; };

__device__ __forceinline__ int fresh_tid() { int t = threadIdx.x; asm volatile("" : "+v"(t)); return t; }
__device__ __forceinline__ float bf2f(unsigned x) { return __uint_as_float(x << 16); }
__device__ __forceinline__ float bflo(unsigned w) { return __uint_as_float(w << 16); }
__device__ __forceinline__ float bfhi(unsigned w) { return __uint_as_float(w & 0xffff0000u); }
__device__ __forceinline__ unsigned pk2(float lo, float hi) { return pg8::cvt_pk_bf16(lo, hi); }
__device__ __forceinline__ float wave_sum(float v) {
#pragma unroll
    for (int o = 32; o; o >>= 1) v += __shfl_xor(v, o);
    return v; }
__device__ __forceinline__ float wave_max(float v) {
#pragma unroll
    for (int o = 32; o; o >>= 1) v = fmaxf(v, __shfl_xor(v, o));
    return v; }
__device__ __forceinline__ float scan_sum(float x, int lane) {
#pragma unroll
    for (int o = 1; o < 64; o <<= 1) { const float y = __shfl_up(x, o); if (lane >= o) x += y; }
    return x; }
__device__ __forceinline__ float scan_max(float x, int lane) {
#pragma unroll
    for (int o = 1; o < 64; o <<= 1) { const float y = __shfl_up(x, o); if (lane >= o) x = fmaxf(x, y); }
    return x; }
__device__ __forceinline__ float logsigmoid(float x) { return fminf(x, 0.f) - log1pf(expf(-fabsf(x))); }
__device__ __forceinline__ bf16x8 ldfrag(LAS const unsigned char* base, int row, int strideB, int kbyte) { return *(LAS const bf16x8*)(base + row * strideB + kbyte); }
#define LDS_BARRIER() do { asm volatile("s_waitcnt lgkmcnt(0)" ::: "memory"); __builtin_amdgcn_s_barrier(); asm volatile("" ::: "memory"); } while (0)
#define MFMA16(a, b, c) __builtin_amdgcn_mfma_f32_16x16x32_bf16((a), (b), (c), 0, 0, 0)

#define XB_TMO      128
#define XB_XCNT(j)  (256  + 64 * (j))
#define XB_XSUB(j)  (1280 + 64 * (j))
#define XB_XGEN(j)  (2304 + 64 * (j))
#define XB_TOP      3328
#define XB_TOPGEN   3392
#define XCD_BAR_WORDS 3456
#define XB_SPIN_CAP (1u << 18)
__device__ __forceinline__ unsigned xb_ld(unsigned* p)              { return __hip_atomic_load(p, __ATOMIC_RELAXED, __HIP_MEMORY_SCOPE_AGENT); }
__device__ __forceinline__ unsigned xb_add(unsigned* p, unsigned v) { return __hip_atomic_fetch_add(p, v, __ATOMIC_RELAXED, __HIP_MEMORY_SCOPE_AGENT); }
__device__ __forceinline__ unsigned xb_xcc_id() { return (unsigned)__builtin_amdgcn_s_getreg((3 << 11) | 20) & 0xFu; }
#define XB_SPIN(cond, bar) do { unsigned _sp = 0; while (cond) { __builtin_amdgcn_s_sleep(1); \
    if ((++_sp & 255u) == 0u) { if (xb_ld(&(bar)[XB_TMO])) break; if (_sp > XB_SPIN_CAP) { atomicAdd(&(bar)[XB_TMO], 1u); break; } } } } while (0)

struct XcdBarrier {
    unsigned* bar; unsigned x;
    volatile LAS unsigned* st;
};

__device__ __forceinline__ XcdBarrier xcd_barrier_post(unsigned* bar, volatile LAS unsigned* st) {
    XcdBarrier b; b.bar = bar; b.x = xb_xcc_id(); b.st = st;
    if (threadIdx.x == 0) (void)xb_add(&bar[XB_XCNT(b.x)], 1u);
    return b;
}
__device__ __forceinline__ void xcd_barrier_complete(unsigned* bar, unsigned x, unsigned& nloc, unsigned& nx) {
    const unsigned G = gridDim.x * gridDim.y * gridDim.z;
    unsigned sum, cnt, mine, sp = 0u;
    for (;;) {
        sum = 0u; cnt = 0u; mine = 0u;
#pragma unroll
        for (unsigned j = 0; j < 16; ++j) { const unsigned c = xb_ld(&bar[XB_XCNT(j)]); sum += c; cnt += (c > 0u) ? 1u : 0u; mine = (j == x) ? c : mine; }
        if (sum == G) break;
        __builtin_amdgcn_s_sleep(1);
        if ((++sp & 255u) == 0u) { if (xb_ld(&bar[XB_TMO])) break; if (sp > XB_SPIN_CAP) { atomicAdd(&bar[XB_TMO], 1u); break; } }
    }
    nloc = mine > 0u ? mine : 1u; nx = cnt > 0u ? cnt : 1u;
}

__device__ __forceinline__ void xcd_barrier(const XcdBarrier& b) {
    asm volatile("s_waitcnt vmcnt(0)" ::: "memory");
    __syncthreads();
    if (threadIdx.x == 0) {
        unsigned* bar = b.bar;
        __builtin_amdgcn_s_waitcnt(0);
        unsigned nloc = b.st[0], nx = b.st[1];
        if (nloc == 0u) { xcd_barrier_complete(bar, b.x, nloc, nx); b.st[0] = nloc; b.st[1] = nx; }
        const unsigned old = xb_add(&bar[XB_XSUB(b.x)], 1u);
        const unsigned gen = old / nloc;
        if (old + 1u == (gen + 1u) * nloc) {
            __builtin_amdgcn_fence(__ATOMIC_RELEASE, "agent");
            asm volatile("s_waitcnt vmcnt(0)" ::: "memory");
            const unsigned og = xb_add(&bar[XB_TOP], 1u);
            const unsigned tg = og / nx;
            if (og + 1u == (tg + 1u) * nx) xb_add(&bar[XB_TOPGEN], 1u);
            else XB_SPIN(xb_ld(&bar[XB_TOPGEN]) == tg, bar);
            __builtin_amdgcn_fence(__ATOMIC_ACQUIRE, "agent");
            xb_add(&bar[XB_XGEN(b.x)], 1u);
            asm volatile("s_waitcnt vmcnt(0)" ::: "memory");
        } else {
            XB_SPIN(xb_ld(&bar[XB_XGEN(b.x)]) == gen, bar);
            __builtin_amdgcn_fence(__ATOMIC_ACQUIRE, "agent");
            asm volatile("s_waitcnt vmcnt(0)" ::: "memory");
        }
    }
    __syncthreads();
}

struct EpiBf16B {
    static constexpr bool PERM = true, AFTER_DRAIN = false;
    bf16_t* O; int ldc; const float* bias;
    __device__ __forceinline__ void operator()(const f32x4 (&acc)[2][2][4][2], const pg8::Unit& u, int wr, int wc, int fr, int fq) const {
        const int row0 = u.pm * 256 + wr * 64 + fr, col0 = u.pn * 256 + wc * 32 + 8 * fq;
        f32x4 bv[2][2];
#pragma unroll
        for (int bj = 0; bj < 2; ++bj)
#pragma unroll
            for (int n = 0; n < 2; ++n) bv[bj][n] = *(const f32x4*)(bias + col0 + bj * 128 + 4 * n);
#pragma unroll
        for (int ai = 0; ai < 2; ++ai)
#pragma unroll
            for (int m = 0; m < 4; ++m) { bf16_t* rowp = O + (size_t)(row0 + ai * 128 + m * 16) * ldc + col0;
#pragma unroll
                for (int bj = 0; bj < 2; ++bj) { const f32x4 v0 = acc[ai][bj][m][0] + bv[bj][0], v1 = acc[ai][bj][m][1] + bv[bj][1];
                    u32x4 w; w.x = pk2(v0[0], v0[1]); w.y = pk2(v0[2], v0[3]); w.z = pk2(v1[0], v1[1]); w.w = pk2(v1[2], v1[3]);
                    *(u32x4*)(rowp + bj * 128) = w; } }
    }
};
struct EpiRes {
    static constexpr bool PERM = false, AFTER_DRAIN = false;
    const bf16_t* base; float* out;
    __device__ __forceinline__ void operator()(const f32x4 (&acc)[2][2][4][2], const pg8::Unit& u, int wr, int wc, int fr, int fq) const {
        const int row0 = u.pm * 256 + wr * 64 + fr, col0 = u.pn * 256 + wc * 32 + 4 * fq;
#pragma unroll
        for (int ai = 0; ai < 2; ++ai)
#pragma unroll
            for (int m = 0; m < 4; ++m) { const size_t off = (size_t)(row0 + ai * 128 + m * 16) * DM + col0;
#pragma unroll
                for (int bj = 0; bj < 2; ++bj)
#pragma unroll
                    for (int n = 0; n < 2; ++n) { const u32x2 b = *(const u32x2*)(base + off + bj * 128 + n * 16);
                        f32x4 o; o[0] = ALPHA * bflo(b.x) + acc[ai][bj][m][n][0]; o[1] = ALPHA * bfhi(b.x) + acc[ai][bj][m][n][1];
                        o[2] = ALPHA * bflo(b.y) + acc[ai][bj][m][n][2]; o[3] = ALPHA * bfhi(b.y) + acc[ai][bj][m][n][3];
                        *(f32x4*)(out + off + bj * 128 + n * 16) = o; } }
    }
};
__device__ __forceinline__ float swiglu(float g, float u) { return g * u / (1.0f + __expf(-g)); }
struct EpiSwiglu {
    static constexpr bool PERM = true, AFTER_DRAIN = false;
    bf16_t* O;
    __device__ __forceinline__ void operator()(const f32x4 (&acc)[2][2][4][2], const pg8::Unit& u, int wr, int wc, int fr, int fq) const {
        const int row0 = u.pm * 256 + wr * 64 + fr, col0 = u.pn * 128 + wc * 32 + 8 * fq;
#pragma unroll
        for (int ai = 0; ai < 2; ++ai)
#pragma unroll
            for (int m = 0; m < 4; ++m) { bf16_t* rowp = O + (size_t)(row0 + ai * 128 + m * 16) * DFF + col0;
                const f32x4 g0 = acc[ai][0][m][0], g1 = acc[ai][0][m][1], u0 = acc[ai][1][m][0], u1 = acc[ai][1][m][1];
                u32x4 w; w.x = pk2(swiglu(g0[0], u0[0]), swiglu(g0[1], u0[1])); w.y = pk2(swiglu(g0[2], u0[2]), swiglu(g0[3], u0[3]));
                w.z = pk2(swiglu(g1[0], u1[0]), swiglu(g1[1], u1[1])); w.w = pk2(swiglu(g1[2], u1[2]), swiglu(g1[3], u1[3]));
                *(u32x4*)rowp = w; }
    }
};

__device__ __forceinline__ void tr_job(LAS float* T, const float* src, int ld, int K, int NC, bf16_t* dst, int mode, int vb, int nvb) {
    const int tid = fresh_tid(); const int nkt = K / 64, ntile = nkt * (NC / 64);
    for (int t = vb; t < ntile; t += nvb) {
        const int k0 = (t % nkt) * 64, n0 = (t / nkt) * 64;
        { const int r = tid >> 3, cs = (tid & 7) * 8; const float* s = src + (size_t)(k0 + r) * ld + n0 + cs;
          const float4 a = *(const float4*)s, b = *(const float4*)(s + 4); LAS float* d = T + r * 65 + cs;
          d[0] = a.x; d[1] = a.y; d[2] = a.z; d[3] = a.w; d[4] = b.x; d[5] = b.y; d[6] = b.z; d[7] = b.w; }
        __syncthreads();
        { const int n = tid >> 3, ks = (tid & 7) * 8, gn = n0 + n; float v[8];
#pragma unroll
          for (int i = 0; i < 8; ++i) v[i] = T[(ks + i) * 65 + n];
          const float sc = (mode == 3 && gn >= 1024 && gn < 1536) ? KSCALE : 1.0f;
          const int drow = (mode == 1) ? 256 * (gn >> 7) + (gn & 127) : (mode == 2) ? 256 * (gn >> 7) + 128 + (gn & 127) : gn;
          u32x4 w; w.x = pk2(v[0] * sc, v[1] * sc); w.y = pk2(v[2] * sc, v[3] * sc); w.z = pk2(v[4] * sc, v[5] * sc); w.w = pk2(v[6] * sc, v[7] * sc);
          *(u32x4*)(dst + (size_t)drow * K + k0 + ks) = w; }
        __syncthreads();
    }
}

__device__ __forceinline__ void phase0(const Params& p, LAS unsigned char* lds) {
    const int tid = fresh_tid(), lane = tid & 63, wave = tid >> 6, G = gridDim.x, bx = blockIdx.x;
    unsigned char* ws = p.ws;
    LAS float* T = (LAS float*)lds;
    int off = 0;
    tr_job(T, p.in[8], INCOLS, DM, NPROJ, (bf16_t*)(ws + WS_WIN), 3, (bx + off) % G, G); off += 640;
    tr_job(T, p.in[13], DM, DM, DM, (bf16_t*)(ws + WS_WOUT), 0, (bx + G - off % G) % G, G); off += 256;
    tr_job(T, p.in[16], DFF, DM, DFF, (bf16_t*)(ws + WS_WGU), 1, (bx + G - off % G) % G, G); off += 704;
    tr_job(T, p.in[17], DFF, DM, DFF, (bf16_t*)(ws + WS_WGU), 2, (bx + G - off % G) % G, G); off += 704;
    tr_job(T, p.in[18], DM, DFF, DM, (bf16_t*)(ws + WS_WDN), 0, (bx + G - off % G) % G, G); off += 704;
#pragma unroll 1
    for (int g = 0; g < 4; ++g) { tr_job(T, p.in[10] + g * 16384, 128, 128, 128, (bf16_t*)(ws + WS_WPOOL) + g * 16384, 0, (bx + G - off % G) % G, G); off += 4; }
    { float* bs = (float*)(ws + WS_BIAS); const float* b_in = p.in[9];
      for (int i = bx * 512 + tid; i < NPROJ; i += G * 512) bs[i] = b_in[i] * ((i >= 1024 && i < 1536) ? KSCALE : 1.0f); }
    LAS float* wg = (LAS float*)lds;
    { const float* w_in = p.in[8]; for (int i = tid; i < 8192; i += 512) { const int g = i >> 10, k = i & 1023; wg[i] = w_in[(size_t)k * INCOLS + NPROJ + g]; } }
    __syncthreads();
    const float* lg = p.in[6]; const float* lb = p.in[7]; const float* b_in = p.in[9];
    bf16_t* h0 = (bf16_t*)(ws + WS_H0); float* gates = (float*)(ws + WS_GATES);
    for (int row = bx * 8 + wave; row < MT; row += G * 8) {
        const float* x = row < MP ? p.in[0] + (size_t)row * DM : p.in[1] + (size_t)(row - MP) * DM;
        float4 v[4];
#pragma unroll
        for (int i = 0; i < 4; ++i) v[i] = *(const float4*)(x + i * 256 + lane * 4);
        float s = 0.f;
#pragma unroll
        for (int i = 0; i < 4; ++i) s += (v[i].x + v[i].y) + (v[i].z + v[i].w);
        const float mu = wave_sum(s) * (1.0f / DM);
        float q = 0.f;
#pragma unroll
        for (int i = 0; i < 4; ++i) { v[i].x -= mu; v[i].y -= mu; v[i].z -= mu; v[i].w -= mu; q += (v[i].x * v[i].x + v[i].y * v[i].y) + (v[i].z * v[i].z + v[i].w * v[i].w); }
        const float rstd = rsqrtf(wave_sum(q) * (1.0f / DM) + LN_EPS);
        float ga[8];
#pragma unroll
        for (int g = 0; g < 8; ++g) ga[g] = 0.f;
#pragma unroll
        for (int i = 0; i < 4; ++i) { const int c = i * 256 + lane * 4; const float4 gg = *(const float4*)(lg + c), bb = *(const float4*)(lb + c);
            float4 y; y.x = v[i].x * rstd * gg.x + bb.x; y.y = v[i].y * rstd * gg.y + bb.y; y.z = v[i].z * rstd * gg.z + bb.z; y.w = v[i].w * rstd * gg.w + bb.w;
            u32x2 w; w.x = pk2(y.x, y.y); w.y = pk2(y.z, y.w); *(u32x2*)(h0 + (size_t)row * DM + c) = w;
#pragma unroll
            for (int g = 0; g < 8; ++g) { const f32x4 wv = *(LAS const f32x4*)(wg + g * 1024 + c); ga[g] += (y.x * wv[0] + y.y * wv[1]) + (y.z * wv[2] + y.w * wv[3]); } }
#pragma unroll
        for (int g = 0; g < 8; ++g) ga[g] = wave_sum(ga[g]);
        float r = ga[0];
#pragma unroll
        for (int g = 1; g < 8; ++g) r = (lane == g) ? ga[g] : r;
        if (lane < 8) gates[(size_t)row * 8 + lane] = r + b_in[NPROJ + lane];
    }
}

__device__ __forceinline__ void gate_scan(const Params& p, LAS unsigned char* lds) {
    const int tid = fresh_tid(), lane = tid & 63, wave = tid >> 6;
    const float* gates = (const float*)(p.ws + WS_GATES); float* mtab = (float*)(p.ws + WS_MTAB); float* btab = (float*)(p.ws + WS_BTAB);
    f32x4* gtab = (f32x4*)(p.ws + WS_GTAB);
    LAS float* sA = (LAS float*)lds; LAS float* sB = sA + 128; LAS float* sM = sA + 256;
    for (int chain = blockIdx.x; chain < 32; chain += gridDim.x) {
        const int batch = chain >> 2, head = chain & 3;
        for (int c = wave; c < 128; c += 8) {
            const size_t row = (size_t)batch * SEQ + c * 64 + lane;
            const float ig = gates[row * 8 + head], fg = gates[row * 8 + 4 + head];
            const float b = scan_sum(logsigmoid(fg), lane); const float A = wave_max(ig - b); const float bl = __shfl(b, 63);
            if (lane == 0) { sA[c] = A; sB[c] = bl; }
        }
        __syncthreads();
        if (tid == 0) { float m = 0.f; mtab[chain * 132] = 0.f; sM[0] = 0.f;
            for (int c = 0; c < 128; ++c) { m = sB[c] + fmaxf(m, sA[c]); mtab[chain * 132 + c + 1] = m; sM[c + 1] = m; btab[chain * 128 + c] = sB[c]; }
            p.out[O_MP + chain] = m; }
        __syncthreads();
        for (int c = wave; c < 128; c += 8) {
            const size_t row = (size_t)batch * SEQ + c * 64 + lane;
            const float ig = gates[row * 8 + head], fg = gates[row * 8 + 4 + head];
            const float b = scan_sum(logsigmoid(fg), lane); const float a = ig - b; const float m_prev = sM[c];
            const float M = fmaxf(m_prev, scan_max(a, lane));
            gtab[row * 4 + head] = (f32x4){a, M, expf(m_prev - M), expf(-(b + M))};
        }
        __syncthreads();
    }
    for (int s = blockIdx.x * 8 + wave; s < DB * 4; s += gridDim.x * 8) {
        const int b_ = s >> 2, head = s & 3; const bool valid = lane < 32; const size_t row = (size_t)MP + b_ * 32 + (lane & 31);
        const float ig = gates[row * 8 + head], fg = gates[row * 8 + 4 + head]; const float m_prev = p.in[5][s];
        const float b = scan_sum(valid ? logsigmoid(fg) : 0.f, lane); const float a = valid ? ig - b : -1e30f;
        const float M = fmaxf(m_prev, scan_max(a, lane));
        if (valid) gtab[row * 4 + head] = (f32x4){a, M, expf(m_prev - M), expf(-(b + M))};
        if (lane == 31) p.out[O_MS + s] = b + M;
    }
}

constexpr int L_Q = 0, L_K = 17408, L_KW = 34816, L_V = 52224, L_CT = 69632, L_S = 104448, L_G = 113664;
typedef short s16x4 __attribute__((ext_vector_type(4)));
__device__ __forceinline__ bf16x8 ldfrag_tr(LAS const unsigned char* base, int row0, int col0, int lane) {
    const int g = lane >> 4, q = (lane & 15) >> 2, pp = lane & 3;
    LAS const unsigned char* a = base + (row0 + 8 * g + q) * 272 + (col0 + 4 * pp) * 2;
    const s16x4 lo = __builtin_amdgcn_ds_read_tr16_b64_v4i16((LAS s16x4*)a);
    const s16x4 hi = __builtin_amdgcn_ds_read_tr16_b64_v4i16((LAS s16x4*)(a + 4 * 272));
    return __builtin_shufflevector(lo, hi, 0, 1, 2, 3, 4, 5, 6, 7);
}

template <bool FULL>
__device__ __forceinline__ void mlstm_run(const Params& p, LAS unsigned char* lds, f32x4 (&accC)[2][4], f32x4 (&accN)[2], int row0, int head, int nch, int L) {
    const int tid = fresh_tid(), lane = tid & 63, wave = __builtin_amdgcn_readfirstlane(tid >> 6), l15 = lane & 15, l4 = lane >> 4, st = wave & 3, tp = wave >> 2;
    const bf16_t* proj = (const bf16_t*)(p.ws + WS_PROJ); const f32x4* gtab = (const f32x4*)(p.ws + WS_GTAB);
    bf16_t* mix = (bf16_t*)(p.ws + WS_MIX);
    LAS unsigned short* sQ = (LAS unsigned short*)(lds + L_Q); LAS unsigned short* sK = (LAS unsigned short*)(lds + L_K);
    LAS unsigned short* sKW = (LAS unsigned short*)(lds + L_KW); LAS unsigned short* sV = (LAS unsigned short*)(lds + L_V);
    LAS unsigned short* sS = (LAS unsigned short*)(lds + L_S); LAS float* sH = (LAS float*)(lds + L_Q);
    LAS float* gA = (LAS float*)(lds + L_G); LAS float* gM = gA + 64; LAS float* gDec = gA + 128; LAS float* gEinv = gA + 192; LAS float* gW = gA + 256;
    LAS float* gQn = gA + 320; LAS float* gDi = gA + 384; LAS float* gN = gA + 448; LAS float* scal = gA + 576; LAS float* gNg = gA + 584;
    const bf16x8 ones = (bf16x8){0x3F80, 0x3F80, 0x3F80, 0x3F80, 0x3F80, 0x3F80, 0x3F80, 0x3F80};
    const int tok0 = tid >> 4, dsg = tid & 15;
    const int orow = tid >> 3, oseg = tid & 7;
    u32x4 kq[2], kk[2], kv[2]; f32x4 pgt = (f32x4){0.f, 0.f, 0.f, 0.f};
    if (FULL && tid < 128) gNg[tid] = p.in[12][head * 128 + tid];
#pragma unroll
    for (int i = 0; i < 2; ++i) { const int tok = tok0 + 32 * i; const bool valid = tok < L; const u32x4 z = (u32x4){0u, 0u, 0u, 0u};
        const bf16_t* src = proj + (size_t)(row0 + tok) * NPROJ + head * 128 + dsg * 8;
        kk[i] = valid ? *(const u32x4*)(src + 1024) : z; kv[i] = valid ? *(const u32x4*)(src + 1536) : z;
        if (FULL) kq[i] = valid ? *(const u32x4*)(src + 512) : z; else kq[i] = z; }
    if (wave == 0 && lane < L) pgt = gtab[(size_t)(row0 + lane) * 4 + head];
#pragma unroll 1
    for (int c = 0; c < nch; ++c) {
        const int r0 = row0 + c * 64;
        if (wave == 0) {
            const bool valid = lane < L; const float a = valid ? pgt[0] : -1e30f; const float Ml = __shfl(pgt[1], L - 1);
            gA[lane] = a; gM[lane] = valid ? pgt[1] : Ml; gDec[lane] = valid ? pgt[2] : 0.f; gEinv[lane] = valid ? pgt[3] : 1.f; gW[lane] = valid ? __expf(a - Ml) : 0.f;
            if (lane == L - 1) scal[0] = pgt[2];
        }
        if (FULL) {
#pragma unroll
            for (int i = 0; i < 2; ++i)
#pragma unroll
                for (int n = 0; n < 4; ++n) { u32x2 w; w.x = pk2(accC[i][n][0], accC[i][n][1]); w.y = pk2(accC[i][n][2], accC[i][n][3]);
                    *(LAS u32x2*)(lds + L_CT + (64 * tp + 16 * n + l15) * 272 + (32 * st + 16 * i + 4 * l4) * 2) = w; }
            if (tp == 0 && l15 == 0) {
#pragma unroll
                for (int i = 0; i < 2; ++i) *(LAS f32x4*)(gN + 32 * st + 16 * i + 4 * l4) = accN[i]; }
        }
#pragma unroll
        for (int i = 0; i < 2; ++i) { const int tok = tok0 + 32 * i;
            if (FULL) { *(LAS u32x4*)(sQ + tok * 136 + dsg * 8) = kq[i]; *(LAS u32x4*)(sK + tok * 136 + dsg * 8) = kk[i]; }
            *(LAS u32x4*)(sV + tok * 136 + dsg * 8) = kv[i]; }
        LDS_BARRIER();
#pragma unroll
        for (int i = 0; i < 2; ++i) { const int tok = tok0 + 32 * i; const float w = gW[tok]; u32x4 o;
            o.x = pk2(bflo(kk[i].x) * w, bfhi(kk[i].x) * w); o.y = pk2(bflo(kk[i].y) * w, bfhi(kk[i].y) * w);
            o.z = pk2(bflo(kk[i].z) * w, bfhi(kk[i].z) * w); o.w = pk2(bflo(kk[i].w) * w, bfhi(kk[i].w) * w);
            *(LAS u32x4*)(sKW + tok * 136 + dsg * 8) = o; }
        if (c + 1 < nch) {
#pragma unroll
            for (int i = 0; i < 2; ++i) { const int tok = tok0 + 32 * i;
                const bf16_t* src = proj + (size_t)(r0 + 64 + tok) * NPROJ + head * 128 + dsg * 8;
                kk[i] = *(const u32x4*)(src + 1024); kv[i] = *(const u32x4*)(src + 1536);
                if (FULL) kq[i] = *(const u32x4*)(src + 512); }
            if (wave == 0) pgt = gtab[(size_t)(r0 + 64 + lane) * 4 + head];
        }
        f32x4 nacc[4];
#pragma unroll
        for (int n = 0; n < 4; ++n) nacc[n] = (f32x4){0.f, 0.f, 0.f, 0.f};
        if (FULL) {
            f32x4 sacc[2]; sacc[0] = (f32x4){0.f, 0.f, 0.f, 0.f}; sacc[1] = sacc[0];
#pragma unroll
            for (int ks = 0; ks < 4; ++ks) { const int kb = (32 * ks + 8 * l4) * 2;
                const bf16x8 a = ldfrag(lds + L_K, 16 * st + l15, 272, kb);
#pragma unroll
                for (int tt = 0; tt < 2; ++tt) { const bf16x8 b = ldfrag(lds + L_Q, 16 * (2 * tp + tt) + l15, 272, kb); sacc[tt] = MFMA16(a, b, sacc[tt]); } }
#pragma unroll
            for (int tt = 0; tt < 2; ++tt) { const int t = 16 * (2 * tp + tt) + l15; const float Mt = gM[t]; float dv[4];
#pragma unroll
                for (int j = 0; j < 4; ++j) { const int s = 16 * st + 4 * l4 + j; dv[j] = (s <= t) ? sacc[tt][j] * __expf(gA[s] - Mt) : 0.f; }
                u32x2 w; w.x = pk2(dv[0], dv[1]); w.y = pk2(dv[2], dv[3]); *(LAS u32x2*)(lds + L_S + t * 144 + (16 * st + 4 * l4) * 2) = w; }
#pragma unroll
            for (int ks = 0; ks < 4; ++ks) { const int kb = (32 * ks + 8 * l4) * 2;
                const bf16x8 a = ldfrag(lds + L_Q, 16 * st + l15, 272, kb);
#pragma unroll
                for (int n = 0; n < 4; ++n) { const bf16x8 b = ldfrag(lds + L_CT, 64 * tp + 16 * n + l15, 272, kb); nacc[n] = MFMA16(a, b, nacc[n]); } }
#pragma unroll
            for (int j = 0; j < 4; ++j) { const float dj = gDec[16 * st + 4 * l4 + j];
#pragma unroll
                for (int n = 0; n < 4; ++n) nacc[n][j] *= dj; }
            { float s = 0.f;
              const u32x4 q0 = *(LAS const u32x4*)(sQ + orow * 136 + oseg * 16), q1 = *(LAS const u32x4*)(sQ + orow * 136 + oseg * 16 + 8);
              const unsigned qw[8] = {q0.x, q0.y, q0.z, q0.w, q1.x, q1.y, q1.z, q1.w};
#pragma unroll
              for (int e = 0; e < 8; ++e) s += bflo(qw[e]) * gN[oseg * 16 + 2 * e] + bfhi(qw[e]) * gN[oseg * 16 + 2 * e + 1];
              s += __shfl_xor(s, 1); s += __shfl_xor(s, 2); s += __shfl_xor(s, 4);
              if (oseg == 0) gQn[orow] = s; }
        }
        LDS_BARRIER();
        if (FULL) {
            const u32x4 s0 = *(LAS const u32x4*)(sS + orow * 72 + oseg * 8);
            float s = (bflo(s0.x) + bfhi(s0.x)) + (bflo(s0.y) + bfhi(s0.y)) + (bflo(s0.z) + bfhi(s0.z)) + (bflo(s0.w) + bfhi(s0.w));
            s += __shfl_xor(s, 1); s += __shfl_xor(s, 2); s += __shfl_xor(s, 4);
            if (oseg == 0) { const float den = gDec[orow] * gQn[orow] + s; gDi[orow] = 1.0f / fmaxf(fabsf(den), gEinv[orow]); } }
        const float wsv = scal[0];
#pragma unroll
        for (int i = 0; i < 2; ++i) { accN[i] *= wsv;
#pragma unroll
            for (int n = 0; n < 4; ++n) accC[i][n] *= wsv; }
#pragma unroll
        for (int ks = 0; ks < 2; ++ks) { bf16x8 bv[4];
#pragma unroll
            for (int n = 0; n < 4; ++n) bv[n] = ldfrag_tr(lds + L_V, 32 * ks, 64 * tp + 16 * n, lane);
            if (FULL) { const bf16x8 a = ldfrag(lds + L_S, 16 * st + l15, 144, (32 * ks + 8 * l4) * 2);
#pragma unroll
                for (int n = 0; n < 4; ++n) nacc[n] = MFMA16(a, bv[n], nacc[n]); }
#pragma unroll
            for (int i = 0; i < 2; ++i) { const bf16x8 a = ldfrag_tr(lds + L_KW, 32 * ks, 32 * st + 16 * i, lane);
                accN[i] = MFMA16(a, ones, accN[i]);
#pragma unroll
                for (int n = 0; n < 4; ++n) accC[i][n] = MFMA16(a, bv[n], accC[i][n]); } }
        LDS_BARRIER();
        if (FULL) {
            u32x4 ow0 = (u32x4){0u, 0u, 0u, 0u}, ow1 = ow0;
            if (orow < L) { const bf16_t* op = proj + (size_t)(r0 + orow) * NPROJ + 2048 + head * 128 + oseg * 16; ow0 = *(const u32x4*)op; ow1 = *(const u32x4*)(op + 8); }
#pragma unroll
            for (int j = 0; j < 4; ++j) { const int t = 16 * st + 4 * l4 + j; const float di = gDi[t];
#pragma unroll
                for (int n = 0; n < 4; ++n) sH[t * 132 + 64 * tp + 16 * n + l15] = nacc[n][j] * di; }
            LDS_BARRIER();
            if (orow < L) {
                f32x4 x[4]; float s = 0.f;
#pragma unroll
                for (int e = 0; e < 4; ++e) { x[e] = *(LAS const f32x4*)(sH + orow * 132 + oseg * 16 + 4 * e); s += (x[e][0] + x[e][1]) + (x[e][2] + x[e][3]); }
                s += __shfl_xor(s, 1); s += __shfl_xor(s, 2); s += __shfl_xor(s, 4);
                const float mean = s * (1.0f / 128.0f); float q = 0.f;
#pragma unroll
                for (int e = 0; e < 4; ++e) { x[e] -= mean; q += (x[e][0] * x[e][0] + x[e][1] * x[e][1]) + (x[e][2] * x[e][2] + x[e][3] * x[e][3]); }
                q += __shfl_xor(q, 1); q += __shfl_xor(q, 2); q += __shfl_xor(q, 4);
                const float rstd = rsqrtf(q * (1.0f / 128.0f) + LN_EPS);
                const unsigned owv[8] = {ow0.x, ow0.y, ow0.z, ow0.w, ow1.x, ow1.y, ow1.z, ow1.w}; unsigned ov[8];
#pragma unroll
                for (int e = 0; e < 4; ++e) { const f32x4 g = *(LAS const f32x4*)(gNg + oseg * 16 + 4 * e);
                    const float y0 = x[e][0] * rstd * g[0] / (1.0f + __expf(-bflo(owv[2 * e]))), y1 = x[e][1] * rstd * g[1] / (1.0f + __expf(-bfhi(owv[2 * e])));
                    const float y2 = x[e][2] * rstd * g[2] / (1.0f + __expf(-bflo(owv[2 * e + 1]))), y3 = x[e][3] * rstd * g[3] / (1.0f + __expf(-bfhi(owv[2 * e + 1])));
                    ov[2 * e] = pk2(y0, y1); ov[2 * e + 1] = pk2(y2, y3); }
                bf16_t* mp = mix + (size_t)(r0 + orow) * DM + 512 + head * 128 + oseg * 16;
                *(u32x4*)mp = (u32x4){ov[0], ov[1], ov[2], ov[3]}; *(u32x4*)(mp + 8) = (u32x4){ov[4], ov[5], ov[6], ov[7]};
            }
            LDS_BARRIER();
        }
    }
}

constexpr int L_PW = 34816, L_PU = 69632;
template <int W>
__device__ __forceinline__ void pool_diff(LAS unsigned char* lds, bool sample, int tilepos0) {
    const int tid = fresh_tid(), co = tid & 15, t0 = (tid >> 4) * 4;
#pragma unroll 1
    for (int tt = 0; tt < 4; ++tt) {
        const int t = t0 + tt; const int sgi = sample ? (t >> 5) : 0, lt = sample ? (t & 31) : t;
        const int rowbase = sample ? sgi * 47 + 15 + lt : 15 + t;
        const int cnt = sample ? W : min(tilepos0 + t + 1, W);
        float sum[8];
#pragma unroll
        for (int e = 0; e < 8; ++e) sum[e] = 0.f;
        u32x4 x0 = (u32x4){0u, 0u, 0u, 0u};
#pragma unroll
        for (int j = 0; j < W; ++j) { const u32x4 r = *(LAS const u32x4*)(lds + L_PU + (rowbase - j) * 272 + co * 16); if (j == 0) x0 = r;
            sum[0] += bflo(r.x); sum[1] += bfhi(r.x); sum[2] += bflo(r.y); sum[3] += bfhi(r.y); sum[4] += bflo(r.z); sum[5] += bfhi(r.z); sum[6] += bflo(r.w); sum[7] += bfhi(r.w); }
        const float inv = 1.0f / (float)cnt;
        u32x4 w; w.x = pk2(sum[0] * inv - bflo(x0.x), sum[1] * inv - bfhi(x0.x)); w.y = pk2(sum[2] * inv - bflo(x0.y), sum[3] * inv - bfhi(x0.y));
        w.z = pk2(sum[4] * inv - bflo(x0.z), sum[5] * inv - bfhi(x0.z)); w.w = pk2(sum[6] * inv - bflo(x0.w), sum[7] * inv - bfhi(x0.w));
        *(LAS u32x4*)(lds + t * 272 + co * 16) = w; }
}

__device__ __forceinline__ void pool_fetch(const Params& p, int item, int tid, u32x4 (&pf)[6]) {
    const int g = item & 3, R0 = (item >> 2) * 128;
    const bf16_t* proj = (const bf16_t*)(p.ws + WS_PROJ); const float* hist = p.in[2];
    const bool sample = R0 >= MP; const int seqrow0 = sample ? 0 : (R0 / SEQ) * SEQ, tilepos0 = sample ? 0 : R0 - seqrow0;
    const int nrows = sample ? 188 : 143;
#pragma unroll
    for (int i = 0; i < 6; ++i) { const int piece = tid + 512 * i, e = piece >> 4, seg = piece & 15; u32x4 val = (u32x4){0u, 0u, 0u, 0u};
        if (e < nrows) {
            if (!sample) { const int pos = tilepos0 - 15 + e; if (pos >= 0) val = *(const u32x4*)(proj + (size_t)(seqrow0 + pos) * NPROJ + g * 128 + seg * 8); }
            else { const int sgi = e / 47, le = e - sgi * 47, b = ((R0 - MP) >> 5) + sgi;
                if (le < 15) { const float* hp = hist + ((size_t)b * 15 + le) * 512 + g * 128 + seg * 8; const float4 a = *(const float4*)hp, c4 = *(const float4*)(hp + 4);
                    val.x = pk2(a.x, a.y); val.y = pk2(a.z, a.w); val.z = pk2(c4.x, c4.y); val.w = pk2(c4.z, c4.w); }
                else val = *(const u32x4*)(proj + (size_t)(MP + b * 32 + le - 15) * NPROJ + g * 128 + seg * 8); } }
        pf[i] = val; }
}

__device__ __forceinline__ void pool_loop(const Params& p, LAS unsigned char* lds, int first, int stride, int end) {
    const int tid = fresh_tid(), lane = tid & 63, wave = __builtin_amdgcn_readfirstlane(tid >> 6), l15 = lane & 15, l4 = lane >> 4, st = wave & 3, tp = wave >> 2;
    bf16_t* mix = (bf16_t*)(p.ws + WS_MIX); const float* pscale = p.in[11];
    if (first >= end) return;
    u32x4 pf[6]; pool_fetch(p, first, tid, pf);
    int gw = -1;
#pragma unroll 1
    for (int item = first; item < end; item += stride) {
        const int g = item & 3, R0 = (item >> 2) * 128;
        const bool sample = R0 >= MP; const int tilepos0 = sample ? 0 : R0 - (R0 / SEQ) * SEQ;
        if (g != gw) { const bf16_t* Wp = (const bf16_t*)(p.ws + WS_WPOOL) + g * 16384; gw = g;
#pragma unroll
            for (int i = 0; i < 4; ++i) { const int piece = tid + 512 * i, row = piece >> 4, seg = piece & 15;
                *(LAS u32x4*)(lds + L_PW + row * 272 + seg * 16) = *(const u32x4*)(Wp + row * 128 + seg * 8); } }
#pragma unroll
        for (int i = 0; i < 6; ++i) { const int piece = tid + 512 * i, e = piece >> 4, seg = piece & 15; if (e < 188) *(LAS u32x4*)(lds + L_PU + e * 272 + seg * 16) = pf[i]; }
        LDS_BARRIER();
        if (item + stride < end) pool_fetch(p, item + stride, tid, pf);
        if (g == 0) pool_diff<2>(lds, sample, tilepos0); else if (g == 1) pool_diff<4>(lds, sample, tilepos0); else if (g == 2) pool_diff<8>(lds, sample, tilepos0); else pool_diff<16>(lds, sample, tilepos0);
        LDS_BARRIER();
        f32x4 acc[2][4];
#pragma unroll
        for (int i = 0; i < 2; ++i)
#pragma unroll
            for (int n = 0; n < 4; ++n) acc[i][n] = (f32x4){0.f, 0.f, 0.f, 0.f};
#pragma unroll
        for (int ks = 0; ks < 4; ++ks) { const int kb = (32 * ks + 8 * l4) * 2; bf16x8 bv[4];
#pragma unroll
            for (int n = 0; n < 4; ++n) bv[n] = ldfrag(lds, 64 * tp + 16 * n + l15, 272, kb);
#pragma unroll
            for (int i = 0; i < 2; ++i) { const bf16x8 a = ldfrag(lds + L_PW, 32 * st + 16 * i + l15, 272, kb);
#pragma unroll
                for (int n = 0; n < 4; ++n) acc[i][n] = MFMA16(a, bv[n], acc[i][n]); } }
        LDS_BARRIER();
#pragma unroll
        for (int i = 0; i < 2; ++i) { const int d0 = 32 * st + 16 * i + 4 * l4; const float4 ps = *(const float4*)(pscale + g * 128 + d0);
#pragma unroll
            for (int n = 0; n < 4; ++n) { const int t = 64 * tp + 16 * n + l15;
                u32x2 w; w.x = pk2(acc[i][n][0] * ps.x, acc[i][n][1] * ps.y); w.y = pk2(acc[i][n][2] * ps.z, acc[i][n][3] * ps.w);
                *(LAS u32x2*)(lds + t * 272 + d0 * 2) = w; } }
        LDS_BARRIER();
        { const int t = tid >> 2, sg = tid & 3; const u32x4 o0 = *(LAS const u32x4*)(lds + t * 272 + sg * 64), o1 = *(LAS const u32x4*)(lds + t * 272 + sg * 64 + 16),
            o2 = *(LAS const u32x4*)(lds + t * 272 + sg * 64 + 32), o3 = *(LAS const u32x4*)(lds + t * 272 + sg * 64 + 48);
          bf16_t* mp = mix + (size_t)(R0 + t) * DM + g * 128 + sg * 32; *(u32x4*)mp = o0; *(u32x4*)(mp + 8) = o1; *(u32x4*)(mp + 16) = o2; *(u32x4*)(mp + 24) = o3; }
    }
    LDS_BARRIER();
}

constexpr int N_S2 = 224, N_SMP = 128, N_POOL = (MT / 128) * 4;

__device__ __forceinline__ void phase2(const Params& p, LAS unsigned char* lds, int kinds) {
    const int tid = fresh_tid(), lane = tid & 63, wave = tid >> 6, l15 = lane & 15, l4 = lane >> 4, st = wave & 3, tp = wave >> 2;
    float* Dst = (float*)(p.ws + WS_DST); float* Dn = (float*)(p.ws + WS_DN); const float* mtab = (const float*)(p.ws + WS_MTAB);
    for (int it = blockIdx.x; it < N_S2 + N_SMP; it += gridDim.x) {
        if (it < N_S2) {
            if (!(kinds & 1)) continue;
            const int chain = it / 7, sc = it % 7, batch = chain >> 2, head = chain & 3;
            f32x4 accC[2][4], accN[2];
#pragma unroll
            for (int i = 0; i < 2; ++i) { accN[i] = (f32x4){0.f, 0.f, 0.f, 0.f};
#pragma unroll
                for (int n = 0; n < 4; ++n) accC[i][n] = (f32x4){0.f, 0.f, 0.f, 0.f}; }
            mlstm_run<false>(p, lds, accC, accN, batch * SEQ + sc * SCN * 64, head, SCN, 64);
#pragma unroll
            for (int i = 0; i < 2; ++i)
#pragma unroll
                for (int n = 0; n < 4; ++n)
#pragma unroll
                    for (int j = 0; j < 4; ++j) Dst[((size_t)it * 32 + (i * 4 + n) * 4 + j) * 512 + tid] = accC[i][n][j];
            if (tp == 0 && l15 == 0) {
#pragma unroll
                for (int i = 0; i < 2; ++i) *(f32x4*)(Dn + it * 128 + 32 * st + 16 * i + 4 * l4) = accN[i]; }
        } else {
            if (!(kinds & 2)) continue;
            const int s = it - N_S2, b = s >> 2, head = s & 3;
            const float* C0 = p.in[3] + (size_t)s * 16384; f32x4 accC[2][4], accN[2];
#pragma unroll
            for (int i = 0; i < 2; ++i) accN[i] = *(const f32x4*)(p.in[4] + s * 128 + 32 * st + 16 * i + 4 * l4);
#pragma unroll
            for (int i = 0; i < 2; ++i)
#pragma unroll
                for (int n = 0; n < 4; ++n)
#pragma unroll
                    for (int j = 0; j < 4; ++j) accC[i][n][j] = C0[(32 * st + 16 * i + 4 * l4 + j) * 128 + 64 * tp + 16 * n + l15];
            mlstm_run<true>(p, lds, accC, accN, MP + b * 32, head, 1, 32);
            float* Co = p.out + O_CS + (size_t)s * 16384;
#pragma unroll
            for (int i = 0; i < 2; ++i)
#pragma unroll
                for (int n = 0; n < 4; ++n)
#pragma unroll
                    for (int j = 0; j < 4; ++j) Co[(32 * st + 16 * i + 4 * l4 + j) * 128 + 64 * tp + 16 * n + l15] = accC[i][n][j];
            if (tp == 0 && l15 == 0) {
#pragma unroll
                for (int i = 0; i < 2; ++i) *(f32x4*)(p.out + O_NS + s * 128 + 32 * st + 16 * i + 4 * l4) = accN[i]; }
        }
    }
    if (kinds & 4) { const int G = gridDim.x; int first = blockIdx.x; while (first < N_S2 + N_SMP) first += G;
        pool_loop(p, lds, first - N_S2 - N_SMP, G, N_POOL); }
    const bf16_t* proj = (const bf16_t*)(p.ws + WS_PROJ);
    for (int idx = blockIdx.x * 512 + tid; idx < (NB + DB) * 15 * 512; idx += gridDim.x * 512) {
        if (idx < NB * 7680) { const int b = idx / 7680, rem = idx % 7680, i = rem >> 9, c = rem & 511;
            p.out[O_POOLP + idx] = bf2f(proj[(size_t)(b * SEQ + SEQ - 15 + i) * NPROJ + c]); }
        else { const int id2 = idx - NB * 7680, b = id2 / 7680, rem = id2 % 7680, i = rem >> 9, c = rem & 511;
            p.out[O_POOLS + id2] = bf2f(proj[(size_t)(MP + b * 32 + 17 + i) * NPROJ + c]); }
    }
}

__device__ __forceinline__ void phase3(const Params& p, LAS unsigned char* lds) {
    const int tid = fresh_tid(), lane = tid & 63, wave = tid >> 6, l15 = lane & 15, l4 = lane >> 4, st = wave & 3, tp = wave >> 2;
    const float* Dst = (const float*)(p.ws + WS_DST); const float* Dn = (const float*)(p.ws + WS_DN);
    const float* mtab = (const float*)(p.ws + WS_MTAB); const float* btab = (const float*)(p.ws + WS_BTAB);
    for (int it = blockIdx.x; it < 256; it += gridDim.x) {
        const int chain = it >> 3, sc = it & 7, batch = chain >> 2, head = chain & 3;
        f32x4 accC[2][4], accN[2];
#pragma unroll
        for (int i = 0; i < 2; ++i) { accN[i] = (f32x4){0.f, 0.f, 0.f, 0.f};
#pragma unroll
            for (int n = 0; n < 4; ++n) accC[i][n] = (f32x4){0.f, 0.f, 0.f, 0.f}; }
#pragma unroll 1
        for (int j = 0; j < sc; ++j) {
            float Bs = 0.f;
            for (int c = 0; c < SCN; ++c) Bs += btab[chain * 128 + j * SCN + c];
            const float Wj = expf(Bs + mtab[chain * 132 + j * SCN] - mtab[chain * 132 + (j + 1) * SCN]);
            const int item = chain * 7 + j;
#pragma unroll
            for (int i = 0; i < 2; ++i)
#pragma unroll
                for (int n = 0; n < 4; ++n)
#pragma unroll
                    for (int q = 0; q < 4; ++q) accC[i][n][q] = Wj * accC[i][n][q] + Dst[((size_t)item * 32 + (i * 4 + n) * 4 + q) * 512 + tid];
#pragma unroll
            for (int i = 0; i < 2; ++i) accN[i] = Wj * accN[i] + *(const f32x4*)(Dn + item * 128 + 32 * st + 16 * i + 4 * l4);
        }
        mlstm_run<true>(p, lds, accC, accN, batch * SEQ + sc * SCN * 64, head, SCN, 64);
        if (sc == 7) {
            float* Co = p.out + O_CP + (size_t)chain * 16384;
#pragma unroll
            for (int i = 0; i < 2; ++i)
#pragma unroll
                for (int n = 0; n < 4; ++n)
#pragma unroll
                    for (int j = 0; j < 4; ++j) Co[(32 * st + 16 * i + 4 * l4 + j) * 128 + 64 * tp + 16 * n + l15] = accC[i][n][j];
            if (tp == 0 && l15 == 0) {
#pragma unroll
                for (int i = 0; i < 2; ++i) *(f32x4*)(p.out + O_NP + chain * 128 + 32 * st + 16 * i + 4 * l4) = accN[i]; }
        }
    }
}

template <bool TO_BF16>
__device__ __forceinline__ void ln_rows(const float* src, const float* gam, const float* bet, bf16_t* ob, float* of) {
    const int tid = fresh_tid(), lane = tid & 63, wave = tid >> 6;
    for (int row = blockIdx.x * 8 + wave; row < MT; row += gridDim.x * 8) {
        const float* x = src + (size_t)row * DM; float4 v[4];
#pragma unroll
        for (int i = 0; i < 4; ++i) v[i] = *(const float4*)(x + i * 256 + lane * 4);
        float s = 0.f;
#pragma unroll
        for (int i = 0; i < 4; ++i) s += (v[i].x + v[i].y) + (v[i].z + v[i].w);
        const float mu = wave_sum(s) * (1.0f / DM); float q = 0.f;
#pragma unroll
        for (int i = 0; i < 4; ++i) { v[i].x -= mu; v[i].y -= mu; v[i].z -= mu; v[i].w -= mu; q += (v[i].x * v[i].x + v[i].y * v[i].y) + (v[i].z * v[i].z + v[i].w * v[i].w); }
        const float rstd = rsqrtf(wave_sum(q) * (1.0f / DM) + LN_EPS);
#pragma unroll
        for (int i = 0; i < 4; ++i) { const int c = i * 256 + lane * 4; const float4 gg = *(const float4*)(gam + c), bb = *(const float4*)(bet + c);
            float4 y; y.x = v[i].x * rstd * gg.x + bb.x; y.y = v[i].y * rstd * gg.y + bb.y; y.z = v[i].z * rstd * gg.z + bb.z; y.w = v[i].w * rstd * gg.w + bb.w;
            if (TO_BF16) { u32x2 w; w.x = pk2(y.x, y.y); w.y = pk2(y.z, y.w); *(u32x2*)(ob + (size_t)row * DM + c) = w; }
            else *(float4*)(of + (size_t)row * DM + c) = y; }
    }
}

__global__ void __launch_bounds__(512) fwd_mega(Params p) {
    extern __shared__ __attribute__((aligned(16))) unsigned char smem[];
    LAS unsigned char* lds = (LAS unsigned char*)smem;
    cg::grid_group grid = cg::this_grid();
    volatile LAS unsigned* stw = (volatile LAS unsigned*)(lds + 131072);
    if (threadIdx.x == 0) { stw[0] = 0u; stw[1] = 0u; }
    __syncthreads();
    const XcdBarrier xbar = xcd_barrier_post((unsigned*)(p.ws + WS_BAR), stw);
    unsigned char* ws = p.ws;
    bf16_t* h0 = (bf16_t*)(ws + WS_H0); bf16_t* proj = (bf16_t*)(ws + WS_PROJ); bf16_t* mix = (bf16_t*)(ws + WS_MIX); bf16_t* act = (bf16_t*)(ws + WS_ACT);
    const int G = gridDim.x, bx = blockIdx.x;

#ifndef PH
#define PH 0x1ff
#endif
#ifndef DBL
#define DBL 0
#endif
    if (DBL & 0x800) { for (int i = 0; i < 10; ++i) xcd_barrier(xbar); }
    if (DBL & 1) { phase0(p, lds); xcd_barrier(xbar); }
    if (PH & 1) phase0(p, lds);
    grid.sync();
    if (PH & 2) { gate_scan(p, lds);
      pg8::Gemm g{h0, (const bf16_t*)(ws + WS_WIN), MT, NPROJ, DM}; pg8::StaticOrder S; S.init(MT, NPROJ, G, bx);
      EpiBf16B e{proj, NPROJ, (const float*)(ws + WS_BIAS)}; pg8::gemm_phase(lds, g, S, e); }
    xcd_barrier(xbar);
    if (DBL & 4) { phase2(p, lds, 15); xcd_barrier(xbar); }
    if (DBL & 0x200) { phase2(p, lds, 4); xcd_barrier(xbar); }
    if (DBL & 0x400) { phase2(p, lds, 1); xcd_barrier(xbar); }
    if (PH & 4) phase2(p, lds, 15);
    xcd_barrier(xbar);
    if (DBL & 8) { phase3(p, lds); xcd_barrier(xbar); }
    if (PH & 8) phase3(p, lds);
    xcd_barrier(xbar);
    if (PH & 16) { pg8::Gemm g{mix, (const bf16_t*)(ws + WS_WOUT), MT, DM, DM}; pg8::StaticOrder S; S.init(MT, DM, G, bx);
      EpiRes e{h0, p.out + O_Y}; pg8::gemm_phase(lds, g, S, e); }
    xcd_barrier(xbar);
    if (DBL & 32) { ln_rows<true>(p.out + O_Y, p.in[14], p.in[15], h0, nullptr); xcd_barrier(xbar); }
    if (PH & 32) ln_rows<true>(p.out + O_Y, p.in[14], p.in[15], h0, nullptr);
    xcd_barrier(xbar);
    if (DBL & 64) { pg8::Gemm g{h0, (const bf16_t*)(ws + WS_WGU), MT, 2 * DFF, DM}; pg8::StaticOrder S; S.init(MT, 2 * DFF, G, bx);
      EpiSwiglu e{act}; pg8::gemm_phase(lds, g, S, e); xcd_barrier(xbar); }
    if (PH & 64) { pg8::Gemm g{h0, (const bf16_t*)(ws + WS_WGU), MT, 2 * DFF, DM}; pg8::StaticOrder S; S.init(MT, 2 * DFF, G, bx);
      EpiSwiglu e{act}; pg8::gemm_phase(lds, g, S, e); }
    xcd_barrier(xbar);
    if (PH & 128) { pg8::Gemm g{act, (const bf16_t*)(ws + WS_WDN), MT, DM, DFF}; pg8::StaticOrder S; S.init(MT, DM, G, bx);
      EpiRes e{h0, p.out + O_Y}; pg8::gemm_phase(lds, g, S, e); }
    xcd_barrier(xbar);
    if (PH & 256) ln_rows<false>(p.out + O_Y, p.in[19], p.in[20], nullptr, p.out + O_Y);
}

extern "C" void kernel_launch(void* const* d_in, const int* in_sizes, int n_in, void* d_out, int out_size, void* d_ws, size_t ws_size, hipStream_t stream) {
    constexpr size_t kDynLds = 131072 + 64;
    static int grid_blocks = 0;
    if (!grid_blocks) {
        if (n_in != 21 || (size_t)out_size != O_END || ws_size < WS_END) { fprintf(stderr, "kernel_launch: unexpected shapes: n_in %d out %d ws %zu (need %zu)\n", n_in, out_size, ws_size, (size_t)WS_END); grid_blocks = -1; return; }
        int dev = 0, cus = 0, per_cu = 0;
        hipGetDevice(&dev);
        hipDeviceGetAttribute(&cus, hipDeviceAttributeMultiprocessorCount, dev);
        if (hipFuncSetAttribute((const void*)fwd_mega, hipFuncAttributeMaxDynamicSharedMemorySize, (int)kDynLds) != hipSuccess) { fprintf(stderr, "kernel_launch: hipFuncSetAttribute failed\n"); grid_blocks = -1; return; }
        if (hipOccupancyMaxActiveBlocksPerMultiprocessor(&per_cu, (const void*)fwd_mega, 512, kDynLds) != hipSuccess || per_cu < 1) { fprintf(stderr, "kernel_launch: occupancy query failed (%d)\n", per_cu); grid_blocks = -1; return; }
        if (per_cu > 1) per_cu = 1;
        grid_blocks = cus * per_cu;
    }
    if (grid_blocks < 0) return;
    if (hipMemsetAsync((char*)d_ws + WS_BAR, 0, XCD_BAR_WORDS * 4, stream) != hipSuccess) { fprintf(stderr, "kernel_launch: memset of the barrier words failed\n"); return; }
    Params p{};
    for (int i = 0; i < 21; ++i) p.in[i] = (const float*)d_in[i];
    p.out = (float*)d_out; p.ws = (unsigned char*)d_ws;
    void* args[] = {&p};
    hipError_t e = hipLaunchCooperativeKernel((const void*)fwd_mega, dim3(grid_blocks), dim3(512), args, kDynLds, stream);
    if (e != hipSuccess) fprintf(stderr, "cooperative launch failed: %s (grid %d)\n", hipGetErrorString(e), grid_blocks);
}
```

```cpp
#include <hip/hip_runtime.h>
#include <hip/hip_cooperative_groups.h>
#include <cstdio>
namespace cg = cooperative_groups;
namespace pg8 {
#define PG8_LAS __attribute__((address_space(3)))
typedef unsigned short bf16_t;
typedef short bf16x8 __attribute__((ext_vector_type(8)));
typedef float f32x4 __attribute__((ext_vector_type(4)));
typedef unsigned u32x4 __attribute__((ext_vector_type(4)));
constexpr int BM = 256, BK = 64, HALF = 128, HTB = HALF * BK * 2  , STAGE_BYTES = 8 * HTB, NXCD = 8, WGM = 8;

__host__ __device__ __forceinline__ int lds_byte(int r, int c) { const int st = (r >> 4) * 2 + (c >> 5), rr = r & 15, cc = c & 31, ob = rr * 64 + cc * 2; return st * 1024 + (ob ^ (((ob >> 9) & 1) << 5)); }
__host__ __device__ __forceinline__ void stage_rc(int b, int& R, int& C) { const int st = b / 1024, sb = b % 1024, swz = sb ^ (((sb >> 9) & 1) << 5); R = (st >> 1) * 16 + swz / 64; C = (st & 1) * 32 + (swz % 64) / 2; }
__host__ __device__ __forceinline__ int perm32(int rho) { const int n = rho >> 4, i = rho & 15; return 8 * (i >> 2) + 4 * n + (i & 3); }

struct Unit { int pm, pn, kt0, nkt; };
struct Gemm { const bf16_t* A; const bf16_t* Bt; int M, N, K; };
struct StaticOrder {
    int nM, nN, nwg, G, c;
    __host__ __device__ void init(int M, int N, int G_, int c_) { nM = M / BM; nN = N / BM; nwg = nM * nN; G = G_; c = c_; }
    __host__ __device__ bool next(int i, Unit& u) const {
        const long L = (long)i * G + c; if (L >= nwg) return false;
        int wgid = (int)L; { const int q = nwg / NXCD, r = nwg % NXCD, xcd = wgid % NXCD, off = wgid / NXCD; wgid = (xcd < r ? xcd * (q + 1) : r * (q + 1) + (xcd - r) * q) + off; }
        const int nig = WGM * nN, gid = wgid / nig, fm = gid * WGM, gsz = (nM - fm) < WGM ? (nM - fm) : WGM;
        u.pm = fm + ((wgid % nig) % gsz); u.pn = (wgid % nig) / gsz; u.kt0 = 0; u.nkt = 0; return true;
    }
    __device__ __forceinline__ void a_ready(const Unit&) const {}
    __device__ __forceinline__ void done(const Unit&) const {}
};
__device__ __forceinline__ unsigned cvt_pk_bf16(float lo, float hi) { unsigned r; asm volatile("v_cvt_pk_bf16_f32 %0, %1, %2" : "=v"(r) : "v"(lo), "v"(hi)); return r; }
template <class Epi, class Sched>
__device__ __forceinline__ void gemm_phase(PG8_LAS unsigned char* lds, const Gemm g, const Sched& S, const Epi& E) {
    int tid_ = threadIdx.x; asm volatile("" : "+v"(tid_)); const int tid = tid_, wid = __builtin_amdgcn_readfirstlane(tid >> 6), lane = tid & 63, wr = wid >> 2, wc = wid & 3, fr = lane & 15, fq = lane >> 4;
    const int K = g.K;
    unsigned voffA[2], voffB[2];
#pragma unroll
    for (int i = 0; i < 2; ++i) { int R, C; stage_rc(tid * 16 + i * 8192, R, C); const int Rb = Epi::PERM ? ((R & ~31) + perm32(R & 31)) : R;
        voffA[i] = (unsigned)(R * K + C) * 2u; voffB[i] = (unsigned)(Rb * K + C) * 2u; }
    const size_t kstep = (size_t)(BK * 2);
    const size_t hstep = (size_t)HALF * K * 2;
    const size_t tstep = 2 * hstep;
    const unsigned ldsw = (unsigned)wid * 1024u;
    const int aoff = lds_byte(wr * 64 + fr, fq * 8), boff = lds_byte(wc * 32 + fr, fq * 8);
#define PG8_SA(b, h) (((b) * 2 + (h)) * HTB)
#define PG8_SB(b, h) ((4 + (b) * 2 + (h)) * HTB)
#define PG8_STAGE(bufoff, gbase, voff) do { _Pragma("unroll") for (int _i = 0; _i < 2; ++_i) \
        __builtin_amdgcn_global_load_lds((const unsigned*)((const char*)(gbase) + (voff)[_i]), (PG8_LAS unsigned*)(lds + (bufoff) + ldsw + _i * 8192), 16, 0, 0); } while (0)
#define PG8_LDA(dst, b, h) do { _Pragma("unroll") for (int m = 0; m < 4; ++m) _Pragma("unroll") for (int k = 0; k < 2; ++k) dst[m][k] = *(const PG8_LAS bf16x8*)(lds + PG8_SA(b, h) + aoff + m * 2048 + k * 1024); } while (0)
#define PG8_LDB(dst, b, h) do { _Pragma("unroll") for (int n = 0; n < 2; ++n) _Pragma("unroll") for (int k = 0; k < 2; ++k) dst[n][k] = *(const PG8_LAS bf16x8*)(lds + PG8_SB(b, h) + boff + n * 2048 + k * 1024); } while (0)
#define PG8_MMA(ai, bj, At, Bt) do { __builtin_amdgcn_s_setprio(1); _Pragma("unroll") for (int m = 0; m < 4; ++m) _Pragma("unroll") for (int n = 0; n < 2; ++n) _Pragma("unroll") for (int k = 0; k < 2; ++k) \
        acc[ai][bj][m][n] = __builtin_amdgcn_mfma_f32_16x16x32_bf16(Bt[n][k], At[m][k], acc[ai][bj][m][n], 0, 0, 0); __builtin_amdgcn_s_setprio(0); } while (0)
#define PG8_WAIT_V(n) asm volatile("s_waitcnt vmcnt(" #n ")" ::: "memory")
#define PG8_WAIT_L(n) asm volatile("s_waitcnt lgkmcnt(" #n ")" ::: "memory")
#define PG8_BAR __builtin_amdgcn_s_barrier()
#define PG8_SCHED __builtin_amdgcn_sched_barrier(0)
    Unit cur, nxt; int ui = 0;
    if (!S.next(0, cur)) return;
    f32x4 acc[2][2][4][2];
#pragma unroll
    for (int a = 0; a < 2; ++a)
#pragma unroll
        for (int b = 0; b < 2; ++b)
#pragma unroll
            for (int m = 0; m < 4; ++m)
#pragma unroll
                for (int n = 0; n < 2; ++n) acc[a][b][m][n] = (f32x4){0.f, 0.f, 0.f, 0.f};
    bf16x8 At[4][2], B0[2][2], B1[2][2];
    const char* cA = (const char*)g.A + (size_t)cur.pm * tstep + (size_t)cur.kt0 * kstep; const char* cB = (const char*)g.Bt + (size_t)cur.pn * tstep + (size_t)cur.kt0 * kstep;
    S.a_ready(cur);
    PG8_STAGE(PG8_SB(0, 0), cB, voffB); PG8_STAGE(PG8_SA(0, 0), cA, voffA); PG8_STAGE(PG8_SB(0, 1), cB + hstep, voffB); PG8_STAGE(PG8_SA(0, 1), cA + hstep, voffA);
    if (wr == 1) PG8_BAR;
    PG8_WAIT_V(4); PG8_BAR;
    PG8_STAGE(PG8_SB(1, 0), cB + kstep, voffB); PG8_STAGE(PG8_SA(1, 0), cA + kstep, voffA); PG8_STAGE(PG8_SB(1, 1), cB + hstep + kstep, voffB);
    PG8_WAIT_V(6); PG8_BAR;
    for (;;) {
        const bool has_next = S.next(ui + 1, nxt);
        const char* nA = has_next ? (const char*)g.A + (size_t)nxt.pm * tstep + (size_t)nxt.kt0 * kstep : cA; const char* nB = has_next ? (const char*)g.Bt + (size_t)nxt.pn * tstep + (size_t)nxt.kt0 * kstep : cB;
        const int nt = cur.nkt;
        for (int t = 0; t < nt; t += 2) {
            const bool last = (t == nt - 2);
            const char* a1 = cA + (size_t)(t + 1) * kstep;
            const char* a2 = last ? nA : cA + (size_t)(t + 2) * kstep; const char* b2 = last ? nB : cB + (size_t)(t + 2) * kstep;
            const char* a3 = a2 + kstep; const char* b3 = b2 + kstep;
            if (last && has_next) S.a_ready(nxt);
            PG8_LDB(B0, 0, 0); PG8_SCHED; PG8_LDA(At, 0, 0); PG8_STAGE(PG8_SA(1, 1), a1 + hstep, voffA);
            PG8_WAIT_L(8); PG8_BAR; PG8_WAIT_L(0); PG8_MMA(0, 0, At, B0); PG8_BAR; PG8_SCHED;
            PG8_LDB(B1, 0, 1); PG8_STAGE(PG8_SB(0, 0), b2, voffB);
            PG8_BAR; PG8_WAIT_L(0); PG8_MMA(0, 1, At, B1); PG8_BAR;
            PG8_LDA(At, 0, 1); PG8_STAGE(PG8_SA(0, 0), a2, voffA);
            PG8_BAR; PG8_WAIT_L(0); PG8_MMA(1, 0, At, B0); PG8_BAR; PG8_SCHED;
            PG8_STAGE(PG8_SB(0, 1), b2 + hstep, voffB);
            PG8_WAIT_V(6); PG8_BAR; PG8_MMA(1, 1, At, B1); PG8_BAR;
            PG8_LDB(B0, 1, 0); PG8_SCHED; PG8_LDA(At, 1, 0); PG8_STAGE(PG8_SA(0, 1), a2 + hstep, voffA);
            PG8_WAIT_L(8); PG8_BAR; PG8_WAIT_L(0); PG8_MMA(0, 0, At, B0); PG8_BAR; PG8_SCHED;
            PG8_LDB(B1, 1, 1); PG8_STAGE(PG8_SB(1, 0), b3, voffB);
            PG8_BAR; PG8_WAIT_L(0); PG8_MMA(0, 1, At, B1); PG8_BAR;
            PG8_LDA(At, 1, 1); PG8_STAGE(PG8_SA(1, 0), a3, voffA);
            PG8_BAR; PG8_WAIT_L(0); PG8_MMA(1, 0, At, B0); PG8_BAR; PG8_SCHED;
            PG8_STAGE(PG8_SB(1, 1), b3 + hstep, voffB);
            PG8_WAIT_V(6); PG8_BAR; PG8_MMA(1, 1, At, B1); PG8_BAR;
        }
        if constexpr (!Epi::AFTER_DRAIN) { E(acc, cur, wr, wc, fr, fq); S.done(cur); }
        if (!has_next) break;
#pragma unroll
        for (int a = 0; a < 2; ++a)
#pragma unroll
            for (int b = 0; b < 2; ++b)
#pragma unroll
                for (int m = 0; m < 4; ++m)
#pragma unroll
                    for (int n = 0; n < 2; ++n) acc[a][b][m][n] = (f32x4){0.f, 0.f, 0.f, 0.f};
        cur = nxt; cA = nA; cB = nB; ++ui;
    }
    PG8_WAIT_V(0);
    if (wr == 0) PG8_BAR;
    PG8_BAR;
    if constexpr (Epi::AFTER_DRAIN) { E.fused(acc, cur, wr, wc, fr, fq, lds, wid, lane); S.done(cur); }
#undef PG8_SA
#undef PG8_SB
#undef PG8_STAGE
#undef PG8_LDA
#undef PG8_LDB
#undef PG8_MMA
#undef PG8_WAIT_V
#undef PG8_WAIT_L
#undef PG8_BAR
#undef PG8_SCHED
}
}

using pg8::bf16_t; using pg8::bf16x8; using pg8::f32x4; using pg8::u32x4;
#define LAS __attribute__((address_space(3)))
typedef unsigned u32x2 __attribute__((ext_vector_type(2)));

constexpr int DM = 1024, NB = 8, SEQ = 8192, DB = 32, DS = 32;
constexpr int MP = NB * SEQ, MS = DB * DS, MT = MP + MS;
constexpr int NPROJ = 2560, INCOLS = 2568, DFF = 2816;
constexpr int SCN = 16;
constexpr float ALPHA = 1.189207115002721f, KSCALE = 0.08838834764831845f, LN_EPS = 1e-5f;

constexpr size_t al256(size_t x) { return (x + 255) & ~(size_t)255; }
constexpr size_t WS_BAR = 0;
constexpr size_t WS_WIN = 16384;
constexpr size_t WS_WOUT = WS_WIN + al256((size_t)NPROJ * DM * 2);
constexpr size_t WS_WGU = WS_WOUT + al256((size_t)DM * DM * 2);
constexpr size_t WS_WDN = WS_WGU + al256((size_t)2 * DFF * DM * 2);
constexpr size_t WS_WPOOL = WS_WDN + al256((size_t)DM * DFF * 2);
constexpr size_t WS_BIAS = WS_WPOOL + al256((size_t)4 * 128 * 128 * 2);
constexpr size_t WS_GATES = WS_BIAS + al256((size_t)NPROJ * 4);
constexpr size_t WS_MTAB = WS_GATES + al256((size_t)MT * 8 * 4);
constexpr size_t WS_BTAB = WS_MTAB + al256((size_t)32 * 132 * 4);
constexpr size_t WS_GTAB = WS_BTAB + al256((size_t)32 * 128 * 4);
constexpr size_t WS_DST = WS_GTAB + al256((size_t)MT * 4 * 16);
constexpr size_t WS_DN = WS_DST + al256((size_t)224 * 16384 * 4);
constexpr size_t WS_H0 = WS_DN + al256((size_t)224 * 128 * 4);
constexpr size_t WS_PROJ = WS_H0 + al256((size_t)MT * DM * 2);
constexpr size_t WS_MIX = WS_PROJ + al256((size_t)MT * NPROJ * 2);
constexpr size_t WS_END = WS_MIX + al256((size_t)MT * DM * 2);
constexpr size_t WS_SLAB = WS_END;
constexpr size_t WS_END2 = WS_SLAB + (size_t)11 * 1024 * 1024 * 4;
constexpr size_t WS_ACT = WS_PROJ;
static_assert((size_t)MT * DFF * 2 <= WS_END - WS_PROJ, "act does not fit");

constexpr size_t O_Y = 0;
constexpr size_t O_POOLP = (size_t)MT * DM;
constexpr size_t O_CP = O_POOLP + (size_t)NB * 15 * 512;
constexpr size_t O_NP = O_CP + (size_t)NB * 4 * 16384;
constexpr size_t O_MP = O_NP + (size_t)NB * 4 * 128;
constexpr size_t O_POOLS = O_MP + (size_t)NB * 4;
constexpr size_t O_CS = O_POOLS + (size_t)DB * 15 * 512;
constexpr size_t O_NS = O_CS + (size_t)DB * 4 * 16384;
constexpr size_t O_MS = O_NS + (size_t)DB * 4 * 128;
constexpr size_t O_END = O_MS + (size_t)DB * 4;

struct Params { const float* in[21]; float* out; unsigned char* ws; };

__device__ __forceinline__ int fresh_tid() { int t = threadIdx.x; asm volatile("" : "+v"(t)); return t; }
__device__ __forceinline__ float bf2f(unsigned x) { return __uint_as_float(x << 16); }
__device__ __forceinline__ float bflo(unsigned w) { return __uint_as_float(w << 16); }
__device__ __forceinline__ float bfhi(unsigned w) { return __uint_as_float(w & 0xffff0000u); }
__device__ __forceinline__ unsigned pk2(float lo, float hi) { return pg8::cvt_pk_bf16(lo, hi); }
__device__ __forceinline__ float wave_sum(float v) {
#pragma unroll
    for (int o = 32; o; o >>= 1) v += __shfl_xor(v, o);
    return v; }
__device__ __forceinline__ float wave_max(float v) {
#pragma unroll
    for (int o = 32; o; o >>= 1) v = fmaxf(v, __shfl_xor(v, o));
    return v; }
__device__ __forceinline__ float scan_sum(float x, int lane) {
#pragma unroll
    for (int o = 1; o < 64; o <<= 1) { const float y = __shfl_up(x, o); if (lane >= o) x += y; }
    return x; }
__device__ __forceinline__ float scan_max(float x, int lane) {
#pragma unroll
    for (int o = 1; o < 64; o <<= 1) { const float y = __shfl_up(x, o); if (lane >= o) x = fmaxf(x, y); }
    return x; }
__device__ __forceinline__ float logsigmoid(float x) { return fminf(x, 0.f) - log1pf(expf(-fabsf(x))); }
__device__ __forceinline__ bf16x8 ldfrag(LAS const unsigned char* base, int row, int strideB, int kbyte) { return *(LAS const bf16x8*)(base + row * strideB + kbyte); }
#define LDS_BARRIER() do { asm volatile("s_waitcnt lgkmcnt(0)" ::: "memory"); __builtin_amdgcn_s_barrier(); asm volatile("" ::: "memory"); } while (0)
#define MFMA16(a, b, c) __builtin_amdgcn_mfma_f32_16x16x32_bf16((a), (b), (c), 0, 0, 0)

#define XB_TMO      128
#define XB_XCNT(j)  (256  + 64 * (j))
#define XB_XSUB(j)  (1280 + 64 * (j))
#define XB_XGEN(j)  (2304 + 64 * (j))
#define XB_TOP      3328
#define XB_TOPGEN   3392
#define XCD_BAR_WORDS 3456
#define XB_SPIN_CAP (1u << 18)
__device__ __forceinline__ unsigned xb_ld(unsigned* p)              { return __hip_atomic_load(p, __ATOMIC_RELAXED, __HIP_MEMORY_SCOPE_AGENT); }
__device__ __forceinline__ unsigned xb_add(unsigned* p, unsigned v) { return __hip_atomic_fetch_add(p, v, __ATOMIC_RELAXED, __HIP_MEMORY_SCOPE_AGENT); }
__device__ __forceinline__ unsigned xb_xcc_id() { return (unsigned)__builtin_amdgcn_s_getreg((3 << 11) | 20) & 0xFu; }
#define XB_SPIN(cond, bar) do { unsigned _sp = 0; while (cond) { __builtin_amdgcn_s_sleep(1); \
    if ((++_sp & 255u) == 0u) { if (xb_ld(&(bar)[XB_TMO])) break; if (_sp > XB_SPIN_CAP) { atomicAdd(&(bar)[XB_TMO], 1u); break; } } } } while (0)

struct XcdBarrier {
    unsigned* bar; unsigned x;
    volatile LAS unsigned* st;
};

__device__ __forceinline__ XcdBarrier xcd_barrier_post(unsigned* bar, volatile LAS unsigned* st) {
    XcdBarrier b; b.bar = bar; b.x = xb_xcc_id(); b.st = st;
    if (threadIdx.x == 0) (void)xb_add(&bar[XB_XCNT(b.x)], 1u);
    return b;
}
__device__ __forceinline__ void xcd_barrier_complete(unsigned* bar, unsigned x, unsigned& nloc, unsigned& nx) {
    const unsigned G = gridDim.x * gridDim.y * gridDim.z;
    unsigned sum, cnt, mine, sp = 0u;
    for (;;) {
        sum = 0u; cnt = 0u; mine = 0u;
#pragma unroll
        for (unsigned j = 0; j < 16; ++j) { const unsigned c = xb_ld(&bar[XB_XCNT(j)]); sum += c; cnt += (c > 0u) ? 1u : 0u; mine = (j == x) ? c : mine; }
        if (sum == G) break;
        __builtin_amdgcn_s_sleep(1);
        if ((++sp & 255u) == 0u) { if (xb_ld(&bar[XB_TMO])) break; if (sp > XB_SPIN_CAP) { atomicAdd(&bar[XB_TMO], 1u); break; } }
    }
    nloc = mine > 0u ? mine : 1u; nx = cnt > 0u ? cnt : 1u;
}

__device__ __forceinline__ void xcd_barrier(const XcdBarrier& b) {
    asm volatile("s_waitcnt vmcnt(0)" ::: "memory");
    __syncthreads();
    if (threadIdx.x == 0) {
        unsigned* bar = b.bar;
        __builtin_amdgcn_s_waitcnt(0);
        unsigned nloc = b.st[0], nx = b.st[1];
        if (nloc == 0u) { xcd_barrier_complete(bar, b.x, nloc, nx); b.st[0] = nloc; b.st[1] = nx; }
        const unsigned old = xb_add(&bar[XB_XSUB(b.x)], 1u);
        const unsigned gen = old / nloc;
        if (old + 1u == (gen + 1u) * nloc) {
            __builtin_amdgcn_fence(__ATOMIC_RELEASE, "agent");
            asm volatile("s_waitcnt vmcnt(0)" ::: "memory");
            const unsigned og = xb_add(&bar[XB_TOP], 1u);
            const unsigned tg = og / nx;
            if (og + 1u == (tg + 1u) * nx) xb_add(&bar[XB_TOPGEN], 1u);
            else XB_SPIN(xb_ld(&bar[XB_TOPGEN]) == tg, bar);
            __builtin_amdgcn_fence(__ATOMIC_ACQUIRE, "agent");
            xb_add(&bar[XB_XGEN(b.x)], 1u);
            asm volatile("s_waitcnt vmcnt(0)" ::: "memory");
        } else {
            XB_SPIN(xb_ld(&bar[XB_XGEN(b.x)]) == gen, bar);
            __builtin_amdgcn_fence(__ATOMIC_ACQUIRE, "agent");
            asm volatile("s_waitcnt vmcnt(0)" ::: "memory");
        }
    }
    __syncthreads();
}

struct SplitOrder {
    int nN, nP, S, nkt, G, c;
    __device__ __forceinline__ void init(int N, int Ktiles, int S_, int G_, int c_) { nN = N / 256; nP = 256 * nN; S = S_; nkt = Ktiles; G = G_; c = c_; }
    __device__ __forceinline__ bool next(int i, pg8::Unit& u) const {
        const long L = (long)i * G + c;
        if (L >= nP + 4 * nN * S) return false;
        int pm, pn, k0 = 0, kn = nkt;
        if (L < nP) { int wgid = (int)L; { const int q = nP / 8, xcd = wgid % 8, off = wgid / 8; wgid = xcd * q + off; }
            const int nig = 8 * nN, gid = wgid / nig, fm = gid * 8; pm = fm + ((wgid % nig) % 8); pn = (wgid % nig) / 8; }
        else { const int j = (int)(L - nP), su = j / S, sl = j - su * S; pm = 256 + su / nN; pn = su % nN; kn = nkt / S; k0 = sl * kn; }
        u.pm = pm; u.pn = pn; u.kt0 = k0; u.nkt = kn; return true;
    }
    __device__ __forceinline__ void a_ready(const pg8::Unit&) const {}
    __device__ __forceinline__ void done(const pg8::Unit&) const {}
};

struct EpiBf16B {
    static constexpr bool PERM = true, AFTER_DRAIN = false;
    bf16_t* O; int ldc; const float* bias;
    __device__ __forceinline__ void operator()(const f32x4 (&acc)[2][2][4][2], const pg8::Unit& u, int wr, int wc, int fr, int fq) const {
        const int row0 = u.pm * 256 + wr * 64 + fr, col0 = u.pn * 256 + wc * 32 + 8 * fq;
        f32x4 bv[2][2];
#pragma unroll
        for (int bj = 0; bj < 2; ++bj)
#pragma unroll
            for (int n = 0; n < 2; ++n) bv[bj][n] = *(const f32x4*)(bias + col0 + bj * 128 + 4 * n);
#pragma unroll
        for (int ai = 0; ai < 2; ++ai)
#pragma unroll
            for (int m = 0; m < 4; ++m) { bf16_t* rowp = O + (size_t)(row0 + ai * 128 + m * 16) * ldc + col0;
#pragma unroll
                for (int bj = 0; bj < 2; ++bj) { const f32x4 v0 = acc[ai][bj][m][0] + bv[bj][0], v1 = acc[ai][bj][m][1] + bv[bj][1];
                    u32x4 w; w.x = pk2(v0[0], v0[1]); w.y = pk2(v0[2], v0[3]); w.z = pk2(v1[0], v1[1]); w.w = pk2(v1[2], v1[3]);
                    *(u32x4*)(rowp + bj * 128) = w; } }
    }
};
struct EpiRes {
    static constexpr bool PERM = false, AFTER_DRAIN = false;
    const bf16_t* base; float* out; float* slab; int nkt_full;
    __device__ __forceinline__ void operator()(const f32x4 (&acc)[2][2][4][2], const pg8::Unit& u, int wr, int wc, int fr, int fq) const {
        const int row0 = u.pm * 256 + wr * 64 + fr, col0 = u.pn * 256 + wc * 32 + 4 * fq;
        if (u.nkt != nkt_full) {
            float* sp = slab + (size_t)(u.kt0 / u.nkt) * (1024 * 1024) + (size_t)(row0 - MP) * DM + col0;
#pragma unroll
            for (int ai = 0; ai < 2; ++ai)
#pragma unroll
                for (int m = 0; m < 4; ++m)
#pragma unroll
                    for (int bj = 0; bj < 2; ++bj)
#pragma unroll
                        for (int n = 0; n < 2; ++n) *(f32x4*)(sp + (size_t)(ai * 128 + m * 16) * DM + bj * 128 + n * 16) = acc[ai][bj][m][n];
            return; }
#pragma unroll
        for (int ai = 0; ai < 2; ++ai)
#pragma unroll
            for (int m = 0; m < 4; ++m) { const size_t off = (size_t)(row0 + ai * 128 + m * 16) * DM + col0;
#pragma unroll
                for (int bj = 0; bj < 2; ++bj)
#pragma unroll
                    for (int n = 0; n < 2; ++n) { const u32x2 b = *(const u32x2*)(base + off + bj * 128 + n * 16);
                        f32x4 o; o[0] = ALPHA * bflo(b.x) + acc[ai][bj][m][n][0]; o[1] = ALPHA * bfhi(b.x) + acc[ai][bj][m][n][1];
                        o[2] = ALPHA * bflo(b.y) + acc[ai][bj][m][n][2]; o[3] = ALPHA * bfhi(b.y) + acc[ai][bj][m][n][3];
                        *(f32x4*)(out + off + bj * 128 + n * 16) = o; } }
    }
};
__device__ __forceinline__ float swiglu(float g, float u) { return g * u / (1.0f + __expf(-g)); }
struct EpiSwiglu {
    static constexpr bool PERM = true, AFTER_DRAIN = false;
    bf16_t* O;
    __device__ __forceinline__ void operator()(const f32x4 (&acc)[2][2][4][2], const pg8::Unit& u, int wr, int wc, int fr, int fq) const {
        const int row0 = u.pm * 256 + wr * 64 + fr, col0 = u.pn * 128 + wc * 32 + 8 * fq;
#pragma unroll
        for (int ai = 0; ai < 2; ++ai)
#pragma unroll
            for (int m = 0; m < 4; ++m) { bf16_t* rowp = O + (size_t)(row0 + ai * 128 + m * 16) * DFF + col0;
                const f32x4 g0 = acc[ai][0][m][0], g1 = acc[ai][0][m][1], u0 = acc[ai][1][m][0], u1 = acc[ai][1][m][1];
                u32x4 w; w.x = pk2(swiglu(g0[0], u0[0]), swiglu(g0[1], u0[1])); w.y = pk2(swiglu(g0[2], u0[2]), swiglu(g0[3], u0[3]));
                w.z = pk2(swiglu(g1[0], u1[0]), swiglu(g1[1], u1[1])); w.w = pk2(swiglu(g1[2], u1[2]), swiglu(g1[3], u1[3]));
                *(u32x4*)rowp = w; }
    }
};

constexpr int TR_TILES = 640 + 256 + 704 + 704 + 704 + 16;
struct TileDesc { const float* src; bf16_t* dst; int ld, K, mode, k0, n0; };
__device__ __forceinline__ TileDesc tile_desc(const Params& p, int t) {
    TileDesc d; unsigned char* ws = p.ws;
    if (t < 640) { d.src = p.in[8]; d.ld = INCOLS; d.K = DM; d.mode = 3; d.dst = (bf16_t*)(ws + WS_WIN); }
    else if (t < 896) { t -= 640; d.src = p.in[13]; d.ld = DM; d.K = DM; d.mode = 0; d.dst = (bf16_t*)(ws + WS_WOUT); }
    else if (t < 1600) { t -= 896; d.src = p.in[16]; d.ld = DFF; d.K = DM; d.mode = 1; d.dst = (bf16_t*)(ws + WS_WGU); }
    else if (t < 2304) { t -= 1600; d.src = p.in[17]; d.ld = DFF; d.K = DM; d.mode = 2; d.dst = (bf16_t*)(ws + WS_WGU); }
    else if (t < 3008) { t -= 2304; d.src = p.in[18]; d.ld = DM; d.K = DFF; d.mode = 0; d.dst = (bf16_t*)(ws + WS_WDN); }
    else { t -= 3008; const int g = t >> 2; t &= 3; d.src = p.in[10] + g * 16384; d.ld = 128; d.K = 128; d.mode = 0; d.dst = (bf16_t*)(ws + WS_WPOOL) + g * 16384; }
    const int nkt = d.K >> 6; d.k0 = (t % nkt) * 64; d.n0 = (t / nkt) * 64; return d;
}

__device__ __forceinline__ void phase0(const Params& p, LAS unsigned char* lds) {
    const int tid = fresh_tid(), lane = tid & 63, wave = tid >> 6, G = gridDim.x, bx = blockIdx.x;
    unsigned char* ws = p.ws;
    LAS float* T = (LAS float*)lds;
    {
        const int r = tid >> 3, cs = (tid & 7) * 8;
        int t = bx; float4 a = make_float4(0.f, 0.f, 0.f, 0.f), b = a; TileDesc d = tile_desc(p, t < TR_TILES ? t : 0);
        if (t < TR_TILES) { const float* s = d.src + (size_t)(d.k0 + r) * d.ld + d.n0 + cs; a = *(const float4*)s; b = *(const float4*)(s + 4); }
#pragma unroll 1
        for (; t < TR_TILES; t += G) {
            { LAS float* q = T + r * 65 + cs; q[0] = a.x; q[1] = a.y; q[2] = a.z; q[3] = a.w; q[4] = b.x; q[5] = b.y; q[6] = b.z; q[7] = b.w; }
            const TileDesc dn = tile_desc(p, t + G < TR_TILES ? t + G : 0);
            if (t + G < TR_TILES) { const float* s = dn.src + (size_t)(dn.k0 + r) * dn.ld + dn.n0 + cs; a = *(const float4*)s; b = *(const float4*)(s + 4); }
            LDS_BARRIER();
            { const int n = tid >> 3, ks = (tid & 7) * 8, gn = d.n0 + n; float v[8];
#pragma unroll
              for (int i = 0; i < 8; ++i) v[i] = T[(ks + i) * 65 + n];
              const float sc = (d.mode == 3 && gn >= 1024 && gn < 1536) ? KSCALE : 1.0f;
              const int drow = (d.mode == 1) ? 256 * (gn >> 7) + (gn & 127) : (d.mode == 2) ? 256 * (gn >> 7) + 128 + (gn & 127) : gn;
              u32x4 w; w.x = pk2(v[0] * sc, v[1] * sc); w.y = pk2(v[2] * sc, v[3] * sc); w.z = pk2(v[4] * sc, v[5] * sc); w.w = pk2(v[6] * sc, v[7] * sc);
              *(u32x4*)(d.dst + (size_t)drow * d.K + d.k0 + ks) = w; }
            LDS_BARRIER();
            d = dn;
        }
    }
    { float* bs = (float*)(ws + WS_BIAS); const float* b_in = p.in[9];
      for (int i = bx * 512 + tid; i < NPROJ; i += G * 512) bs[i] = b_in[i] * ((i >= 1024 && i < 1536) ? KSCALE : 1.0f); }
    f32x4 wlo[4][4], whi[4][4];
    { const float* w_in = p.in[8];
#pragma unroll
      for (int i = 0; i < 4; ++i)
#pragma unroll
          for (int e = 0; e < 4; ++e) { const float* wp = w_in + (size_t)(i * 256 + lane * 4 + e) * INCOLS + NPROJ; wlo[i][e] = *(const f32x4*)wp; whi[i][e] = *(const f32x4*)(wp + 4); } }
    const float* lg = p.in[6]; const float* lb = p.in[7]; const float* b_in = p.in[9];
    bf16_t* h0 = (bf16_t*)(ws + WS_H0); float* gates = (float*)(ws + WS_GATES);
    const float gb_perm = lane < 8 ? b_in[NPROJ + (((lane & 1) << 2) | (lane & 2) | ((lane >> 2) & 1))] : 0.f;
    int row = bx * 8 + wave; float4 v[4];
    if (row < MT) { const float* x = row < MP ? p.in[0] + (size_t)row * DM : p.in[1] + (size_t)(row - MP) * DM;
#pragma unroll
        for (int i = 0; i < 4; ++i) v[i] = *(const float4*)(x + i * 256 + lane * 4); }
#pragma unroll 1
    for (; row < MT; row += G * 8) {
        const int nrow = row + G * 8; float4 nv[4];
        if (nrow < MT) { const float* x = nrow < MP ? p.in[0] + (size_t)nrow * DM : p.in[1] + (size_t)(nrow - MP) * DM;
#pragma unroll
            for (int i = 0; i < 4; ++i) nv[i] = *(const float4*)(x + i * 256 + lane * 4); }
        else {
#pragma unroll
            for (int i = 0; i < 4; ++i) nv[i] = make_float4(0.f, 0.f, 0.f, 0.f); }
        float s = 0.f;
#pragma unroll
        for (int i = 0; i < 4; ++i) s += (v[i].x + v[i].y) + (v[i].z + v[i].w);
        const float mu = wave_sum(s) * (1.0f / DM);
        float q = 0.f;
#pragma unroll
        for (int i = 0; i < 4; ++i) { v[i].x -= mu; v[i].y -= mu; v[i].z -= mu; v[i].w -= mu; q += (v[i].x * v[i].x + v[i].y * v[i].y) + (v[i].z * v[i].z + v[i].w * v[i].w); }
        const float rstd = rsqrtf(wave_sum(q) * (1.0f / DM) + LN_EPS);
        f32x4 glo = (f32x4){0.f, 0.f, 0.f, 0.f}, ghi = glo;
#pragma unroll
        for (int i = 0; i < 4; ++i) { const int c = i * 256 + lane * 4; const float4 gg = *(const float4*)(lg + c), bb = *(const float4*)(lb + c);
            float4 y; y.x = v[i].x * rstd * gg.x + bb.x; y.y = v[i].y * rstd * gg.y + bb.y; y.z = v[i].z * rstd * gg.z + bb.z; y.w = v[i].w * rstd * gg.w + bb.w;
            u32x2 w; w.x = pk2(y.x, y.y); w.y = pk2(y.z, y.w); *(u32x2*)(h0 + (size_t)row * DM + c) = w;
            glo += y.x * wlo[i][0] + y.y * wlo[i][1] + y.z * wlo[i][2] + y.w * wlo[i][3];
            ghi += y.x * whi[i][0] + y.y * whi[i][1] + y.z * whi[i][2] + y.w * whi[i][3]; }
        { const bool b0 = lane & 1, b1 = lane & 2, b2 = lane & 4;
          f32x4 k4, s4;
#pragma unroll
          for (int j = 0; j < 4; ++j) { k4[j] = b0 ? ghi[j] : glo[j]; s4[j] = b0 ? glo[j] : ghi[j]; }
#pragma unroll
          for (int j = 0; j < 4; ++j) k4[j] += __shfl_xor(s4[j], 1);
          float k2a = b1 ? k4[2] : k4[0], k2b = b1 ? k4[3] : k4[1];
          k2a += __shfl_xor(b1 ? k4[0] : k4[2], 2); k2b += __shfl_xor(b1 ? k4[1] : k4[3], 2);
          float k1 = b2 ? k2b : k2a; k1 += __shfl_xor(b2 ? k2a : k2b, 4);
          k1 += __shfl_xor(k1, 8); k1 += __shfl_xor(k1, 16); k1 += __shfl_xor(k1, 32);
          const int gidx = ((lane & 1) << 2) | (lane & 2) | ((lane >> 2) & 1);
          if (lane < 8) gates[(size_t)row * 8 + gidx] = k1 + gb_perm; }
#pragma unroll
        for (int i = 0; i < 4; ++i) v[i] = nv[i];
    }
}

__device__ __forceinline__ void gate_scan(const Params& p, LAS unsigned char* lds) {
    const int tid = fresh_tid(), lane = tid & 63, wave = tid >> 6;
    const float* gates = (const float*)(p.ws + WS_GATES); float* mtab = (float*)(p.ws + WS_MTAB); float* btab = (float*)(p.ws + WS_BTAB);
    f32x4* gtab = (f32x4*)(p.ws + WS_GTAB);
    LAS float* sA = (LAS float*)lds; LAS float* sB = sA + 128; LAS float* sM = sA + 256;
    for (int chain = blockIdx.x; chain < 32; chain += gridDim.x) {
        const int batch = chain >> 2, head = chain & 3;
        for (int c = wave; c < 128; c += 8) {
            const size_t row = (size_t)batch * SEQ + c * 64 + lane;
            const float ig = gates[row * 8 + head], fg = gates[row * 8 + 4 + head];
            const float b = scan_sum(logsigmoid(fg), lane); const float A = wave_max(ig - b); const float bl = __shfl(b, 63);
            if (lane == 0) { sA[c] = A; sB[c] = bl; }
        }
        __syncthreads();
        if (tid == 0) { float m = 0.f; mtab[chain * 132] = 0.f; sM[0] = 0.f;
            for (int c = 0; c < 128; ++c) { m = sB[c] + fmaxf(m, sA[c]); mtab[chain * 132 + c + 1] = m; sM[c + 1] = m; btab[chain * 128 + c] = sB[c]; }
            p.out[O_MP + chain] = m; }
        __syncthreads();
        for (int c = wave; c < 128; c += 8) {
            const size_t row = (size_t)batch * SEQ + c * 64 + lane;
            const float ig = gates[row * 8 + head], fg = gates[row * 8 + 4 + head];
            const float b = scan_sum(logsigmoid(fg), lane); const float a = ig - b; const float m_prev = sM[c];
            const float M = fmaxf(m_prev, scan_max(a, lane));
            gtab[row * 4 + head] = (f32x4){a, M, expf(m_prev - M), expf(-(b + M))};
        }
        __syncthreads();
    }
    for (int s = blockIdx.x * 8 + wave; s < DB * 4; s += gridDim.x * 8) {
        const int b_ = s >> 2, head = s & 3; const bool valid = lane < 32; const size_t row = (size_t)MP + b_ * 32 + (lane & 31);
        const float ig = gates[row * 8 + head], fg = gates[row * 8 + 4 + head]; const float m_prev = p.in[5][s];
        const float b = scan_sum(valid ? logsigmoid(fg) : 0.f, lane); const float a = valid ? ig - b : -1e30f;
        const float M = fmaxf(m_prev, scan_max(a, lane));
        if (valid) gtab[row * 4 + head] = (f32x4){a, M, expf(m_prev - M), expf(-(b + M))};
        if (lane == 31) p.out[O_MS + s] = b + M;
    }
}

constexpr int L_Q = 0, L_K = 17408, L_KW = 34816, L_V = 52224, L_CT = 69632, L_S = 104448, L_G = 113664;
typedef short s16x4 __attribute__((ext_vector_type(4)));
__device__ __forceinline__ bf16x8 ldfrag_tr(LAS const unsigned char* base, int row0, int col0, int lane) {
    const int g = lane >> 4, q = (lane & 15) >> 2, pp = lane & 3;
    LAS const unsigned char* a = base + (row0 + 8 * g + q) * 272 + (col0 + 4 * pp) * 2;
    const s16x4 lo = __builtin_amdgcn_ds_read_tr16_b64_v4i16((LAS s16x4*)a);
    const s16x4 hi = __builtin_amdgcn_ds_read_tr16_b64_v4i16((LAS s16x4*)(a + 4 * 272));
    return __builtin_shufflevector(lo, hi, 0, 1, 2, 3, 4, 5, 6, 7);
}

template <bool FULL>
__device__ __forceinline__ void mlstm_run(const Params& p, LAS unsigned char* lds, f32x4 (&accC)[2][4], f32x4 (&accN)[2], int row0, int head, int nch, int L) {
    const int tid = fresh_tid(), lane = tid & 63, wave = __builtin_amdgcn_readfirstlane(tid >> 6), l15 = lane & 15, l4 = lane >> 4, st = wave & 3, tp = wave >> 2;
    const bf16_t* proj = (const bf16_t*)(p.ws + WS_PROJ); const f32x4* gtab = (const f32x4*)(p.ws + WS_GTAB);
    bf16_t* mix = (bf16_t*)(p.ws + WS_MIX);
    LAS unsigned short* sQ = (LAS unsigned short*)(lds + L_Q); LAS unsigned short* sK = (LAS unsigned short*)(lds + L_K);
    LAS unsigned short* sKW = (LAS unsigned short*)(lds + L_KW); LAS unsigned short* sV = (LAS unsigned short*)(lds + L_V);
    LAS unsigned short* sS = (LAS unsigned short*)(lds + L_S); LAS float* sH = (LAS float*)(lds + L_Q);
    LAS float* gA = (LAS float*)(lds + L_G); LAS float* gM = gA + 64; LAS float* gDec = gA + 128; LAS float* gEinv = gA + 192; LAS float* gW = gA + 256;
    LAS float* gQn = gA + 320; LAS float* gDi = gA + 384; LAS float* gN = gA + 448; LAS float* scal = gA + 576; LAS float* gNg = gA + 584;
    const bf16x8 ones = (bf16x8){0x3F80, 0x3F80, 0x3F80, 0x3F80, 0x3F80, 0x3F80, 0x3F80, 0x3F80};
    const int tok0 = tid >> 4, dsg = tid & 15;
    const int orow = tid >> 3, oseg = tid & 7;
    u32x4 kq[2], kk[2], kv[2]; f32x4 pgt = (f32x4){0.f, 0.f, 0.f, 0.f};
    if (FULL && tid < 128) gNg[tid] = p.in[12][head * 128 + tid];
#pragma unroll
    for (int i = 0; i < 2; ++i) { const int tok = tok0 + 32 * i; const bool valid = tok < L; const u32x4 z = (u32x4){0u, 0u, 0u, 0u};
        const bf16_t* src = proj + (size_t)(row0 + tok) * NPROJ + head * 128 + dsg * 8;
        kk[i] = valid ? *(const u32x4*)(src + 1024) : z; kv[i] = valid ? *(const u32x4*)(src + 1536) : z;
        if (FULL) kq[i] = valid ? *(const u32x4*)(src + 512) : z; else kq[i] = z; }
    if (wave == 0 && lane < L) pgt = gtab[(size_t)(row0 + lane) * 4 + head];
#pragma unroll 1
    for (int c = 0; c < nch; ++c) {
        const int r0 = row0 + c * 64;
        if (wave == 0) {
            const bool valid = lane < L; const float a = valid ? pgt[0] : -1e30f; const float Ml = __shfl(pgt[1], L - 1);
            gA[lane] = a; gM[lane] = valid ? pgt[1] : Ml; gDec[lane] = valid ? pgt[2] : 0.f; gEinv[lane] = valid ? pgt[3] : 1.f; gW[lane] = valid ? __expf(a - Ml) : 0.f;
            if (lane == L - 1) scal[0] = pgt[2];
        }
        if (FULL) {
#pragma unroll
            for (int i = 0; i < 2; ++i)
#pragma unroll
                for (int n = 0; n < 4; ++n) { u32x2 w; w.x = pk2(accC[i][n][0], accC[i][n][1]); w.y = pk2(accC[i][n][2], accC[i][n][3]);
                    *(LAS u32x2*)(lds + L_CT + (64 * tp + 16 * n + l15) * 272 + (32 * st + 16 * i + 4 * l4) * 2) = w; }
            if (tp == 0 && l15 == 0) {
#pragma unroll
                for (int i = 0; i < 2; ++i) *(LAS f32x4*)(gN + 32 * st + 16 * i + 4 * l4) = accN[i]; }
        }
#pragma unroll
        for (int i = 0; i < 2; ++i) { const int tok = tok0 + 32 * i;
            if (FULL) { *(LAS u32x4*)(sQ + tok * 136 + dsg * 8) = kq[i]; *(LAS u32x4*)(sK + tok * 136 + dsg * 8) = kk[i]; }
            *(LAS u32x4*)(sV + tok * 136 + dsg * 8) = kv[i]; }
        LDS_BARRIER();
#pragma unroll
        for (int i = 0; i < 2; ++i) { const int tok = tok0 + 32 * i; const float w = gW[tok]; u32x4 o;
            o.x = pk2(bflo(kk[i].x) * w, bfhi(kk[i].x) * w); o.y = pk2(bflo(kk[i].y) * w, bfhi(kk[i].y) * w);
            o.z = pk2(bflo(kk[i].z) * w, bfhi(kk[i].z) * w); o.w = pk2(bflo(kk[i].w) * w, bfhi(kk[i].w) * w);
            *(LAS u32x4*)(sKW + tok * 136 + dsg * 8) = o; }
        if (c + 1 < nch) {
#pragma unroll
            for (int i = 0; i < 2; ++i) { const int tok = tok0 + 32 * i;
                const bf16_t* src = proj + (size_t)(r0 + 64 + tok) * NPROJ + head * 128 + dsg * 8;
                kk[i] = *(const u32x4*)(src + 1024); kv[i] = *(const u32x4*)(src + 1536);
                if (FULL) kq[i] = *(const u32x4*)(src + 512); }
            if (wave == 0) pgt = gtab[(size_t)(r0 + 64 + lane) * 4 + head];
        }
        f32x4 nacc[4];
#pragma unroll
        for (int n = 0; n < 4; ++n) nacc[n] = (f32x4){0.f, 0.f, 0.f, 0.f};
        if (FULL) {
            f32x4 sacc[2]; sacc[0] = (f32x4){0.f, 0.f, 0.f, 0.f}; sacc[1] = sacc[0];
#pragma unroll
            for (int ks = 0; ks < 4; ++ks) { const int kb = (32 * ks + 8 * l4) * 2;
                const bf16x8 a = ldfrag(lds + L_K, 16 * st + l15, 272, kb);
#pragma unroll
                for (int tt = 0; tt < 2; ++tt) { const bf16x8 b = ldfrag(lds + L_Q, 16 * (2 * tp + tt) + l15, 272, kb); sacc[tt] = MFMA16(a, b, sacc[tt]); } }
#pragma unroll
            for (int tt = 0; tt < 2; ++tt) { const int t = 16 * (2 * tp + tt) + l15; const float Mt = gM[t]; float dv[4];
#pragma unroll
                for (int j = 0; j < 4; ++j) { const int s = 16 * st + 4 * l4 + j; dv[j] = (s <= t) ? sacc[tt][j] * __expf(gA[s] - Mt) : 0.f; }
                u32x2 w; w.x = pk2(dv[0], dv[1]); w.y = pk2(dv[2], dv[3]); *(LAS u32x2*)(lds + L_S + t * 144 + (16 * st + 4 * l4) * 2) = w; }
#pragma unroll
            for (int ks = 0; ks < 4; ++ks) { const int kb = (32 * ks + 8 * l4) * 2;
                const bf16x8 a = ldfrag(lds + L_Q, 16 * st + l15, 272, kb);
#pragma unroll
                for (int n = 0; n < 4; ++n) { const bf16x8 b = ldfrag(lds + L_CT, 64 * tp + 16 * n + l15, 272, kb); nacc[n] = MFMA16(a, b, nacc[n]); } }
#pragma unroll
            for (int j = 0; j < 4; ++j) { const float dj = gDec[16 * st + 4 * l4 + j];
#pragma unroll
                for (int n = 0; n < 4; ++n) nacc[n][j] *= dj; }
            { float s = 0.f;
              const u32x4 q0 = *(LAS const u32x4*)(sQ + orow * 136 + oseg * 16), q1 = *(LAS const u32x4*)(sQ + orow * 136 + oseg * 16 + 8);
              const unsigned qw[8] = {q0.x, q0.y, q0.z, q0.w, q1.x, q1.y, q1.z, q1.w};
#pragma unroll
              for (int e = 0; e < 8; ++e) s += bflo(qw[e]) * gN[oseg * 16 + 2 * e] + bfhi(qw[e]) * gN[oseg * 16 + 2 * e + 1];
              s += __shfl_xor(s, 1); s += __shfl_xor(s, 2); s += __shfl_xor(s, 4);
              if (oseg == 0) gQn[orow] = s; }
        }
        LDS_BARRIER();
        if (FULL) {
            const u32x4 s0 = *(LAS const u32x4*)(sS + orow * 72 + oseg * 8);
            float s = (bflo(s0.x) + bfhi(s0.x)) + (bflo(s0.y) + bfhi(s0.y)) + (bflo(s0.z) + bfhi(s0.z)) + (bflo(s0.w) + bfhi(s0.w));
            s += __shfl_xor(s, 1); s += __shfl_xor(s, 2); s += __shfl_xor(s, 4);
            if (oseg == 0) { const float den = gDec[orow] * gQn[orow] + s; gDi[orow] = 1.0f / fmaxf(fabsf(den), gEinv[orow]); } }
        const float wsv = scal[0];
#pragma unroll
        for (int i = 0; i < 2; ++i) { accN[i] *= wsv;
#pragma unroll
            for (int n = 0; n < 4; ++n) accC[i][n] *= wsv; }
#pragma unroll
        for (int ks = 0; ks < 2; ++ks) { bf16x8 bv[4];
#pragma unroll
            for (int n = 0; n < 4; ++n) bv[n] = ldfrag_tr(lds + L_V, 32 * ks, 64 * tp + 16 * n, lane);
            if (FULL) { const bf16x8 a = ldfrag(lds + L_S, 16 * st + l15, 144, (32 * ks + 8 * l4) * 2);
#pragma unroll
                for (int n = 0; n < 4; ++n) nacc[n] = MFMA16(a, bv[n], nacc[n]); }
#pragma unroll
            for (int i = 0; i < 2; ++i) { const bf16x8 a = ldfrag_tr(lds + L_KW, 32 * ks, 32 * st + 16 * i, lane);
                accN[i] = MFMA16(a, ones, accN[i]);
#pragma unroll
                for (int n = 0; n < 4; ++n) accC[i][n] = MFMA16(a, bv[n], accC[i][n]); } }
        LDS_BARRIER();
        if (FULL) {
            u32x4 ow0 = (u32x4){0u, 0u, 0u, 0u}, ow1 = ow0;
            if (orow < L) { const bf16_t* op = proj + (size_t)(r0 + orow) * NPROJ + 2048 + head * 128 + oseg * 16; ow0 = *(const u32x4*)op; ow1 = *(const u32x4*)(op + 8); }
#pragma unroll
            for (int j = 0; j < 4; ++j) { const int t = 16 * st + 4 * l4 + j; const float di = gDi[t];
#pragma unroll
                for (int n = 0; n < 4; ++n) sH[t * 132 + 64 * tp + 16 * n + l15] = nacc[n][j] * di; }
            LDS_BARRIER();
            if (orow < L) {
                f32x4 x[4]; float s = 0.f;
#pragma unroll
                for (int e = 0; e < 4; ++e) { x[e] = *(LAS const f32x4*)(sH + orow * 132 + oseg * 16 + 4 * e); s += (x[e][0] + x[e][1]) + (x[e][2] + x[e][3]); }
                s += __shfl_xor(s, 1); s += __shfl_xor(s, 2); s += __shfl_xor(s, 4);
                const float mean = s * (1.0f / 128.0f); float q = 0.f;
#pragma unroll
                for (int e = 0; e < 4; ++e) { x[e] -= mean; q += (x[e][0] * x[e][0] + x[e][1] * x[e][1]) + (x[e][2] * x[e][2] + x[e][3] * x[e][3]); }
                q += __shfl_xor(q, 1); q += __shfl_xor(q, 2); q += __shfl_xor(q, 4);
                const float rstd = rsqrtf(q * (1.0f / 128.0f) + LN_EPS);
                const unsigned owv[8] = {ow0.x, ow0.y, ow0.z, ow0.w, ow1.x, ow1.y, ow1.z, ow1.w}; unsigned ov[8];
#pragma unroll
                for (int e = 0; e < 4; ++e) { const f32x4 g = *(LAS const f32x4*)(gNg + oseg * 16 + 4 * e);
                    const float y0 = x[e][0] * rstd * g[0] / (1.0f + __expf(-bflo(owv[2 * e]))), y1 = x[e][1] * rstd * g[1] / (1.0f + __expf(-bfhi(owv[2 * e])));
                    const float y2 = x[e][2] * rstd * g[2] / (1.0f + __expf(-bflo(owv[2 * e + 1]))), y3 = x[e][3] * rstd * g[3] / (1.0f + __expf(-bfhi(owv[2 * e + 1])));
                    ov[2 * e] = pk2(y0, y1); ov[2 * e + 1] = pk2(y2, y3); }
                bf16_t* mp = mix + (size_t)(r0 + orow) * DM + 512 + head * 128 + oseg * 16;
                *(u32x4*)mp = (u32x4){ov[0], ov[1], ov[2], ov[3]}; *(u32x4*)(mp + 8) = (u32x4){ov[4], ov[5], ov[6], ov[7]};
            }
            LDS_BARRIER();
        }
    }
}

constexpr int L_PW = 34816, L_PU = 69632;
template <int W>
__device__ __forceinline__ void pool_diff(LAS unsigned char* lds, bool sample, int tilepos0) {
    const int tid = fresh_tid(), co = tid & 15, t0 = (tid >> 4) * 4;
#pragma unroll 1
    for (int tt = 0; tt < 4; ++tt) {
        const int t = t0 + tt; const int sgi = sample ? (t >> 5) : 0, lt = sample ? (t & 31) : t;
        const int rowbase = sample ? sgi * 47 + 15 + lt : 15 + t;
        const int cnt = sample ? W : min(tilepos0 + t + 1, W);
        float sum[8];
#pragma unroll
        for (int e = 0; e < 8; ++e) sum[e] = 0.f;
        u32x4 x0 = (u32x4){0u, 0u, 0u, 0u};
#pragma unroll
        for (int j = 0; j < W; ++j) { const u32x4 r = *(LAS const u32x4*)(lds + L_PU + (rowbase - j) * 272 + co * 16); if (j == 0) x0 = r;
            sum[0] += bflo(r.x); sum[1] += bfhi(r.x); sum[2] += bflo(r.y); sum[3] += bfhi(r.y); sum[4] += bflo(r.z); sum[5] += bfhi(r.z); sum[6] += bflo(r.w); sum[7] += bfhi(r.w); }
        const float inv = 1.0f / (float)cnt;
        u32x4 w; w.x = pk2(sum[0] * inv - bflo(x0.x), sum[1] * inv - bfhi(x0.x)); w.y = pk2(sum[2] * inv - bflo(x0.y), sum[3] * inv - bfhi(x0.y));
        w.z = pk2(sum[4] * inv - bflo(x0.z), sum[5] * inv - bfhi(x0.z)); w.w = pk2(sum[6] * inv - bflo(x0.w), sum[7] * inv - bfhi(x0.w));
        *(LAS u32x4*)(lds + t * 272 + co * 16) = w; }
}

__device__ __forceinline__ void pool_fetch(const Params& p, int item, int tid, u32x4 (&pf)[6]) {
    const int g = item & 3, R0 = (item >> 2) * 128;
    const bf16_t* proj = (const bf16_t*)(p.ws + WS_PROJ); const float* hist = p.in[2];
    const bool sample = R0 >= MP; const int seqrow0 = sample ? 0 : (R0 / SEQ) * SEQ, tilepos0 = sample ? 0 : R0 - seqrow0;
    const int nrows = sample ? 188 : 143;
#pragma unroll
    for (int i = 0; i < 6; ++i) { const int piece = tid + 512 * i, e = piece >> 4, seg = piece & 15; u32x4 val = (u32x4){0u, 0u, 0u, 0u};
        if (e < nrows) {
            if (!sample) { const int pos = tilepos0 - 15 + e; if (pos >= 0) val = *(const u32x4*)(proj + (size_t)(seqrow0 + pos) * NPROJ + g * 128 + seg * 8); }
            else { const int sgi = e / 47, le = e - sgi * 47, b = ((R0 - MP) >> 5) + sgi;
                if (le < 15) { const float* hp = hist + ((size_t)b * 15 + le) * 512 + g * 128 + seg * 8; const float4 a = *(const float4*)hp, c4 = *(const float4*)(hp + 4);
                    val.x = pk2(a.x, a.y); val.y = pk2(a.z, a.w); val.z = pk2(c4.x, c4.y); val.w = pk2(c4.z, c4.w); }
                else val = *(const u32x4*)(proj + (size_t)(MP + b * 32 + le - 15) * NPROJ + g * 128 + seg * 8); } }
        pf[i] = val; }
}

__device__ __forceinline__ void pool_loop(const Params& p, LAS unsigned char* lds, int first, int stride, int end) {
    const int tid = fresh_tid(), lane = tid & 63, wave = __builtin_amdgcn_readfirstlane(tid >> 6), l15 = lane & 15, l4 = lane >> 4, st = wave & 3, tp = wave >> 2;
    bf16_t* mix = (bf16_t*)(p.ws + WS_MIX); const float* pscale = p.in[11];
    if (first >= end) return;
    u32x4 pf[6]; pool_fetch(p, first, tid, pf);
    int gw = -1;
#pragma unroll 1
    for (int item = first; item < end; item += stride) {
        const int g = item & 3, R0 = (item >> 2) * 128;
        const bool sample = R0 >= MP; const int tilepos0 = sample ? 0 : R0 - (R0 / SEQ) * SEQ;
        if (g != gw) { const bf16_t* Wp = (const bf16_t*)(p.ws + WS_WPOOL) + g * 16384; gw = g;
#pragma unroll
            for (int i = 0; i < 4; ++i) { const int piece = tid + 512 * i, row = piece >> 4, seg = piece & 15;
                *(LAS u32x4*)(lds + L_PW + row * 272 + seg * 16) = *(const u32x4*)(Wp + row * 128 + seg * 8); } }
#pragma unroll
        for (int i = 0; i < 6; ++i) { const int piece = tid + 512 * i, e = piece >> 4, seg = piece & 15; if (e < 188) *(LAS u32x4*)(lds + L_PU + e * 272 + seg * 16) = pf[i]; }
        LDS_BARRIER();
        if (item + stride < end) pool_fetch(p, item + stride, tid, pf);
        if (g == 0) pool_diff<2>(lds, sample, tilepos0); else if (g == 1) pool_diff<4>(lds, sample, tilepos0); else if (g == 2) pool_diff<8>(lds, sample, tilepos0); else pool_diff<16>(lds, sample, tilepos0);
        LDS_BARRIER();
        f32x4 acc[2][4];
#pragma unroll
        for (int i = 0; i < 2; ++i)
#pragma unroll
            for (int n = 0; n < 4; ++n) acc[i][n] = (f32x4){0.f, 0.f, 0.f, 0.f};
#pragma unroll
        for (int ks = 0; ks < 4; ++ks) { const int kb = (32 * ks + 8 * l4) * 2; bf16x8 bv[4];
#pragma unroll
            for (int n = 0; n < 4; ++n) bv[n] = ldfrag(lds, 64 * tp + 16 * n + l15, 272, kb);
#pragma unroll
            for (int i = 0; i < 2; ++i) { const bf16x8 a = ldfrag(lds + L_PW, 32 * st + 16 * i + l15, 272, kb);
#pragma unroll
                for (int n = 0; n < 4; ++n) acc[i][n] = MFMA16(a, bv[n], acc[i][n]); } }
        LDS_BARRIER();
#pragma unroll
        for (int i = 0; i < 2; ++i) { const int d0 = 32 * st + 16 * i + 4 * l4; const float4 ps = *(const float4*)(pscale + g * 128 + d0);
#pragma unroll
            for (int n = 0; n < 4; ++n) { const int t = 64 * tp + 16 * n + l15;
                u32x2 w; w.x = pk2(acc[i][n][0] * ps.x, acc[i][n][1] * ps.y); w.y = pk2(acc[i][n][2] * ps.z, acc[i][n][3] * ps.w);
                *(LAS u32x2*)(lds + t * 272 + d0 * 2) = w; } }
        LDS_BARRIER();
        { const int t = tid >> 2, sg = tid & 3; const u32x4 o0 = *(LAS const u32x4*)(lds + t * 272 + sg * 64), o1 = *(LAS const u32x4*)(lds + t * 272 + sg * 64 + 16),
            o2 = *(LAS const u32x4*)(lds + t * 272 + sg * 64 + 32), o3 = *(LAS const u32x4*)(lds + t * 272 + sg * 64 + 48);
          bf16_t* mp = mix + (size_t)(R0 + t) * DM + g * 128 + sg * 32; *(u32x4*)mp = o0; *(u32x4*)(mp + 8) = o1; *(u32x4*)(mp + 16) = o2; *(u32x4*)(mp + 24) = o3; }
    }
    LDS_BARRIER();
}

constexpr int N_S2 = 224, N_SMP = 128, N_POOL = (MT / 128) * 4;

__device__ __forceinline__ void phase2(const Params& p, LAS unsigned char* lds, int kinds) {
    const int tid = fresh_tid(), lane = tid & 63, wave = tid >> 6, l15 = lane & 15, l4 = lane >> 4, st = wave & 3, tp = wave >> 2;
    float* Dst = (float*)(p.ws + WS_DST); float* Dn = (float*)(p.ws + WS_DN); const float* mtab = (const float*)(p.ws + WS_MTAB);
    for (int it = blockIdx.x; it < N_S2 + N_SMP; it += gridDim.x) {
        if (it < N_S2) {
            if (!(kinds & 1)) continue;
            const int chain = it / 7, sc = it % 7, batch = chain >> 2, head = chain & 3;
            f32x4 accC[2][4], accN[2];
#pragma unroll
            for (int i = 0; i < 2; ++i) { accN[i] = (f32x4){0.f, 0.f, 0.f, 0.f};
#pragma unroll
                for (int n = 0; n < 4; ++n) accC[i][n] = (f32x4){0.f, 0.f, 0.f, 0.f}; }
            mlstm_run<false>(p, lds, accC, accN, batch * SEQ + sc * SCN * 64, head, SCN, 64);
#pragma unroll
            for (int i = 0; i < 2; ++i)
#pragma unroll
                for (int n = 0; n < 4; ++n)
#pragma unroll
                    for (int j = 0; j < 4; ++j) Dst[((size_t)it * 32 + (i * 4 + n) * 4 + j) * 512 + tid] = accC[i][n][j];
            if (tp == 0 && l15 == 0) {
#pragma unroll
                for (int i = 0; i < 2; ++i) *(f32x4*)(Dn + it * 128 + 32 * st + 16 * i + 4 * l4) = accN[i]; }
        } else {
            if (!(kinds & 2)) continue;
            const int s = it - N_S2, b = s >> 2, head = s & 3;
            const float* C0 = p.in[3] + (size_t)s * 16384; f32x4 accC[2][4], accN[2];
#pragma unroll
            for (int i = 0; i < 2; ++i) accN[i] = *(const f32x4*)(p.in[4] + s * 128 + 32 * st + 16 * i + 4 * l4);
#pragma unroll
            for (int i = 0; i < 2; ++i)
#pragma unroll
                for (int n = 0; n < 4; ++n)
#pragma unroll
                    for (int j = 0; j < 4; ++j) accC[i][n][j] = C0[(32 * st + 16 * i + 4 * l4 + j) * 128 + 64 * tp + 16 * n + l15];
            mlstm_run<true>(p, lds, accC, accN, MP + b * 32, head, 1, 32);
            float* Co = p.out + O_CS + (size_t)s * 16384;
#pragma unroll
            for (int i = 0; i < 2; ++i)
#pragma unroll
                for (int n = 0; n < 4; ++n)
#pragma unroll
                    for (int j = 0; j < 4; ++j) Co[(32 * st + 16 * i + 4 * l4 + j) * 128 + 64 * tp + 16 * n + l15] = accC[i][n][j];
            if (tp == 0 && l15 == 0) {
#pragma unroll
                for (int i = 0; i < 2; ++i) *(f32x4*)(p.out + O_NS + s * 128 + 32 * st + 16 * i + 4 * l4) = accN[i]; }
        }
    }
    if (kinds & 4) { const int G = gridDim.x; int first = blockIdx.x; while (first < N_S2 + N_SMP) first += G;
        pool_loop(p, lds, first - N_S2 - N_SMP, G, N_POOL); }
    const bf16_t* proj = (const bf16_t*)(p.ws + WS_PROJ);
    for (int idx = blockIdx.x * 512 + tid; idx < (NB + DB) * 15 * 512; idx += gridDim.x * 512) {
        if (idx < NB * 7680) { const int b = idx / 7680, rem = idx % 7680, i = rem >> 9, c = rem & 511;
            p.out[O_POOLP + idx] = bf2f(proj[(size_t)(b * SEQ + SEQ - 15 + i) * NPROJ + c]); }
        else { const int id2 = idx - NB * 7680, b = id2 / 7680, rem = id2 % 7680, i = rem >> 9, c = rem & 511;
            p.out[O_POOLS + id2] = bf2f(proj[(size_t)(MP + b * 32 + 17 + i) * NPROJ + c]); }
    }
}

__device__ __forceinline__ void phase3(const Params& p, LAS unsigned char* lds) {
    const int tid = fresh_tid(), lane = tid & 63, wave = tid >> 6, l15 = lane & 15, l4 = lane >> 4, st = wave & 3, tp = wave >> 2;
    const float* Dst = (const float*)(p.ws + WS_DST); const float* Dn = (const float*)(p.ws + WS_DN);
    const float* mtab = (const float*)(p.ws + WS_MTAB); const float* btab = (const float*)(p.ws + WS_BTAB);
    for (int it = blockIdx.x; it < 256; it += gridDim.x) {
        const int chain = it >> 3, sc = it & 7, batch = chain >> 2, head = chain & 3;
        f32x4 accC[2][4], accN[2];
#pragma unroll
        for (int i = 0; i < 2; ++i) { accN[i] = (f32x4){0.f, 0.f, 0.f, 0.f};
#pragma unroll
            for (int n = 0; n < 4; ++n) accC[i][n] = (f32x4){0.f, 0.f, 0.f, 0.f}; }
#pragma unroll 1
        for (int j = 0; j < sc; ++j) {
            float Bs = 0.f;
            for (int c = 0; c < SCN; ++c) Bs += btab[chain * 128 + j * SCN + c];
            const float Wj = expf(Bs + mtab[chain * 132 + j * SCN] - mtab[chain * 132 + (j + 1) * SCN]);
            const int item = chain * 7 + j;
#pragma unroll
            for (int i = 0; i < 2; ++i)
#pragma unroll
                for (int n = 0; n < 4; ++n)
#pragma unroll
                    for (int q = 0; q < 4; ++q) accC[i][n][q] = Wj * accC[i][n][q] + Dst[((size_t)item * 32 + (i * 4 + n) * 4 + q) * 512 + tid];
#pragma unroll
            for (int i = 0; i < 2; ++i) accN[i] = Wj * accN[i] + *(const f32x4*)(Dn + item * 128 + 32 * st + 16 * i + 4 * l4);
        }
        mlstm_run<true>(p, lds, accC, accN, batch * SEQ + sc * SCN * 64, head, SCN, 64);
        if (sc == 7) {
            float* Co = p.out + O_CP + (size_t)chain * 16384;
#pragma unroll
            for (int i = 0; i < 2; ++i)
#pragma unroll
                for (int n = 0; n < 4; ++n)
#pragma unroll
                    for (int j = 0; j < 4; ++j) Co[(32 * st + 16 * i + 4 * l4 + j) * 128 + 64 * tp + 16 * n + l15] = accC[i][n][j];
            if (tp == 0 && l15 == 0) {
#pragma unroll
                for (int i = 0; i < 2; ++i) *(f32x4*)(p.out + O_NP + chain * 128 + 32 * st + 16 * i + 4 * l4) = accN[i]; }
        }
    }
}

__device__ __forceinline__ void ln_load(const float* src, const float* slab, int S, const bf16_t* hb, int row, int lane, float4 (&v)[4]) {
    if (row >= MP) {
#pragma unroll
        for (int i = 0; i < 4; ++i) { const int c = i * 256 + lane * 4; const u32x2 h2 = *(const u32x2*)(hb + (size_t)row * DM + c);
            float4 a = make_float4(ALPHA * bflo(h2.x), ALPHA * bfhi(h2.x), ALPHA * bflo(h2.y), ALPHA * bfhi(h2.y));
            const float* sp = slab + (size_t)(row - MP) * DM + c;
#pragma unroll 1
            for (int sl = 0; sl < S; ++sl) { const float4 t = *(const float4*)(sp + (size_t)sl * (1024 * 1024)); a.x += t.x; a.y += t.y; a.z += t.z; a.w += t.w; }
            v[i] = a; }
    } else {
#pragma unroll
        for (int i = 0; i < 4; ++i) v[i] = *(const float4*)(src + (size_t)row * DM + i * 256 + lane * 4); }
}
template <bool TO_BF16>
__device__ __forceinline__ void ln_rows(const float* src, const float* gam, const float* bet, bf16_t* ob, float* of, const float* slab, int S, const bf16_t* hb) {
    const int tid = fresh_tid(), lane = tid & 63, wave = tid >> 6, stride = gridDim.x * 8;
    int row = blockIdx.x * 8 + wave; float4 v[4];
    if (row < MT) ln_load(src, slab, S, hb, row, lane, v);
#pragma unroll 1
    for (; row < MT; row += stride) {
        const int nrow = row + stride; float4 nv[4];
        if (nrow < MT) ln_load(src, slab, S, hb, nrow, lane, nv);
        else {
#pragma unroll
            for (int i = 0; i < 4; ++i) nv[i] = make_float4(0.f, 0.f, 0.f, 0.f); }
        float s = 0.f;
#pragma unroll
        for (int i = 0; i < 4; ++i) s += (v[i].x + v[i].y) + (v[i].z + v[i].w);
        const float mu = wave_sum(s) * (1.0f / DM); float q = 0.f;
#pragma unroll
        for (int i = 0; i < 4; ++i) { v[i].x -= mu; v[i].y -= mu; v[i].z -= mu; v[i].w -= mu; q += (v[i].x * v[i].x + v[i].y * v[i].y) + (v[i].z * v[i].z + v[i].w * v[i].w); }
        const float rstd = rsqrtf(wave_sum(q) * (1.0f / DM) + LN_EPS);
#pragma unroll
        for (int i = 0; i < 4; ++i) { const int c = i * 256 + lane * 4; const float4 gg = *(const float4*)(gam + c), bb = *(const float4*)(bet + c);
            float4 y; y.x = v[i].x * rstd * gg.x + bb.x; y.y = v[i].y * rstd * gg.y + bb.y; y.z = v[i].z * rstd * gg.z + bb.z; y.w = v[i].w * rstd * gg.w + bb.w;
            if (TO_BF16) { u32x2 w; w.x = pk2(y.x, y.y); w.y = pk2(y.z, y.w); *(u32x2*)(ob + (size_t)row * DM + c) = w; }
            else *(float4*)(of + (size_t)row * DM + c) = y; }
#pragma unroll
        for (int i = 0; i < 4; ++i) v[i] = nv[i];
    }
}

__global__ void __launch_bounds__(512) fwd_mega(Params p) {
    extern __shared__ __attribute__((aligned(16))) unsigned char smem[];
    LAS unsigned char* lds = (LAS unsigned char*)smem;
    cg::grid_group grid = cg::this_grid();
    volatile LAS unsigned* stw = (volatile LAS unsigned*)(lds + 131072);
    if (threadIdx.x == 0) { stw[0] = 0u; stw[1] = 0u; }
    __syncthreads();
    const XcdBarrier xbar = xcd_barrier_post((unsigned*)(p.ws + WS_BAR), stw);
    unsigned char* ws = p.ws;
    bf16_t* h0 = (bf16_t*)(ws + WS_H0); bf16_t* proj = (bf16_t*)(ws + WS_PROJ); bf16_t* mix = (bf16_t*)(ws + WS_MIX); bf16_t* act = (bf16_t*)(ws + WS_ACT);
    float* slab = (float*)(ws + WS_SLAB);
    const int G = gridDim.x, bx = blockIdx.x;
#ifndef DBL
#define DBL 0
#endif
    if (DBL & 0x800) { for (int i = 0; i < 10; ++i) xcd_barrier(xbar); }
    if (DBL & 1) { phase0(p, lds); xcd_barrier(xbar); }
    phase0(p, lds);
    grid.sync();
    gate_scan(p, lds);
    { pg8::Gemm g{h0, (const bf16_t*)(ws + WS_WIN), MT, NPROJ, DM}; SplitOrder S; S.init(NPROJ, DM / 64, 1, G, bx);
      EpiBf16B e{proj, NPROJ, (const float*)(ws + WS_BIAS)}; pg8::gemm_phase(lds, g, S, e); }
    xcd_barrier(xbar);
    if (DBL & 4) { phase2(p, lds, 15); xcd_barrier(xbar); }
    if (DBL & 0x200) { phase2(p, lds, 4); xcd_barrier(xbar); }
    if (DBL & 0x400) { phase2(p, lds, 1); xcd_barrier(xbar); }
    phase2(p, lds, 15);
    xcd_barrier(xbar);
    if (DBL & 8) { phase3(p, lds); xcd_barrier(xbar); }
    phase3(p, lds);
    xcd_barrier(xbar);
    { pg8::Gemm g{mix, (const bf16_t*)(ws + WS_WOUT), MT, DM, DM}; SplitOrder S; S.init(DM, DM / 64, 4, G, bx);
      EpiRes e{h0, p.out + O_Y, slab, DM / 64}; pg8::gemm_phase(lds, g, S, e); }
    xcd_barrier(xbar);
    ln_rows<true>(p.out + O_Y, p.in[14], p.in[15], h0, nullptr, slab, 4, h0);
    xcd_barrier(xbar);
    { pg8::Gemm g{h0, (const bf16_t*)(ws + WS_WGU), MT, 2 * DFF, DM}; SplitOrder S; S.init(2 * DFF, DM / 64, 1, G, bx);
      EpiSwiglu e{act}; pg8::gemm_phase(lds, g, S, e); }
    xcd_barrier(xbar);
    { pg8::Gemm g{act, (const bf16_t*)(ws + WS_WDN), MT, DM, DFF}; SplitOrder S; S.init(DM, DFF / 64, 11, G, bx);
      EpiRes e{h0, p.out + O_Y, slab, DFF / 64}; pg8::gemm_phase(lds, g, S, e); }
    xcd_barrier(xbar);
    ln_rows<false>(p.out + O_Y, p.in[19], p.in[20], nullptr, p.out + O_Y, slab, 11, h0);
}

extern "C" void kernel_launch(void* const* d_in, const int* in_sizes, int n_in, void* d_out, int out_size, void* d_ws, size_t ws_size, hipStream_t stream) {
    constexpr size_t kDynLds = 131072 + 64;
    static int grid_blocks = 0;
    if (!grid_blocks) {
        if (n_in != 21 || (size_t)out_size != O_END || ws_size < WS_END2) { fprintf(stderr, "kernel_launch: unexpected shapes: n_in %d out %d ws %zu (need %zu)\n", n_in, out_size, ws_size, (size_t)WS_END2); grid_blocks = -1; return; }
        int dev = 0, cus = 0, per_cu = 0;
        hipGetDevice(&dev);
        hipDeviceGetAttribute(&cus, hipDeviceAttributeMultiprocessorCount, dev);
        if (hipFuncSetAttribute((const void*)fwd_mega, hipFuncAttributeMaxDynamicSharedMemorySize, (int)kDynLds) != hipSuccess) { fprintf(stderr, "kernel_launch: hipFuncSetAttribute failed\n"); grid_blocks = -1; return; }
        if (hipOccupancyMaxActiveBlocksPerMultiprocessor(&per_cu, (const void*)fwd_mega, 512, kDynLds) != hipSuccess || per_cu < 1) { fprintf(stderr, "kernel_launch: occupancy query failed (%d)\n", per_cu); grid_blocks = -1; return; }
        if (per_cu > 1) per_cu = 1;
        grid_blocks = cus * per_cu;
    }
    if (grid_blocks < 0) return;
    if (hipMemsetAsync((char*)d_ws + WS_BAR, 0, XCD_BAR_WORDS * 4, stream) != hipSuccess) { fprintf(stderr, "kernel_launch: memset of the barrier words failed\n"); return; }
    Params p{};
    for (int i = 0; i < 21; ++i) p.in[i] = (const float*)d_in[i];
    p.out = (float*)d_out; p.ws = (unsigned char*)d_ws;
    void* args[] = {&p};
    hipError_t e = hipLaunchCooperativeKernel((const void*)fwd_mega, dim3(grid_blocks), dim3(512), args, kDynLds, stream);
    if (e != hipSuccess) fprintf(stderr, "cooperative launch failed: %s (grid %d)\n", hipGetErrorString(e), grid_blocks);
}
```

```cpp
#include <hip/hip_runtime.h>
#include <hip/hip_cooperative_groups.h>
#include <cstdio>
namespace cg = cooperative_groups;
namespace pg8 {
#define PG8_LAS __attribute__((address_space(3)))
typedef unsigned short bf16_t;
typedef short bf16x8 __attribute__((ext_vector_type(8)));
typedef float f32x4 __attribute__((ext_vector_type(4)));
typedef unsigned u32x4 __attribute__((ext_vector_type(4)));
constexpr int BM = 256, BK = 64, HALF = 128, HTB = HALF * BK * 2  , STAGE_BYTES = 8 * HTB, NXCD = 8, WGM = 8;

__host__ __device__ __forceinline__ int lds_byte(int r, int c) { const int st = (r >> 4) * 2 + (c >> 5), rr = r & 15, cc = c & 31, ob = rr * 64 + cc * 2; return st * 1024 + (ob ^ (((ob >> 9) & 1) << 5)); }
__host__ __device__ __forceinline__ void stage_rc(int b, int& R, int& C) { const int st = b / 1024, sb = b % 1024, swz = sb ^ (((sb >> 9) & 1) << 5); R = (st >> 1) * 16 + swz / 64; C = (st & 1) * 32 + (swz % 64) / 2; }
__host__ __device__ __forceinline__ int perm32(int rho) { const int n = rho >> 4, i = rho & 15; return 8 * (i >> 2) + 4 * n + (i & 3); }

struct Unit { int pm, pn, kt0, nkt; };
struct Gemm { const bf16_t* A; const bf16_t* Bt; int M, N, K; };
struct StaticOrder {
    int nM, nN, nwg, G, c;
    __host__ __device__ void init(int M, int N, int G_, int c_) { nM = M / BM; nN = N / BM; nwg = nM * nN; G = G_; c = c_; }
    __host__ __device__ bool next(int i, Unit& u) const {
        const long L = (long)i * G + c; if (L >= nwg) return false;
        int wgid = (int)L; { const int q = nwg / NXCD, r = nwg % NXCD, xcd = wgid % NXCD, off = wgid / NXCD; wgid = (xcd < r ? xcd * (q + 1) : r * (q + 1) + (xcd - r) * q) + off; }
        const int nig = WGM * nN, gid = wgid / nig, fm = gid * WGM, gsz = (nM - fm) < WGM ? (nM - fm) : WGM;
        u.pm = fm + ((wgid % nig) % gsz); u.pn = (wgid % nig) / gsz; u.kt0 = 0; u.nkt = 0; return true;
    }
    __device__ __forceinline__ void a_ready(const Unit&) const {}
    __device__ __forceinline__ void done(const Unit&) const {}
};
__device__ __forceinline__ unsigned cvt_pk_bf16(float lo, float hi) { unsigned r; asm volatile("v_cvt_pk_bf16_f32 %0, %1, %2" : "=v"(r) : "v"(lo), "v"(hi)); return r; }
template <class Epi, class Sched>
__device__ __forceinline__ void gemm_phase(PG8_LAS unsigned char* lds, const Gemm g, const Sched& S, const Epi& E) {
    int tid_ = threadIdx.x; asm volatile("" : "+v"(tid_)); const int tid = tid_, wid = __builtin_amdgcn_readfirstlane(tid >> 6), lane = tid & 63, wr = wid >> 2, wc = wid & 3, fr = lane & 15, fq = lane >> 4;
    const int K = g.K;
    unsigned voffA[2], voffB[2];
#pragma unroll
    for (int i = 0; i < 2; ++i) { int R, C; stage_rc(tid * 16 + i * 8192, R, C); const int Rb = Epi::PERM ? ((R & ~31) + perm32(R & 31)) : R;
        voffA[i] = (unsigned)(R * K + C) * 2u; voffB[i] = (unsigned)(Rb * K + C) * 2u; }
    const size_t kstep = (size_t)(BK * 2);
    const size_t hstep = (size_t)HALF * K * 2;
    const size_t tstep = 2 * hstep;
    const unsigned ldsw = (unsigned)wid * 1024u;
    const int aoff = lds_byte(wr * 64 + fr, fq * 8), boff = lds_byte(wc * 32 + fr, fq * 8);
#define PG8_SA(b, h) (((b) * 2 + (h)) * HTB)
#define PG8_SB(b, h) ((4 + (b) * 2 + (h)) * HTB)
#define PG8_STAGE(bufoff, gbase, voff) do { _Pragma("unroll") for (int _i = 0; _i < 2; ++_i) \
        __builtin_amdgcn_global_load_lds((const unsigned*)((const char*)(gbase) + (voff)[_i]), (PG8_LAS unsigned*)(lds + (bufoff) + ldsw + _i * 8192), 16, 0, 0); } while (0)
#define PG8_LDA(dst, b, h) do { _Pragma("unroll") for (int m = 0; m < 4; ++m) _Pragma("unroll") for (int k = 0; k < 2; ++k) dst[m][k] = *(const PG8_LAS bf16x8*)(lds + PG8_SA(b, h) + aoff + m * 2048 + k * 1024); } while (0)
#define PG8_LDB(dst, b, h) do { _Pragma("unroll") for (int n = 0; n < 2; ++n) _Pragma("unroll") for (int k = 0; k < 2; ++k) dst[n][k] = *(const PG8_LAS bf16x8*)(lds + PG8_SB(b, h) + boff + n * 2048 + k * 1024); } while (0)
#define PG8_MMA(ai, bj, At, Bt) do { __builtin_amdgcn_s_setprio(1); _Pragma("unroll") for (int m = 0; m < 4; ++m) _Pragma("unroll") for (int n = 0; n < 2; ++n) _Pragma("unroll") for (int k = 0; k < 2; ++k) \
        acc[ai][bj][m][n] = __builtin_amdgcn_mfma_f32_16x16x32_bf16(Bt[n][k], At[m][k], acc[ai][bj][m][n], 0, 0, 0); __builtin_amdgcn_s_setprio(0); } while (0)
#define PG8_WAIT_V(n) asm volatile("s_waitcnt vmcnt(" #n ")" ::: "memory")
#define PG8_WAIT_L(n) asm volatile("s_waitcnt lgkmcnt(" #n ")" ::: "memory")
#define PG8_BAR __builtin_amdgcn_s_barrier()
#define PG8_SCHED __builtin_amdgcn_sched_barrier(0)
    Unit cur, nxt; int ui = 0;
    if (!S.next(0, cur)) return;
    f32x4 acc[2][2][4][2];
#pragma unroll
    for (int a = 0; a < 2; ++a)
#pragma unroll
        for (int b = 0; b < 2; ++b)
#pragma unroll
            for (int m = 0; m < 4; ++m)
#pragma unroll
                for (int n = 0; n < 2; ++n) acc[a][b][m][n] = (f32x4){0.f, 0.f, 0.f, 0.f};
    bf16x8 At[4][2], B0[2][2], B1[2][2];
    const char* cA = (const char*)g.A + (size_t)cur.pm * tstep + (size_t)cur.kt0 * kstep; const char* cB = (const char*)g.Bt + (size_t)cur.pn * tstep + (size_t)cur.kt0 * kstep;
    S.a_ready(cur);
    PG8_STAGE(PG8_SB(0, 0), cB, voffB); PG8_STAGE(PG8_SA(0, 0), cA, voffA); PG8_STAGE(PG8_SB(0, 1), cB + hstep, voffB); PG8_STAGE(PG8_SA(0, 1), cA + hstep, voffA);
    if (wr == 1) PG8_BAR;
    PG8_WAIT_V(4); PG8_BAR;
    PG8_STAGE(PG8_SB(1, 0), cB + kstep, voffB); PG8_STAGE(PG8_SA(1, 0), cA + kstep, voffA); PG8_STAGE(PG8_SB(1, 1), cB + hstep + kstep, voffB);
    PG8_WAIT_V(6); PG8_BAR;
    for (;;) {
        const bool has_next = S.next(ui + 1, nxt);
        const char* nA = has_next ? (const char*)g.A + (size_t)nxt.pm * tstep + (size_t)nxt.kt0 * kstep : cA; const char* nB = has_next ? (const char*)g.Bt + (size_t)nxt.pn * tstep + (size_t)nxt.kt0 * kstep : cB;
        const int nt = cur.nkt;
        for (int t = 0; t < nt; t += 2) {
            const bool last = (t == nt - 2);
            const char* a1 = cA + (size_t)(t + 1) * kstep;
            const char* a2 = last ? nA : cA + (size_t)(t + 2) * kstep; const char* b2 = last ? nB : cB + (size_t)(t + 2) * kstep;
            const char* a3 = a2 + kstep; const char* b3 = b2 + kstep;
            if (last && has_next) S.a_ready(nxt);
            PG8_LDB(B0, 0, 0); PG8_SCHED; PG8_LDA(At, 0, 0); PG8_STAGE(PG8_SA(1, 1), a1 + hstep, voffA);
            PG8_WAIT_L(8); PG8_BAR; PG8_WAIT_L(0); PG8_MMA(0, 0, At, B0); PG8_BAR; PG8_SCHED;
            PG8_LDB(B1, 0, 1); PG8_STAGE(PG8_SB(0, 0), b2, voffB);
            PG8_BAR; PG8_WAIT_L(0); PG8_MMA(0, 1, At, B1); PG8_BAR;
            PG8_LDA(At, 0, 1); PG8_STAGE(PG8_SA(0, 0), a2, voffA);
            PG8_BAR; PG8_WAIT_L(0); PG8_MMA(1, 0, At, B0); PG8_BAR; PG8_SCHED;
            PG8_STAGE(PG8_SB(0, 1), b2 + hstep, voffB);
            PG8_WAIT_V(6); PG8_BAR; PG8_MMA(1, 1, At, B1); PG8_BAR;
            PG8_LDB(B0, 1, 0); PG8_SCHED; PG8_LDA(At, 1, 0); PG8_STAGE(PG8_SA(0, 1), a2 + hstep, voffA);
            PG8_WAIT_L(8); PG8_BAR; PG8_WAIT_L(0); PG8_MMA(0, 0, At, B0); PG8_BAR; PG8_SCHED;
            PG8_LDB(B1, 1, 1); PG8_STAGE(PG8_SB(1, 0), b3, voffB);
            PG8_BAR; PG8_WAIT_L(0); PG8_MMA(0, 1, At, B1); PG8_BAR;
            PG8_LDA(At, 1, 1); PG8_STAGE(PG8_SA(1, 0), a3, voffA);
            PG8_BAR; PG8_WAIT_L(0); PG8_MMA(1, 0, At, B0); PG8_BAR; PG8_SCHED;
            PG8_STAGE(PG8_SB(1, 1), b3 + hstep, voffB);
            PG8_WAIT_V(6); PG8_BAR; PG8_MMA(1, 1, At, B1); PG8_BAR;
        }
        if constexpr (!Epi::AFTER_DRAIN) { E(acc, cur, wr, wc, fr, fq); S.done(cur); }
        if (!has_next) break;
#pragma unroll
        for (int a = 0; a < 2; ++a)
#pragma unroll
            for (int b = 0; b < 2; ++b)
#pragma unroll
                for (int m = 0; m < 4; ++m)
#pragma unroll
                    for (int n = 0; n < 2; ++n) acc[a][b][m][n] = (f32x4){0.f, 0.f, 0.f, 0.f};
        cur = nxt; cA = nA; cB = nB; ++ui;
    }
    PG8_WAIT_V(0);
    if (wr == 0) PG8_BAR;
    PG8_BAR;
    if constexpr (Epi::AFTER_DRAIN) { E.fused(acc, cur, wr, wc, fr, fq, lds, wid, lane); S.done(cur); }
#undef PG8_SA
#undef PG8_SB
#undef PG8_STAGE
#undef PG8_LDA
#undef PG8_LDB
#undef PG8_MMA
#undef PG8_WAIT_V
#undef PG8_WAIT_L
#undef PG8_BAR
#undef PG8_SCHED
}
}

using pg8::bf16_t; using pg8::bf16x8; using pg8::f32x4; using pg8::u32x4;
#define LAS __attribute__((address_space(3)))
typedef unsigned u32x2 __attribute__((ext_vector_type(2)));

constexpr int DM = 1024, NB = 8, SEQ = 8192, DB = 32, DS = 32;
constexpr int MP = NB * SEQ, MS = DB * DS, MT = MP + MS;
constexpr int NPROJ = 2560, INCOLS = 2568, DFF = 2816;
constexpr int SCN = 16;
constexpr float ALPHA = 1.189207115002721f, KSCALE = 0.08838834764831845f, LN_EPS = 1e-5f;

constexpr size_t al256(size_t x) { return (x + 255) & ~(size_t)255; }
constexpr size_t WS_BAR = 0;
constexpr size_t WS_WIN = 16384;
constexpr size_t WS_WOUT = WS_WIN + al256((size_t)NPROJ * DM * 2);
constexpr size_t WS_WGU = WS_WOUT + al256((size_t)DM * DM * 2);
constexpr size_t WS_WDN = WS_WGU + al256((size_t)2 * DFF * DM * 2);
constexpr size_t WS_WPOOL = WS_WDN + al256((size_t)DM * DFF * 2);
constexpr size_t WS_BIAS = WS_WPOOL + al256((size_t)4 * 128 * 128 * 2);
constexpr size_t WS_GATES = WS_BIAS + al256((size_t)NPROJ * 4);
constexpr size_t WS_MTAB = WS_GATES + al256((size_t)MT * 8 * 4);
constexpr size_t WS_BTAB = WS_MTAB + al256((size_t)32 * 132 * 4);
constexpr size_t WS_GTAB = WS_BTAB + al256((size_t)32 * 128 * 4);
constexpr size_t WS_DST = WS_GTAB + al256((size_t)MT * 4 * 16);
constexpr size_t WS_DN = WS_DST + al256((size_t)224 * 16384 * 4);
constexpr size_t WS_H0 = WS_DN + al256((size_t)224 * 128 * 4);
constexpr size_t WS_PROJ = WS_H0 + al256((size_t)MT * DM * 2);
constexpr size_t WS_MIX = WS_PROJ + al256((size_t)MT * NPROJ * 2);
constexpr size_t WS_END = WS_MIX + al256((size_t)MT * DM * 2);
constexpr size_t WS_SLAB = WS_END;
constexpr size_t WS_END2 = WS_SLAB + (size_t)11 * 1024 * 1024 * 4;
constexpr size_t WS_ACT = WS_PROJ;
static_assert((size_t)MT * DFF * 2 <= WS_END - WS_PROJ, "act does not fit");

constexpr size_t O_Y = 0;
constexpr size_t O_POOLP = (size_t)MT * DM;
constexpr size_t O_CP = O_POOLP + (size_t)NB * 15 * 512;
constexpr size_t O_NP = O_CP + (size_t)NB * 4 * 16384;
constexpr size_t O_MP = O_NP + (size_t)NB * 4 * 128;
constexpr size_t O_POOLS = O_MP + (size_t)NB * 4;
constexpr size_t O_CS = O_POOLS + (size_t)DB * 15 * 512;
constexpr size_t O_NS = O_CS + (size_t)DB * 4 * 16384;
constexpr size_t O_MS = O_NS + (size_t)DB * 4 * 128;
constexpr size_t O_END = O_MS + (size_t)DB * 4;

struct Params { const float* in[21]; float* out; unsigned char* ws; };

__device__ __forceinline__ int fresh_tid() { int t = threadIdx.x; asm volatile("" : "+v"(t)); return t; }
__device__ __forceinline__ float bf2f(unsigned x) { return __uint_as_float(x << 16); }
__device__ __forceinline__ float bflo(unsigned w) { return __uint_as_float(w << 16); }
__device__ __forceinline__ float bfhi(unsigned w) { return __uint_as_float(w & 0xffff0000u); }
__device__ __forceinline__ unsigned pk2(float lo, float hi) { return pg8::cvt_pk_bf16(lo, hi); }
__device__ __forceinline__ float wave_sum(float v) {
#pragma unroll
    for (int o = 32; o; o >>= 1) v += __shfl_xor(v, o);
    return v; }
__device__ __forceinline__ float wave_max(float v) {
#pragma unroll
    for (int o = 32; o; o >>= 1) v = fmaxf(v, __shfl_xor(v, o));
    return v; }
__device__ __forceinline__ float scan_sum(float x, int lane) {
#pragma unroll
    for (int o = 1; o < 64; o <<= 1) { const float y = __shfl_up(x, o); if (lane >= o) x += y; }
    return x; }
__device__ __forceinline__ float scan_max(float x, int lane) {
#pragma unroll
    for (int o = 1; o < 64; o <<= 1) { const float y = __shfl_up(x, o); if (lane >= o) x = fmaxf(x, y); }
    return x; }
__device__ __forceinline__ float logsigmoid(float x) { return fminf(x, 0.f) - log1pf(expf(-fabsf(x))); }
__device__ __forceinline__ bf16x8 ldfrag(LAS const unsigned char* base, int row, int strideB, int kbyte) { return *(LAS const bf16x8*)(base + row * strideB + kbyte); }
#define LDS_BARRIER() do { asm volatile("s_waitcnt lgkmcnt(0)" ::: "memory"); __builtin_amdgcn_s_barrier(); asm volatile("" ::: "memory"); } while (0)
#define MFMA16(a, b, c) __builtin_amdgcn_mfma_f32_16x16x32_bf16((a), (b), (c), 0, 0, 0)

#define XB_TMO      128
#define XB_XCNT(j)  (256  + 64 * (j))
#define XB_XSUB(j)  (1280 + 64 * (j))
#define XB_XGEN(j)  (2304 + 64 * (j))
#define XB_TOP      3328
#define XB_TOPGEN   3392
#define XCD_BAR_WORDS 3456
#define XB_SPIN_CAP (1u << 18)
__device__ __forceinline__ unsigned xb_ld(unsigned* p)              { return __hip_atomic_load(p, __ATOMIC_RELAXED, __HIP_MEMORY_SCOPE_AGENT); }
__device__ __forceinline__ unsigned xb_add(unsigned* p, unsigned v) { return __hip_atomic_fetch_add(p, v, __ATOMIC_RELAXED, __HIP_MEMORY_SCOPE_AGENT); }
__device__ __forceinline__ unsigned xb_xcc_id() { return (unsigned)__builtin_amdgcn_s_getreg((3 << 11) | 20) & 0xFu; }
#define XB_SPIN(cond, bar) do { unsigned _sp = 0; while (cond) { __builtin_amdgcn_s_sleep(1); \
    if ((++_sp & 255u) == 0u) { if (xb_ld(&(bar)[XB_TMO])) break; if (_sp > XB_SPIN_CAP) { atomicAdd(&(bar)[XB_TMO], 1u); break; } } } } while (0)

struct XcdBarrier {
    unsigned* bar; unsigned x;
    volatile LAS unsigned* st;
};

__device__ __forceinline__ XcdBarrier xcd_barrier_post(unsigned* bar, volatile LAS unsigned* st) {
    XcdBarrier b; b.bar = bar; b.x = xb_xcc_id(); b.st = st;
    if (threadIdx.x == 0) (void)xb_add(&bar[XB_XCNT(b.x)], 1u);
    return b;
}
__device__ __forceinline__ void xcd_barrier_complete(unsigned* bar, unsigned x, unsigned& nloc, unsigned& nx) {
    const unsigned G = gridDim.x * gridDim.y * gridDim.z;
    unsigned sum, cnt, mine, sp = 0u;
    for (;;) {
        sum = 0u; cnt = 0u; mine = 0u;
#pragma unroll
        for (unsigned j = 0; j < 16; ++j) { const unsigned c = xb_ld(&bar[XB_XCNT(j)]); sum += c; cnt += (c > 0u) ? 1u : 0u; mine = (j == x) ? c : mine; }
        if (sum == G) break;
        __builtin_amdgcn_s_sleep(1);
        if ((++sp & 255u) == 0u) { if (xb_ld(&bar[XB_TMO])) break; if (sp > XB_SPIN_CAP) { atomicAdd(&bar[XB_TMO], 1u); break; } }
    }
    nloc = mine > 0u ? mine : 1u; nx = cnt > 0u ? cnt : 1u;
}

__device__ __forceinline__ void xcd_barrier(const XcdBarrier& b) {
    asm volatile("s_waitcnt vmcnt(0)" ::: "memory");
    __syncthreads();
    if (threadIdx.x == 0) {
        unsigned* bar = b.bar;
        __builtin_amdgcn_s_waitcnt(0);
        unsigned nloc = b.st[0], nx = b.st[1];
        if (nloc == 0u) { xcd_barrier_complete(bar, b.x, nloc, nx); b.st[0] = nloc; b.st[1] = nx; }
        const unsigned old = xb_add(&bar[XB_XSUB(b.x)], 1u);
        const unsigned gen = old / nloc;
        if (old + 1u == (gen + 1u) * nloc) {
            __builtin_amdgcn_fence(__ATOMIC_RELEASE, "agent");
            asm volatile("s_waitcnt vmcnt(0)" ::: "memory");
            const unsigned og = xb_add(&bar[XB_TOP], 1u);
            const unsigned tg = og / nx;
            if (og + 1u == (tg + 1u) * nx) xb_add(&bar[XB_TOPGEN], 1u);
            else XB_SPIN(xb_ld(&bar[XB_TOPGEN]) == tg, bar);
            __builtin_amdgcn_fence(__ATOMIC_ACQUIRE, "agent");
            xb_add(&bar[XB_XGEN(b.x)], 1u);
            asm volatile("s_waitcnt vmcnt(0)" ::: "memory");
        } else {
            XB_SPIN(xb_ld(&bar[XB_XGEN(b.x)]) == gen, bar);
            __builtin_amdgcn_fence(__ATOMIC_ACQUIRE, "agent");
            asm volatile("s_waitcnt vmcnt(0)" ::: "memory");
        }
    }
    __syncthreads();
}

struct SplitOrder {
    int nN, nP, S, nkt, G, c;
    __device__ __forceinline__ void init(int N, int Ktiles, int S_, int G_, int c_) { nN = N / 256; nP = 256 * nN; S = S_; nkt = Ktiles; G = G_; c = c_; }
    __device__ __forceinline__ bool next(int i, pg8::Unit& u) const {
        const long L = (long)i * G + c;
        if (L >= nP + 4 * nN * S) return false;
        int pm, pn, k0 = 0, kn = nkt;
        if (L < nP) { int wgid = (int)L; { const int q = nP / 8, xcd = wgid % 8, off = wgid / 8; wgid = xcd * q + off; }
            const int nig = 8 * nN, gid = wgid / nig, fm = gid * 8; pm = fm + ((wgid % nig) % 8); pn = (wgid % nig) / 8; }
        else { const int j = (int)(L - nP), su = j / S, sl = j - su * S; pm = 256 + su / nN; pn = su % nN; kn = nkt / S; k0 = sl * kn; }
        u.pm = pm; u.pn = pn; u.kt0 = k0; u.nkt = kn; return true;
    }
    __device__ __forceinline__ void a_ready(const pg8::Unit&) const {}
    __device__ __forceinline__ void done(const pg8::Unit&) const {}
};

struct EpiBf16B {
    static constexpr bool PERM = true, AFTER_DRAIN = false;
    bf16_t* O; int ldc; const float* bias;
    __device__ __forceinline__ void operator()(const f32x4 (&acc)[2][2][4][2], const pg8::Unit& u, int wr, int wc, int fr, int fq) const {
        const int row0 = u.pm * 256 + wr * 64 + fr, col0 = u.pn * 256 + wc * 32 + 8 * fq;
        f32x4 bv[2][2];
#pragma unroll
        for (int bj = 0; bj < 2; ++bj)
#pragma unroll
            for (int n = 0; n < 2; ++n) bv[bj][n] = *(const f32x4*)(bias + col0 + bj * 128 + 4 * n);
#pragma unroll
        for (int ai = 0; ai < 2; ++ai)
#pragma unroll
            for (int m = 0; m < 4; ++m) { bf16_t* rowp = O + (size_t)(row0 + ai * 128 + m * 16) * ldc + col0;
#pragma unroll
                for (int bj = 0; bj < 2; ++bj) { const f32x4 v0 = acc[ai][bj][m][0] + bv[bj][0], v1 = acc[ai][bj][m][1] + bv[bj][1];
                    u32x4 w; w.x = pk2(v0[0], v0[1]); w.y = pk2(v0[2], v0[3]); w.z = pk2(v1[0], v1[1]); w.w = pk2(v1[2], v1[3]);
                    *(u32x4*)(rowp + bj * 128) = w; } }
    }
};
struct EpiRes {
    static constexpr bool PERM = false, AFTER_DRAIN = false;
    const bf16_t* base; float* out; float* slab; int nkt_full;
    __device__ __forceinline__ void operator()(const f32x4 (&acc)[2][2][4][2], const pg8::Unit& u, int wr, int wc, int fr, int fq) const {
        const int row0 = u.pm * 256 + wr * 64 + fr, col0 = u.pn * 256 + wc * 32 + 4 * fq;
        if (u.nkt != nkt_full) {
            float* sp = slab + (size_t)(u.kt0 / u.nkt) * (1024 * 1024) + (size_t)(row0 - MP) * DM + col0;
#pragma unroll
            for (int ai = 0; ai < 2; ++ai)
#pragma unroll
                for (int m = 0; m < 4; ++m)
#pragma unroll
                    for (int bj = 0; bj < 2; ++bj)
#pragma unroll
                        for (int n = 0; n < 2; ++n) *(f32x4*)(sp + (size_t)(ai * 128 + m * 16) * DM + bj * 128 + n * 16) = acc[ai][bj][m][n];
            return; }
#pragma unroll
        for (int ai = 0; ai < 2; ++ai)
#pragma unroll
            for (int m = 0; m < 4; ++m) { const size_t off = (size_t)(row0 + ai * 128 + m * 16) * DM + col0;
#pragma unroll
                for (int bj = 0; bj < 2; ++bj)
#pragma unroll
                    for (int n = 0; n < 2; ++n) { const u32x2 b = *(const u32x2*)(base + off + bj * 128 + n * 16);
                        f32x4 o; o[0] = ALPHA * bflo(b.x) + acc[ai][bj][m][n][0]; o[1] = ALPHA * bfhi(b.x) + acc[ai][bj][m][n][1];
                        o[2] = ALPHA * bflo(b.y) + acc[ai][bj][m][n][2]; o[3] = ALPHA * bfhi(b.y) + acc[ai][bj][m][n][3];
                        *(f32x4*)(out + off + bj * 128 + n * 16) = o; } }
    }
};
__device__ __forceinline__ float swiglu(float g, float u) { return g * u / (1.0f + __expf(-g)); }
struct EpiSwiglu {
    static constexpr bool PERM = true, AFTER_DRAIN = false;
    bf16_t* O;
    __device__ __forceinline__ void operator()(const f32x4 (&acc)[2][2][4][2], const pg8::Unit& u, int wr, int wc, int fr, int fq) const {
        const int row0 = u.pm * 256 + wr * 64 + fr, col0 = u.pn * 128 + wc * 32 + 8 * fq;
#pragma unroll
        for (int ai = 0; ai < 2; ++ai)
#pragma unroll
            for (int m = 0; m < 4; ++m) { bf16_t* rowp = O + (size_t)(row0 + ai * 128 + m * 16) * DFF + col0;
                const f32x4 g0 = acc[ai][0][m][0], g1 = acc[ai][0][m][1], u0 = acc[ai][1][m][0], u1 = acc[ai][1][m][1];
                u32x4 w; w.x = pk2(swiglu(g0[0], u0[0]), swiglu(g0[1], u0[1])); w.y = pk2(swiglu(g0[2], u0[2]), swiglu(g0[3], u0[3]));
                w.z = pk2(swiglu(g1[0], u1[0]), swiglu(g1[1], u1[1])); w.w = pk2(swiglu(g1[2], u1[2]), swiglu(g1[3], u1[3]));
                *(u32x4*)rowp = w; }
    }
};

constexpr int TR_TILES = 640 + 256 + 704 + 704 + 704 + 16;
struct TileDesc { const float* src; bf16_t* dst; int ld, K, mode, k0, n0; };
__device__ __forceinline__ TileDesc tile_desc(const Params& p, int t) {
    TileDesc d; unsigned char* ws = p.ws;
    if (t < 640) { d.src = p.in[8]; d.ld = INCOLS; d.K = DM; d.mode = 3; d.dst = (bf16_t*)(ws + WS_WIN); }
    else if (t < 896) { t -= 640; d.src = p.in[13]; d.ld = DM; d.K = DM; d.mode = 0; d.dst = (bf16_t*)(ws + WS_WOUT); }
    else if (t < 1600) { t -= 896; d.src = p.in[16]; d.ld = DFF; d.K = DM; d.mode = 1; d.dst = (bf16_t*)(ws + WS_WGU); }
    else if (t < 2304) { t -= 1600; d.src = p.in[17]; d.ld = DFF; d.K = DM; d.mode = 2; d.dst = (bf16_t*)(ws + WS_WGU); }
    else if (t < 3008) { t -= 2304; d.src = p.in[18]; d.ld = DM; d.K = DFF; d.mode = 0; d.dst = (bf16_t*)(ws + WS_WDN); }
    else { t -= 3008; const int g = t >> 2; t &= 3; d.src = p.in[10] + g * 16384; d.ld = 128; d.K = 128; d.mode = 0; d.dst = (bf16_t*)(ws + WS_WPOOL) + g * 16384; }
    const int nkt = d.K >> 6; d.k0 = (t % nkt) * 64; d.n0 = (t / nkt) * 64; return d;
}

__device__ __forceinline__ void phase0(const Params& p, LAS unsigned char* lds) {
    const int tid = fresh_tid(), lane = tid & 63, wave = tid >> 6, G = gridDim.x, bx = blockIdx.x;
    unsigned char* ws = p.ws;
    LAS float* T = (LAS float*)lds;
    {
        const int r = tid >> 3, cs = (tid & 7) * 8;
        int t = bx; float4 a = make_float4(0.f, 0.f, 0.f, 0.f), b = a; TileDesc d = tile_desc(p, t < TR_TILES ? t : 0);
        if (t < TR_TILES) { const float* s = d.src + (size_t)(d.k0 + r) * d.ld + d.n0 + cs; a = *(const float4*)s; b = *(const float4*)(s + 4); }
#pragma unroll 1
        for (; t < TR_TILES; t += G) {
            { LAS float* q = T + r * 65 + cs; q[0] = a.x; q[1] = a.y; q[2] = a.z; q[3] = a.w; q[4] = b.x; q[5] = b.y; q[6] = b.z; q[7] = b.w; }
            const TileDesc dn = tile_desc(p, t + G < TR_TILES ? t + G : 0);
            if (t + G < TR_TILES) { const float* s = dn.src + (size_t)(dn.k0 + r) * dn.ld + dn.n0 + cs; a = *(const float4*)s; b = *(const float4*)(s + 4); }
            LDS_BARRIER();
            { const int n = tid >> 3, ks = (tid & 7) * 8, gn = d.n0 + n; float v[8];
#pragma unroll
              for (int i = 0; i < 8; ++i) v[i] = T[(ks + i) * 65 + n];
              const float sc = (d.mode == 3 && gn >= 1024 && gn < 1536) ? KSCALE : 1.0f;
              const int drow = (d.mode == 1) ? 256 * (gn >> 7) + (gn & 127) : (d.mode == 2) ? 256 * (gn >> 7) + 128 + (gn & 127) : gn;
              u32x4 w; w.x = pk2(v[0] * sc, v[1] * sc); w.y = pk2(v[2] * sc, v[3] * sc); w.z = pk2(v[4] * sc, v[5] * sc); w.w = pk2(v[6] * sc, v[7] * sc);
              *(u32x4*)(d.dst + (size_t)drow * d.K + d.k0 + ks) = w; }
            LDS_BARRIER();
            d = dn;
        }
    }
    { float* bs = (float*)(ws + WS_BIAS); const float* b_in = p.in[9];
      for (int i = bx * 512 + tid; i < NPROJ; i += G * 512) bs[i] = b_in[i] * ((i >= 1024 && i < 1536) ? KSCALE : 1.0f); }
    f32x4 wlo[4][4], whi[4][4];
    { const float* w_in = p.in[8];
#pragma unroll
      for (int i = 0; i < 4; ++i)
#pragma unroll
          for (int e = 0; e < 4; ++e) { const float* wp = w_in + (size_t)(i * 256 + lane * 4 + e) * INCOLS + NPROJ; wlo[i][e] = *(const f32x4*)wp; whi[i][e] = *(const f32x4*)(wp + 4); } }
    const float* lg = p.in[6]; const float* lb = p.in[7]; const float* b_in = p.in[9];
    bf16_t* h0 = (bf16_t*)(ws + WS_H0); float* gates = (float*)(ws + WS_GATES);
    const float gb_perm = lane < 8 ? b_in[NPROJ + (((lane & 1) << 2) | (lane & 2) | ((lane >> 2) & 1))] : 0.f;
    int row = bx * 8 + wave; float4 v[4];
    if (row < MT) { const float* x = row < MP ? p.in[0] + (size_t)row * DM : p.in[1] + (size_t)(row - MP) * DM;
#pragma unroll
        for (int i = 0; i < 4; ++i) v[i] = *(const float4*)(x + i * 256 + lane * 4); }
#pragma unroll 1
    for (; row < MT; row += G * 8) {
        const int nrow = row + G * 8; float4 nv[4];
        if (nrow < MT) { const float* x = nrow < MP ? p.in[0] + (size_t)nrow * DM : p.in[1] + (size_t)(nrow - MP) * DM;
#pragma unroll
            for (int i = 0; i < 4; ++i) nv[i] = *(const float4*)(x + i * 256 + lane * 4); }
        else {
#pragma unroll
            for (int i = 0; i < 4; ++i) nv[i] = make_float4(0.f, 0.f, 0.f, 0.f); }
        float s = 0.f;
#pragma unroll
        for (int i = 0; i < 4; ++i) s += (v[i].x + v[i].y) + (v[i].z + v[i].w);
        const float mu = wave_sum(s) * (1.0f / DM);
        float q = 0.f;
#pragma unroll
        for (int i = 0; i < 4; ++i) { v[i].x -= mu; v[i].y -= mu; v[i].z -= mu; v[i].w -= mu; q += (v[i].x * v[i].x + v[i].y * v[i].y) + (v[i].z * v[i].z + v[i].w * v[i].w); }
        const float rstd = rsqrtf(wave_sum(q) * (1.0f / DM) + LN_EPS);
        f32x4 glo = (f32x4){0.f, 0.f, 0.f, 0.f}, ghi = glo;
#pragma unroll
        for (int i = 0; i < 4; ++i) { const int c = i * 256 + lane * 4; const float4 gg = *(const float4*)(lg + c), bb = *(const float4*)(lb + c);
            float4 y; y.x = v[i].x * rstd * gg.x + bb.x; y.y = v[i].y * rstd * gg.y + bb.y; y.z = v[i].z * rstd * gg.z + bb.z; y.w = v[i].w * rstd * gg.w + bb.w;
            u32x2 w; w.x = pk2(y.x, y.y); w.y = pk2(y.z, y.w); *(u32x2*)(h0 + (size_t)row * DM + c) = w;
            glo += y.x * wlo[i][0] + y.y * wlo[i][1] + y.z * wlo[i][2] + y.w * wlo[i][3];
            ghi += y.x * whi[i][0] + y.y * whi[i][1] + y.z * whi[i][2] + y.w * whi[i][3]; }
        { const bool b0 = lane & 1, b1 = lane & 2, b2 = lane & 4;
          f32x4 k4, s4;
#pragma unroll
          for (int j = 0; j < 4; ++j) { k4[j] = b0 ? ghi[j] : glo[j]; s4[j] = b0 ? glo[j] : ghi[j]; }
#pragma unroll
          for (int j = 0; j < 4; ++j) k4[j] += __shfl_xor(s4[j], 1);
          float k2a = b1 ? k4[2] : k4[0], k2b = b1 ? k4[3] : k4[1];
          k2a += __shfl_xor(b1 ? k4[0] : k4[2], 2); k2b += __shfl_xor(b1 ? k4[1] : k4[3], 2);
          float k1 = b2 ? k2b : k2a; k1 += __shfl_xor(b2 ? k2a : k2b, 4);
          k1 += __shfl_xor(k1, 8); k1 += __shfl_xor(k1, 16); k1 += __shfl_xor(k1, 32);
          const int gidx = ((lane & 1) << 2) | (lane & 2) | ((lane >> 2) & 1);
          if (lane < 8) gates[(size_t)row * 8 + gidx] = k1 + gb_perm; }
#pragma unroll
        for (int i = 0; i < 4; ++i) v[i] = nv[i];
    }
}

__device__ __forceinline__ void gate_scan(const Params& p, LAS unsigned char* lds) {
    const int tid = fresh_tid(), lane = tid & 63, wave = tid >> 6;
    const float* gates = (const float*)(p.ws + WS_GATES); float* mtab = (float*)(p.ws + WS_MTAB); float* btab = (float*)(p.ws + WS_BTAB);
    f32x4* gtab = (f32x4*)(p.ws + WS_GTAB);
    LAS float* sA = (LAS float*)lds; LAS float* sB = sA + 128; LAS float* sM = sA + 256;
    for (int chain = blockIdx.x; chain < 32; chain += gridDim.x) {
        const int batch = chain >> 2, head = chain & 3;
        for (int c = wave; c < 128; c += 8) {
            const size_t row = (size_t)batch * SEQ + c * 64 + lane;
            const float ig = gates[row * 8 + head], fg = gates[row * 8 + 4 + head];
            const float b = scan_sum(logsigmoid(fg), lane); const float A = wave_max(ig - b); const float bl = __shfl(b, 63);
            if (lane == 0) { sA[c] = A; sB[c] = bl; }
        }
        __syncthreads();
        if (tid == 0) { float m = 0.f; mtab[chain * 132] = 0.f; sM[0] = 0.f;
            for (int c = 0; c < 128; ++c) { m = sB[c] + fmaxf(m, sA[c]); mtab[chain * 132 + c + 1] = m; sM[c + 1] = m; btab[chain * 128 + c] = sB[c]; }
            p.out[O_MP + chain] = m; }
        __syncthreads();
        for (int c = wave; c < 128; c += 8) {
            const size_t row = (size_t)batch * SEQ + c * 64 + lane;
            const float ig = gates[row * 8 + head], fg = gates[row * 8 + 4 + head];
            const float b = scan_sum(logsigmoid(fg), lane); const float a = ig - b; const float m_prev = sM[c];
            const float M = fmaxf(m_prev, scan_max(a, lane));
            gtab[row * 4 + head] = (f32x4){a, M, expf(m_prev - M), expf(-(b + M))};
        }
        __syncthreads();
    }
    for (int s = blockIdx.x * 8 + wave; s < DB * 4; s += gridDim.x * 8) {
        const int b_ = s >> 2, head = s & 3; const bool valid = lane < 32; const size_t row = (size_t)MP + b_ * 32 + (lane & 31);
        const float ig = gates[row * 8 + head], fg = gates[row * 8 + 4 + head]; const float m_prev = p.in[5][s];
        const float b = scan_sum(valid ? logsigmoid(fg) : 0.f, lane); const float a = valid ? ig - b : -1e30f;
        const float M = fmaxf(m_prev, scan_max(a, lane));
        if (valid) gtab[row * 4 + head] = (f32x4){a, M, expf(m_prev - M), expf(-(b + M))};
        if (lane == 31) p.out[O_MS + s] = b + M;
    }
}

constexpr int L_Q = 0, L_K = 17408, L_KW = 34816, L_V = 52224, L_CT = 69632, L_S = 104448, L_G = 113664;
typedef short s16x4 __attribute__((ext_vector_type(4)));
__device__ __forceinline__ bf16x8 ldfrag_tr(LAS const unsigned char* base, int row0, int col0, int lane) {
    const int g = lane >> 4, q = (lane & 15) >> 2, pp = lane & 3;
    LAS const unsigned char* a = base + (row0 + 8 * g + q) * 272 + (col0 + 4 * pp) * 2;
    const s16x4 lo = __builtin_amdgcn_ds_read_tr16_b64_v4i16((LAS s16x4*)a);
    const s16x4 hi = __builtin_amdgcn_ds_read_tr16_b64_v4i16((LAS s16x4*)(a + 4 * 272));
    return __builtin_shufflevector(lo, hi, 0, 1, 2, 3, 4, 5, 6, 7);
}

template <bool FULL>
__device__ __forceinline__ void mlstm_run(const Params& p, LAS unsigned char* lds, f32x4 (&accC)[2][4], f32x4 (&accN)[2], int row0, int head, int nch, int L) {
    const int tid = fresh_tid(), lane = tid & 63, wave = __builtin_amdgcn_readfirstlane(tid >> 6), l15 = lane & 15, l4 = lane >> 4, st = wave & 3, tp = wave >> 2;
    const bf16_t* proj = (const bf16_t*)(p.ws + WS_PROJ); const f32x4* gtab = (const f32x4*)(p.ws + WS_GTAB);
    bf16_t* mix = (bf16_t*)(p.ws + WS_MIX);
    LAS unsigned short* sQ = (LAS unsigned short*)(lds + L_Q); LAS unsigned short* sK = (LAS unsigned short*)(lds + L_K);
    LAS unsigned short* sKW = (LAS unsigned short*)(lds + L_KW); LAS unsigned short* sV = (LAS unsigned short*)(lds + L_V);
    LAS unsigned short* sS = (LAS unsigned short*)(lds + L_S); LAS float* sH = (LAS float*)(lds + L_Q);
    LAS float* gA = (LAS float*)(lds + L_G); LAS float* gM = gA + 64; LAS float* gDec = gA + 128; LAS float* gEinv = gA + 192; LAS float* gW = gA + 256;
    LAS float* gQn = gA + 320; LAS float* gDi = gA + 384; LAS float* gN = gA + 448; LAS float* scal = gA + 576; LAS float* gNg = gA + 584;
    const bf16x8 ones = (bf16x8){0x3F80, 0x3F80, 0x3F80, 0x3F80, 0x3F80, 0x3F80, 0x3F80, 0x3F80};
    const int tok0 = tid >> 4, dsg = tid & 15;
    const int orow = tid >> 3, oseg = tid & 7;
    u32x4 kq[2], kk[2], kv[2]; f32x4 pgt = (f32x4){0.f, 0.f, 0.f, 0.f};
    if (FULL && tid < 128) gNg[tid] = p.in[12][head * 128 + tid];
#pragma unroll
    for (int i = 0; i < 2; ++i) { const int tok = tok0 + 32 * i; const bool valid = tok < L; const u32x4 z = (u32x4){0u, 0u, 0u, 0u};
        const bf16_t* src = proj + (size_t)(row0 + tok) * NPROJ + head * 128 + dsg * 8;
        kk[i] = valid ? *(const u32x4*)(src + 1024) : z; kv[i] = valid ? *(const u32x4*)(src + 1536) : z;
        if (FULL) kq[i] = valid ? *(const u32x4*)(src + 512) : z; else kq[i] = z; }
    if (wave == 0 && lane < L) pgt = gtab[(size_t)(row0 + lane) * 4 + head];
#pragma unroll 1
    for (int c = 0; c < nch; ++c) {
        const int r0 = row0 + c * 64;
        if (wave == 0) {
            const bool valid = lane < L; const float a = valid ? pgt[0] : -1e30f; const float Ml = __shfl(pgt[1], L - 1);
            gA[lane] = a; gM[lane] = valid ? pgt[1] : Ml; gDec[lane] = valid ? pgt[2] : 0.f; gEinv[lane] = valid ? pgt[3] : 1.f; gW[lane] = valid ? __expf(a - Ml) : 0.f;
            if (lane == L - 1) scal[0] = pgt[2];
        }
        if (FULL) {
#pragma unroll
            for (int i = 0; i < 2; ++i)
#pragma unroll
                for (int n = 0; n < 4; ++n) { u32x2 w; w.x = pk2(accC[i][n][0], accC[i][n][1]); w.y = pk2(accC[i][n][2], accC[i][n][3]);
                    *(LAS u32x2*)(lds + L_CT + (64 * tp + 16 * n + l15) * 272 + (32 * st + 16 * i + 4 * l4) * 2) = w; }
            if (tp == 0 && l15 == 0) {
#pragma unroll
                for (int i = 0; i < 2; ++i) *(LAS f32x4*)(gN + 32 * st + 16 * i + 4 * l4) = accN[i]; }
        }
#pragma unroll
        for (int i = 0; i < 2; ++i) { const int tok = tok0 + 32 * i;
            if (FULL) { *(LAS u32x4*)(sQ + tok * 136 + dsg * 8) = kq[i]; *(LAS u32x4*)(sK + tok * 136 + dsg * 8) = kk[i]; }
            *(LAS u32x4*)(sV + tok * 136 + dsg * 8) = kv[i]; }
        LDS_BARRIER();
#pragma unroll
        for (int i = 0; i < 2; ++i) { const int tok = tok0 + 32 * i; const float w = gW[tok]; u32x4 o;
            o.x = pk2(bflo(kk[i].x) * w, bfhi(kk[i].x) * w); o.y = pk2(bflo(kk[i].y) * w, bfhi(kk[i].y) * w);
            o.z = pk2(bflo(kk[i].z) * w, bfhi(kk[i].z) * w); o.w = pk2(bflo(kk[i].w) * w, bfhi(kk[i].w) * w);
            *(LAS u32x4*)(sKW + tok * 136 + dsg * 8) = o; }
        if (c + 1 < nch) {
#pragma unroll
            for (int i = 0; i < 2; ++i) { const int tok = tok0 + 32 * i;
                const bf16_t* src = proj + (size_t)(r0 + 64 + tok) * NPROJ + head * 128 + dsg * 8;
                kk[i] = *(const u32x4*)(src + 1024); kv[i] = *(const u32x4*)(src + 1536);
                if (FULL) kq[i] = *(const u32x4*)(src + 512); }
            if (wave == 0) pgt = gtab[(size_t)(r0 + 64 + lane) * 4 + head];
        }
        f32x4 nacc[4];
#pragma unroll
        for (int n = 0; n < 4; ++n) nacc[n] = (f32x4){0.f, 0.f, 0.f, 0.f};
        if (FULL) {
            f32x4 sacc[2]; sacc[0] = (f32x4){0.f, 0.f, 0.f, 0.f}; sacc[1] = sacc[0];
#pragma unroll
            for (int ks = 0; ks < 4; ++ks) { const int kb = (32 * ks + 8 * l4) * 2;
                const bf16x8 a = ldfrag(lds + L_K, 16 * st + l15, 272, kb);
#pragma unroll
                for (int tt = 0; tt < 2; ++tt) { const bf16x8 b = ldfrag(lds + L_Q, 16 * (2 * tp + tt) + l15, 272, kb); sacc[tt] = MFMA16(a, b, sacc[tt]); } }
#pragma unroll
            for (int tt = 0; tt < 2; ++tt) { const int t = 16 * (2 * tp + tt) + l15; const float Mt = gM[t]; float dv[4];
#pragma unroll
                for (int j = 0; j < 4; ++j) { const int s = 16 * st + 4 * l4 + j; dv[j] = (s <= t) ? sacc[tt][j] * __expf(gA[s] - Mt) : 0.f; }
                u32x2 w; w.x = pk2(dv[0], dv[1]); w.y = pk2(dv[2], dv[3]); *(LAS u32x2*)(lds + L_S + t * 144 + (16 * st + 4 * l4) * 2) = w; }
#pragma unroll
            for (int ks = 0; ks < 4; ++ks) { const int kb = (32 * ks + 8 * l4) * 2;
                const bf16x8 a = ldfrag(lds + L_Q, 16 * st + l15, 272, kb);
#pragma unroll
                for (int n = 0; n < 4; ++n) { const bf16x8 b = ldfrag(lds + L_CT, 64 * tp + 16 * n + l15, 272, kb); nacc[n] = MFMA16(a, b, nacc[n]); } }
#pragma unroll
            for (int j = 0; j < 4; ++j) { const float dj = gDec[16 * st + 4 * l4 + j];
#pragma unroll
                for (int n = 0; n < 4; ++n) nacc[n][j] *= dj; }
            { float s = 0.f;
              const u32x4 q0 = *(LAS const u32x4*)(sQ + orow * 136 + oseg * 16), q1 = *(LAS const u32x4*)(sQ + orow * 136 + oseg * 16 + 8);
              const unsigned qw[8] = {q0.x, q0.y, q0.z, q0.w, q1.x, q1.y, q1.z, q1.w};
#pragma unroll
              for (int e = 0; e < 8; ++e) s += bflo(qw[e]) * gN[oseg * 16 + 2 * e] + bfhi(qw[e]) * gN[oseg * 16 + 2 * e + 1];
              s += __shfl_xor(s, 1); s += __shfl_xor(s, 2); s += __shfl_xor(s, 4);
              if (oseg == 0) gQn[orow] = s; }
        }
        LDS_BARRIER();
        if (FULL) {
            const u32x4 s0 = *(LAS const u32x4*)(sS + orow * 72 + oseg * 8);
            float s = (bflo(s0.x) + bfhi(s0.x)) + (bflo(s0.y) + bfhi(s0.y)) + (bflo(s0.z) + bfhi(s0.z)) + (bflo(s0.w) + bfhi(s0.w));
            s += __shfl_xor(s, 1); s += __shfl_xor(s, 2); s += __shfl_xor(s, 4);
            if (oseg == 0) { const float den = gDec[orow] * gQn[orow] + s; gDi[orow] = 1.0f / fmaxf(fabsf(den), gEinv[orow]); } }
        const float wsv = scal[0];
#pragma unroll
        for (int i = 0; i < 2; ++i) { accN[i] *= wsv;
#pragma unroll
            for (int n = 0; n < 4; ++n) accC[i][n] *= wsv; }
#pragma unroll
        for (int ks = 0; ks < 2; ++ks) { bf16x8 bv[4];
#pragma unroll
            for (int n = 0; n < 4; ++n) bv[n] = ldfrag_tr(lds + L_V, 32 * ks, 64 * tp + 16 * n, lane);
            if (FULL) { const bf16x8 a = ldfrag(lds + L_S, 16 * st + l15, 144, (32 * ks + 8 * l4) * 2);
#pragma unroll
                for (int n = 0; n < 4; ++n) nacc[n] = MFMA16(a, bv[n], nacc[n]); }
#pragma unroll
            for (int i = 0; i < 2; ++i) { const bf16x8 a = ldfrag_tr(lds + L_KW, 32 * ks, 32 * st + 16 * i, lane);
                accN[i] = MFMA16(a, ones, accN[i]);
#pragma unroll
                for (int n = 0; n < 4; ++n) accC[i][n] = MFMA16(a, bv[n], accC[i][n]); } }
        LDS_BARRIER();
        if (FULL) {
            u32x4 ow0 = (u32x4){0u, 0u, 0u, 0u}, ow1 = ow0;
            if (orow < L) { const bf16_t* op = proj + (size_t)(r0 + orow) * NPROJ + 2048 + head * 128 + oseg * 16; ow0 = *(const u32x4*)op; ow1 = *(const u32x4*)(op + 8); }
#pragma unroll
            for (int j = 0; j < 4; ++j) { const int t = 16 * st + 4 * l4 + j; const float di = gDi[t];
#pragma unroll
                for (int n = 0; n < 4; ++n) sH[t * 132 + 64 * tp + 16 * n + l15] = nacc[n][j] * di; }
            LDS_BARRIER();
            if (orow < L) {
                f32x4 x[4]; float s = 0.f;
#pragma unroll
                for (int e = 0; e < 4; ++e) { x[e] = *(LAS const f32x4*)(sH + orow * 132 + oseg * 16 + 4 * e); s += (x[e][0] + x[e][1]) + (x[e][2] + x[e][3]); }
                s += __shfl_xor(s, 1); s += __shfl_xor(s, 2); s += __shfl_xor(s, 4);
                const float mean = s * (1.0f / 128.0f); float q = 0.f;
#pragma unroll
                for (int e = 0; e < 4; ++e) { x[e] -= mean; q += (x[e][0] * x[e][0] + x[e][1] * x[e][1]) + (x[e][2] * x[e][2] + x[e][3] * x[e][3]); }
                q += __shfl_xor(q, 1); q += __shfl_xor(q, 2); q += __shfl_xor(q, 4);
                const float rstd = rsqrtf(q * (1.0f / 128.0f) + LN_EPS);
                const unsigned owv[8] = {ow0.x, ow0.y, ow0.z, ow0.w, ow1.x, ow1.y, ow1.z, ow1.w}; unsigned ov[8];
#pragma unroll
                for (int e = 0; e < 4; ++e) { const f32x4 g = *(LAS const f32x4*)(gNg + oseg * 16 + 4 * e);
                    const float y0 = x[e][0] * rstd * g[0] / (1.0f + __expf(-bflo(owv[2 * e]))), y1 = x[e][1] * rstd * g[1] / (1.0f + __expf(-bfhi(owv[2 * e])));
                    const float y2 = x[e][2] * rstd * g[2] / (1.0f + __expf(-bflo(owv[2 * e + 1]))), y3 = x[e][3] * rstd * g[3] / (1.0f + __expf(-bfhi(owv[2 * e + 1])));
                    ov[2 * e] = pk2(y0, y1); ov[2 * e + 1] = pk2(y2, y3); }
                bf16_t* mp = mix + (size_t)(r0 + orow) * DM + 512 + head * 128 + oseg * 16;
                *(u32x4*)mp = (u32x4){ov[0], ov[1], ov[2], ov[3]}; *(u32x4*)(mp + 8) = (u32x4){ov[4], ov[5], ov[6], ov[7]};
            }
            LDS_BARRIER();
        }
    }
}

constexpr int L_PW = 34816, L_PU = 69632;
template <int W>
__device__ __forceinline__ void pool_diff(LAS unsigned char* lds, bool sample, int tilepos0) {
    const int tid = fresh_tid(), co = tid & 15, t0 = (tid >> 4) * 4;
#pragma unroll 1
    for (int tt = 0; tt < 4; ++tt) {
        const int t = t0 + tt; const int sgi = sample ? (t >> 5) : 0, lt = sample ? (t & 31) : t;
        const int rowbase = sample ? sgi * 47 + 15 + lt : 15 + t;
        const int cnt = sample ? W : min(tilepos0 + t + 1, W);
        float sum[8];
#pragma unroll
        for (int e = 0; e < 8; ++e) sum[e] = 0.f;
        u32x4 x0 = (u32x4){0u, 0u, 0u, 0u};
#pragma unroll
        for (int j = 0; j < W; ++j) { const u32x4 r = *(LAS const u32x4*)(lds + L_PU + (rowbase - j) * 272 + co * 16); if (j == 0) x0 = r;
            sum[0] += bflo(r.x); sum[1] += bfhi(r.x); sum[2] += bflo(r.y); sum[3] += bfhi(r.y); sum[4] += bflo(r.z); sum[5] += bfhi(r.z); sum[6] += bflo(r.w); sum[7] += bfhi(r.w); }
        const float inv = 1.0f / (float)cnt;
        u32x4 w; w.x = pk2(sum[0] * inv - bflo(x0.x), sum[1] * inv - bfhi(x0.x)); w.y = pk2(sum[2] * inv - bflo(x0.y), sum[3] * inv - bfhi(x0.y));
        w.z = pk2(sum[4] * inv - bflo(x0.z), sum[5] * inv - bfhi(x0.z)); w.w = pk2(sum[6] * inv - bflo(x0.w), sum[7] * inv - bfhi(x0.w));
        *(LAS u32x4*)(lds + t * 272 + co * 16) = w; }
}

__device__ __forceinline__ void pool_fetch(const Params& p, int item, int tid, u32x4 (&pf)[6]) {
    const int g = item & 3, R0 = (item >> 2) * 128;
    const bf16_t* proj = (const bf16_t*)(p.ws + WS_PROJ); const float* hist = p.in[2];
    if (R0 < MP) {
        const int seqrow0 = (R0 / SEQ) * SEQ, tilepos0 = R0 - seqrow0;
        u32x4 raw[6];
#pragma unroll
        for (int i = 0; i < 6; ++i) { const int piece = tid + 512 * i, e = piece >> 4, seg = piece & 15; int pos = tilepos0 - 15 + (e < 143 ? e : 142); pos = pos < 0 ? 0 : pos;
            raw[i] = *(const u32x4*)(proj + (size_t)(seqrow0 + pos) * NPROJ + g * 128 + seg * 8); }
#pragma unroll
        for (int i = 0; i < 6; ++i) { const int piece = tid + 512 * i, e = piece >> 4; const bool valid = (e < 143) && (tilepos0 - 15 + e >= 0);
            pf[i] = valid ? raw[i] : (u32x4){0u, 0u, 0u, 0u}; }
    } else {
#pragma unroll
        for (int i = 0; i < 6; ++i) { const int piece = tid + 512 * i, e = piece >> 4, seg = piece & 15; u32x4 val = (u32x4){0u, 0u, 0u, 0u};
            if (e < 188) { const int sgi = e / 47, le = e - sgi * 47, b = ((R0 - MP) >> 5) + sgi;
                if (le < 15) { const float* hp = hist + ((size_t)b * 15 + le) * 512 + g * 128 + seg * 8; const float4 a = *(const float4*)hp, c4 = *(const float4*)(hp + 4);
                    val.x = pk2(a.x, a.y); val.y = pk2(a.z, a.w); val.z = pk2(c4.x, c4.y); val.w = pk2(c4.z, c4.w); }
                else val = *(const u32x4*)(proj + (size_t)(MP + b * 32 + le - 15) * NPROJ + g * 128 + seg * 8); }
            pf[i] = val; }
    }
}

__device__ __forceinline__ void pool_loop(const Params& p, LAS unsigned char* lds, int first, int stride, int end) {
    const int tid = fresh_tid(), lane = tid & 63, wave = __builtin_amdgcn_readfirstlane(tid >> 6), l15 = lane & 15, l4 = lane >> 4, st = wave & 3, tp = wave >> 2;
    bf16_t* mix = (bf16_t*)(p.ws + WS_MIX); const float* pscale = p.in[11];
    if (first >= end) return;
    u32x4 pf[6]; pool_fetch(p, first, tid, pf);
    int gw = -1;
#pragma unroll 1
    for (int item = first; item < end; item += stride) {
        const int g = item & 3, R0 = (item >> 2) * 128;
        const bool sample = R0 >= MP; const int tilepos0 = sample ? 0 : R0 - (R0 / SEQ) * SEQ;
        if (g != gw) { const bf16_t* Wp = (const bf16_t*)(p.ws + WS_WPOOL) + g * 16384; gw = g;
#pragma unroll
            for (int i = 0; i < 4; ++i) { const int piece = tid + 512 * i, row = piece >> 4, seg = piece & 15;
                *(LAS u32x4*)(lds + L_PW + row * 272 + seg * 16) = *(const u32x4*)(Wp + row * 128 + seg * 8); } }
#pragma unroll
        for (int i = 0; i < 6; ++i) { const int piece = tid + 512 * i, e = piece >> 4, seg = piece & 15; if (e < 188) *(LAS u32x4*)(lds + L_PU + e * 272 + seg * 16) = pf[i]; }
        LDS_BARRIER();
        if (item + stride < end) pool_fetch(p, item + stride, tid, pf);
        if (g == 0) pool_diff<2>(lds, sample, tilepos0); else if (g == 1) pool_diff<4>(lds, sample, tilepos0); else if (g == 2) pool_diff<8>(lds, sample, tilepos0); else pool_diff<16>(lds, sample, tilepos0);
        LDS_BARRIER();
        f32x4 acc[2][4];
#pragma unroll
        for (int i = 0; i < 2; ++i)
#pragma unroll
            for (int n = 0; n < 4; ++n) acc[i][n] = (f32x4){0.f, 0.f, 0.f, 0.f};
#pragma unroll
        for (int ks = 0; ks < 4; ++ks) { const int kb = (32 * ks + 8 * l4) * 2; bf16x8 bv[4];
#pragma unroll
            for (int n = 0; n < 4; ++n) bv[n] = ldfrag(lds, 64 * tp + 16 * n + l15, 272, kb);
#pragma unroll
            for (int i = 0; i < 2; ++i) { const bf16x8 a = ldfrag(lds + L_PW, 32 * st + 16 * i + l15, 272, kb);
#pragma unroll
                for (int n = 0; n < 4; ++n) acc[i][n] = MFMA16(a, bv[n], acc[i][n]); } }
        LDS_BARRIER();
#pragma unroll
        for (int i = 0; i < 2; ++i) { const int d0 = 32 * st + 16 * i + 4 * l4; const float4 ps = *(const float4*)(pscale + g * 128 + d0);
#pragma unroll
            for (int n = 0; n < 4; ++n) { const int t = 64 * tp + 16 * n + l15;
                u32x2 w; w.x = pk2(acc[i][n][0] * ps.x, acc[i][n][1] * ps.y); w.y = pk2(acc[i][n][2] * ps.z, acc[i][n][3] * ps.w);
                *(LAS u32x2*)(lds + t * 272 + d0 * 2) = w; } }
        LDS_BARRIER();
        { const int t = tid >> 2, sg = tid & 3; const u32x4 o0 = *(LAS const u32x4*)(lds + t * 272 + sg * 64), o1 = *(LAS const u32x4*)(lds + t * 272 + sg * 64 + 16),
            o2 = *(LAS const u32x4*)(lds + t * 272 + sg * 64 + 32), o3 = *(LAS const u32x4*)(lds + t * 272 + sg * 64 + 48);
          bf16_t* mp = mix + (size_t)(R0 + t) * DM + g * 128 + sg * 32; *(u32x4*)mp = o0; *(u32x4*)(mp + 8) = o1; *(u32x4*)(mp + 16) = o2; *(u32x4*)(mp + 24) = o3; }
    }
    LDS_BARRIER();
}

constexpr int N_S2 = 224, N_SMP = 128, N_POOL = (MT / 128) * 4;

__device__ __forceinline__ void phase2(const Params& p, LAS unsigned char* lds, int kinds) {
    const int tid = fresh_tid(), lane = tid & 63, wave = tid >> 6, l15 = lane & 15, l4 = lane >> 4, st = wave & 3, tp = wave >> 2;
    float* Dst = (float*)(p.ws + WS_DST); float* Dn = (float*)(p.ws + WS_DN); const float* mtab = (const float*)(p.ws + WS_MTAB);
    for (int it = blockIdx.x; it < N_S2 + N_SMP; it += gridDim.x) {
        if (it < N_S2) {
            if (!(kinds & 1)) continue;
            const int chain = it / 7, sc = it % 7, batch = chain >> 2, head = chain & 3;
            f32x4 accC[2][4], accN[2];
#pragma unroll
            for (int i = 0; i < 2; ++i) { accN[i] = (f32x4){0.f, 0.f, 0.f, 0.f};
#pragma unroll
                for (int n = 0; n < 4; ++n) accC[i][n] = (f32x4){0.f, 0.f, 0.f, 0.f}; }
            mlstm_run<false>(p, lds, accC, accN, batch * SEQ + sc * SCN * 64, head, SCN, 64);
#pragma unroll
            for (int i = 0; i < 2; ++i)
#pragma unroll
                for (int n = 0; n < 4; ++n)
#pragma unroll
                    for (int j = 0; j < 4; ++j) Dst[((size_t)it * 32 + (i * 4 + n) * 4 + j) * 512 + tid] = accC[i][n][j];
            if (tp == 0 && l15 == 0) {
#pragma unroll
                for (int i = 0; i < 2; ++i) *(f32x4*)(Dn + it * 128 + 32 * st + 16 * i + 4 * l4) = accN[i]; }
        } else {
            if (!(kinds & 2)) continue;
            const int s = it - N_S2, b = s >> 2, head = s & 3;
            const float* C0 = p.in[3] + (size_t)s * 16384; f32x4 accC[2][4], accN[2];
#pragma unroll
            for (int i = 0; i < 2; ++i) accN[i] = *(const f32x4*)(p.in[4] + s * 128 + 32 * st + 16 * i + 4 * l4);
#pragma unroll
            for (int i = 0; i < 2; ++i)
#pragma unroll
                for (int n = 0; n < 4; ++n)
#pragma unroll
                    for (int j = 0; j < 4; ++j) accC[i][n][j] = C0[(32 * st + 16 * i + 4 * l4 + j) * 128 + 64 * tp + 16 * n + l15];
            mlstm_run<true>(p, lds, accC, accN, MP + b * 32, head, 1, 32);
            float* Co = p.out + O_CS + (size_t)s * 16384;
#pragma unroll
            for (int i = 0; i < 2; ++i)
#pragma unroll
                for (int n = 0; n < 4; ++n)
#pragma unroll
                    for (int j = 0; j < 4; ++j) Co[(32 * st + 16 * i + 4 * l4 + j) * 128 + 64 * tp + 16 * n + l15] = accC[i][n][j];
            if (tp == 0 && l15 == 0) {
#pragma unroll
                for (int i = 0; i < 2; ++i) *(f32x4*)(p.out + O_NS + s * 128 + 32 * st + 16 * i + 4 * l4) = accN[i]; }
        }
    }
    if (kinds & 4) { const int G = gridDim.x; int first = blockIdx.x; while (first < N_S2 + N_SMP) first += G;
        pool_loop(p, lds, first - N_S2 - N_SMP, G, N_POOL); }
    const bf16_t* proj = (const bf16_t*)(p.ws + WS_PROJ);
    for (int idx = blockIdx.x * 512 + tid; idx < (NB + DB) * 15 * 512; idx += gridDim.x * 512) {
        if (idx < NB * 7680) { const int b = idx / 7680, rem = idx % 7680, i = rem >> 9, c = rem & 511;
            p.out[O_POOLP + idx] = bf2f(proj[(size_t)(b * SEQ + SEQ - 15 + i) * NPROJ + c]); }
        else { const int id2 = idx - NB * 7680, b = id2 / 7680, rem = id2 % 7680, i = rem >> 9, c = rem & 511;
            p.out[O_POOLS + id2] = bf2f(proj[(size_t)(MP + b * 32 + 17 + i) * NPROJ + c]); }
    }
}

__device__ __forceinline__ void phase3(const Params& p, LAS unsigned char* lds) {
    const int tid = fresh_tid(), lane = tid & 63, wave = tid >> 6, l15 = lane & 15, l4 = lane >> 4, st = wave & 3, tp = wave >> 2;
    const float* Dst = (const float*)(p.ws + WS_DST); const float* Dn = (const float*)(p.ws + WS_DN);
    const float* mtab = (const float*)(p.ws + WS_MTAB); const float* btab = (const float*)(p.ws + WS_BTAB);
    for (int it = blockIdx.x; it < 256; it += gridDim.x) {
        const int chain = it >> 3, sc = it & 7, batch = chain >> 2, head = chain & 3;
        f32x4 accC[2][4], accN[2];
#pragma unroll
        for (int i = 0; i < 2; ++i) { accN[i] = (f32x4){0.f, 0.f, 0.f, 0.f};
#pragma unroll
            for (int n = 0; n < 4; ++n) accC[i][n] = (f32x4){0.f, 0.f, 0.f, 0.f}; }
#pragma unroll 1
        for (int j = 0; j < sc; ++j) {
            float Bs = 0.f;
            for (int c = 0; c < SCN; ++c) Bs += btab[chain * 128 + j * SCN + c];
            const float Wj = expf(Bs + mtab[chain * 132 + j * SCN] - mtab[chain * 132 + (j + 1) * SCN]);
            const int item = chain * 7 + j;
#pragma unroll
            for (int i = 0; i < 2; ++i)
#pragma unroll
                for (int n = 0; n < 4; ++n)
#pragma unroll
                    for (int q = 0; q < 4; ++q) accC[i][n][q] = Wj * accC[i][n][q] + Dst[((size_t)item * 32 + (i * 4 + n) * 4 + q) * 512 + tid];
#pragma unroll
            for (int i = 0; i < 2; ++i) accN[i] = Wj * accN[i] + *(const f32x4*)(Dn + item * 128 + 32 * st + 16 * i + 4 * l4);
        }
        mlstm_run<true>(p, lds, accC, accN, batch * SEQ + sc * SCN * 64, head, SCN, 64);
        if (sc == 7) {
            float* Co = p.out + O_CP + (size_t)chain * 16384;
#pragma unroll
            for (int i = 0; i < 2; ++i)
#pragma unroll
                for (int n = 0; n < 4; ++n)
#pragma unroll
                    for (int j = 0; j < 4; ++j) Co[(32 * st + 16 * i + 4 * l4 + j) * 128 + 64 * tp + 16 * n + l15] = accC[i][n][j];
            if (tp == 0 && l15 == 0) {
#pragma unroll
                for (int i = 0; i < 2; ++i) *(f32x4*)(p.out + O_NP + chain * 128 + 32 * st + 16 * i + 4 * l4) = accN[i]; }
        }
    }
}

__device__ __forceinline__ void ln_load(const float* src, const float* slab, int S, const bf16_t* hb, int row, int lane, float4 (&v)[4]) {
    if (row >= MP) {
#pragma unroll
        for (int i = 0; i < 4; ++i) { const int c = i * 256 + lane * 4; const u32x2 h2 = *(const u32x2*)(hb + (size_t)row * DM + c);
            float4 a = make_float4(ALPHA * bflo(h2.x), ALPHA * bfhi(h2.x), ALPHA * bflo(h2.y), ALPHA * bfhi(h2.y));
            const float* sp = slab + (size_t)(row - MP) * DM + c;
#pragma unroll 1
            for (int sl = 0; sl < S; ++sl) { const float4 t = *(const float4*)(sp + (size_t)sl * (1024 * 1024)); a.x += t.x; a.y += t.y; a.z += t.z; a.w += t.w; }
            v[i] = a; }
    } else {
#pragma unroll
        for (int i = 0; i < 4; ++i) v[i] = *(const float4*)(src + (size_t)row * DM + i * 256 + lane * 4); }
}
template <bool TO_BF16>
__device__ __forceinline__ void ln_rows(const float* src, const float* gam, const float* bet, bf16_t* ob, float* of, const float* slab, int S, const bf16_t* hb) {
    const int tid = fresh_tid(), lane = tid & 63, wave = tid >> 6, stride = gridDim.x * 8;
    int row = blockIdx.x * 8 + wave; float4 v[4];
    if (row < MT) ln_load(src, slab, S, hb, row, lane, v);
#pragma unroll 1
    for (; row < MT; row += stride) {
        const int nrow = row + stride; float4 nv[4];
        if (nrow < MT) ln_load(src, slab, S, hb, nrow, lane, nv);
        else {
#pragma unroll
            for (int i = 0; i < 4; ++i) nv[i] = make_float4(0.f, 0.f, 0.f, 0.f); }
        float s = 0.f;
#pragma unroll
        for (int i = 0; i < 4; ++i) s += (v[i].x + v[i].y) + (v[i].z + v[i].w);
        const float mu = wave_sum(s) * (1.0f / DM); float q = 0.f;
#pragma unroll
        for (int i = 0; i < 4; ++i) { v[i].x -= mu; v[i].y -= mu; v[i].z -= mu; v[i].w -= mu; q += (v[i].x * v[i].x + v[i].y * v[i].y) + (v[i].z * v[i].z + v[i].w * v[i].w); }
        const float rstd = rsqrtf(wave_sum(q) * (1.0f / DM) + LN_EPS);
#pragma unroll
        for (int i = 0; i < 4; ++i) { const int c = i * 256 + lane * 4; const float4 gg = *(const float4*)(gam + c), bb = *(const float4*)(bet + c);
            float4 y; y.x = v[i].x * rstd * gg.x + bb.x; y.y = v[i].y * rstd * gg.y + bb.y; y.z = v[i].z * rstd * gg.z + bb.z; y.w = v[i].w * rstd * gg.w + bb.w;
            if (TO_BF16) { u32x2 w; w.x = pk2(y.x, y.y); w.y = pk2(y.z, y.w); *(u32x2*)(ob + (size_t)row * DM + c) = w; }
            else *(float4*)(of + (size_t)row * DM + c) = y; }
#pragma unroll
        for (int i = 0; i < 4; ++i) v[i] = nv[i];
    }
}

__global__ void __launch_bounds__(512) fwd_mega(Params p) {
    extern __shared__ __attribute__((aligned(16))) unsigned char smem[];
    LAS unsigned char* lds = (LAS unsigned char*)smem;
    cg::grid_group grid = cg::this_grid();
    volatile LAS unsigned* stw = (volatile LAS unsigned*)(lds + 131072);
    if (threadIdx.x == 0) { stw[0] = 0u; stw[1] = 0u; }
    __syncthreads();
    const XcdBarrier xbar = xcd_barrier_post((unsigned*)(p.ws + WS_BAR), stw);
    unsigned char* ws = p.ws;
    bf16_t* h0 = (bf16_t*)(ws + WS_H0); bf16_t* proj = (bf16_t*)(ws + WS_PROJ); bf16_t* mix = (bf16_t*)(ws + WS_MIX); bf16_t* act = (bf16_t*)(ws + WS_ACT);
    float* slab = (float*)(ws + WS_SLAB);
    const int G = gridDim.x, bx = blockIdx.x;
#ifndef DBL
#define DBL 0
#endif
    if (DBL & 0x800) { for (int i = 0; i < 10; ++i) xcd_barrier(xbar); }
    if (DBL & 1) { phase0(p, lds); xcd_barrier(xbar); }
    phase0(p, lds);
    grid.sync();
    gate_scan(p, lds);
    { pg8::Gemm g{h0, (const bf16_t*)(ws + WS_WIN), MT, NPROJ, DM}; SplitOrder S; S.init(NPROJ, DM / 64, 1, G, bx);
      EpiBf16B e{proj, NPROJ, (const float*)(ws + WS_BIAS)}; pg8::gemm_phase(lds, g, S, e); }
    xcd_barrier(xbar);
    if (DBL & 4) { phase2(p, lds, 15); xcd_barrier(xbar); }
    if (DBL & 0x200) { phase2(p, lds, 4); xcd_barrier(xbar); }
    if (DBL & 0x400) { phase2(p, lds, 1); xcd_barrier(xbar); }
    phase2(p, lds, 15);
    xcd_barrier(xbar);
    if (DBL & 8) { phase3(p, lds); xcd_barrier(xbar); }
    phase3(p, lds);
    xcd_barrier(xbar);
    { pg8::Gemm g{mix, (const bf16_t*)(ws + WS_WOUT), MT, DM, DM}; SplitOrder S; S.init(DM, DM / 64, 4, G, bx);
      EpiRes e{h0, p.out + O_Y, slab, DM / 64}; pg8::gemm_phase(lds, g, S, e); }
    xcd_barrier(xbar);
    ln_rows<true>(p.out + O_Y, p.in[14], p.in[15], h0, nullptr, slab, 4, h0);
    xcd_barrier(xbar);
    { pg8::Gemm g{h0, (const bf16_t*)(ws + WS_WGU), MT, 2 * DFF, DM}; SplitOrder S; S.init(2 * DFF, DM / 64, 1, G, bx);
      EpiSwiglu e{act}; pg8::gemm_phase(lds, g, S, e); }
    xcd_barrier(xbar);
    { pg8::Gemm g{act, (const bf16_t*)(ws + WS_WDN), MT, DM, DFF}; SplitOrder S; S.init(DM, DFF / 64, 11, G, bx);
      EpiRes e{h0, p.out + O_Y, slab, DFF / 64}; pg8::gemm_phase(lds, g, S, e); }
    xcd_barrier(xbar);
    ln_rows<false>(p.out + O_Y, p.in[19], p.in[20], nullptr, p.out + O_Y, slab, 11, h0);
}

extern "C" void kernel_launch(void* const* d_in, const int* in_sizes, int n_in, void* d_out, int out_size, void* d_ws, size_t ws_size, hipStream_t stream) {
    constexpr size_t kDynLds = 131072 + 64;
    static int grid_blocks = 0;
    if (!grid_blocks) {
        if (n_in != 21 || (size_t)out_size != O_END || ws_size < WS_END2) { fprintf(stderr, "kernel_launch: unexpected shapes: n_in %d out %d ws %zu (need %zu)\n", n_in, out_size, ws_size, (size_t)WS_END2); grid_blocks = -1; return; }
        int dev = 0, cus = 0, per_cu = 0;
        hipGetDevice(&dev);
        hipDeviceGetAttribute(&cus, hipDeviceAttributeMultiprocessorCount, dev);
        if (hipFuncSetAttribute((const void*)fwd_mega, hipFuncAttributeMaxDynamicSharedMemorySize, (int)kDynLds) != hipSuccess) { fprintf(stderr, "kernel_launch: hipFuncSetAttribute failed\n"); grid_blocks = -1; return; }
        if (hipOccupancyMaxActiveBlocksPerMultiprocessor(&per_cu, (const void*)fwd_mega, 512, kDynLds) != hipSuccess || per_cu < 1) { fprintf(stderr, "kernel_launch: occupancy query failed (%d)\n", per_cu); grid_blocks = -1; return; }
        if (per_cu > 1) per_cu = 1;
        grid_blocks = cus * per_cu;
    }
    if (grid_blocks < 0) return;
    if (hipMemsetAsync((char*)d_ws + WS_BAR, 0, XCD_BAR_WORDS * 4, stream) != hipSuccess) { fprintf(stderr, "kernel_launch: memset of the barrier words failed\n"); return; }
    Params p{};
    for (int i = 0; i < 21; ++i) p.in[i] = (const float*)d_in[i];
    p.out = (float*)d_out; p.ws = (unsigned char*)d_ws;
    void* args[] = {&p};
    hipError_t e = hipLaunchCooperativeKernel((const void*)fwd_mega, dim3(grid_blocks), dim3(512), args, kDynLds, stream);
    if (e != hipSuccess) fprintf(stderr, "cooperative launch failed: %s (grid %d)\n", hipGetErrorString(e), grid_blocks);
}
```

```cpp
#include <hip/hip_runtime.h>
#include <hip/hip_cooperative_groups.h>
#include <cstdio>
namespace cg = cooperative_groups;
namespace pg8 {
#define PG8_LAS __attribute__((address_space(3)))
typedef unsigned short bf16_t;
typedef short bf16x8 __attribute__((ext_vector_type(8)));
typedef float f32x4 __attribute__((ext_vector_type(4)));
typedef unsigned u32x4 __attribute__((ext_vector_type(4)));
constexpr int BM = 256, BK = 64, HALF = 128, HTB = HALF * BK * 2  , STAGE_BYTES = 8 * HTB, NXCD = 8, WGM = 8;

__host__ __device__ __forceinline__ int lds_byte(int r, int c) { const int st = (r >> 4) * 2 + (c >> 5), rr = r & 15, cc = c & 31, ob = rr * 64 + cc * 2; return st * 1024 + (ob ^ (((ob >> 9) & 1) << 5)); }
__host__ __device__ __forceinline__ void stage_rc(int b, int& R, int& C) { const int st = b / 1024, sb = b % 1024, swz = sb ^ (((sb >> 9) & 1) << 5); R = (st >> 1) * 16 + swz / 64; C = (st & 1) * 32 + (swz % 64) / 2; }
__host__ __device__ __forceinline__ int perm32(int rho) { const int n = rho >> 4, i = rho & 15; return 8 * (i >> 2) + 4 * n + (i & 3); }

struct Unit { int pm, pn, kt0, nkt; };
struct Gemm { const bf16_t* A; const bf16_t* Bt; int M, N, K; };
struct StaticOrder {
    int nM, nN, nwg, G, c;
    __host__ __device__ void init(int M, int N, int G_, int c_) { nM = M / BM; nN = N / BM; nwg = nM * nN; G = G_; c = c_; }
    __host__ __device__ bool next(int i, Unit& u) const {
        const long L = (long)i * G + c; if (L >= nwg) return false;
        int wgid = (int)L; { const int q = nwg / NXCD, r = nwg % NXCD, xcd = wgid % NXCD, off = wgid / NXCD; wgid = (xcd < r ? xcd * (q + 1) : r * (q + 1) + (xcd - r) * q) + off; }
        const int nig = WGM * nN, gid = wgid / nig, fm = gid * WGM, gsz = (nM - fm) < WGM ? (nM - fm) : WGM;
        u.pm = fm + ((wgid % nig) % gsz); u.pn = (wgid % nig) / gsz; u.kt0 = 0; u.nkt = 0; return true;
    }
    __device__ __forceinline__ void a_ready(const Unit&) const {}
    __device__ __forceinline__ void done(const Unit&) const {}
};
__device__ __forceinline__ unsigned cvt_pk_bf16(float lo, float hi) { unsigned r; asm volatile("v_cvt_pk_bf16_f32 %0, %1, %2" : "=v"(r) : "v"(lo), "v"(hi)); return r; }
template <class Epi, class Sched>
__device__ __forceinline__ void gemm_phase(PG8_LAS unsigned char* lds, const Gemm g, const Sched& S, const Epi& E) {
    int tid_ = threadIdx.x; asm volatile("" : "+v"(tid_)); const int tid = tid_, wid = __builtin_amdgcn_readfirstlane(tid >> 6), lane = tid & 63, wr = wid >> 2, wc = wid & 3, fr = lane & 15, fq = lane >> 4;
    const int K = g.K;
    unsigned voffA[2], voffB[2];
#pragma unroll
    for (int i = 0; i < 2; ++i) { int R, C; stage_rc(tid * 16 + i * 8192, R, C); const int Rb = Epi::PERM ? ((R & ~31) + perm32(R & 31)) : R;
        voffA[i] = (unsigned)(R * K + C) * 2u; voffB[i] = (unsigned)(Rb * K + C) * 2u; }
    const size_t kstep = (size_t)(BK * 2);
    const size_t hstep = (size_t)HALF * K * 2;
    const size_t tstep = 2 * hstep;
    const unsigned ldsw = (unsigned)wid * 1024u;
    const int aoff = lds_byte(wr * 64 + fr, fq * 8), boff = lds_byte(wc * 32 + fr, fq * 8);
#define PG8_SA(b, h) (((b) * 2 + (h)) * HTB)
#define PG8_SB(b, h) ((4 + (b) * 2 + (h)) * HTB)
#define PG8_STAGE(bufoff, gbase, voff) do { _Pragma("unroll") for (int _i = 0; _i < 2; ++_i) \
        __builtin_amdgcn_global_load_lds((const unsigned*)((const char*)(gbase) + (voff)[_i]), (PG8_LAS unsigned*)(lds + (bufoff) + ldsw + _i * 8192), 16, 0, 0); } while (0)
#define PG8_LDA(dst, b, h) do { _Pragma("unroll") for (int m = 0; m < 4; ++m) _Pragma("unroll") for (int k = 0; k < 2; ++k) dst[m][k] = *(const PG8_LAS bf16x8*)(lds + PG8_SA(b, h) + aoff + m * 2048 + k * 1024); } while (0)
#define PG8_LDB(dst, b, h) do { _Pragma("unroll") for (int n = 0; n < 2; ++n) _Pragma("unroll") for (int k = 0; k < 2; ++k) dst[n][k] = *(const PG8_LAS bf16x8*)(lds + PG8_SB(b, h) + boff + n * 2048 + k * 1024); } while (0)
#define PG8_MMA(ai, bj, At, Bt) do { __builtin_amdgcn_s_setprio(1); _Pragma("unroll") for (int m = 0; m < 4; ++m) _Pragma("unroll") for (int n = 0; n < 2; ++n) _Pragma("unroll") for (int k = 0; k < 2; ++k) \
        acc[ai][bj][m][n] = __builtin_amdgcn_mfma_f32_16x16x32_bf16(Bt[n][k], At[m][k], acc[ai][bj][m][n], 0, 0, 0); __builtin_amdgcn_s_setprio(0); } while (0)
#define PG8_WAIT_V(n) asm volatile("s_waitcnt vmcnt(" #n ")" ::: "memory")
#define PG8_WAIT_L(n) asm volatile("s_waitcnt lgkmcnt(" #n ")" ::: "memory")
#define PG8_BAR __builtin_amdgcn_s_barrier()
#define PG8_SCHED __builtin_amdgcn_sched_barrier(0)
    Unit cur, nxt; int ui = 0;
    if (!S.next(0, cur)) return;
    f32x4 acc[2][2][4][2];
#pragma unroll
    for (int a = 0; a < 2; ++a)
#pragma unroll
        for (int b = 0; b < 2; ++b)
#pragma unroll
            for (int m = 0; m < 4; ++m)
#pragma unroll
                for (int n = 0; n < 2; ++n) acc[a][b][m][n] = (f32x4){0.f, 0.f, 0.f, 0.f};
    bf16x8 At[4][2], B0[2][2], B1[2][2];
    const char* cA = (const char*)g.A + (size_t)cur.pm * tstep + (size_t)cur.kt0 * kstep; const char* cB = (const char*)g.Bt + (size_t)cur.pn * tstep + (size_t)cur.kt0 * kstep;
    S.a_ready(cur);
    PG8_STAGE(PG8_SB(0, 0), cB, voffB); PG8_STAGE(PG8_SA(0, 0), cA, voffA); PG8_STAGE(PG8_SB(0, 1), cB + hstep, voffB); PG8_STAGE(PG8_SA(0, 1), cA + hstep, voffA);
    if (wr == 1) PG8_BAR;
    PG8_WAIT_V(4); PG8_BAR;
    PG8_STAGE(PG8_SB(1, 0), cB + kstep, voffB); PG8_STAGE(PG8_SA(1, 0), cA + kstep, voffA); PG8_STAGE(PG8_SB(1, 1), cB + hstep + kstep, voffB);
    PG8_WAIT_V(6); PG8_BAR;
    for (;;) {
        const bool has_next = S.next(ui + 1, nxt);
        const char* nA = has_next ? (const char*)g.A + (size_t)nxt.pm * tstep + (size_t)nxt.kt0 * kstep : cA; const char* nB = has_next ? (const char*)g.Bt + (size_t)nxt.pn * tstep + (size_t)nxt.kt0 * kstep : cB;
        const int nt = cur.nkt;
        for (int t = 0; t < nt; t += 2) {
            const bool last = (t == nt - 2);
            const char* a1 = cA + (size_t)(t + 1) * kstep;
            const char* a2 = last ? nA : cA + (size_t)(t + 2) * kstep; const char* b2 = last ? nB : cB + (size_t)(t + 2) * kstep;
            const char* a3 = a2 + kstep; const char* b3 = b2 + kstep;
            if (last && has_next) S.a_ready(nxt);
            PG8_LDB(B0, 0, 0); PG8_SCHED; PG8_LDA(At, 0, 0); PG8_STAGE(PG8_SA(1, 1), a1 + hstep, voffA);
            PG8_WAIT_L(8); PG8_BAR; PG8_WAIT_L(0); PG8_MMA(0, 0, At, B0); PG8_BAR; PG8_SCHED;
            PG8_LDB(B1, 0, 1); PG8_STAGE(PG8_SB(0, 0), b2, voffB);
            PG8_BAR; PG8_WAIT_L(0); PG8_MMA(0, 1, At, B1); PG8_BAR;
            PG8_LDA(At, 0, 1); PG8_STAGE(PG8_SA(0, 0), a2, voffA);
            PG8_BAR; PG8_WAIT_L(0); PG8_MMA(1, 0, At, B0); PG8_BAR; PG8_SCHED;
            PG8_STAGE(PG8_SB(0, 1), b2 + hstep, voffB);
            PG8_WAIT_V(6); PG8_BAR; PG8_MMA(1, 1, At, B1); PG8_BAR;
            PG8_LDB(B0, 1, 0); PG8_SCHED; PG8_LDA(At, 1, 0); PG8_STAGE(PG8_SA(0, 1), a2 + hstep, voffA);
            PG8_WAIT_L(8); PG8_BAR; PG8_WAIT_L(0); PG8_MMA(0, 0, At, B0); PG8_BAR; PG8_SCHED;
            PG8_LDB(B1, 1, 1); PG8_STAGE(PG8_SB(1, 0), b3, voffB);
            PG8_BAR; PG8_WAIT_L(0); PG8_MMA(0, 1, At, B1); PG8_BAR;
            PG8_LDA(At, 1, 1); PG8_STAGE(PG8_SA(1, 0), a3, voffA);
            PG8_BAR; PG8_WAIT_L(0); PG8_MMA(1, 0, At, B0); PG8_BAR; PG8_SCHED;
            PG8_STAGE(PG8_SB(1, 1), b3 + hstep, voffB);
            PG8_WAIT_V(6); PG8_BAR; PG8_MMA(1, 1, At, B1); PG8_BAR;
        }
        if constexpr (!Epi::AFTER_DRAIN) { E(acc, cur, wr, wc, fr, fq); S.done(cur); }
        if (!has_next) break;
#pragma unroll
        for (int a = 0; a < 2; ++a)
#pragma unroll
            for (int b = 0; b < 2; ++b)
#pragma unroll
                for (int m = 0; m < 4; ++m)
#pragma unroll
                    for (int n = 0; n < 2; ++n) acc[a][b][m][n] = (f32x4){0.f, 0.f, 0.f, 0.f};
        cur = nxt; cA = nA; cB = nB; ++ui;
    }
    PG8_WAIT_V(0);
    if (wr == 0) PG8_BAR;
    PG8_BAR;
    if constexpr (Epi::AFTER_DRAIN) { E.fused(acc, cur, wr, wc, fr, fq, lds, wid, lane); S.done(cur); }
#undef PG8_SA
#undef PG8_SB
#undef PG8_STAGE
#undef PG8_LDA
#undef PG8_LDB
#undef PG8_MMA
#undef PG8_WAIT_V
#undef PG8_WAIT_L
#undef PG8_BAR
#undef PG8_SCHED
}
}

using pg8::bf16_t; using pg8::bf16x8; using pg8::f32x4; using pg8::u32x4;
#define LAS __attribute__((address_space(3)))
typedef unsigned u32x2 __attribute__((ext_vector_type(2)));

constexpr int DM = 1024, NB = 8, SEQ = 8192, DB = 32, DS = 32;
constexpr int MP = NB * SEQ, MS = DB * DS, MT = MP + MS;
constexpr int NPROJ = 2560, INCOLS = 2568, DFF = 2816;
constexpr int SCN = 16;
constexpr float ALPHA = 1.189207115002721f, KSCALE = 0.08838834764831845f, LN_EPS = 1e-5f;

constexpr size_t al256(size_t x) { return (x + 255) & ~(size_t)255; }
constexpr size_t WS_BAR = 0;
constexpr size_t WS_WIN = 16384;
constexpr size_t WS_WOUT = WS_WIN + al256((size_t)NPROJ * DM * 2);
constexpr size_t WS_WGU = WS_WOUT + al256((size_t)DM * DM * 2);
constexpr size_t WS_WDN = WS_WGU + al256((size_t)2 * DFF * DM * 2);
constexpr size_t WS_WPOOL = WS_WDN + al256((size_t)DM * DFF * 2);
constexpr size_t WS_BIAS = WS_WPOOL + al256((size_t)4 * 128 * 128 * 2);
constexpr size_t WS_GATES = WS_BIAS + al256((size_t)NPROJ * 4);
constexpr size_t WS_MTAB = WS_GATES + al256((size_t)MT * 8 * 4);
constexpr size_t WS_BTAB = WS_MTAB + al256((size_t)32 * 132 * 4);
constexpr size_t WS_GTAB = WS_BTAB + al256((size_t)32 * 128 * 4);
constexpr size_t WS_DST = WS_GTAB + al256((size_t)MT * 4 * 16);
constexpr size_t WS_DN = WS_DST + al256((size_t)224 * 16384 * 4);
constexpr size_t WS_H0 = WS_DN + al256((size_t)224 * 128 * 4);
constexpr size_t WS_PROJ = WS_H0 + al256((size_t)MT * DM * 2);
constexpr size_t WS_MIX = WS_PROJ + al256((size_t)MT * NPROJ * 2);
constexpr size_t WS_END = WS_MIX + al256((size_t)MT * DM * 2);
constexpr size_t WS_SLAB = WS_END;
constexpr size_t WS_END2 = WS_SLAB + (size_t)11 * 1024 * 1024 * 4;
constexpr size_t WS_ACT = WS_PROJ;
static_assert((size_t)MT * DFF * 2 <= WS_END - WS_PROJ, "act does not fit");

constexpr size_t O_Y = 0;
constexpr size_t O_POOLP = (size_t)MT * DM;
constexpr size_t O_CP = O_POOLP + (size_t)NB * 15 * 512;
constexpr size_t O_NP = O_CP + (size_t)NB * 4 * 16384;
constexpr size_t O_MP = O_NP + (size_t)NB * 4 * 128;
constexpr size_t O_POOLS = O_MP + (size_t)NB * 4;
constexpr size_t O_CS = O_POOLS + (size_t)DB * 15 * 512;
constexpr size_t O_NS = O_CS + (size_t)DB * 4 * 16384;
constexpr size_t O_MS = O_NS + (size_t)DB * 4 * 128;
constexpr size_t O_END = O_MS + (size_t)DB * 4;

struct Params { const float* in[21]; float* out; unsigned char* ws; };

__device__ __forceinline__ int fresh_tid() { int t = threadIdx.x; asm volatile("" : "+v"(t)); return t; }
__device__ __forceinline__ float bf2f(unsigned x) { return __uint_as_float(x << 16); }
__device__ __forceinline__ float bflo(unsigned w) { return __uint_as_float(w << 16); }
__device__ __forceinline__ float bfhi(unsigned w) { return __uint_as_float(w & 0xffff0000u); }
__device__ __forceinline__ unsigned pk2(float lo, float hi) { return pg8::cvt_pk_bf16(lo, hi); }
__device__ __forceinline__ float wave_sum(float v) {
#pragma unroll
    for (int o = 32; o; o >>= 1) v += __shfl_xor(v, o);
    return v; }
__device__ __forceinline__ float wave_max(float v) {
#pragma unroll
    for (int o = 32; o; o >>= 1) v = fmaxf(v, __shfl_xor(v, o));
    return v; }
__device__ __forceinline__ float scan_sum(float x, int lane) {
#pragma unroll
    for (int o = 1; o < 64; o <<= 1) { const float y = __shfl_up(x, o); if (lane >= o) x += y; }
    return x; }
__device__ __forceinline__ float scan_max(float x, int lane) {
#pragma unroll
    for (int o = 1; o < 64; o <<= 1) { const float y = __shfl_up(x, o); if (lane >= o) x = fmaxf(x, y); }
    return x; }
__device__ __forceinline__ float logsigmoid(float x) { return fminf(x, 0.f) - log1pf(expf(-fabsf(x))); }
__device__ __forceinline__ bf16x8 ldfrag(LAS const unsigned char* base, int row, int strideB, int kbyte) { return *(LAS const bf16x8*)(base + row * strideB + kbyte); }
#define LDS_BARRIER() do { asm volatile("s_waitcnt lgkmcnt(0)" ::: "memory"); __builtin_amdgcn_s_barrier(); asm volatile("" ::: "memory"); } while (0)
#define MFMA16(a, b, c) __builtin_amdgcn_mfma_f32_16x16x32_bf16((a), (b), (c), 0, 0, 0)

#define XB_TMO      128
#define XB_XCNT(j)  (256  + 64 * (j))
#define XB_XSUB(j)  (1280 + 64 * (j))
#define XB_XGEN(j)  (2304 + 64 * (j))
#define XB_TOP      3328
#define XB_TOPGEN   3392
#define XCD_BAR_WORDS 3456
#define XB_SPIN_CAP (1u << 18)
__device__ __forceinline__ unsigned xb_ld(unsigned* p)              { return __hip_atomic_load(p, __ATOMIC_RELAXED, __HIP_MEMORY_SCOPE_AGENT); }
__device__ __forceinline__ unsigned xb_add(unsigned* p, unsigned v) { return __hip_atomic_fetch_add(p, v, __ATOMIC_RELAXED, __HIP_MEMORY_SCOPE_AGENT); }
__device__ __forceinline__ unsigned xb_xcc_id() { return (unsigned)__builtin_amdgcn_s_getreg((3 << 11) | 20) & 0xFu; }
#define XB_SPIN(cond, bar) do { unsigned _sp = 0; while (cond) { __builtin_amdgcn_s_sleep(1); \
    if ((++_sp & 255u) == 0u) { if (xb_ld(&(bar)[XB_TMO])) break; if (_sp > XB_SPIN_CAP) { atomicAdd(&(bar)[XB_TMO], 1u); break; } } } } while (0)

struct XcdBarrier {
    unsigned* bar; unsigned x;
    volatile LAS unsigned* st;
};

__device__ __forceinline__ XcdBarrier xcd_barrier_post(unsigned* bar, volatile LAS unsigned* st) {
    XcdBarrier b; b.bar = bar; b.x = xb_xcc_id(); b.st = st;
    if (threadIdx.x == 0) (void)xb_add(&bar[XB_XCNT(b.x)], 1u);
    return b;
}
__device__ __forceinline__ void xcd_barrier_complete(unsigned* bar, unsigned x, unsigned& nloc, unsigned& nx) {
    const unsigned G = gridDim.x * gridDim.y * gridDim.z;
    unsigned sum, cnt, mine, sp = 0u;
    for (;;) {
        sum = 0u; cnt = 0u; mine = 0u;
#pragma unroll
        for (unsigned j = 0; j < 16; ++j) { const unsigned c = xb_ld(&bar[XB_XCNT(j)]); sum += c; cnt += (c > 0u) ? 1u : 0u; mine = (j == x) ? c : mine; }
        if (sum == G) break;
        __builtin_amdgcn_s_sleep(1);
        if ((++sp & 255u) == 0u) { if (xb_ld(&bar[XB_TMO])) break; if (sp > XB_SPIN_CAP) { atomicAdd(&bar[XB_TMO], 1u); break; } }
    }
    nloc = mine > 0u ? mine : 1u; nx = cnt > 0u ? cnt : 1u;
}

__device__ __forceinline__ void xcd_barrier(const XcdBarrier& b) {
    asm volatile("s_waitcnt vmcnt(0)" ::: "memory");
    __syncthreads();
    if (threadIdx.x == 0) {
        unsigned* bar = b.bar;
        __builtin_amdgcn_s_waitcnt(0);
        unsigned nloc = b.st[0], nx = b.st[1];
        if (nloc == 0u) { xcd_barrier_complete(bar, b.x, nloc, nx); b.st[0] = nloc; b.st[1] = nx; }
        const unsigned old = xb_add(&bar[XB_XSUB(b.x)], 1u);
        const unsigned gen = old / nloc;
        if (old + 1u == (gen + 1u) * nloc) {
            __builtin_amdgcn_fence(__ATOMIC_RELEASE, "agent");
            asm volatile("s_waitcnt vmcnt(0)" ::: "memory");
            const unsigned og = xb_add(&bar[XB_TOP], 1u);
            const unsigned tg = og / nx;
            if (og + 1u == (tg + 1u) * nx) xb_add(&bar[XB_TOPGEN], 1u);
            else XB_SPIN(xb_ld(&bar[XB_TOPGEN]) == tg, bar);
            __builtin_amdgcn_fence(__ATOMIC_ACQUIRE, "agent");
            xb_add(&bar[XB_XGEN(b.x)], 1u);
            asm volatile("s_waitcnt vmcnt(0)" ::: "memory");
        } else {
            XB_SPIN(xb_ld(&bar[XB_XGEN(b.x)]) == gen, bar);
            __builtin_amdgcn_fence(__ATOMIC_ACQUIRE, "agent");
            asm volatile("s_waitcnt vmcnt(0)" ::: "memory");
        }
    }
    __syncthreads();
}

struct SplitOrder {
    int nN, nP, S, nkt, G, c;
    __device__ __forceinline__ void init(int N, int Ktiles, int S_, int G_, int c_) { nN = N / 256; nP = 256 * nN; S = S_; nkt = Ktiles; G = G_; c = c_; }
    __device__ __forceinline__ bool next(int i, pg8::Unit& u) const {
        const long L = (long)i * G + c;
        if (L >= nP + 4 * nN * S) return false;
        int pm, pn, k0 = 0, kn = nkt;
        if (L < nP) { int wgid = (int)L; { const int q = nP / 8, xcd = wgid % 8, off = wgid / 8; wgid = xcd * q + off; }
            const int nig = 8 * nN, gid = wgid / nig, fm = gid * 8; pm = fm + ((wgid % nig) % 8); pn = (wgid % nig) / 8; }
        else { const int j = (int)(L - nP), su = j / S, sl = j - su * S; pm = 256 + su / nN; pn = su % nN; kn = nkt / S; k0 = sl * kn; }
        u.pm = pm; u.pn = pn; u.kt0 = k0; u.nkt = kn; return true;
    }
    __device__ __forceinline__ void a_ready(const pg8::Unit&) const {}
    __device__ __forceinline__ void done(const pg8::Unit&) const {}
};

struct EpiBf16B {
    static constexpr bool PERM = true, AFTER_DRAIN = false;
    bf16_t* O; int ldc; const float* bias;
    __device__ __forceinline__ void operator()(const f32x4 (&acc)[2][2][4][2], const pg8::Unit& u, int wr, int wc, int fr, int fq) const {
        const int row0 = u.pm * 256 + wr * 64 + fr, col0 = u.pn * 256 + wc * 32 + 8 * fq;
        f32x4 bv[2][2];
#pragma unroll
        for (int bj = 0; bj < 2; ++bj)
#pragma unroll
            for (int n = 0; n < 2; ++n) bv[bj][n] = *(const f32x4*)(bias + col0 + bj * 128 + 4 * n);
#pragma unroll
        for (int ai = 0; ai < 2; ++ai)
#pragma unroll
            for (int m = 0; m < 4; ++m) { bf16_t* rowp = O + (size_t)(row0 + ai * 128 + m * 16) * ldc + col0;
#pragma unroll
                for (int bj = 0; bj < 2; ++bj) { const f32x4 v0 = acc[ai][bj][m][0] + bv[bj][0], v1 = acc[ai][bj][m][1] + bv[bj][1];
                    u32x4 w; w.x = pk2(v0[0], v0[1]); w.y = pk2(v0[2], v0[3]); w.z = pk2(v1[0], v1[1]); w.w = pk2(v1[2], v1[3]);
                    *(u32x4*)(rowp + bj * 128) = w; } }
    }
};
struct EpiRes {
    static constexpr bool PERM = false, AFTER_DRAIN = false;
    const bf16_t* base; float* out; float* slab; int nkt_full;
    __device__ __forceinline__ void operator()(const f32x4 (&acc)[2][2][4][2], const pg8::Unit& u, int wr, int wc, int fr, int fq) const {
        const int row0 = u.pm * 256 + wr * 64 + fr, col0 = u.pn * 256 + wc * 32 + 4 * fq;
        if (u.nkt != nkt_full) {
            float* sp = slab + (size_t)(u.kt0 / u.nkt) * (1024 * 1024) + (size_t)(row0 - MP) * DM + col0;
#pragma unroll
            for (int ai = 0; ai < 2; ++ai)
#pragma unroll
                for (int m = 0; m < 4; ++m)
#pragma unroll
                    for (int bj = 0; bj < 2; ++bj)
#pragma unroll
                        for (int n = 0; n < 2; ++n) *(f32x4*)(sp + (size_t)(ai * 128 + m * 16) * DM + bj * 128 + n * 16) = acc[ai][bj][m][n];
            return; }
#pragma unroll
        for (int ai = 0; ai < 2; ++ai)
#pragma unroll
            for (int m = 0; m < 4; ++m) { const size_t off = (size_t)(row0 + ai * 128 + m * 16) * DM + col0;
#pragma unroll
                for (int bj = 0; bj < 2; ++bj)
#pragma unroll
                    for (int n = 0; n < 2; ++n) { const u32x2 b = *(const u32x2*)(base + off + bj * 128 + n * 16);
                        f32x4 o; o[0] = ALPHA * bflo(b.x) + acc[ai][bj][m][n][0]; o[1] = ALPHA * bfhi(b.x) + acc[ai][bj][m][n][1];
                        o[2] = ALPHA * bflo(b.y) + acc[ai][bj][m][n][2]; o[3] = ALPHA * bfhi(b.y) + acc[ai][bj][m][n][3];
                        *(f32x4*)(out + off + bj * 128 + n * 16) = o; } }
    }
};
__device__ __forceinline__ float fsigmoid(float x) { return __builtin_amdgcn_rcpf(1.0f + __expf(-x)); }
__device__ __forceinline__ float swiglu(float g, float u) { return g * u * fsigmoid(g); }
struct EpiSwiglu {
    static constexpr bool PERM = true, AFTER_DRAIN = false;
    bf16_t* O;
    __device__ __forceinline__ void operator()(const f32x4 (&acc)[2][2][4][2], const pg8::Unit& u, int wr, int wc, int fr, int fq) const {
        const int row0 = u.pm * 256 + wr * 64 + fr, col0 = u.pn * 128 + wc * 32 + 8 * fq;
#pragma unroll
        for (int ai = 0; ai < 2; ++ai)
#pragma unroll
            for (int m = 0; m < 4; ++m) { bf16_t* rowp = O + (size_t)(row0 + ai * 128 + m * 16) * DFF + col0;
                const f32x4 g0 = acc[ai][0][m][0], g1 = acc[ai][0][m][1], u0 = acc[ai][1][m][0], u1 = acc[ai][1][m][1];
                u32x4 w; w.x = pk2(swiglu(g0[0], u0[0]), swiglu(g0[1], u0[1])); w.y = pk2(swiglu(g0[2], u0[2]), swiglu(g0[3], u0[3]));
                w.z = pk2(swiglu(g1[0], u1[0]), swiglu(g1[1], u1[1])); w.w = pk2(swiglu(g1[2], u1[2]), swiglu(g1[3], u1[3]));
                *(u32x4*)rowp = w; }
    }
};

constexpr int TR_TILES = 640 + 256 + 704 + 704 + 704 + 16;
struct TileDesc { const float* src; bf16_t* dst; int ld, K, mode, k0, n0; };
__device__ __forceinline__ TileDesc tile_desc(const Params& p, int t) {
    TileDesc d; unsigned char* ws = p.ws;
    if (t < 640) { d.src = p.in[8]; d.ld = INCOLS; d.K = DM; d.mode = 3; d.dst = (bf16_t*)(ws + WS_WIN); }
    else if (t < 896) { t -= 640; d.src = p.in[13]; d.ld = DM; d.K = DM; d.mode = 0; d.dst = (bf16_t*)(ws + WS_WOUT); }
    else if (t < 1600) { t -= 896; d.src = p.in[16]; d.ld = DFF; d.K = DM; d.mode = 1; d.dst = (bf16_t*)(ws + WS_WGU); }
    else if (t < 2304) { t -= 1600; d.src = p.in[17]; d.ld = DFF; d.K = DM; d.mode = 2; d.dst = (bf16_t*)(ws + WS_WGU); }
    else if (t < 3008) { t -= 2304; d.src = p.in[18]; d.ld = DM; d.K = DFF; d.mode = 0; d.dst = (bf16_t*)(ws + WS_WDN); }
    else { t -= 3008; const int g = t >> 2; t &= 3; d.src = p.in[10] + g * 16384; d.ld = 128; d.K = 128; d.mode = 0; d.dst = (bf16_t*)(ws + WS_WPOOL) + g * 16384; }
    const int nkt = d.K >> 6; d.k0 = (t % nkt) * 64; d.n0 = (t / nkt) * 64; return d;
}

__device__ __forceinline__ void phase0(const Params& p, LAS unsigned char* lds) {
    const int tid = fresh_tid(), lane = tid & 63, wave = tid >> 6, G = gridDim.x, bx = blockIdx.x;
    unsigned char* ws = p.ws;
    LAS float* T = (LAS float*)lds;
    {
        const int r = tid >> 3, cs = (tid & 7) * 8;
        int t = bx; float4 a = make_float4(0.f, 0.f, 0.f, 0.f), b = a; TileDesc d = tile_desc(p, t < TR_TILES ? t : 0);
        if (t < TR_TILES) { const float* s = d.src + (size_t)(d.k0 + r) * d.ld + d.n0 + cs; a = *(const float4*)s; b = *(const float4*)(s + 4); }
#pragma unroll 1
        for (; t < TR_TILES; t += G) {
            { LAS float* q = T + r * 65 + cs; q[0] = a.x; q[1] = a.y; q[2] = a.z; q[3] = a.w; q[4] = b.x; q[5] = b.y; q[6] = b.z; q[7] = b.w; }
            const TileDesc dn = tile_desc(p, t + G < TR_TILES ? t + G : 0);
            if (t + G < TR_TILES) { const float* s = dn.src + (size_t)(dn.k0 + r) * dn.ld + dn.n0 + cs; a = *(const float4*)s; b = *(const float4*)(s + 4); }
            LDS_BARRIER();
            { const int n = tid >> 3, ks = (tid & 7) * 8, gn = d.n0 + n; float v[8];
#pragma unroll
              for (int i = 0; i < 8; ++i) v[i] = T[(ks + i) * 65 + n];
              const float sc = (d.mode == 3 && gn >= 1024 && gn < 1536) ? KSCALE : 1.0f;
              const int drow = (d.mode == 1) ? 256 * (gn >> 7) + (gn & 127) : (d.mode == 2) ? 256 * (gn >> 7) + 128 + (gn & 127) : gn;
              u32x4 w; w.x = pk2(v[0] * sc, v[1] * sc); w.y = pk2(v[2] * sc, v[3] * sc); w.z = pk2(v[4] * sc, v[5] * sc); w.w = pk2(v[6] * sc, v[7] * sc);
              *(u32x4*)(d.dst + (size_t)drow * d.K + d.k0 + ks) = w; }
            LDS_BARRIER();
            d = dn;
        }
    }
    { float* bs = (float*)(ws + WS_BIAS); const float* b_in = p.in[9];
      for (int i = bx * 512 + tid; i < NPROJ; i += G * 512) bs[i] = b_in[i] * ((i >= 1024 && i < 1536) ? KSCALE : 1.0f); }
    f32x4 wlo[4][4], whi[4][4];
    { const float* w_in = p.in[8];
#pragma unroll
      for (int i = 0; i < 4; ++i)
#pragma unroll
          for (int e = 0; e < 4; ++e) { const float* wp = w_in + (size_t)(i * 256 + lane * 4 + e) * INCOLS + NPROJ; wlo[i][e] = *(const f32x4*)wp; whi[i][e] = *(const f32x4*)(wp + 4); } }
    const float* lg = p.in[6]; const float* lb = p.in[7]; const float* b_in = p.in[9];
    bf16_t* h0 = (bf16_t*)(ws + WS_H0); float* gates = (float*)(ws + WS_GATES);
    const float gb_perm = lane < 8 ? b_in[NPROJ + (((lane & 1) << 2) | (lane & 2) | ((lane >> 2) & 1))] : 0.f;
    int row = bx * 8 + wave; float4 v[4];
    if (row < MT) { const float* x = row < MP ? p.in[0] + (size_t)row * DM : p.in[1] + (size_t)(row - MP) * DM;
#pragma unroll
        for (int i = 0; i < 4; ++i) v[i] = *(const float4*)(x + i * 256 + lane * 4); }
#pragma unroll 1
    for (; row < MT; row += G * 8) {
        const int nrow = row + G * 8; float4 nv[4];
        if (nrow < MT) { const float* x = nrow < MP ? p.in[0] + (size_t)nrow * DM : p.in[1] + (size_t)(nrow - MP) * DM;
#pragma unroll
            for (int i = 0; i < 4; ++i) nv[i] = *(const float4*)(x + i * 256 + lane * 4); }
        else {
#pragma unroll
            for (int i = 0; i < 4; ++i) nv[i] = make_float4(0.f, 0.f, 0.f, 0.f); }
        float s = 0.f;
#pragma unroll
        for (int i = 0; i < 4; ++i) s += (v[i].x + v[i].y) + (v[i].z + v[i].w);
        const float mu = wave_sum(s) * (1.0f / DM);
        float q = 0.f;
#pragma unroll
        for (int i = 0; i < 4; ++i) { v[i].x -= mu; v[i].y -= mu; v[i].z -= mu; v[i].w -= mu; q += (v[i].x * v[i].x + v[i].y * v[i].y) + (v[i].z * v[i].z + v[i].w * v[i].w); }
        const float rstd = rsqrtf(wave_sum(q) * (1.0f / DM) + LN_EPS);
        f32x4 glo = (f32x4){0.f, 0.f, 0.f, 0.f}, ghi = glo;
#pragma unroll
        for (int i = 0; i < 4; ++i) { const int c = i * 256 + lane * 4; const float4 gg = *(const float4*)(lg + c), bb = *(const float4*)(lb + c);
            float4 y; y.x = v[i].x * rstd * gg.x + bb.x; y.y = v[i].y * rstd * gg.y + bb.y; y.z = v[i].z * rstd * gg.z + bb.z; y.w = v[i].w * rstd * gg.w + bb.w;
            u32x2 w; w.x = pk2(y.x, y.y); w.y = pk2(y.z, y.w); *(u32x2*)(h0 + (size_t)row * DM + c) = w;
            glo += y.x * wlo[i][0] + y.y * wlo[i][1] + y.z * wlo[i][2] + y.w * wlo[i][3];
            ghi += y.x * whi[i][0] + y.y * whi[i][1] + y.z * whi[i][2] + y.w * whi[i][3]; }
        { const bool b0 = lane & 1, b1 = lane & 2, b2 = lane & 4;
          f32x4 k4, s4;
#pragma unroll
          for (int j = 0; j < 4; ++j) { k4[j] = b0 ? ghi[j] : glo[j]; s4[j] = b0 ? glo[j] : ghi[j]; }
#pragma unroll
          for (int j = 0; j < 4; ++j) k4[j] += __shfl_xor(s4[j], 1);
          float k2a = b1 ? k4[2] : k4[0], k2b = b1 ? k4[3] : k4[1];
          k2a += __shfl_xor(b1 ? k4[0] : k4[2], 2); k2b += __shfl_xor(b1 ? k4[1] : k4[3], 2);
          float k1 = b2 ? k2b : k2a; k1 += __shfl_xor(b2 ? k2a : k2b, 4);
          k1 += __shfl_xor(k1, 8); k1 += __shfl_xor(k1, 16); k1 += __shfl_xor(k1, 32);
          const int gidx = ((lane & 1) << 2) | (lane & 2) | ((lane >> 2) & 1);
          if (lane < 8) gates[(size_t)row * 8 + gidx] = k1 + gb_perm; }
#pragma unroll
        for (int i = 0; i < 4; ++i) v[i] = nv[i];
    }
}

__device__ __forceinline__ void gate_scan(const Params& p, LAS unsigned char* lds) {
    const int tid = fresh_tid(), lane = tid & 63, wave = tid >> 6;
    const float* gates = (const float*)(p.ws + WS_GATES); float* mtab = (float*)(p.ws + WS_MTAB); float* btab = (float*)(p.ws + WS_BTAB);
    f32x4* gtab = (f32x4*)(p.ws + WS_GTAB);
    LAS float* sA = (LAS float*)lds; LAS float* sB = sA + 128; LAS float* sM = sA + 256;
    for (int chain = blockIdx.x; chain < 32; chain += gridDim.x) {
        const int batch = chain >> 2, head = chain & 3;
        for (int c = wave; c < 128; c += 8) {
            const size_t row = (size_t)batch * SEQ + c * 64 + lane;
            const float ig = gates[row * 8 + head], fg = gates[row * 8 + 4 + head];
            const float b = scan_sum(logsigmoid(fg), lane); const float A = wave_max(ig - b); const float bl = __shfl(b, 63);
            if (lane == 0) { sA[c] = A; sB[c] = bl; }
        }
        __syncthreads();
        if (tid == 0) { float m = 0.f; mtab[chain * 132] = 0.f; sM[0] = 0.f;
            for (int c = 0; c < 128; ++c) { m = sB[c] + fmaxf(m, sA[c]); mtab[chain * 132 + c + 1] = m; sM[c + 1] = m; btab[chain * 128 + c] = sB[c]; }
            p.out[O_MP + chain] = m; }
        __syncthreads();
        for (int c = wave; c < 128; c += 8) {
            const size_t row = (size_t)batch * SEQ + c * 64 + lane;
            const float ig = gates[row * 8 + head], fg = gates[row * 8 + 4 + head];
            const float b = scan_sum(logsigmoid(fg), lane); const float a = ig - b; const float m_prev = sM[c];
            const float M = fmaxf(m_prev, scan_max(a, lane));
            gtab[row * 4 + head] = (f32x4){a, M, expf(m_prev - M), expf(-(b + M))};
        }
        __syncthreads();
    }
    for (int s = blockIdx.x * 8 + wave; s < DB * 4; s += gridDim.x * 8) {
        const int b_ = s >> 2, head = s & 3; const bool valid = lane < 32; const size_t row = (size_t)MP + b_ * 32 + (lane & 31);
        const float ig = gates[row * 8 + head], fg = gates[row * 8 + 4 + head]; const float m_prev = p.in[5][s];
        const float b = scan_sum(valid ? logsigmoid(fg) : 0.f, lane); const float a = valid ? ig - b : -1e30f;
        const float M = fmaxf(m_prev, scan_max(a, lane));
        if (valid) gtab[row * 4 + head] = (f32x4){a, M, expf(m_prev - M), expf(-(b + M))};
        if (lane == 31) p.out[O_MS + s] = b + M;
    }
}

constexpr int L_Q = 0, L_K = 17408, L_KW = 34816, L_V = 52224, L_CT = 69632, L_S = 104448, L_G = 113664;
typedef short s16x4 __attribute__((ext_vector_type(4)));
__device__ __forceinline__ bf16x8 ldfrag_tr(LAS const unsigned char* base, int row0, int col0, int lane) {
    const int g = lane >> 4, q = (lane & 15) >> 2, pp = lane & 3;
    LAS const unsigned char* a = base + (row0 + 8 * g + q) * 272 + (col0 + 4 * pp) * 2;
    const s16x4 lo = __builtin_amdgcn_ds_read_tr16_b64_v4i16((LAS s16x4*)a);
    const s16x4 hi = __builtin_amdgcn_ds_read_tr16_b64_v4i16((LAS s16x4*)(a + 4 * 272));
    return __builtin_shufflevector(lo, hi, 0, 1, 2, 3, 4, 5, 6, 7);
}

template <bool FULL>
__device__ __forceinline__ void mlstm_run(const Params& p, LAS unsigned char* lds, f32x4 (&accC)[2][4], f32x4 (&accN)[2], int row0, int head, int nch, int L) {
    const int tid = fresh_tid(), lane = tid & 63, wave = __builtin_amdgcn_readfirstlane(tid >> 6), l15 = lane & 15, l4 = lane >> 4, st = wave & 3, tp = wave >> 2;
    const bf16_t* proj = (const bf16_t*)(p.ws + WS_PROJ); const f32x4* gtab = (const f32x4*)(p.ws + WS_GTAB);
    bf16_t* mix = (bf16_t*)(p.ws + WS_MIX);
    LAS unsigned short* sQ = (LAS unsigned short*)(lds + L_Q); LAS unsigned short* sK = (LAS unsigned short*)(lds + L_K);
    LAS unsigned short* sKW = (LAS unsigned short*)(lds + L_KW); LAS unsigned short* sV = (LAS unsigned short*)(lds + L_V);
    LAS unsigned short* sS = (LAS unsigned short*)(lds + L_S); LAS float* sH = (LAS float*)(lds + L_Q);
    LAS float* gA = (LAS float*)(lds + L_G); LAS float* gM = gA + 64; LAS float* gDec = gA + 128; LAS float* gEinv = gA + 192; LAS float* gW = gA + 256;
    LAS float* gQn = gA + 320; LAS float* gDi = gA + 384; LAS float* gN = gA + 448; LAS float* scal = gA + 576; LAS float* gNg = gA + 584;
    const bf16x8 ones = (bf16x8){0x3F80, 0x3F80, 0x3F80, 0x3F80, 0x3F80, 0x3F80, 0x3F80, 0x3F80};
    const int tok0 = tid >> 4, dsg = tid & 15;
    const int orow = tid >> 3, oseg = tid & 7;
    u32x4 kq[2], kk[2], kv[2]; f32x4 pgt = (f32x4){0.f, 0.f, 0.f, 0.f};
    if (FULL && tid < 128) gNg[tid] = p.in[12][head * 128 + tid];
#pragma unroll
    for (int i = 0; i < 2; ++i) { const int tok = tok0 + 32 * i; const bool valid = tok < L; const u32x4 z = (u32x4){0u, 0u, 0u, 0u};
        const bf16_t* src = proj + (size_t)(row0 + tok) * NPROJ + head * 128 + dsg * 8;
        kk[i] = valid ? *(const u32x4*)(src + 1024) : z; kv[i] = valid ? *(const u32x4*)(src + 1536) : z;
        if (FULL) kq[i] = valid ? *(const u32x4*)(src + 512) : z; else kq[i] = z; }
    if (wave == 0 && lane < L) pgt = gtab[(size_t)(row0 + lane) * 4 + head];
#pragma unroll 1
    for (int c = 0; c < nch; ++c) {
        const int r0 = row0 + c * 64;
        if (wave == 0) {
            const bool valid = lane < L; const float a = valid ? pgt[0] : -1e30f; const float Ml = __shfl(pgt[1], L - 1);
            gA[lane] = a; gM[lane] = valid ? pgt[1] : Ml; gDec[lane] = valid ? pgt[2] : 0.f; gEinv[lane] = valid ? pgt[3] : 1.f; gW[lane] = valid ? __expf(a - Ml) : 0.f;
            if (lane == L - 1) scal[0] = pgt[2];
        }
        if (FULL) {
#pragma unroll
            for (int i = 0; i < 2; ++i)
#pragma unroll
                for (int n = 0; n < 4; ++n) { u32x2 w; w.x = pk2(accC[i][n][0], accC[i][n][1]); w.y = pk2(accC[i][n][2], accC[i][n][3]);
                    *(LAS u32x2*)(lds + L_CT + (64 * tp + 16 * n + l15) * 272 + (32 * st + 16 * i + 4 * l4) * 2) = w; }
            if (tp == 0 && l15 == 0) {
#pragma unroll
                for (int i = 0; i < 2; ++i) *(LAS f32x4*)(gN + 32 * st + 16 * i + 4 * l4) = accN[i]; }
        }
#pragma unroll
        for (int i = 0; i < 2; ++i) { const int tok = tok0 + 32 * i;
            if (FULL) { *(LAS u32x4*)(sQ + tok * 136 + dsg * 8) = kq[i]; *(LAS u32x4*)(sK + tok * 136 + dsg * 8) = kk[i]; }
            *(LAS u32x4*)(sV + tok * 136 + dsg * 8) = kv[i]; }
        LDS_BARRIER();
#pragma unroll
        for (int i = 0; i < 2; ++i) { const int tok = tok0 + 32 * i; const float w = gW[tok]; u32x4 o;
            o.x = pk2(bflo(kk[i].x) * w, bfhi(kk[i].x) * w); o.y = pk2(bflo(kk[i].y) * w, bfhi(kk[i].y) * w);
            o.z = pk2(bflo(kk[i].z) * w, bfhi(kk[i].z) * w); o.w = pk2(bflo(kk[i].w) * w, bfhi(kk[i].w) * w);
            *(LAS u32x4*)(sKW + tok * 136 + dsg * 8) = o; }
        if (c + 1 < nch) {
#pragma unroll
            for (int i = 0; i < 2; ++i) { const int tok = tok0 + 32 * i;
                const bf16_t* src = proj + (size_t)(r0 + 64 + tok) * NPROJ + head * 128 + dsg * 8;
                kk[i] = *(const u32x4*)(src + 1024); kv[i] = *(const u32x4*)(src + 1536);
                if (FULL) kq[i] = *(const u32x4*)(src + 512); }
            if (wave == 0) pgt = gtab[(size_t)(r0 + 64 + lane) * 4 + head];
        }
        f32x4 nacc[4];
#pragma unroll
        for (int n = 0; n < 4; ++n) nacc[n] = (f32x4){0.f, 0.f, 0.f, 0.f};
        if (FULL) {
            f32x4 sacc[2]; sacc[0] = (f32x4){0.f, 0.f, 0.f, 0.f}; sacc[1] = sacc[0];
#pragma unroll
            for (int ks = 0; ks < 4; ++ks) { const int kb = (32 * ks + 8 * l4) * 2;
                const bf16x8 a = ldfrag(lds + L_K, 16 * st + l15, 272, kb);
#pragma unroll
                for (int tt = 0; tt < 2; ++tt) { const bf16x8 b = ldfrag(lds + L_Q, 16 * (2 * tp + tt) + l15, 272, kb); sacc[tt] = MFMA16(a, b, sacc[tt]); } }
#pragma unroll
            for (int tt = 0; tt < 2; ++tt) { const int t = 16 * (2 * tp + tt) + l15; const float Mt = gM[t]; float dv[4];
#pragma unroll
                for (int j = 0; j < 4; ++j) { const int s = 16 * st + 4 * l4 + j; dv[j] = (s <= t) ? sacc[tt][j] * __expf(gA[s] - Mt) : 0.f; }
                u32x2 w; w.x = pk2(dv[0], dv[1]); w.y = pk2(dv[2], dv[3]); *(LAS u32x2*)(lds + L_S + t * 144 + (16 * st + 4 * l4) * 2) = w; }
#pragma unroll
            for (int ks = 0; ks < 4; ++ks) { const int kb = (32 * ks + 8 * l4) * 2;
                const bf16x8 a = ldfrag(lds + L_Q, 16 * st + l15, 272, kb);
#pragma unroll
                for (int n = 0; n < 4; ++n) { const bf16x8 b = ldfrag(lds + L_CT, 64 * tp + 16 * n + l15, 272, kb); nacc[n] = MFMA16(a, b, nacc[n]); } }
#pragma unroll
            for (int j = 0; j < 4; ++j) { const float dj = gDec[16 * st + 4 * l4 + j];
#pragma unroll
                for (int n = 0; n < 4; ++n) nacc[n][j] *= dj; }
            { float s = 0.f;
              const u32x4 q0 = *(LAS const u32x4*)(sQ + orow * 136 + oseg * 16), q1 = *(LAS const u32x4*)(sQ + orow * 136 + oseg * 16 + 8);
              const unsigned qw[8] = {q0.x, q0.y, q0.z, q0.w, q1.x, q1.y, q1.z, q1.w};
#pragma unroll
              for (int e = 0; e < 8; ++e) s += bflo(qw[e]) * gN[oseg * 16 + 2 * e] + bfhi(qw[e]) * gN[oseg * 16 + 2 * e + 1];
              s += __shfl_xor(s, 1); s += __shfl_xor(s, 2); s += __shfl_xor(s, 4);
              if (oseg == 0) gQn[orow] = s; }
        }
        LDS_BARRIER();
        if (FULL) {
            const u32x4 s0 = *(LAS const u32x4*)(sS + orow * 72 + oseg * 8);
            float s = (bflo(s0.x) + bfhi(s0.x)) + (bflo(s0.y) + bfhi(s0.y)) + (bflo(s0.z) + bfhi(s0.z)) + (bflo(s0.w) + bfhi(s0.w));
            s += __shfl_xor(s, 1); s += __shfl_xor(s, 2); s += __shfl_xor(s, 4);
            if (oseg == 0) { const float den = gDec[orow] * gQn[orow] + s; gDi[orow] = __builtin_amdgcn_rcpf(fmaxf(fabsf(den), gEinv[orow])); } }
        const float wsv = scal[0];
#pragma unroll
        for (int i = 0; i < 2; ++i) { accN[i] *= wsv;
#pragma unroll
            for (int n = 0; n < 4; ++n) accC[i][n] *= wsv; }
#pragma unroll
        for (int ks = 0; ks < 2; ++ks) { bf16x8 bv[4];
#pragma unroll
            for (int n = 0; n < 4; ++n) bv[n] = ldfrag_tr(lds + L_V, 32 * ks, 64 * tp + 16 * n, lane);
            if (FULL) { const bf16x8 a = ldfrag(lds + L_S, 16 * st + l15, 144, (32 * ks + 8 * l4) * 2);
#pragma unroll
                for (int n = 0; n < 4; ++n) nacc[n] = MFMA16(a, bv[n], nacc[n]); }
#pragma unroll
            for (int i = 0; i < 2; ++i) { const bf16x8 a = ldfrag_tr(lds + L_KW, 32 * ks, 32 * st + 16 * i, lane);
                accN[i] = MFMA16(a, ones, accN[i]);
#pragma unroll
                for (int n = 0; n < 4; ++n) accC[i][n] = MFMA16(a, bv[n], accC[i][n]); } }
        LDS_BARRIER();
        if (FULL) {
            u32x4 ow0 = (u32x4){0u, 0u, 0u, 0u}, ow1 = ow0;
            if (orow < L) { const bf16_t* op = proj + (size_t)(r0 + orow) * NPROJ + 2048 + head * 128 + oseg * 16; ow0 = *(const u32x4*)op; ow1 = *(const u32x4*)(op + 8); }
#pragma unroll
            for (int j = 0; j < 4; ++j) { const int t = 16 * st + 4 * l4 + j; const float di = gDi[t];
#pragma unroll
                for (int n = 0; n < 4; ++n) sH[t * 132 + 64 * tp + 16 * n + l15] = nacc[n][j] * di; }
            LDS_BARRIER();
            if (orow < L) {
                f32x4 x[4]; float s = 0.f;
#pragma unroll
                for (int e = 0; e < 4; ++e) { x[e] = *(LAS const f32x4*)(sH + orow * 132 + oseg * 16 + 4 * e); s += (x[e][0] + x[e][1]) + (x[e][2] + x[e][3]); }
                s += __shfl_xor(s, 1); s += __shfl_xor(s, 2); s += __shfl_xor(s, 4);
                const float mean = s * (1.0f / 128.0f); float q = 0.f;
#pragma unroll
                for (int e = 0; e < 4; ++e) { x[e] -= mean; q += (x[e][0] * x[e][0] + x[e][1] * x[e][1]) + (x[e][2] * x[e][2] + x[e][3] * x[e][3]); }
                q += __shfl_xor(q, 1); q += __shfl_xor(q, 2); q += __shfl_xor(q, 4);
                const float rstd = rsqrtf(q * (1.0f / 128.0f) + LN_EPS);
                const unsigned owv[8] = {ow0.x, ow0.y, ow0.z, ow0.w, ow1.x, ow1.y, ow1.z, ow1.w}; unsigned ov[8];
#pragma unroll
                for (int e = 0; e < 4; ++e) { const f32x4 g = *(LAS const f32x4*)(gNg + oseg * 16 + 4 * e);
                    const float y0 = x[e][0] * rstd * g[0] * fsigmoid(bflo(owv[2 * e])), y1 = x[e][1] * rstd * g[1] * fsigmoid(bfhi(owv[2 * e]));
                    const float y2 = x[e][2] * rstd * g[2] * fsigmoid(bflo(owv[2 * e + 1])), y3 = x[e][3] * rstd * g[3] * fsigmoid(bfhi(owv[2 * e + 1]));
                    ov[2 * e] = pk2(y0, y1); ov[2 * e + 1] = pk2(y2, y3); }
                bf16_t* mp = mix + (size_t)(r0 + orow) * DM + 512 + head * 128 + oseg * 16;
                *(u32x4*)mp = (u32x4){ov[0], ov[1], ov[2], ov[3]}; *(u32x4*)(mp + 8) = (u32x4){ov[4], ov[5], ov[6], ov[7]};
            }
            LDS_BARRIER();
        }
    }
}

constexpr int L_PW = 34816, L_PU = 69632;
template <int W>
__device__ __forceinline__ void pool_diff(LAS unsigned char* lds, bool sample, int tilepos0) {
    const int tid = fresh_tid(), co = tid & 15, t0 = (tid >> 4) * 4;
#pragma unroll 1
    for (int tt = 0; tt < 4; ++tt) {
        const int t = t0 + tt; const int sgi = sample ? (t >> 5) : 0, lt = sample ? (t & 31) : t;
        const int rowbase = sample ? sgi * 47 + 15 + lt : 15 + t;
        const int cnt = sample ? W : min(tilepos0 + t + 1, W);
        float sum[8];
#pragma unroll
        for (int e = 0; e < 8; ++e) sum[e] = 0.f;
        u32x4 x0 = (u32x4){0u, 0u, 0u, 0u};
#pragma unroll
        for (int j = 0; j < W; ++j) { const u32x4 r = *(LAS const u32x4*)(lds + L_PU + (rowbase - j) * 272 + co * 16); if (j == 0) x0 = r;
            sum[0] += bflo(r.x); sum[1] += bfhi(r.x); sum[2] += bflo(r.y); sum[3] += bfhi(r.y); sum[4] += bflo(r.z); sum[5] += bfhi(r.z); sum[6] += bflo(r.w); sum[7] += bfhi(r.w); }
        const float inv = 1.0f / (float)cnt;
        u32x4 w; w.x = pk2(sum[0] * inv - bflo(x0.x), sum[1] * inv - bfhi(x0.x)); w.y = pk2(sum[2] * inv - bflo(x0.y), sum[3] * inv - bfhi(x0.y));
        w.z = pk2(sum[4] * inv - bflo(x0.z), sum[5] * inv - bfhi(x0.z)); w.w = pk2(sum[6] * inv - bflo(x0.w), sum[7] * inv - bfhi(x0.w));
        *(LAS u32x4*)(lds + t * 272 + co * 16) = w; }
}

__device__ __forceinline__ void pool_fetch(const Params& p, int item, int tid, u32x4 (&pf)[6]) {
    const int g = item & 3, R0 = (item >> 2) * 128;
    const bf16_t* proj = (const bf16_t*)(p.ws + WS_PROJ); const float* hist = p.in[2];
    if (R0 < MP) {
        const int seqrow0 = (R0 / SEQ) * SEQ, tilepos0 = R0 - seqrow0;
        u32x4 raw[6];
#pragma unroll
        for (int i = 0; i < 6; ++i) { const int piece = tid + 512 * i, e = piece >> 4, seg = piece & 15; int pos = tilepos0 - 15 + (e < 143 ? e : 142); pos = pos < 0 ? 0 : pos;
            raw[i] = *(const u32x4*)(proj + (size_t)(seqrow0 + pos) * NPROJ + g * 128 + seg * 8); }
#pragma unroll
        for (int i = 0; i < 6; ++i) { const int piece = tid + 512 * i, e = piece >> 4; const bool valid = (e < 143) && (tilepos0 - 15 + e >= 0);
            pf[i] = valid ? raw[i] : (u32x4){0u, 0u, 0u, 0u}; }
    } else {
#pragma unroll
        for (int i = 0; i < 6; ++i) { const int piece = tid + 512 * i, e = piece >> 4, seg = piece & 15; u32x4 val = (u32x4){0u, 0u, 0u, 0u};
            if (e < 188) { const int sgi = e / 47, le = e - sgi * 47, b = ((R0 - MP) >> 5) + sgi;
                if (le < 15) { const float* hp = hist + ((size_t)b * 15 + le) * 512 + g * 128 + seg * 8; const float4 a = *(const float4*)hp, c4 = *(const float4*)(hp + 4);
                    val.x = pk2(a.x, a.y); val.y = pk2(a.z, a.w); val.z = pk2(c4.x, c4.y); val.w = pk2(c4.z, c4.w); }
                else val = *(const u32x4*)(proj + (size_t)(MP + b * 32 + le - 15) * NPROJ + g * 128 + seg * 8); }
            pf[i] = val; }
    }
}

__device__ __forceinline__ void pool_loop(const Params& p, LAS unsigned char* lds, int first, int stride, int end) {
    const int tid = fresh_tid(), lane = tid & 63, wave = __builtin_amdgcn_readfirstlane(tid >> 6), l15 = lane & 15, l4 = lane >> 4, st = wave & 3, tp = wave >> 2;
    bf16_t* mix = (bf16_t*)(p.ws + WS_MIX); const float* pscale = p.in[11];
    if (first >= end) return;
    u32x4 pf[6]; pool_fetch(p, first, tid, pf);
    int gw = -1;
#pragma unroll 1
    for (int item = first; item < end; item += stride) {
        const int g = item & 3, R0 = (item >> 2) * 128;
        const bool sample = R0 >= MP; const int tilepos0 = sample ? 0 : R0 - (R0 / SEQ) * SEQ;
        if (g != gw) { const bf16_t* Wp = (const bf16_t*)(p.ws + WS_WPOOL) + g * 16384; gw = g;
#pragma unroll
            for (int i = 0; i < 4; ++i) { const int piece = tid + 512 * i, row = piece >> 4, seg = piece & 15;
                *(LAS u32x4*)(lds + L_PW + row * 272 + seg * 16) = *(const u32x4*)(Wp + row * 128 + seg * 8); } }
#pragma unroll
        for (int i = 0; i < 6; ++i) { const int piece = tid + 512 * i, e = piece >> 4, seg = piece & 15; if (e < 188) *(LAS u32x4*)(lds + L_PU + e * 272 + seg * 16) = pf[i]; }
        LDS_BARRIER();
        if (item + stride < end) pool_fetch(p, item + stride, tid, pf);
        if (g == 0) pool_diff<2>(lds, sample, tilepos0); else if (g == 1) pool_diff<4>(lds, sample, tilepos0); else if (g == 2) pool_diff<8>(lds, sample, tilepos0); else pool_diff<16>(lds, sample, tilepos0);
        LDS_BARRIER();
        f32x4 acc[2][4];
#pragma unroll
        for (int i = 0; i < 2; ++i)
#pragma unroll
            for (int n = 0; n < 4; ++n) acc[i][n] = (f32x4){0.f, 0.f, 0.f, 0.f};
#pragma unroll
        for (int ks = 0; ks < 4; ++ks) { const int kb = (32 * ks + 8 * l4) * 2; bf16x8 bv[4];
#pragma unroll
            for (int n = 0; n < 4; ++n) bv[n] = ldfrag(lds, 64 * tp + 16 * n + l15, 272, kb);
#pragma unroll
            for (int i = 0; i < 2; ++i) { const bf16x8 a = ldfrag(lds + L_PW, 32 * st + 16 * i + l15, 272, kb);
#pragma unroll
                for (int n = 0; n < 4; ++n) acc[i][n] = MFMA16(a, bv[n], acc[i][n]); } }
        LDS_BARRIER();
#pragma unroll
        for (int i = 0; i < 2; ++i) { const int d0 = 32 * st + 16 * i + 4 * l4; const float4 ps = *(const float4*)(pscale + g * 128 + d0);
#pragma unroll
            for (int n = 0; n < 4; ++n) { const int t = 64 * tp + 16 * n + l15;
                u32x2 w; w.x = pk2(acc[i][n][0] * ps.x, acc[i][n][1] * ps.y); w.y = pk2(acc[i][n][2] * ps.z, acc[i][n][3] * ps.w);
                *(LAS u32x2*)(lds + t * 272 + d0 * 2) = w; } }
        LDS_BARRIER();
        { const int t = tid >> 2, sg = tid & 3; const u32x4 o0 = *(LAS const u32x4*)(lds + t * 272 + sg * 64), o1 = *(LAS const u32x4*)(lds + t * 272 + sg * 64 + 16),
            o2 = *(LAS const u32x4*)(lds + t * 272 + sg * 64 + 32), o3 = *(LAS const u32x4*)(lds + t * 272 + sg * 64 + 48);
          bf16_t* mp = mix + (size_t)(R0 + t) * DM + g * 128 + sg * 32; *(u32x4*)mp = o0; *(u32x4*)(mp + 8) = o1; *(u32x4*)(mp + 16) = o2; *(u32x4*)(mp + 24) = o3; }
    }
    LDS_BARRIER();
}

constexpr int N_S2 = 224, N_SMP = 128, N_POOL = (MT / 128) * 4;

__device__ __forceinline__ void phase2(const Params& p, LAS unsigned char* lds, int kinds) {
    const int tid = fresh_tid(), lane = tid & 63, wave = tid >> 6, l15 = lane & 15, l4 = lane >> 4, st = wave & 3, tp = wave >> 2;
    float* Dst = (float*)(p.ws + WS_DST); float* Dn = (float*)(p.ws + WS_DN); const float* mtab = (const float*)(p.ws + WS_MTAB);
    for (int it = blockIdx.x; it < N_S2 + N_SMP; it += gridDim.x) {
        if (it < N_S2) {
            if (!(kinds & 1)) continue;
            const int chain = it / 7, sc = it % 7, batch = chain >> 2, head = chain & 3;
            f32x4 accC[2][4], accN[2];
#pragma unroll
            for (int i = 0; i < 2; ++i) { accN[i] = (f32x4){0.f, 0.f, 0.f, 0.f};
#pragma unroll
                for (int n = 0; n < 4; ++n) accC[i][n] = (f32x4){0.f, 0.f, 0.f, 0.f}; }
            mlstm_run<false>(p, lds, accC, accN, batch * SEQ + sc * SCN * 64, head, SCN, 64);
#pragma unroll
            for (int i = 0; i < 2; ++i)
#pragma unroll
                for (int n = 0; n < 4; ++n)
#pragma unroll
                    for (int j = 0; j < 4; ++j) Dst[((size_t)it * 32 + (i * 4 + n) * 4 + j) * 512 + tid] = accC[i][n][j];
            if (tp == 0 && l15 == 0) {
#pragma unroll
                for (int i = 0; i < 2; ++i) *(f32x4*)(Dn + it * 128 + 32 * st + 16 * i + 4 * l4) = accN[i]; }
        } else {
            if (!(kinds & 2)) continue;
            const int s = it - N_S2, b = s >> 2, head = s & 3;
            const float* C0 = p.in[3] + (size_t)s * 16384; f32x4 accC[2][4], accN[2];
#pragma unroll
            for (int i = 0; i < 2; ++i) accN[i] = *(const f32x4*)(p.in[4] + s * 128 + 32 * st + 16 * i + 4 * l4);
#pragma unroll
            for (int i = 0; i < 2; ++i)
#pragma unroll
                for (int n = 0; n < 4; ++n)
#pragma unroll
                    for (int j = 0; j < 4; ++j) accC[i][n][j] = C0[(32 * st + 16 * i + 4 * l4 + j) * 128 + 64 * tp + 16 * n + l15];
            mlstm_run<true>(p, lds, accC, accN, MP + b * 32, head, 1, 32);
            float* Co = p.out + O_CS + (size_t)s * 16384;
#pragma unroll
            for (int i = 0; i < 2; ++i)
#pragma unroll
                for (int n = 0; n < 4; ++n)
#pragma unroll
                    for (int j = 0; j < 4; ++j) Co[(32 * st + 16 * i + 4 * l4 + j) * 128 + 64 * tp + 16 * n + l15] = accC[i][n][j];
            if (tp == 0 && l15 == 0) {
#pragma unroll
                for (int i = 0; i < 2; ++i) *(f32x4*)(p.out + O_NS + s * 128 + 32 * st + 16 * i + 4 * l4) = accN[i]; }
        }
    }
    if (kinds & 4) { const int G = gridDim.x; int first = blockIdx.x; while (first < N_S2 + N_SMP) first += G;
        pool_loop(p, lds, first - N_S2 - N_SMP, G, N_POOL); }
    const bf16_t* proj = (const bf16_t*)(p.ws + WS_PROJ);
    for (int idx = blockIdx.x * 512 + tid; idx < (NB + DB) * 15 * 512; idx += gridDim.x * 512) {
        if (idx < NB * 7680) { const int b = idx / 7680, rem = idx % 7680, i = rem >> 9, c = rem & 511;
            p.out[O_POOLP + idx] = bf2f(proj[(size_t)(b * SEQ + SEQ - 15 + i) * NPROJ + c]); }
        else { const int id2 = idx - NB * 7680, b = id2 / 7680, rem = id2 % 7680, i = rem >> 9, c = rem & 511;
            p.out[O_POOLS + id2] = bf2f(proj[(size_t)(MP + b * 32 + 17 + i) * NPROJ + c]); }
    }
}

__device__ __forceinline__ void phase3(const Params& p, LAS unsigned char* lds) {
    const int tid = fresh_tid(), lane = tid & 63, wave = tid >> 6, l15 = lane & 15, l4 = lane >> 4, st = wave & 3, tp = wave >> 2;
    const float* Dst = (const float*)(p.ws + WS_DST); const float* Dn = (const float*)(p.ws + WS_DN);
    const float* mtab = (const float*)(p.ws + WS_MTAB); const float* btab = (const float*)(p.ws + WS_BTAB);
    for (int it = blockIdx.x; it < 256; it += gridDim.x) {
        const int chain = it >> 3, sc = it & 7, batch = chain >> 2, head = chain & 3;
        f32x4 accC[2][4], accN[2];
#pragma unroll
        for (int i = 0; i < 2; ++i) { accN[i] = (f32x4){0.f, 0.f, 0.f, 0.f};
#pragma unroll
            for (int n = 0; n < 4; ++n) accC[i][n] = (f32x4){0.f, 0.f, 0.f, 0.f}; }
#pragma unroll 1
        for (int j = 0; j < sc; ++j) {
            float Bs = 0.f;
            for (int c = 0; c < SCN; ++c) Bs += btab[chain * 128 + j * SCN + c];
            const float Wj = expf(Bs + mtab[chain * 132 + j * SCN] - mtab[chain * 132 + (j + 1) * SCN]);
            const int item = chain * 7 + j;
#pragma unroll
            for (int i = 0; i < 2; ++i)
#pragma unroll
                for (int n = 0; n < 4; ++n)
#pragma unroll
                    for (int q = 0; q < 4; ++q) accC[i][n][q] = Wj * accC[i][n][q] + Dst[((size_t)item * 32 + (i * 4 + n) * 4 + q) * 512 + tid];
#pragma unroll
            for (int i = 0; i < 2; ++i) accN[i] = Wj * accN[i] + *(const f32x4*)(Dn + item * 128 + 32 * st + 16 * i + 4 * l4);
        }
        mlstm_run<true>(p, lds, accC, accN, batch * SEQ + sc * SCN * 64, head, SCN, 64);
        if (sc == 7) {
            float* Co = p.out + O_CP + (size_t)chain * 16384;
#pragma unroll
            for (int i = 0; i < 2; ++i)
#pragma unroll
                for (int n = 0; n < 4; ++n)
#pragma unroll
                    for (int j = 0; j < 4; ++j) Co[(32 * st + 16 * i + 4 * l4 + j) * 128 + 64 * tp + 16 * n + l15] = accC[i][n][j];
            if (tp == 0 && l15 == 0) {
#pragma unroll
                for (int i = 0; i < 2; ++i) *(f32x4*)(p.out + O_NP + chain * 128 + 32 * st + 16 * i + 4 * l4) = accN[i]; }
        }
    }
}

__device__ __forceinline__ void ln_load(const float* src, const float* slab, int S, const bf16_t* hb, int row, int lane, float4 (&v)[4]) {
    if (row >= MP) {
#pragma unroll
        for (int i = 0; i < 4; ++i) { const int c = i * 256 + lane * 4; const u32x2 h2 = *(const u32x2*)(hb + (size_t)row * DM + c);
            float4 a = make_float4(ALPHA * bflo(h2.x), ALPHA * bfhi(h2.x), ALPHA * bflo(h2.y), ALPHA * bfhi(h2.y));
            const float* sp = slab + (size_t)(row - MP) * DM + c;
#pragma unroll 1
            for (int sl = 0; sl < S; ++sl) { const float4 t = *(const float4*)(sp + (size_t)sl * (1024 * 1024)); a.x += t.x; a.y += t.y; a.z += t.z; a.w += t.w; }
            v[i] = a; }
    } else {
#pragma unroll
        for (int i = 0; i < 4; ++i) v[i] = *(const float4*)(src + (size_t)row * DM + i * 256 + lane * 4); }
}
template <bool TO_BF16>
__device__ __forceinline__ void ln_rows(const float* src, const float* gam, const float* bet, bf16_t* ob, float* of, const float* slab, int S, const bf16_t* hb) {
    const int tid = fresh_tid(), lane = tid & 63, wave = tid >> 6, stride = gridDim.x * 8;
    int row = blockIdx.x * 8 + wave; float4 v[4];
    if (row < MT) ln_load(src, slab, S, hb, row, lane, v);
#pragma unroll 1
    for (; row < MT; row += stride) {
        const int nrow = row + stride; float4 nv[4];
        if (nrow < MT) ln_load(src, slab, S, hb, nrow, lane, nv);
        else {
#pragma unroll
            for (int i = 0; i < 4; ++i) nv[i] = make_float4(0.f, 0.f, 0.f, 0.f); }
        float s = 0.f;
#pragma unroll
        for (int i = 0; i < 4; ++i) s += (v[i].x + v[i].y) + (v[i].z + v[i].w);
        const float mu = wave_sum(s) * (1.0f / DM); float q = 0.f;
#pragma unroll
        for (int i = 0; i < 4; ++i) { v[i].x -= mu; v[i].y -= mu; v[i].z -= mu; v[i].w -= mu; q += (v[i].x * v[i].x + v[i].y * v[i].y) + (v[i].z * v[i].z + v[i].w * v[i].w); }
        const float rstd = rsqrtf(wave_sum(q) * (1.0f / DM) + LN_EPS);
#pragma unroll
        for (int i = 0; i < 4; ++i) { const int c = i * 256 + lane * 4; const float4 gg = *(const float4*)(gam + c), bb = *(const float4*)(bet + c);
            float4 y; y.x = v[i].x * rstd * gg.x + bb.x; y.y = v[i].y * rstd * gg.y + bb.y; y.z = v[i].z * rstd * gg.z + bb.z; y.w = v[i].w * rstd * gg.w + bb.w;
            if (TO_BF16) { u32x2 w; w.x = pk2(y.x, y.y); w.y = pk2(y.z, y.w); *(u32x2*)(ob + (size_t)row * DM + c) = w; }
            else *(float4*)(of + (size_t)row * DM + c) = y; }
#pragma unroll
        for (int i = 0; i < 4; ++i) v[i] = nv[i];
    }
}

__global__ void __launch_bounds__(512) fwd_mega(Params p) {
    extern __shared__ __attribute__((aligned(16))) unsigned char smem[];
    LAS unsigned char* lds = (LAS unsigned char*)smem;
    cg::grid_group grid = cg::this_grid();
    volatile LAS unsigned* stw = (volatile LAS unsigned*)(lds + 131072);
    if (threadIdx.x == 0) { stw[0] = 0u; stw[1] = 0u; }
    __syncthreads();
    const XcdBarrier xbar = xcd_barrier_post((unsigned*)(p.ws + WS_BAR), stw);
    unsigned char* ws = p.ws;
    bf16_t* h0 = (bf16_t*)(ws + WS_H0); bf16_t* proj = (bf16_t*)(ws + WS_PROJ); bf16_t* mix = (bf16_t*)(ws + WS_MIX); bf16_t* act = (bf16_t*)(ws + WS_ACT);
    float* slab = (float*)(ws + WS_SLAB);
    const int G = gridDim.x, bx = blockIdx.x;
#ifndef DBL
#define DBL 0
#endif
    if (DBL & 0x800) { for (int i = 0; i < 10; ++i) xcd_barrier(xbar); }
    if (DBL & 1) { phase0(p, lds); xcd_barrier(xbar); }
    phase0(p, lds);
    grid.sync();
    gate_scan(p, lds);
    { pg8::Gemm g{h0, (const bf16_t*)(ws + WS_WIN), MT, NPROJ, DM}; SplitOrder S; S.init(NPROJ, DM / 64, 1, G, bx);
      EpiBf16B e{proj, NPROJ, (const float*)(ws + WS_BIAS)}; pg8::gemm_phase(lds, g, S, e); }
    xcd_barrier(xbar);
    if (DBL & 4) { phase2(p, lds, 15); xcd_barrier(xbar); }
    if (DBL & 0x200) { phase2(p, lds, 4); xcd_barrier(xbar); }
    if (DBL & 0x400) { phase2(p, lds, 1); xcd_barrier(xbar); }
    phase2(p, lds, 15);
    xcd_barrier(xbar);
    if (DBL & 8) { phase3(p, lds); xcd_barrier(xbar); }
    phase3(p, lds);
    xcd_barrier(xbar);
    { pg8::Gemm g{mix, (const bf16_t*)(ws + WS_WOUT), MT, DM, DM}; SplitOrder S; S.init(DM, DM / 64, 4, G, bx);
      EpiRes e{h0, p.out + O_Y, slab, DM / 64}; pg8::gemm_phase(lds, g, S, e); }
    xcd_barrier(xbar);
    ln_rows<true>(p.out + O_Y, p.in[14], p.in[15], h0, nullptr, slab, 4, h0);
    xcd_barrier(xbar);
    { pg8::Gemm g{h0, (const bf16_t*)(ws + WS_WGU), MT, 2 * DFF, DM}; SplitOrder S; S.init(2 * DFF, DM / 64, 1, G, bx);
      EpiSwiglu e{act}; pg8::gemm_phase(lds, g, S, e); }
    xcd_barrier(xbar);
    { pg8::Gemm g{act, (const bf16_t*)(ws + WS_WDN), MT, DM, DFF}; SplitOrder S; S.init(DM, DFF / 64, 11, G, bx);
      EpiRes e{h0, p.out + O_Y, slab, DFF / 64}; pg8::gemm_phase(lds, g, S, e); }
    xcd_barrier(xbar);
    ln_rows<false>(p.out + O_Y, p.in[19], p.in[20], nullptr, p.out + O_Y, slab, 11, h0);
}

extern "C" void kernel_launch(void* const* d_in, const int* in_sizes, int n_in, void* d_out, int out_size, void* d_ws, size_t ws_size, hipStream_t stream) {
    constexpr size_t kDynLds = 131072 + 64;
    static int grid_blocks = 0;
    if (!grid_blocks) {
        if (n_in != 21 || (size_t)out_size != O_END || ws_size < WS_END2) { fprintf(stderr, "kernel_launch: unexpected shapes: n_in %d out %d ws %zu (need %zu)\n", n_in, out_size, ws_size, (size_t)WS_END2); grid_blocks = -1; return; }
        int dev = 0, cus = 0, per_cu = 0;
        hipGetDevice(&dev);
        hipDeviceGetAttribute(&cus, hipDeviceAttributeMultiprocessorCount, dev);
        if (hipFuncSetAttribute((const void*)fwd_mega, hipFuncAttributeMaxDynamicSharedMemorySize, (int)kDynLds) != hipSuccess) { fprintf(stderr, "kernel_launch: hipFuncSetAttribute failed\n"); grid_blocks = -1; return; }
        if (hipOccupancyMaxActiveBlocksPerMultiprocessor(&per_cu, (const void*)fwd_mega, 512, kDynLds) != hipSuccess || per_cu < 1) { fprintf(stderr, "kernel_launch: occupancy query failed (%d)\n", per_cu); grid_blocks = -1; return; }
        if (per_cu > 1) per_cu = 1;
        grid_blocks = cus * per_cu;
    }
    if (grid_blocks < 0) return;
    if (hipMemsetAsync((char*)d_ws + WS_BAR, 0, XCD_BAR_WORDS * 4, stream) != hipSuccess) { fprintf(stderr, "kernel_launch: memset of the barrier words failed\n"); return; }
    Params p{};
    for (int i = 0; i < 21; ++i) p.in[i] = (const float*)d_in[i];
    p.out = (float*)d_out; p.ws = (unsigned char*)d_ws;
    void* args[] = {&p};
    hipError_t e = hipLaunchCooperativeKernel((const void*)fwd_mega, dim3(grid_blocks), dim3(512), args, kDynLds, stream);
    if (e != hipSuccess) fprintf(stderr, "cooperative launch failed: %s (grid %d)\n", hipGetErrorString(e), grid_blocks);
}
```

```cpp
#include <hip/hip_runtime.h>
#include <hip/hip_cooperative_groups.h>
#include <cstdio>
namespace cg = cooperative_groups;
namespace pg8 {
#define PG8_LAS __attribute__((address_space(3)))
typedef unsigned short bf16_t;
typedef short bf16x8 __attribute__((ext_vector_type(8)));
typedef float f32x4 __attribute__((ext_vector_type(4)));
typedef unsigned u32x4 __attribute__((ext_vector_type(4)));
constexpr int BM = 256, BK = 64, HALF = 128, HTB = HALF * BK * 2  , STAGE_BYTES = 8 * HTB, NXCD = 8, WGM = 8;

__host__ __device__ __forceinline__ int lds_byte(int r, int c) { const int st = (r >> 4) * 2 + (c >> 5), rr = r & 15, cc = c & 31, ob = rr * 64 + cc * 2; return st * 1024 + (ob ^ (((ob >> 9) & 1) << 5)); }
__host__ __device__ __forceinline__ void stage_rc(int b, int& R, int& C) { const int st = b / 1024, sb = b % 1024, swz = sb ^ (((sb >> 9) & 1) << 5); R = (st >> 1) * 16 + swz / 64; C = (st & 1) * 32 + (swz % 64) / 2; }
__host__ __device__ __forceinline__ int perm32(int rho) { const int n = rho >> 4, i = rho & 15; return 8 * (i >> 2) + 4 * n + (i & 3); }

struct Unit { int pm, pn, kt0, nkt; };
struct Gemm { const bf16_t* A; const bf16_t* Bt; int M, N, K; };
struct StaticOrder {
    int nM, nN, nwg, G, c;
    __host__ __device__ void init(int M, int N, int G_, int c_) { nM = M / BM; nN = N / BM; nwg = nM * nN; G = G_; c = c_; }
    __host__ __device__ bool next(int i, Unit& u) const {
        const long L = (long)i * G + c; if (L >= nwg) return false;
        int wgid = (int)L; { const int q = nwg / NXCD, r = nwg % NXCD, xcd = wgid % NXCD, off = wgid / NXCD; wgid = (xcd < r ? xcd * (q + 1) : r * (q + 1) + (xcd - r) * q) + off; }
        const int nig = WGM * nN, gid = wgid / nig, fm = gid * WGM, gsz = (nM - fm) < WGM ? (nM - fm) : WGM;
        u.pm = fm + ((wgid % nig) % gsz); u.pn = (wgid % nig) / gsz; u.kt0 = 0; u.nkt = 0; return true;
    }
    __device__ __forceinline__ void a_ready(const Unit&) const {}
    __device__ __forceinline__ void done(const Unit&) const {}
};
__device__ __forceinline__ unsigned cvt_pk_bf16(float lo, float hi) { unsigned r; asm volatile("v_cvt_pk_bf16_f32 %0, %1, %2" : "=v"(r) : "v"(lo), "v"(hi)); return r; }
template <class Epi, class Sched>
__device__ __forceinline__ void gemm_phase(PG8_LAS unsigned char* lds, const Gemm g, const Sched& S, const Epi& E) {
    int tid_ = threadIdx.x; asm volatile("" : "+v"(tid_)); const int tid = tid_, wid = __builtin_amdgcn_readfirstlane(tid >> 6), lane = tid & 63, wr = wid >> 2, wc = wid & 3, fr = lane & 15, fq = lane >> 4;
    const int K = g.K;
    unsigned voffA[2], voffB[2];
#pragma unroll
    for (int i = 0; i < 2; ++i) { int R, C; stage_rc(tid * 16 + i * 8192, R, C); const int Rb = Epi::PERM ? ((R & ~31) + perm32(R & 31)) : R;
        voffA[i] = (unsigned)(R * K + C) * 2u; voffB[i] = (unsigned)(Rb * K + C) * 2u; }
    const size_t kstep = (size_t)(BK * 2);
    const size_t hstep = (size_t)HALF * K * 2;
    const size_t tstep = 2 * hstep;
    const unsigned ldsw = (unsigned)wid * 1024u;
    const int aoff = lds_byte(wr * 64 + fr, fq * 8), boff = lds_byte(wc * 32 + fr, fq * 8);
#define PG8_SA(b, h) (((b) * 2 + (h)) * HTB)
#define PG8_SB(b, h) ((4 + (b) * 2 + (h)) * HTB)
#define PG8_STAGE(bufoff, gbase, voff) do { _Pragma("unroll") for (int _i = 0; _i < 2; ++_i) \
        __builtin_amdgcn_global_load_lds((const unsigned*)((const char*)(gbase) + (voff)[_i]), (PG8_LAS unsigned*)(lds + (bufoff) + ldsw + _i * 8192), 16, 0, 0); } while (0)
#define PG8_LDA(dst, b, h) do { _Pragma("unroll") for (int m = 0; m < 4; ++m) _Pragma("unroll") for (int k = 0; k < 2; ++k) dst[m][k] = *(const PG8_LAS bf16x8*)(lds + PG8_SA(b, h) + aoff + m * 2048 + k * 1024); } while (0)
#define PG8_LDB(dst, b, h) do { _Pragma("unroll") for (int n = 0; n < 2; ++n) _Pragma("unroll") for (int k = 0; k < 2; ++k) dst[n][k] = *(const PG8_LAS bf16x8*)(lds + PG8_SB(b, h) + boff + n * 2048 + k * 1024); } while (0)
#define PG8_MMA(ai, bj, At, Bt) do { __builtin_amdgcn_s_setprio(1); _Pragma("unroll") for (int m = 0; m < 4; ++m) _Pragma("unroll") for (int n = 0; n < 2; ++n) _Pragma("unroll") for (int k = 0; k < 2; ++k) \
        acc[ai][bj][m][n] = __builtin_amdgcn_mfma_f32_16x16x32_bf16(Bt[n][k], At[m][k], acc[ai][bj][m][n], 0, 0, 0); __builtin_amdgcn_s_setprio(0); } while (0)
#define PG8_WAIT_V(n) asm volatile("s_waitcnt vmcnt(" #n ")" ::: "memory")
#define PG8_WAIT_L(n) asm volatile("s_waitcnt lgkmcnt(" #n ")" ::: "memory")
#define PG8_BAR __builtin_amdgcn_s_barrier()
#define PG8_SCHED __builtin_amdgcn_sched_barrier(0)
    Unit cur, nxt; int ui = 0;
    if (!S.next(0, cur)) return;
    f32x4 acc[2][2][4][2];
#pragma unroll
    for (int a = 0; a < 2; ++a)
#pragma unroll
        for (int b = 0; b < 2; ++b)
#pragma unroll
            for (int m = 0; m < 4; ++m)
#pragma unroll
                for (int n = 0; n < 2; ++n) acc[a][b][m][n] = (f32x4){0.f, 0.f, 0.f, 0.f};
    bf16x8 At[4][2], B0[2][2], B1[2][2];
    const char* cA = (const char*)g.A + (size_t)cur.pm * tstep + (size_t)cur.kt0 * kstep; const char* cB = (const char*)g.Bt + (size_t)cur.pn * tstep + (size_t)cur.kt0 * kstep;
    S.a_ready(cur);
    PG8_STAGE(PG8_SB(0, 0), cB, voffB); PG8_STAGE(PG8_SA(0, 0), cA, voffA); PG8_STAGE(PG8_SB(0, 1), cB + hstep, voffB); PG8_STAGE(PG8_SA(0, 1), cA + hstep, voffA);
    if (wr == 1) PG8_BAR;
    PG8_WAIT_V(4); PG8_BAR;
    PG8_STAGE(PG8_SB(1, 0), cB + kstep, voffB); PG8_STAGE(PG8_SA(1, 0), cA + kstep, voffA); PG8_STAGE(PG8_SB(1, 1), cB + hstep + kstep, voffB);
    PG8_WAIT_V(6); PG8_BAR;
    for (;;) {
        const bool has_next = S.next(ui + 1, nxt);
        const char* nA = has_next ? (const char*)g.A + (size_t)nxt.pm * tstep + (size_t)nxt.kt0 * kstep : cA; const char* nB = has_next ? (const char*)g.Bt + (size_t)nxt.pn * tstep + (size_t)nxt.kt0 * kstep : cB;
        const int nt = cur.nkt;
        for (int t = 0; t < nt; t += 2) {
            const bool last = (t == nt - 2);
            const char* a1 = cA + (size_t)(t + 1) * kstep;
            const char* a2 = last ? nA : cA + (size_t)(t + 2) * kstep; const char* b2 = last ? nB : cB + (size_t)(t + 2) * kstep;
            const char* a3 = a2 + kstep; const char* b3 = b2 + kstep;
            if (last && has_next) S.a_ready(nxt);
            PG8_LDB(B0, 0, 0); PG8_SCHED; PG8_LDA(At, 0, 0); PG8_STAGE(PG8_SA(1, 1), a1 + hstep, voffA);
            PG8_WAIT_L(8); PG8_BAR; PG8_WAIT_L(0); PG8_MMA(0, 0, At, B0); PG8_BAR; PG8_SCHED;
            PG8_LDB(B1, 0, 1); PG8_STAGE(PG8_SB(0, 0), b2, voffB);
            PG8_BAR; PG8_WAIT_L(0); PG8_MMA(0, 1, At, B1); PG8_BAR;
            PG8_LDA(At, 0, 1); PG8_STAGE(PG8_SA(0, 0), a2, voffA);
            PG8_BAR; PG8_WAIT_L(0); PG8_MMA(1, 0, At, B0); PG8_BAR; PG8_SCHED;
            PG8_STAGE(PG8_SB(0, 1), b2 + hstep, voffB);
            PG8_WAIT_V(6); PG8_BAR; PG8_MMA(1, 1, At, B1); PG8_BAR;
            PG8_LDB(B0, 1, 0); PG8_SCHED; PG8_LDA(At, 1, 0); PG8_STAGE(PG8_SA(0, 1), a2 + hstep, voffA);
            PG8_WAIT_L(8); PG8_BAR; PG8_WAIT_L(0); PG8_MMA(0, 0, At, B0); PG8_BAR; PG8_SCHED;
            PG8_LDB(B1, 1, 1); PG8_STAGE(PG8_SB(1, 0), b3, voffB);
            PG8_BAR; PG8_WAIT_L(0); PG8_MMA(0, 1, At, B1); PG8_BAR;
            PG8_LDA(At, 1, 1); PG8_STAGE(PG8_SA(1, 0), a3, voffA);
            PG8_BAR; PG8_WAIT_L(0); PG8_MMA(1, 0, At, B0); PG8_BAR; PG8_SCHED;
            PG8_STAGE(PG8_SB(1, 1), b3 + hstep, voffB);
            PG8_WAIT_V(6); PG8_BAR; PG8_MMA(1, 1, At, B1); PG8_BAR;
        }
        if constexpr (!Epi::AFTER_DRAIN) { E(acc, cur, wr, wc, fr, fq); S.done(cur); }
        if (!has_next) break;
#pragma unroll
        for (int a = 0; a < 2; ++a)
#pragma unroll
            for (int b = 0; b < 2; ++b)
#pragma unroll
                for (int m = 0; m < 4; ++m)
#pragma unroll
                    for (int n = 0; n < 2; ++n) acc[a][b][m][n] = (f32x4){0.f, 0.f, 0.f, 0.f};
        cur = nxt; cA = nA; cB = nB; ++ui;
    }
    PG8_WAIT_V(0);
    if (wr == 0) PG8_BAR;
    PG8_BAR;
    if constexpr (Epi::AFTER_DRAIN) { E.fused(acc, cur, wr, wc, fr, fq, lds, wid, lane); S.done(cur); }
#undef PG8_SA
#undef PG8_SB
#undef PG8_STAGE
#undef PG8_LDA
#undef PG8_LDB
#undef PG8_MMA
#undef PG8_WAIT_V
#undef PG8_WAIT_L
#undef PG8_BAR
#undef PG8_SCHED
}
}

using pg8::bf16_t; using pg8::bf16x8; using pg8::f32x4; using pg8::u32x4;
#define LAS __attribute__((address_space(3)))
typedef unsigned u32x2 __attribute__((ext_vector_type(2)));

constexpr int DM = 1024, NB = 8, SEQ = 8192, DB = 32, DS = 32;
constexpr int MP = NB * SEQ, MS = DB * DS, MT = MP + MS;
constexpr int NPROJ = 2560, INCOLS = 2568, DFF = 2816;
constexpr int SCN = 16;
constexpr float ALPHA = 1.189207115002721f, KSCALE = 0.08838834764831845f, LN_EPS = 1e-5f;

constexpr size_t al256(size_t x) { return (x + 255) & ~(size_t)255; }
constexpr size_t WS_BAR = 0;
constexpr size_t WS_WIN = 16384;
constexpr size_t WS_WOUT = WS_WIN + al256((size_t)NPROJ * DM * 2);
constexpr size_t WS_WGU = WS_WOUT + al256((size_t)DM * DM * 2);
constexpr size_t WS_WDN = WS_WGU + al256((size_t)2 * DFF * DM * 2);
constexpr size_t WS_WPOOL = WS_WDN + al256((size_t)DM * DFF * 2);
constexpr size_t WS_BIAS = WS_WPOOL + al256((size_t)4 * 128 * 128 * 2);
constexpr size_t WS_GATES = WS_BIAS + al256((size_t)NPROJ * 4);
constexpr size_t WS_MTAB = WS_GATES + al256((size_t)MT * 8 * 4);
constexpr size_t WS_BTAB = WS_MTAB + al256((size_t)32 * 132 * 4);
constexpr size_t WS_GTAB = WS_BTAB + al256((size_t)32 * 128 * 4);
constexpr size_t WS_DST = WS_GTAB + al256((size_t)MT * 4 * 16);
constexpr size_t WS_DN = WS_DST + al256((size_t)224 * 16384 * 4);
constexpr size_t WS_H0 = WS_DN + al256((size_t)224 * 128 * 4);
constexpr size_t WS_PROJ = WS_H0 + al256((size_t)MT * DM * 2);
constexpr size_t WS_MIX = WS_PROJ + al256((size_t)MT * NPROJ * 2);
constexpr size_t WS_END = WS_MIX + al256((size_t)MT * DM * 2);
constexpr size_t WS_SLAB = WS_END;
constexpr size_t WS_END2 = WS_SLAB + (size_t)11 * 1024 * 1024 * 4;
constexpr size_t WS_R2 = WS_END2;
constexpr size_t WS_END3 = WS_R2 + al256((size_t)MT * DM * 2);
constexpr size_t WS_R1 = WS_PROJ;
constexpr size_t WS_ACT = WS_PROJ;
static_assert((size_t)MT * DFF * 2 <= WS_END - WS_PROJ, "act does not fit");

constexpr size_t O_Y = 0;
constexpr size_t O_POOLP = (size_t)MT * DM;
constexpr size_t O_CP = O_POOLP + (size_t)NB * 15 * 512;
constexpr size_t O_NP = O_CP + (size_t)NB * 4 * 16384;
constexpr size_t O_MP = O_NP + (size_t)NB * 4 * 128;
constexpr size_t O_POOLS = O_MP + (size_t)NB * 4;
constexpr size_t O_CS = O_POOLS + (size_t)DB * 15 * 512;
constexpr size_t O_NS = O_CS + (size_t)DB * 4 * 16384;
constexpr size_t O_MS = O_NS + (size_t)DB * 4 * 128;
constexpr size_t O_END = O_MS + (size_t)DB * 4;

struct Params { const float* in[21]; float* out; unsigned char* ws; };

__device__ __forceinline__ int fresh_tid() { int t = threadIdx.x; asm volatile("" : "+v"(t)); return t; }
__device__ __forceinline__ float bf2f(unsigned x) { return __uint_as_float(x << 16); }
__device__ __forceinline__ float bflo(unsigned w) { return __uint_as_float(w << 16); }
__device__ __forceinline__ float bfhi(unsigned w) { return __uint_as_float(w & 0xffff0000u); }
__device__ __forceinline__ unsigned pk2(float lo, float hi) { return pg8::cvt_pk_bf16(lo, hi); }
__device__ __forceinline__ float wave_sum(float v) {
#pragma unroll
    for (int o = 32; o; o >>= 1) v += __shfl_xor(v, o);
    return v; }
__device__ __forceinline__ float wave_max(float v) {
#pragma unroll
    for (int o = 32; o; o >>= 1) v = fmaxf(v, __shfl_xor(v, o));
    return v; }
__device__ __forceinline__ float scan_sum(float x, int lane) {
#pragma unroll
    for (int o = 1; o < 64; o <<= 1) { const float y = __shfl_up(x, o); if (lane >= o) x += y; }
    return x; }
__device__ __forceinline__ float scan_max(float x, int lane) {
#pragma unroll
    for (int o = 1; o < 64; o <<= 1) { const float y = __shfl_up(x, o); if (lane >= o) x = fmaxf(x, y); }
    return x; }
__device__ __forceinline__ float logsigmoid(float x) { return fminf(x, 0.f) - log1pf(expf(-fabsf(x))); }
__device__ __forceinline__ bf16x8 ldfrag(LAS const unsigned char* base, int row, int strideB, int kbyte) { return *(LAS const bf16x8*)(base + row * strideB + kbyte); }
#define LDS_BARRIER() do { asm volatile("s_waitcnt lgkmcnt(0)" ::: "memory"); __builtin_amdgcn_s_barrier(); asm volatile("" ::: "memory"); } while (0)
#define MFMA16(a, b, c) __builtin_amdgcn_mfma_f32_16x16x32_bf16((a), (b), (c), 0, 0, 0)

#define XB_TMO      128
#define XB_XCNT(j)  (256  + 64 * (j))
#define XB_XSUB(j)  (1280 + 64 * (j))
#define XB_XGEN(j)  (2304 + 64 * (j))
#define XB_TOP      3328
#define XB_TOPGEN   3392
#define XCD_BAR_WORDS 3456
#define XB_SPIN_CAP (1u << 18)
__device__ __forceinline__ unsigned xb_ld(unsigned* p)              { return __hip_atomic_load(p, __ATOMIC_RELAXED, __HIP_MEMORY_SCOPE_AGENT); }
__device__ __forceinline__ unsigned xb_add(unsigned* p, unsigned v) { return __hip_atomic_fetch_add(p, v, __ATOMIC_RELAXED, __HIP_MEMORY_SCOPE_AGENT); }
__device__ __forceinline__ unsigned xb_xcc_id() { return (unsigned)__builtin_amdgcn_s_getreg((3 << 11) | 20) & 0xFu; }
#define XB_SPIN(cond, bar) do { unsigned _sp = 0; while (cond) { __builtin_amdgcn_s_sleep(1); \
    if ((++_sp & 255u) == 0u) { if (xb_ld(&(bar)[XB_TMO])) break; if (_sp > XB_SPIN_CAP) { atomicAdd(&(bar)[XB_TMO], 1u); break; } } } } while (0)

struct XcdBarrier {
    unsigned* bar; unsigned x;
    volatile LAS unsigned* st;
};

__device__ __forceinline__ XcdBarrier xcd_barrier_post(unsigned* bar, volatile LAS unsigned* st) {
    XcdBarrier b; b.bar = bar; b.x = xb_xcc_id(); b.st = st;
    if (threadIdx.x == 0) (void)xb_add(&bar[XB_XCNT(b.x)], 1u);
    return b;
}
__device__ __forceinline__ void xcd_barrier_complete(unsigned* bar, unsigned x, unsigned& nloc, unsigned& nx) {
    const unsigned G = gridDim.x * gridDim.y * gridDim.z;
    unsigned sum, cnt, mine, sp = 0u;
    for (;;) {
        sum = 0u; cnt = 0u; mine = 0u;
#pragma unroll
        for (unsigned j = 0; j < 16; ++j) { const unsigned c = xb_ld(&bar[XB_XCNT(j)]); sum += c; cnt += (c > 0u) ? 1u : 0u; mine = (j == x) ? c : mine; }
        if (sum == G) break;
        __builtin_amdgcn_s_sleep(1);
        if ((++sp & 255u) == 0u) { if (xb_ld(&bar[XB_TMO])) break; if (sp > XB_SPIN_CAP) { atomicAdd(&bar[XB_TMO], 1u); break; } }
    }
    nloc = mine > 0u ? mine : 1u; nx = cnt > 0u ? cnt : 1u;
}

__device__ __forceinline__ void xcd_barrier(const XcdBarrier& b) {
    asm volatile("s_waitcnt vmcnt(0)" ::: "memory");
    __syncthreads();
    if (threadIdx.x == 0) {
        unsigned* bar = b.bar;
        __builtin_amdgcn_s_waitcnt(0);
        unsigned nloc = b.st[0], nx = b.st[1];
        if (nloc == 0u) { xcd_barrier_complete(bar, b.x, nloc, nx); b.st[0] = nloc; b.st[1] = nx; }
        const unsigned old = xb_add(&bar[XB_XSUB(b.x)], 1u);
        const unsigned gen = old / nloc;
        if (old + 1u == (gen + 1u) * nloc) {
            __builtin_amdgcn_fence(__ATOMIC_RELEASE, "agent");
            asm volatile("s_waitcnt vmcnt(0)" ::: "memory");
            const unsigned og = xb_add(&bar[XB_TOP], 1u);
            const unsigned tg = og / nx;
            if (og + 1u == (tg + 1u) * nx) xb_add(&bar[XB_TOPGEN], 1u);
            else XB_SPIN(xb_ld(&bar[XB_TOPGEN]) == tg, bar);
            __builtin_amdgcn_fence(__ATOMIC_ACQUIRE, "agent");
            xb_add(&bar[XB_XGEN(b.x)], 1u);
            asm volatile("s_waitcnt vmcnt(0)" ::: "memory");
        } else {
            XB_SPIN(xb_ld(&bar[XB_XGEN(b.x)]) == gen, bar);
            __builtin_amdgcn_fence(__ATOMIC_ACQUIRE, "agent");
            asm volatile("s_waitcnt vmcnt(0)" ::: "memory");
        }
    }
    __syncthreads();
}

struct SplitOrder {
    int nN, nP, S, nkt, G, c;
    __device__ __forceinline__ void init(int N, int Ktiles, int S_, int G_, int c_) { nN = N / 256; nP = 256 * nN; S = S_; nkt = Ktiles; G = G_; c = c_; }
    __device__ __forceinline__ bool next(int i, pg8::Unit& u) const {
        const long L = (long)i * G + c;
        if (L >= nP + 4 * nN * S) return false;
        int pm, pn, k0 = 0, kn = nkt;
        if (L < nP) { int wgid = (int)L; { const int q = nP / 8, xcd = wgid % 8, off = wgid / 8; wgid = xcd * q + off; }
            const int nig = 8 * nN, gid = wgid / nig, fm = gid * 8; pm = fm + ((wgid % nig) % 8); pn = (wgid % nig) / 8; }
        else { const int j = (int)(L - nP), su = j / S, sl = j - su * S; pm = 256 + su / nN; pn = su % nN; kn = nkt / S; k0 = sl * kn; }
        u.pm = pm; u.pn = pn; u.kt0 = k0; u.nkt = kn; return true;
    }
    __device__ __forceinline__ void a_ready(const pg8::Unit&) const {}
    __device__ __forceinline__ void done(const pg8::Unit&) const {}
};

struct EpiBf16B {
    static constexpr bool PERM = true, AFTER_DRAIN = false;
    bf16_t* O; int ldc; const float* bias;
    __device__ __forceinline__ void operator()(const f32x4 (&acc)[2][2][4][2], const pg8::Unit& u, int wr, int wc, int fr, int fq) const {
        const int row0 = u.pm * 256 + wr * 64 + fr, col0 = u.pn * 256 + wc * 32 + 8 * fq;
        f32x4 bv[2][2];
#pragma unroll
        for (int bj = 0; bj < 2; ++bj)
#pragma unroll
            for (int n = 0; n < 2; ++n) bv[bj][n] = *(const f32x4*)(bias + col0 + bj * 128 + 4 * n);
#pragma unroll
        for (int ai = 0; ai < 2; ++ai)
#pragma unroll
            for (int m = 0; m < 4; ++m) { bf16_t* rowp = O + (size_t)(row0 + ai * 128 + m * 16) * ldc + col0;
#pragma unroll
                for (int bj = 0; bj < 2; ++bj) { const f32x4 v0 = acc[ai][bj][m][0] + bv[bj][0], v1 = acc[ai][bj][m][1] + bv[bj][1];
                    u32x4 w; w.x = pk2(v0[0], v0[1]); w.y = pk2(v0[2], v0[3]); w.z = pk2(v1[0], v1[1]); w.w = pk2(v1[2], v1[3]);
                    *(u32x4*)(rowp + bj * 128) = w; } }
    }
};
struct EpiRes {
    static constexpr bool PERM = true, AFTER_DRAIN = false;
    const bf16_t* base; bf16_t* out; float* slab; int nkt_full;
    __device__ __forceinline__ void operator()(const f32x4 (&acc)[2][2][4][2], const pg8::Unit& u, int wr, int wc, int fr, int fq) const {
        const int row0 = u.pm * 256 + wr * 64 + fr, col0 = u.pn * 256 + wc * 32 + 8 * fq;
        if (u.nkt != nkt_full) {
            float* sp = slab + (size_t)(u.kt0 / u.nkt) * (1024 * 1024) + (size_t)(row0 - MP) * DM + col0;
#pragma unroll
            for (int ai = 0; ai < 2; ++ai)
#pragma unroll
                for (int m = 0; m < 4; ++m)
#pragma unroll
                    for (int bj = 0; bj < 2; ++bj)
#pragma unroll
                        for (int n = 0; n < 2; ++n) *(f32x4*)(sp + (size_t)(ai * 128 + m * 16) * DM + bj * 128 + 4 * n) = acc[ai][bj][m][n];
            return; }
#pragma unroll
        for (int ai = 0; ai < 2; ++ai)
#pragma unroll
            for (int m = 0; m < 4; ++m) { const size_t off = (size_t)(row0 + ai * 128 + m * 16) * DM + col0;
#pragma unroll
                for (int bj = 0; bj < 2; ++bj) { const u32x4 b = *(const u32x4*)(base + off + bj * 128); const f32x4 a0 = acc[ai][bj][m][0], a1 = acc[ai][bj][m][1];
                    u32x4 w; w.x = pk2(ALPHA * bflo(b.x) + a0[0], ALPHA * bfhi(b.x) + a0[1]); w.y = pk2(ALPHA * bflo(b.y) + a0[2], ALPHA * bfhi(b.y) + a0[3]);
                    w.z = pk2(ALPHA * bflo(b.z) + a1[0], ALPHA * bfhi(b.z) + a1[1]); w.w = pk2(ALPHA * bflo(b.w) + a1[2], ALPHA * bfhi(b.w) + a1[3]);
                    *(u32x4*)(out + off + bj * 128) = w; } }
    }
};
__device__ __forceinline__ float fsigmoid(float x) { return __builtin_amdgcn_rcpf(1.0f + __expf(-x)); }
__device__ __forceinline__ float swiglu(float g, float u) { return g * u * fsigmoid(g); }
struct EpiSwiglu {
    static constexpr bool PERM = true, AFTER_DRAIN = false;
    bf16_t* O;
    __device__ __forceinline__ void operator()(const f32x4 (&acc)[2][2][4][2], const pg8::Unit& u, int wr, int wc, int fr, int fq) const {
        const int row0 = u.pm * 256 + wr * 64 + fr, col0 = u.pn * 128 + wc * 32 + 8 * fq;
#pragma unroll
        for (int ai = 0; ai < 2; ++ai)
#pragma unroll
            for (int m = 0; m < 4; ++m) { bf16_t* rowp = O + (size_t)(row0 + ai * 128 + m * 16) * DFF + col0;
                const f32x4 g0 = acc[ai][0][m][0], g1 = acc[ai][0][m][1], u0 = acc[ai][1][m][0], u1 = acc[ai][1][m][1];
                u32x4 w; w.x = pk2(swiglu(g0[0], u0[0]), swiglu(g0[1], u0[1])); w.y = pk2(swiglu(g0[2], u0[2]), swiglu(g0[3], u0[3]));
                w.z = pk2(swiglu(g1[0], u1[0]), swiglu(g1[1], u1[1])); w.w = pk2(swiglu(g1[2], u1[2]), swiglu(g1[3], u1[3]));
                *(u32x4*)rowp = w; }
    }
};

constexpr int TR_TILES = 640 + 256 + 704 + 704 + 704 + 16;
struct TileDesc { const float* src; bf16_t* dst; int ld, K, mode, k0, n0; };
__device__ __forceinline__ TileDesc tile_desc(const Params& p, int t) {
    TileDesc d; unsigned char* ws = p.ws;
    if (t < 640) { d.src = p.in[8]; d.ld = INCOLS; d.K = DM; d.mode = 3; d.dst = (bf16_t*)(ws + WS_WIN); }
    else if (t < 896) { t -= 640; d.src = p.in[13]; d.ld = DM; d.K = DM; d.mode = 0; d.dst = (bf16_t*)(ws + WS_WOUT); }
    else if (t < 1600) { t -= 896; d.src = p.in[16]; d.ld = DFF; d.K = DM; d.mode = 1; d.dst = (bf16_t*)(ws + WS_WGU); }
    else if (t < 2304) { t -= 1600; d.src = p.in[17]; d.ld = DFF; d.K = DM; d.mode = 2; d.dst = (bf16_t*)(ws + WS_WGU); }
    else if (t < 3008) { t -= 2304; d.src = p.in[18]; d.ld = DM; d.K = DFF; d.mode = 0; d.dst = (bf16_t*)(ws + WS_WDN); }
    else { t -= 3008; const int g = t >> 2; t &= 3; d.src = p.in[10] + g * 16384; d.ld = 128; d.K = 128; d.mode = 0; d.dst = (bf16_t*)(ws + WS_WPOOL) + g * 16384; }
    const int nkt = d.K >> 6; d.k0 = (t % nkt) * 64; d.n0 = (t / nkt) * 64; return d;
}

__device__ __forceinline__ void phase0(const Params& p, LAS unsigned char* lds) {
    const int tid = fresh_tid(), lane = tid & 63, wave = tid >> 6, G = gridDim.x, bx = blockIdx.x;
    unsigned char* ws = p.ws;
    LAS float* T = (LAS float*)lds;
    {
        const int r = tid >> 3, cs = (tid & 7) * 8;
        int t = bx; float4 a = make_float4(0.f, 0.f, 0.f, 0.f), b = a; TileDesc d = tile_desc(p, t < TR_TILES ? t : 0);
        if (t < TR_TILES) { const float* s = d.src + (size_t)(d.k0 + r) * d.ld + d.n0 + cs; a = *(const float4*)s; b = *(const float4*)(s + 4); }
#pragma unroll 1
        for (; t < TR_TILES; t += G) {
            { LAS float* q = T + r * 65 + cs; q[0] = a.x; q[1] = a.y; q[2] = a.z; q[3] = a.w; q[4] = b.x; q[5] = b.y; q[6] = b.z; q[7] = b.w; }
            const TileDesc dn = tile_desc(p, t + G < TR_TILES ? t + G : 0);
            if (t + G < TR_TILES) { const float* s = dn.src + (size_t)(dn.k0 + r) * dn.ld + dn.n0 + cs; a = *(const float4*)s; b = *(const float4*)(s + 4); }
            LDS_BARRIER();
            { const int n = tid >> 3, ks = (tid & 7) * 8, gn = d.n0 + n; float v[8];
#pragma unroll
              for (int i = 0; i < 8; ++i) v[i] = T[(ks + i) * 65 + n];
              const float sc = (d.mode == 3 && gn >= 1024 && gn < 1536) ? KSCALE : 1.0f;
              const int drow = (d.mode == 1) ? 256 * (gn >> 7) + (gn & 127) : (d.mode == 2) ? 256 * (gn >> 7) + 128 + (gn & 127) : gn;
              u32x4 w; w.x = pk2(v[0] * sc, v[1] * sc); w.y = pk2(v[2] * sc, v[3] * sc); w.z = pk2(v[4] * sc, v[5] * sc); w.w = pk2(v[6] * sc, v[7] * sc);
              *(u32x4*)(d.dst + (size_t)drow * d.K + d.k0 + ks) = w; }
            LDS_BARRIER();
            d = dn;
        }
    }
    { float* bs = (float*)(ws + WS_BIAS); const float* b_in = p.in[9];
      for (int i = bx * 512 + tid; i < NPROJ; i += G * 512) bs[i] = b_in[i] * ((i >= 1024 && i < 1536) ? KSCALE : 1.0f); }
    f32x4 wlo[4][4], whi[4][4];
    { const float* w_in = p.in[8];
#pragma unroll
      for (int i = 0; i < 4; ++i)
#pragma unroll
          for (int e = 0; e < 4; ++e) { const float* wp = w_in + (size_t)(i * 256 + lane * 4 + e) * INCOLS + NPROJ; wlo[i][e] = *(const f32x4*)wp; whi[i][e] = *(const f32x4*)(wp + 4); } }
    const float* lg = p.in[6]; const float* lb = p.in[7]; const float* b_in = p.in[9];
    bf16_t* h0 = (bf16_t*)(ws + WS_H0); float* gates = (float*)(ws + WS_GATES);
    const float gb_perm = lane < 8 ? b_in[NPROJ + (((lane & 1) << 2) | (lane & 2) | ((lane >> 2) & 1))] : 0.f;
    int row = bx * 8 + wave; float4 v[4];
    if (row < MT) { const float* x = row < MP ? p.in[0] + (size_t)row * DM : p.in[1] + (size_t)(row - MP) * DM;
#pragma unroll
        for (int i = 0; i < 4; ++i) v[i] = *(const float4*)(x + i * 256 + lane * 4); }
#pragma unroll 1
    for (; row < MT; row += G * 8) {
        const int nrow = row + G * 8; float4 nv[4];
        if (nrow < MT) { const float* x = nrow < MP ? p.in[0] + (size_t)nrow * DM : p.in[1] + (size_t)(nrow - MP) * DM;
#pragma unroll
            for (int i = 0; i < 4; ++i) nv[i] = *(const float4*)(x + i * 256 + lane * 4); }
        else {
#pragma unroll
            for (int i = 0; i < 4; ++i) nv[i] = make_float4(0.f, 0.f, 0.f, 0.f); }
        float s = 0.f;
#pragma unroll
        for (int i = 0; i < 4; ++i) s += (v[i].x + v[i].y) + (v[i].z + v[i].w);
        const float mu = wave_sum(s) * (1.0f / DM);
        float q = 0.f;
#pragma unroll
        for (int i = 0; i < 4; ++i) { v[i].x -= mu; v[i].y -= mu; v[i].z -= mu; v[i].w -= mu; q += (v[i].x * v[i].x + v[i].y * v[i].y) + (v[i].z * v[i].z + v[i].w * v[i].w); }
        const float rstd = rsqrtf(wave_sum(q) * (1.0f / DM) + LN_EPS);
        f32x4 glo = (f32x4){0.f, 0.f, 0.f, 0.f}, ghi = glo;
#pragma unroll
        for (int i = 0; i < 4; ++i) { const int c = i * 256 + lane * 4; const float4 gg = *(const float4*)(lg + c), bb = *(const float4*)(lb + c);
            float4 y; y.x = v[i].x * rstd * gg.x + bb.x; y.y = v[i].y * rstd * gg.y + bb.y; y.z = v[i].z * rstd * gg.z + bb.z; y.w = v[i].w * rstd * gg.w + bb.w;
            u32x2 w; w.x = pk2(y.x, y.y); w.y = pk2(y.z, y.w); *(u32x2*)(h0 + (size_t)row * DM + c) = w;
            glo += y.x * wlo[i][0] + y.y * wlo[i][1] + y.z * wlo[i][2] + y.w * wlo[i][3];
            ghi += y.x * whi[i][0] + y.y * whi[i][1] + y.z * whi[i][2] + y.w * whi[i][3]; }
        { const bool b0 = lane & 1, b1 = lane & 2, b2 = lane & 4;
          f32x4 k4, s4;
#pragma unroll
          for (int j = 0; j < 4; ++j) { k4[j] = b0 ? ghi[j] : glo[j]; s4[j] = b0 ? glo[j] : ghi[j]; }
#pragma unroll
          for (int j = 0; j < 4; ++j) k4[j] += __shfl_xor(s4[j], 1);
          float k2a = b1 ? k4[2] : k4[0], k2b = b1 ? k4[3] : k4[1];
          k2a += __shfl_xor(b1 ? k4[0] : k4[2], 2); k2b += __shfl_xor(b1 ? k4[1] : k4[3], 2);
          float k1 = b2 ? k2b : k2a; k1 += __shfl_xor(b2 ? k2a : k2b, 4);
          k1 += __shfl_xor(k1, 8); k1 += __shfl_xor(k1, 16); k1 += __shfl_xor(k1, 32);
          const int gidx = ((lane & 1) << 2) | (lane & 2) | ((lane >> 2) & 1);
          if (lane < 8) gates[(size_t)row * 8 + gidx] = k1 + gb_perm; }
#pragma unroll
        for (int i = 0; i < 4; ++i) v[i] = nv[i];
    }
}

__device__ __forceinline__ void gate_scan(const Params& p, LAS unsigned char* lds) {
    const int tid = fresh_tid(), lane = tid & 63, wave = tid >> 6;
    const float* gates = (const float*)(p.ws + WS_GATES); float* mtab = (float*)(p.ws + WS_MTAB); float* btab = (float*)(p.ws + WS_BTAB);
    f32x4* gtab = (f32x4*)(p.ws + WS_GTAB);
    LAS float* sA = (LAS float*)lds; LAS float* sB = sA + 128; LAS float* sM = sA + 256;
    for (int chain = blockIdx.x; chain < 32; chain += gridDim.x) {
        const int batch = chain >> 2, head = chain & 3;
        for (int c = wave; c < 128; c += 8) {
            const size_t row = (size_t)batch * SEQ + c * 64 + lane;
            const float ig = gates[row * 8 + head], fg = gates[row * 8 + 4 + head];
            const float b = scan_sum(logsigmoid(fg), lane); const float A = wave_max(ig - b); const float bl = __shfl(b, 63);
            if (lane == 0) { sA[c] = A; sB[c] = bl; }
        }
        __syncthreads();
        if (tid == 0) { float m = 0.f; mtab[chain * 132] = 0.f; sM[0] = 0.f;
            for (int c = 0; c < 128; ++c) { m = sB[c] + fmaxf(m, sA[c]); mtab[chain * 132 + c + 1] = m; sM[c + 1] = m; btab[chain * 128 + c] = sB[c]; }
            p.out[O_MP + chain] = m; }
        __syncthreads();
        for (int c = wave; c < 128; c += 8) {
            const size_t row = (size_t)batch * SEQ + c * 64 + lane;
            const float ig = gates[row * 8 + head], fg = gates[row * 8 + 4 + head];
            const float b = scan_sum(logsigmoid(fg), lane); const float a = ig - b; const float m_prev = sM[c];
            const float M = fmaxf(m_prev, scan_max(a, lane));
            gtab[row * 4 + head] = (f32x4){a, M, expf(m_prev - M), expf(-(b + M))};
        }
        __syncthreads();
    }
    for (int s = blockIdx.x * 8 + wave; s < DB * 4; s += gridDim.x * 8) {
        const int b_ = s >> 2, head = s & 3; const bool valid = lane < 32; const size_t row = (size_t)MP + b_ * 32 + (lane & 31);
        const float ig = gates[row * 8 + head], fg = gates[row * 8 + 4 + head]; const float m_prev = p.in[5][s];
        const float b = scan_sum(valid ? logsigmoid(fg) : 0.f, lane); const float a = valid ? ig - b : -1e30f;
        const float M = fmaxf(m_prev, scan_max(a, lane));
        if (valid) gtab[row * 4 + head] = (f32x4){a, M, expf(m_prev - M), expf(-(b + M))};
        if (lane == 31) p.out[O_MS + s] = b + M;
    }
}

constexpr int L_Q = 0, L_K = 17408, L_KW = 34816, L_V = 52224, L_CT = 69632, L_S = 104448, L_G = 113664;
typedef short s16x4 __attribute__((ext_vector_type(4)));
__device__ __forceinline__ bf16x8 ldfrag_tr(LAS const unsigned char* base, int row0, int col0, int lane) {
    const int g = lane >> 4, q = (lane & 15) >> 2, pp = lane & 3;
    LAS const unsigned char* a = base + (row0 + 8 * g + q) * 272 + (col0 + 4 * pp) * 2;
    const s16x4 lo = __builtin_amdgcn_ds_read_tr16_b64_v4i16((LAS s16x4*)a);
    const s16x4 hi = __builtin_amdgcn_ds_read_tr16_b64_v4i16((LAS s16x4*)(a + 4 * 272));
    return __builtin_shufflevector(lo, hi, 0, 1, 2, 3, 4, 5, 6, 7);
}

template <bool FULL>
__device__ __forceinline__ void mlstm_run(const Params& p, LAS unsigned char* lds, f32x4 (&accC)[2][4], f32x4 (&accN)[2], int row0, int head, int nch, int L) {
    const int tid = fresh_tid(), lane = tid & 63, wave = __builtin_amdgcn_readfirstlane(tid >> 6), l15 = lane & 15, l4 = lane >> 4, st = wave & 3, tp = wave >> 2;
    const bf16_t* proj = (const bf16_t*)(p.ws + WS_PROJ); const f32x4* gtab = (const f32x4*)(p.ws + WS_GTAB);
    bf16_t* mix = (bf16_t*)(p.ws + WS_MIX);
    LAS unsigned short* sQ = (LAS unsigned short*)(lds + L_Q); LAS unsigned short* sK = (LAS unsigned short*)(lds + L_K);
    LAS unsigned short* sKW = (LAS unsigned short*)(lds + L_KW); LAS unsigned short* sV = (LAS unsigned short*)(lds + L_V);
    LAS unsigned short* sS = (LAS unsigned short*)(lds + L_S); LAS float* sH = (LAS float*)(lds + L_Q);
    LAS float* gA = (LAS float*)(lds + L_G); LAS float* gM = gA + 64; LAS float* gDec = gA + 128; LAS float* gEinv = gA + 192; LAS float* gW = gA + 256;
    LAS float* gQn = gA + 320; LAS float* gDi = gA + 384; LAS float* gN = gA + 448; LAS float* scal = gA + 576; LAS float* gNg = gA + 584;
    const bf16x8 ones = (bf16x8){0x3F80, 0x3F80, 0x3F80, 0x3F80, 0x3F80, 0x3F80, 0x3F80, 0x3F80};
    const int tok0 = tid >> 4, dsg = tid & 15;
    const int orow = tid >> 3, oseg = tid & 7;
    u32x4 kq[2], kk[2], kv[2]; f32x4 pgt = (f32x4){0.f, 0.f, 0.f, 0.f};
    if (FULL && tid < 128) gNg[tid] = p.in[12][head * 128 + tid];
#pragma unroll
    for (int i = 0; i < 2; ++i) { const int tok = tok0 + 32 * i; const bool valid = tok < L; const u32x4 z = (u32x4){0u, 0u, 0u, 0u};
        const bf16_t* src = proj + (size_t)(row0 + tok) * NPROJ + head * 128 + dsg * 8;
        kk[i] = valid ? *(const u32x4*)(src + 1024) : z; kv[i] = valid ? *(const u32x4*)(src + 1536) : z;
        if (FULL) kq[i] = valid ? *(const u32x4*)(src + 512) : z; else kq[i] = z; }
    if (wave == 0 && lane < L) pgt = gtab[(size_t)(row0 + lane) * 4 + head];
#pragma unroll 1
    for (int c = 0; c < nch; ++c) {
        const int r0 = row0 + c * 64;
        if (wave == 0) {
            const bool valid = lane < L; const float a = valid ? pgt[0] : -1e30f; const float Ml = __shfl(pgt[1], L - 1);
            gA[lane] = a; gM[lane] = valid ? pgt[1] : Ml; gDec[lane] = valid ? pgt[2] : 0.f; gEinv[lane] = valid ? pgt[3] : 1.f; gW[lane] = valid ? __expf(a - Ml) : 0.f;
            if (lane == L - 1) scal[0] = pgt[2];
        }
        if (FULL) {
#pragma unroll
            for (int i = 0; i < 2; ++i)
#pragma unroll
                for (int n = 0; n < 4; ++n) { u32x2 w; w.x = pk2(accC[i][n][0], accC[i][n][1]); w.y = pk2(accC[i][n][2], accC[i][n][3]);
                    *(LAS u32x2*)(lds + L_CT + (64 * tp + 16 * n + l15) * 272 + (32 * st + 16 * i + 4 * l4) * 2) = w; }
            if (tp == 0 && l15 == 0) {
#pragma unroll
                for (int i = 0; i < 2; ++i) *(LAS f32x4*)(gN + 32 * st + 16 * i + 4 * l4) = accN[i]; }
        }
#pragma unroll
        for (int i = 0; i < 2; ++i) { const int tok = tok0 + 32 * i;
            if (FULL) { *(LAS u32x4*)(sQ + tok * 136 + dsg * 8) = kq[i]; *(LAS u32x4*)(sK + tok * 136 + dsg * 8) = kk[i]; }
            *(LAS u32x4*)(sV + tok * 136 + dsg * 8) = kv[i]; }
        LDS_BARRIER();
#pragma unroll
        for (int i = 0; i < 2; ++i) { const int tok = tok0 + 32 * i; const float w = gW[tok]; u32x4 o;
            o.x = pk2(bflo(kk[i].x) * w, bfhi(kk[i].x) * w); o.y = pk2(bflo(kk[i].y) * w, bfhi(kk[i].y) * w);
            o.z = pk2(bflo(kk[i].z) * w, bfhi(kk[i].z) * w); o.w = pk2(bflo(kk[i].w) * w, bfhi(kk[i].w) * w);
            *(LAS u32x4*)(sKW + tok * 136 + dsg * 8) = o; }
        if (c + 1 < nch) {
#pragma unroll
            for (int i = 0; i < 2; ++i) { const int tok = tok0 + 32 * i;
                const bf16_t* src = proj + (size_t)(r0 + 64 + tok) * NPROJ + head * 128 + dsg * 8;
                kk[i] = *(const u32x4*)(src + 1024); kv[i] = *(const u32x4*)(src + 1536);
                if (FULL) kq[i] = *(const u32x4*)(src + 512); }
            if (wave == 0) pgt = gtab[(size_t)(r0 + 64 + lane) * 4 + head];
        }
        f32x4 nacc[4];
#pragma unroll
        for (int n = 0; n < 4; ++n) nacc[n] = (f32x4){0.f, 0.f, 0.f, 0.f};
        if (FULL) {
            f32x4 sacc[2]; sacc[0] = (f32x4){0.f, 0.f, 0.f, 0.f}; sacc[1] = sacc[0];
#pragma unroll
            for (int ks = 0; ks < 4; ++ks) { const int kb = (32 * ks + 8 * l4) * 2;
                const bf16x8 a = ldfrag(lds + L_K, 16 * st + l15, 272, kb);
#pragma unroll
                for (int tt = 0; tt < 2; ++tt) { const bf16x8 b = ldfrag(lds + L_Q, 16 * (2 * tp + tt) + l15, 272, kb); sacc[tt] = MFMA16(a, b, sacc[tt]); } }
#pragma unroll
            for (int tt = 0; tt < 2; ++tt) { const int t = 16 * (2 * tp + tt) + l15; const float Mt = gM[t]; float dv[4];
#pragma unroll
                for (int j = 0; j < 4; ++j) { const int s = 16 * st + 4 * l4 + j; dv[j] = (s <= t) ? sacc[tt][j] * __expf(gA[s] - Mt) : 0.f; }
                u32x2 w; w.x = pk2(dv[0], dv[1]); w.y = pk2(dv[2], dv[3]); *(LAS u32x2*)(lds + L_S + t * 144 + (16 * st + 4 * l4) * 2) = w; }
#pragma unroll
            for (int ks = 0; ks < 4; ++ks) { const int kb = (32 * ks + 8 * l4) * 2;
                const bf16x8 a = ldfrag(lds + L_Q, 16 * st + l15, 272, kb);
#pragma unroll
                for (int n = 0; n < 4; ++n) { const bf16x8 b = ldfrag(lds + L_CT, 64 * tp + 16 * n + l15, 272, kb); nacc[n] = MFMA16(a, b, nacc[n]); } }
#pragma unroll
            for (int j = 0; j < 4; ++j) { const float dj = gDec[16 * st + 4 * l4 + j];
#pragma unroll
                for (int n = 0; n < 4; ++n) nacc[n][j] *= dj; }
            { float s = 0.f;
              const u32x4 q0 = *(LAS const u32x4*)(sQ + orow * 136 + oseg * 16), q1 = *(LAS const u32x4*)(sQ + orow * 136 + oseg * 16 + 8);
              const unsigned qw[8] = {q0.x, q0.y, q0.z, q0.w, q1.x, q1.y, q1.z, q1.w};
#pragma unroll
              for (int e = 0; e < 8; ++e) s += bflo(qw[e]) * gN[oseg * 16 + 2 * e] + bfhi(qw[e]) * gN[oseg * 16 + 2 * e + 1];
              s += __shfl_xor(s, 1); s += __shfl_xor(s, 2); s += __shfl_xor(s, 4);
              if (oseg == 0) gQn[orow] = s; }
        }
        LDS_BARRIER();
        if (FULL) {
            const u32x4 s0 = *(LAS const u32x4*)(sS + orow * 72 + oseg * 8);
            float s = (bflo(s0.x) + bfhi(s0.x)) + (bflo(s0.y) + bfhi(s0.y)) + (bflo(s0.z) + bfhi(s0.z)) + (bflo(s0.w) + bfhi(s0.w));
            s += __shfl_xor(s, 1); s += __shfl_xor(s, 2); s += __shfl_xor(s, 4);
            if (oseg == 0) { const float den = gDec[orow] * gQn[orow] + s; gDi[orow] = __builtin_amdgcn_rcpf(fmaxf(fabsf(den), gEinv[orow])); } }
        const float wsv = scal[0];
#pragma unroll
        for (int i = 0; i < 2; ++i) { accN[i] *= wsv;
#pragma unroll
            for (int n = 0; n < 4; ++n) accC[i][n] *= wsv; }
#pragma unroll
        for (int ks = 0; ks < 2; ++ks) { bf16x8 bv[4];
#pragma unroll
            for (int n = 0; n < 4; ++n) bv[n] = ldfrag_tr(lds + L_V, 32 * ks, 64 * tp + 16 * n, lane);
            if (FULL) { const bf16x8 a = ldfrag(lds + L_S, 16 * st + l15, 144, (32 * ks + 8 * l4) * 2);
#pragma unroll
                for (int n = 0; n < 4; ++n) nacc[n] = MFMA16(a, bv[n], nacc[n]); }
#pragma unroll
            for (int i = 0; i < 2; ++i) { const bf16x8 a = ldfrag_tr(lds + L_KW, 32 * ks, 32 * st + 16 * i, lane);
                accN[i] = MFMA16(a, ones, accN[i]);
#pragma unroll
                for (int n = 0; n < 4; ++n) accC[i][n] = MFMA16(a, bv[n], accC[i][n]); } }
        LDS_BARRIER();
        if (FULL) {
            u32x4 ow0 = (u32x4){0u, 0u, 0u, 0u}, ow1 = ow0;
            if (orow < L) { const bf16_t* op = proj + (size_t)(r0 + orow) * NPROJ + 2048 + head * 128 + oseg * 16; ow0 = *(const u32x4*)op; ow1 = *(const u32x4*)(op + 8); }
#pragma unroll
            for (int j = 0; j < 4; ++j) { const int t = 16 * st + 4 * l4 + j; const float di = gDi[t];
#pragma unroll
                for (int n = 0; n < 4; ++n) sH[t * 132 + 64 * tp + 16 * n + l15] = nacc[n][j] * di; }
            LDS_BARRIER();
            if (orow < L) {
                f32x4 x[4]; float s = 0.f;
#pragma unroll
                for (int e = 0; e < 4; ++e) { x[e] = *(LAS const f32x4*)(sH + orow * 132 + oseg * 16 + 4 * e); s += (x[e][0] + x[e][1]) + (x[e][2] + x[e][3]); }
                s += __shfl_xor(s, 1); s += __shfl_xor(s, 2); s += __shfl_xor(s, 4);
                const float mean = s * (1.0f / 128.0f); float q = 0.f;
#pragma unroll
                for (int e = 0; e < 4; ++e) { x[e] -= mean; q += (x[e][0] * x[e][0] + x[e][1] * x[e][1]) + (x[e][2] * x[e][2] + x[e][3] * x[e][3]); }
                q += __shfl_xor(q, 1); q += __shfl_xor(q, 2); q += __shfl_xor(q, 4);
                const float rstd = rsqrtf(q * (1.0f / 128.0f) + LN_EPS);
                const unsigned owv[8] = {ow0.x, ow0.y, ow0.z, ow0.w, ow1.x, ow1.y, ow1.z, ow1.w}; unsigned ov[8];
#pragma unroll
                for (int e = 0; e < 4; ++e) { const f32x4 g = *(LAS const f32x4*)(gNg + oseg * 16 + 4 * e);
                    const float y0 = x[e][0] * rstd * g[0] * fsigmoid(bflo(owv[2 * e])), y1 = x[e][1] * rstd * g[1] * fsigmoid(bfhi(owv[2 * e]));
                    const float y2 = x[e][2] * rstd * g[2] * fsigmoid(bflo(owv[2 * e + 1])), y3 = x[e][3] * rstd * g[3] * fsigmoid(bfhi(owv[2 * e + 1]));
                    ov[2 * e] = pk2(y0, y1); ov[2 * e + 1] = pk2(y2, y3); }
                bf16_t* mp = mix + (size_t)(r0 + orow) * DM + 512 + head * 128 + oseg * 16;
                *(u32x4*)mp = (u32x4){ov[0], ov[1], ov[2], ov[3]}; *(u32x4*)(mp + 8) = (u32x4){ov[4], ov[5], ov[6], ov[7]};
            }
            LDS_BARRIER();
        }
    }
}

constexpr int L_PW = 34816, L_PU = 69632;
template <int W>
__device__ __forceinline__ void pool_diff(LAS unsigned char* lds, bool sample, int tilepos0) {
    const int tid = fresh_tid(), co = tid & 15, t0 = (tid >> 4) * 4;
#pragma unroll 1
    for (int tt = 0; tt < 4; ++tt) {
        const int t = t0 + tt; const int sgi = sample ? (t >> 5) : 0, lt = sample ? (t & 31) : t;
        const int rowbase = sample ? sgi * 47 + 15 + lt : 15 + t;
        const int cnt = sample ? W : min(tilepos0 + t + 1, W);
        float sum[8];
#pragma unroll
        for (int e = 0; e < 8; ++e) sum[e] = 0.f;
        u32x4 x0 = (u32x4){0u, 0u, 0u, 0u};
#pragma unroll
        for (int j = 0; j < W; ++j) { const u32x4 r = *(LAS const u32x4*)(lds + L_PU + (rowbase - j) * 272 + co * 16); if (j == 0) x0 = r;
            sum[0] += bflo(r.x); sum[1] += bfhi(r.x); sum[2] += bflo(r.y); sum[3] += bfhi(r.y); sum[4] += bflo(r.z); sum[5] += bfhi(r.z); sum[6] += bflo(r.w); sum[7] += bfhi(r.w); }
        const float inv = 1.0f / (float)cnt;
        u32x4 w; w.x = pk2(sum[0] * inv - bflo(x0.x), sum[1] * inv - bfhi(x0.x)); w.y = pk2(sum[2] * inv - bflo(x0.y), sum[3] * inv - bfhi(x0.y));
        w.z = pk2(sum[4] * inv - bflo(x0.z), sum[5] * inv - bfhi(x0.z)); w.w = pk2(sum[6] * inv - bflo(x0.w), sum[7] * inv - bfhi(x0.w));
        *(LAS u32x4*)(lds + t * 272 + co * 16) = w; }
}

__device__ __forceinline__ void pool_fetch(const Params& p, int item, int tid, u32x4 (&pf)[6]) {
    const int g = item & 3, R0 = (item >> 2) * 128;
    const bf16_t* proj = (const bf16_t*)(p.ws + WS_PROJ); const float* hist = p.in[2];
    if (R0 < MP) {
        const int seqrow0 = (R0 / SEQ) * SEQ, tilepos0 = R0 - seqrow0;
        u32x4 raw[6];
#pragma unroll
        for (int i = 0; i < 6; ++i) { const int piece = tid + 512 * i, e = piece >> 4, seg = piece & 15; int pos = tilepos0 - 15 + (e < 143 ? e : 142); pos = pos < 0 ? 0 : pos;
            raw[i] = *(const u32x4*)(proj + (size_t)(seqrow0 + pos) * NPROJ + g * 128 + seg * 8); }
#pragma unroll
        for (int i = 0; i < 6; ++i) { const int piece = tid + 512 * i, e = piece >> 4; const bool valid = (e < 143) && (tilepos0 - 15 + e >= 0);
            pf[i] = valid ? raw[i] : (u32x4){0u, 0u, 0u, 0u}; }
    } else {
#pragma unroll
        for (int i = 0; i < 6; ++i) { const int piece = tid + 512 * i, e = piece >> 4, seg = piece & 15; u32x4 val = (u32x4){0u, 0u, 0u, 0u};
            if (e < 188) { const int sgi = e / 47, le = e - sgi * 47, b = ((R0 - MP) >> 5) + sgi;
                if (le < 15) { const float* hp = hist + ((size_t)b * 15 + le) * 512 + g * 128 + seg * 8; const float4 a = *(const float4*)hp, c4 = *(const float4*)(hp + 4);
                    val.x = pk2(a.x, a.y); val.y = pk2(a.z, a.w); val.z = pk2(c4.x, c4.y); val.w = pk2(c4.z, c4.w); }
                else val = *(const u32x4*)(proj + (size_t)(MP + b * 32 + le - 15) * NPROJ + g * 128 + seg * 8); }
            pf[i] = val; }
    }
}

__device__ __forceinline__ void pool_loop(const Params& p, LAS unsigned char* lds, int first, int stride, int end) {
    const int tid = fresh_tid(), lane = tid & 63, wave = __builtin_amdgcn_readfirstlane(tid >> 6), l15 = lane & 15, l4 = lane >> 4, st = wave & 3, tp = wave >> 2;
    bf16_t* mix = (bf16_t*)(p.ws + WS_MIX); const float* pscale = p.in[11];
    if (first >= end) return;
    u32x4 pf[6]; pool_fetch(p, first, tid, pf);
    int gw = -1;
#pragma unroll 1
    for (int item = first; item < end; item += stride) {
        const int g = item & 3, R0 = (item >> 2) * 128;
        const bool sample = R0 >= MP; const int tilepos0 = sample ? 0 : R0 - (R0 / SEQ) * SEQ;
        if (g != gw) { const bf16_t* Wp = (const bf16_t*)(p.ws + WS_WPOOL) + g * 16384; gw = g;
#pragma unroll
            for (int i = 0; i < 4; ++i) { const int piece = tid + 512 * i, row = piece >> 4, seg = piece & 15;
                *(LAS u32x4*)(lds + L_PW + row * 272 + seg * 16) = *(const u32x4*)(Wp + row * 128 + seg * 8); } }
#pragma unroll
        for (int i = 0; i < 6; ++i) { const int piece = tid + 512 * i, e = piece >> 4, seg = piece & 15; if (e < 188) *(LAS u32x4*)(lds + L_PU + e * 272 + seg * 16) = pf[i]; }
        LDS_BARRIER();
        if (item + stride < end) pool_fetch(p, item + stride, tid, pf);
        if (g == 0) pool_diff<2>(lds, sample, tilepos0); else if (g == 1) pool_diff<4>(lds, sample, tilepos0); else if (g == 2) pool_diff<8>(lds, sample, tilepos0); else pool_diff<16>(lds, sample, tilepos0);
        LDS_BARRIER();
        f32x4 acc[2][4];
#pragma unroll
        for (int i = 0; i < 2; ++i)
#pragma unroll
            for (int n = 0; n < 4; ++n) acc[i][n] = (f32x4){0.f, 0.f, 0.f, 0.f};
#pragma unroll
        for (int ks = 0; ks < 4; ++ks) { const int kb = (32 * ks + 8 * l4) * 2; bf16x8 bv[4];
#pragma unroll
            for (int n = 0; n < 4; ++n) bv[n] = ldfrag(lds, 64 * tp + 16 * n + l15, 272, kb);
#pragma unroll
            for (int i = 0; i < 2; ++i) { const bf16x8 a = ldfrag(lds + L_PW, 32 * st + 16 * i + l15, 272, kb);
#pragma unroll
                for (int n = 0; n < 4; ++n) acc[i][n] = MFMA16(a, bv[n], acc[i][n]); } }
        LDS_BARRIER();
#pragma unroll
        for (int i = 0; i < 2; ++i) { const int d0 = 32 * st + 16 * i + 4 * l4; const float4 ps = *(const float4*)(pscale + g * 128 + d0);
#pragma unroll
            for (int n = 0; n < 4; ++n) { const int t = 64 * tp + 16 * n + l15;
                u32x2 w; w.x = pk2(acc[i][n][0] * ps.x, acc[i][n][1] * ps.y); w.y = pk2(acc[i][n][2] * ps.z, acc[i][n][3] * ps.w);
                *(LAS u32x2*)(lds + t * 272 + d0 * 2) = w; } }
        LDS_BARRIER();
        { const int t = tid >> 2, sg = tid & 3; const u32x4 o0 = *(LAS const u32x4*)(lds + t * 272 + sg * 64), o1 = *(LAS const u32x4*)(lds + t * 272 + sg * 64 + 16),
            o2 = *(LAS const u32x4*)(lds + t * 272 + sg * 64 + 32), o3 = *(LAS const u32x4*)(lds + t * 272 + sg * 64 + 48);
          bf16_t* mp = mix + (size_t)(R0 + t) * DM + g * 128 + sg * 32; *(u32x4*)mp = o0; *(u32x4*)(mp + 8) = o1; *(u32x4*)(mp + 16) = o2; *(u32x4*)(mp + 24) = o3; }
    }
    LDS_BARRIER();
}

constexpr int N_S2 = 224, N_SMP = 128, N_POOL = (MT / 128) * 4;

__device__ __forceinline__ void phase2(const Params& p, LAS unsigned char* lds, int kinds) {
    const int tid = fresh_tid(), lane = tid & 63, wave = tid >> 6, l15 = lane & 15, l4 = lane >> 4, st = wave & 3, tp = wave >> 2;
    float* Dst = (float*)(p.ws + WS_DST); float* Dn = (float*)(p.ws + WS_DN); const float* mtab = (const float*)(p.ws + WS_MTAB);
    for (int it = blockIdx.x; it < N_S2 + N_SMP; it += gridDim.x) {
        if (it < N_S2) {
            if (!(kinds & 1)) continue;
            const int chain = it / 7, sc = it % 7, batch = chain >> 2, head = chain & 3;
            f32x4 accC[2][4], accN[2];
#pragma unroll
            for (int i = 0; i < 2; ++i) { accN[i] = (f32x4){0.f, 0.f, 0.f, 0.f};
#pragma unroll
                for (int n = 0; n < 4; ++n) accC[i][n] = (f32x4){0.f, 0.f, 0.f, 0.f}; }
            mlstm_run<false>(p, lds, accC, accN, batch * SEQ + sc * SCN * 64, head, SCN, 64);
#pragma unroll
            for (int i = 0; i < 2; ++i)
#pragma unroll
                for (int n = 0; n < 4; ++n)
#pragma unroll
                    for (int j = 0; j < 4; ++j) Dst[((size_t)it * 32 + (i * 4 + n) * 4 + j) * 512 + tid] = accC[i][n][j];
            if (tp == 0 && l15 == 0) {
#pragma unroll
                for (int i = 0; i < 2; ++i) *(f32x4*)(Dn + it * 128 + 32 * st + 16 * i + 4 * l4) = accN[i]; }
        } else {
            if (!(kinds & 2)) continue;
            const int s = it - N_S2, b = s >> 2, head = s & 3;
            const float* C0 = p.in[3] + (size_t)s * 16384; f32x4 accC[2][4], accN[2];
#pragma unroll
            for (int i = 0; i < 2; ++i) accN[i] = *(const f32x4*)(p.in[4] + s * 128 + 32 * st + 16 * i + 4 * l4);
#pragma unroll
            for (int i = 0; i < 2; ++i)
#pragma unroll
                for (int n = 0; n < 4; ++n)
#pragma unroll
                    for (int j = 0; j < 4; ++j) accC[i][n][j] = C0[(32 * st + 16 * i + 4 * l4 + j) * 128 + 64 * tp + 16 * n + l15];
            mlstm_run<true>(p, lds, accC, accN, MP + b * 32, head, 1, 32);
            float* Co = p.out + O_CS + (size_t)s * 16384;
#pragma unroll
            for (int i = 0; i < 2; ++i)
#pragma unroll
                for (int n = 0; n < 4; ++n)
#pragma unroll
                    for (int j = 0; j < 4; ++j) Co[(32 * st + 16 * i + 4 * l4 + j) * 128 + 64 * tp + 16 * n + l15] = accC[i][n][j];
            if (tp == 0 && l15 == 0) {
#pragma unroll
                for (int i = 0; i < 2; ++i) *(f32x4*)(p.out + O_NS + s * 128 + 32 * st + 16 * i + 4 * l4) = accN[i]; }
        }
    }
    if (kinds & 4) { const int G = gridDim.x; int first = blockIdx.x; while (first < N_S2 + N_SMP) first += G;
        pool_loop(p, lds, first - N_S2 - N_SMP, G, N_POOL); }
    const bf16_t* proj = (const bf16_t*)(p.ws + WS_PROJ);
    for (int idx = blockIdx.x * 512 + tid; idx < (NB + DB) * 15 * 512; idx += gridDim.x * 512) {
        if (idx < NB * 7680) { const int b = idx / 7680, rem = idx % 7680, i = rem >> 9, c = rem & 511;
            p.out[O_POOLP + idx] = bf2f(proj[(size_t)(b * SEQ + SEQ - 15 + i) * NPROJ + c]); }
        else { const int id2 = idx - NB * 7680, b = id2 / 7680, rem = id2 % 7680, i = rem >> 9, c = rem & 511;
            p.out[O_POOLS + id2] = bf2f(proj[(size_t)(MP + b * 32 + 17 + i) * NPROJ + c]); }
    }
}

__device__ __forceinline__ void phase3(const Params& p, LAS unsigned char* lds) {
    const int tid = fresh_tid(), lane = tid & 63, wave = tid >> 6, l15 = lane & 15, l4 = lane >> 4, st = wave & 3, tp = wave >> 2;
    const float* Dst = (const float*)(p.ws + WS_DST); const float* Dn = (const float*)(p.ws + WS_DN);
    const float* mtab = (const float*)(p.ws + WS_MTAB); const float* btab = (const float*)(p.ws + WS_BTAB);
    for (int it = blockIdx.x; it < 256; it += gridDim.x) {
        const int chain = it >> 3, sc = it & 7, batch = chain >> 2, head = chain & 3;
        f32x4 accC[2][4], accN[2];
#pragma unroll
        for (int i = 0; i < 2; ++i) { accN[i] = (f32x4){0.f, 0.f, 0.f, 0.f};
#pragma unroll
            for (int n = 0; n < 4; ++n) accC[i][n] = (f32x4){0.f, 0.f, 0.f, 0.f}; }
#pragma unroll 1
        for (int j = 0; j < sc; ++j) {
            float Bs = 0.f;
            for (int c = 0; c < SCN; ++c) Bs += btab[chain * 128 + j * SCN + c];
            const float Wj = expf(Bs + mtab[chain * 132 + j * SCN] - mtab[chain * 132 + (j + 1) * SCN]);
            const int item = chain * 7 + j;
#pragma unroll
            for (int i = 0; i < 2; ++i)
#pragma unroll
                for (int n = 0; n < 4; ++n)
#pragma unroll
                    for (int q = 0; q < 4; ++q) accC[i][n][q] = Wj * accC[i][n][q] + Dst[((size_t)item * 32 + (i * 4 + n) * 4 + q) * 512 + tid];
#pragma unroll
            for (int i = 0; i < 2; ++i) accN[i] = Wj * accN[i] + *(const f32x4*)(Dn + item * 128 + 32 * st + 16 * i + 4 * l4);
        }
        mlstm_run<true>(p, lds, accC, accN, batch * SEQ + sc * SCN * 64, head, SCN, 64);
        if (sc == 7) {
            float* Co = p.out + O_CP + (size_t)chain * 16384;
#pragma unroll
            for (int i = 0; i < 2; ++i)
#pragma unroll
                for (int n = 0; n < 4; ++n)
#pragma unroll
                    for (int j = 0; j < 4; ++j) Co[(32 * st + 16 * i + 4 * l4 + j) * 128 + 64 * tp + 16 * n + l15] = accC[i][n][j];
            if (tp == 0 && l15 == 0) {
#pragma unroll
                for (int i = 0; i < 2; ++i) *(f32x4*)(p.out + O_NP + chain * 128 + 32 * st + 16 * i + 4 * l4) = accN[i]; }
        }
    }
}

__device__ __forceinline__ void ln_load(const bf16_t* src, const float* slab, int S, const bf16_t* hb, int row, int lane, float4 (&v)[4]) {
    if (row >= MP) {
#pragma unroll
        for (int i = 0; i < 4; ++i) { const int c = i * 256 + lane * 4; const u32x2 h2 = *(const u32x2*)(hb + (size_t)row * DM + c);
            float4 a = make_float4(ALPHA * bflo(h2.x), ALPHA * bfhi(h2.x), ALPHA * bflo(h2.y), ALPHA * bfhi(h2.y));
            const float* sp = slab + (size_t)(row - MP) * DM + c;
#pragma unroll 1
            for (int sl = 0; sl < S; ++sl) { const float4 t = *(const float4*)(sp + (size_t)sl * (1024 * 1024)); a.x += t.x; a.y += t.y; a.z += t.z; a.w += t.w; }
            v[i] = a; }
    } else {
#pragma unroll
        for (int i = 0; i < 4; ++i) { const u32x2 r = *(const u32x2*)(src + (size_t)row * DM + i * 256 + lane * 4); v[i] = make_float4(bflo(r.x), bfhi(r.x), bflo(r.y), bfhi(r.y)); } }
}
template <bool TO_BF16>
__device__ __forceinline__ void ln_rows(const bf16_t* src, const float* gam, const float* bet, bf16_t* ob, float* of, const float* slab, int S, const bf16_t* hb) {
    const int tid = fresh_tid(), lane = tid & 63, wave = tid >> 6, stride = gridDim.x * 8;
    int row = blockIdx.x * 8 + wave; float4 v[4];
    if (row < MT) ln_load(src, slab, S, hb, row, lane, v);
#pragma unroll 1
    for (; row < MT; row += stride) {
        const int nrow = row + stride; float4 nv[4];
        if (nrow < MT) ln_load(src, slab, S, hb, nrow, lane, nv);
        else {
#pragma unroll
            for (int i = 0; i < 4; ++i) nv[i] = make_float4(0.f, 0.f, 0.f, 0.f); }
        float s = 0.f;
#pragma unroll
        for (int i = 0; i < 4; ++i) s += (v[i].x + v[i].y) + (v[i].z + v[i].w);
        const float mu = wave_sum(s) * (1.0f / DM); float q = 0.f;
#pragma unroll
        for (int i = 0; i < 4; ++i) { v[i].x -= mu; v[i].y -= mu; v[i].z -= mu; v[i].w -= mu; q += (v[i].x * v[i].x + v[i].y * v[i].y) + (v[i].z * v[i].z + v[i].w * v[i].w); }
        const float rstd = rsqrtf(wave_sum(q) * (1.0f / DM) + LN_EPS);
#pragma unroll
        for (int i = 0; i < 4; ++i) { const int c = i * 256 + lane * 4; const float4 gg = *(const float4*)(gam + c), bb = *(const float4*)(bet + c);
            float4 y; y.x = v[i].x * rstd * gg.x + bb.x; y.y = v[i].y * rstd * gg.y + bb.y; y.z = v[i].z * rstd * gg.z + bb.z; y.w = v[i].w * rstd * gg.w + bb.w;
            if (TO_BF16) { u32x2 w; w.x = pk2(y.x, y.y); w.y = pk2(y.z, y.w); *(u32x2*)(ob + (size_t)row * DM + c) = w; }
            else *(float4*)(of + (size_t)row * DM + c) = y; }
#pragma unroll
        for (int i = 0; i < 4; ++i) v[i] = nv[i];
    }
}

__global__ void __launch_bounds__(512) fwd_mega(Params p) {
    extern __shared__ __attribute__((aligned(16))) unsigned char smem[];
    LAS unsigned char* lds = (LAS unsigned char*)smem;
    cg::grid_group grid = cg::this_grid();
    volatile LAS unsigned* stw = (volatile LAS unsigned*)(lds + 131072);
    if (threadIdx.x == 0) { stw[0] = 0u; stw[1] = 0u; }
    __syncthreads();
    const XcdBarrier xbar = xcd_barrier_post((unsigned*)(p.ws + WS_BAR), stw);
    unsigned char* ws = p.ws;
    bf16_t* h0 = (bf16_t*)(ws + WS_H0); bf16_t* proj = (bf16_t*)(ws + WS_PROJ); bf16_t* mix = (bf16_t*)(ws + WS_MIX); bf16_t* act = (bf16_t*)(ws + WS_ACT);
    float* slab = (float*)(ws + WS_SLAB);
    const int G = gridDim.x, bx = blockIdx.x;
#ifndef DBL
#define DBL 0
#endif
    if (DBL & 0x800) { for (int i = 0; i < 10; ++i) xcd_barrier(xbar); }
    if (DBL & 1) { phase0(p, lds); xcd_barrier(xbar); }
    phase0(p, lds);
    grid.sync();
    gate_scan(p, lds);
    { pg8::Gemm g{h0, (const bf16_t*)(ws + WS_WIN), MT, NPROJ, DM}; SplitOrder S; S.init(NPROJ, DM / 64, 1, G, bx);
      EpiBf16B e{proj, NPROJ, (const float*)(ws + WS_BIAS)}; pg8::gemm_phase(lds, g, S, e); }
    xcd_barrier(xbar);
    if (DBL & 4) { phase2(p, lds, 15); xcd_barrier(xbar); }
    if (DBL & 0x200) { phase2(p, lds, 4); xcd_barrier(xbar); }
    if (DBL & 0x400) { phase2(p, lds, 1); xcd_barrier(xbar); }
    phase2(p, lds, 15);
    xcd_barrier(xbar);
    if (DBL & 8) { phase3(p, lds); xcd_barrier(xbar); }
    phase3(p, lds);
    xcd_barrier(xbar);
    { pg8::Gemm g{mix, (const bf16_t*)(ws + WS_WOUT), MT, DM, DM}; SplitOrder S; S.init(DM, DM / 64, 4, G, bx);
      EpiRes e{h0, (bf16_t*)(ws + WS_R1), slab, DM / 64}; pg8::gemm_phase(lds, g, S, e); }
    xcd_barrier(xbar);
    ln_rows<true>((const bf16_t*)(ws + WS_R1), p.in[14], p.in[15], h0, nullptr, slab, 4, h0);
    xcd_barrier(xbar);
    { pg8::Gemm g{h0, (const bf16_t*)(ws + WS_WGU), MT, 2 * DFF, DM}; SplitOrder S; S.init(2 * DFF, DM / 64, 1, G, bx);
      EpiSwiglu e{act}; pg8::gemm_phase(lds, g, S, e); }
    xcd_barrier(xbar);
    { pg8::Gemm g{act, (const bf16_t*)(ws + WS_WDN), MT, DM, DFF}; SplitOrder S; S.init(DM, DFF / 64, 11, G, bx);
      EpiRes e{h0, (bf16_t*)(ws + WS_R2), slab, DFF / 64}; pg8::gemm_phase(lds, g, S, e); }
    xcd_barrier(xbar);
    ln_rows<false>((const bf16_t*)(ws + WS_R2), p.in[19], p.in[20], nullptr, p.out + O_Y, slab, 11, h0);
}

extern "C" void kernel_launch(void* const* d_in, const int* in_sizes, int n_in, void* d_out, int out_size, void* d_ws, size_t ws_size, hipStream_t stream) {
    constexpr size_t kDynLds = 131072 + 64;
    static int grid_blocks = 0;
    if (!grid_blocks) {
        if (n_in != 21 || (size_t)out_size != O_END || ws_size < WS_END3) { fprintf(stderr, "kernel_launch: unexpected shapes: n_in %d out %d ws %zu (need %zu)\n", n_in, out_size, ws_size, (size_t)WS_END3); grid_blocks = -1; return; }
        int dev = 0, cus = 0, per_cu = 0;
        hipGetDevice(&dev);
        hipDeviceGetAttribute(&cus, hipDeviceAttributeMultiprocessorCount, dev);
        if (hipFuncSetAttribute((const void*)fwd_mega, hipFuncAttributeMaxDynamicSharedMemorySize, (int)kDynLds) != hipSuccess) { fprintf(stderr, "kernel_launch: hipFuncSetAttribute failed\n"); grid_blocks = -1; return; }
        if (hipOccupancyMaxActiveBlocksPerMultiprocessor(&per_cu, (const void*)fwd_mega, 512, kDynLds) != hipSuccess || per_cu < 1) { fprintf(stderr, "kernel_launch: occupancy query failed (%d)\n", per_cu); grid_blocks = -1; return; }
        if (per_cu > 1) per_cu = 1;
        grid_blocks = cus * per_cu;
    }
    if (grid_blocks < 0) return;
    if (hipMemsetAsync((char*)d_ws + WS_BAR, 0, XCD_BAR_WORDS * 4, stream) != hipSuccess) { fprintf(stderr, "kernel_launch: memset of the barrier words failed\n"); return; }
    Params p{};
    for (int i = 0; i < 21; ++i) p.in[i] = (const float*)d_in[i];
    p.out = (float*)d_out; p.ws = (unsigned char*)d_ws;
    void* args[] = {&p};
    hipError_t e = hipLaunchCooperativeKernel((const void*)fwd_mega, dim3(grid_blocks), dim3(512), args, kDynLds, stream);
    if (e != hipSuccess) fprintf(stderr, "cooperative launch failed: %s (grid %d)\n", hipGetErrorString(e), grid_blocks);
}
```

```cpp
#include <hip/hip_runtime.h>
#include <hip/hip_cooperative_groups.h>
#include <cstdio>
namespace cg = cooperative_groups;
namespace pg8 {
#define PG8_LAS __attribute__((address_space(3)))
typedef unsigned short bf16_t;
typedef short bf16x8 __attribute__((ext_vector_type(8)));
typedef float f32x4 __attribute__((ext_vector_type(4)));
typedef unsigned u32x4 __attribute__((ext_vector_type(4)));
constexpr int BM = 256, BK = 64, HALF = 128, HTB = HALF * BK * 2  , STAGE_BYTES = 8 * HTB, NXCD = 8, WGM = 8;

__host__ __device__ __forceinline__ int lds_byte(int r, int c) { const int st = (r >> 4) * 2 + (c >> 5), rr = r & 15, cc = c & 31, ob = rr * 64 + cc * 2; return st * 1024 + (ob ^ (((ob >> 9) & 1) << 5)); }
__host__ __device__ __forceinline__ void stage_rc(int b, int& R, int& C) { const int st = b / 1024, sb = b % 1024, swz = sb ^ (((sb >> 9) & 1) << 5); R = (st >> 1) * 16 + swz / 64; C = (st & 1) * 32 + (swz % 64) / 2; }
__host__ __device__ __forceinline__ int perm32(int rho) { const int n = rho >> 4, i = rho & 15; return 8 * (i >> 2) + 4 * n + (i & 3); }

struct Unit { int pm, pn, kt0, nkt; };
struct Gemm { const bf16_t* A; const bf16_t* Bt; int M, N, K; };
struct StaticOrder {
    int nM, nN, nwg, G, c;
    __host__ __device__ void init(int M, int N, int G_, int c_) { nM = M / BM; nN = N / BM; nwg = nM * nN; G = G_; c = c_; }
    __host__ __device__ bool next(int i, Unit& u) const {
        const long L = (long)i * G + c; if (L >= nwg) return false;
        int wgid = (int)L; { const int q = nwg / NXCD, r = nwg % NXCD, xcd = wgid % NXCD, off = wgid / NXCD; wgid = (xcd < r ? xcd * (q + 1) : r * (q + 1) + (xcd - r) * q) + off; }
        const int nig = WGM * nN, gid = wgid / nig, fm = gid * WGM, gsz = (nM - fm) < WGM ? (nM - fm) : WGM;
        u.pm = fm + ((wgid % nig) % gsz); u.pn = (wgid % nig) / gsz; u.kt0 = 0; u.nkt = 0; return true;
    }
    __device__ __forceinline__ void a_ready(const Unit&) const {}
    __device__ __forceinline__ void done(const Unit&) const {}
};
__device__ __forceinline__ unsigned cvt_pk_bf16(float lo, float hi) { unsigned r; asm volatile("v_cvt_pk_bf16_f32 %0, %1, %2" : "=v"(r) : "v"(lo), "v"(hi)); return r; }
template <class Epi, class Sched>
__device__ __forceinline__ void gemm_phase(PG8_LAS unsigned char* lds, const Gemm g, const Sched& S, const Epi& E) {
    int tid_ = threadIdx.x; asm volatile("" : "+v"(tid_)); const int tid = tid_, wid = __builtin_amdgcn_readfirstlane(tid >> 6), lane = tid & 63, wr = wid >> 2, wc = wid & 3, fr = lane & 15, fq = lane >> 4;
    const int K = g.K;
    unsigned voffA[2], voffB[2];
#pragma unroll
    for (int i = 0; i < 2; ++i) { int R, C; stage_rc(tid * 16 + i * 8192, R, C); const int Rb = Epi::PERM ? ((R & ~31) + perm32(R & 31)) : R;
        voffA[i] = (unsigned)(R * K + C) * 2u; voffB[i] = (unsigned)(Rb * K + C) * 2u; }
    const size_t kstep = (size_t)(BK * 2);
    const size_t hstep = (size_t)HALF * K * 2;
    const size_t tstep = 2 * hstep;
    const unsigned ldsw = (unsigned)wid * 1024u;
    const int aoff = lds_byte(wr * 64 + fr, fq * 8), boff = lds_byte(wc * 32 + fr, fq * 8);
#define PG8_SA(b, h) (((b) * 2 + (h)) * HTB)
#define PG8_SB(b, h) ((4 + (b) * 2 + (h)) * HTB)
#define PG8_STAGE(bufoff, gbase, voff) do { _Pragma("unroll") for (int _i = 0; _i < 2; ++_i) \
        __builtin_amdgcn_global_load_lds((const unsigned*)((const char*)(gbase) + (voff)[_i]), (PG8_LAS unsigned*)(lds + (bufoff) + ldsw + _i * 8192), 16, 0, 0); } while (0)
#define PG8_LDA(dst, b, h) do { _Pragma("unroll") for (int m = 0; m < 4; ++m) _Pragma("unroll") for (int k = 0; k < 2; ++k) dst[m][k] = *(const PG8_LAS bf16x8*)(lds + PG8_SA(b, h) + aoff + m * 2048 + k * 1024); } while (0)
#define PG8_LDB(dst, b, h) do { _Pragma("unroll") for (int n = 0; n < 2; ++n) _Pragma("unroll") for (int k = 0; k < 2; ++k) dst[n][k] = *(const PG8_LAS bf16x8*)(lds + PG8_SB(b, h) + boff + n * 2048 + k * 1024); } while (0)
#define PG8_MMA(ai, bj, At, Bt) do { __builtin_amdgcn_s_setprio(1); _Pragma("unroll") for (int m = 0; m < 4; ++m) _Pragma("unroll") for (int n = 0; n < 2; ++n) _Pragma("unroll") for (int k = 0; k < 2; ++k) \
        acc[ai][bj][m][n] = __builtin_amdgcn_mfma_f32_16x16x32_bf16(Bt[n][k], At[m][k], acc[ai][bj][m][n], 0, 0, 0); __builtin_amdgcn_s_setprio(0); } while (0)
#define PG8_WAIT_V(n) asm volatile("s_waitcnt vmcnt(" #n ")" ::: "memory")
#define PG8_WAIT_L(n) asm volatile("s_waitcnt lgkmcnt(" #n ")" ::: "memory")
#define PG8_BAR __builtin_amdgcn_s_barrier()
#define PG8_SCHED __builtin_amdgcn_sched_barrier(0)
    Unit cur, nxt; int ui = 0;
    if (!S.next(0, cur)) return;
    f32x4 acc[2][2][4][2];
#pragma unroll
    for (int a = 0; a < 2; ++a)
#pragma unroll
        for (int b = 0; b < 2; ++b)
#pragma unroll
            for (int m = 0; m < 4; ++m)
#pragma unroll
                for (int n = 0; n < 2; ++n) acc[a][b][m][n] = (f32x4){0.f, 0.f, 0.f, 0.f};
    bf16x8 At[4][2], B0[2][2], B1[2][2];
    const char* cA = (const char*)g.A + (size_t)cur.pm * tstep + (size_t)cur.kt0 * kstep; const char* cB = (const char*)g.Bt + (size_t)cur.pn * tstep + (size_t)cur.kt0 * kstep;
    S.a_ready(cur);
    PG8_STAGE(PG8_SB(0, 0), cB, voffB); PG8_STAGE(PG8_SA(0, 0), cA, voffA); PG8_STAGE(PG8_SB(0, 1), cB + hstep, voffB); PG8_STAGE(PG8_SA(0, 1), cA + hstep, voffA);
    if (wr == 1) PG8_BAR;
    PG8_WAIT_V(4); PG8_BAR;
    PG8_STAGE(PG8_SB(1, 0), cB + kstep, voffB); PG8_STAGE(PG8_SA(1, 0), cA + kstep, voffA); PG8_STAGE(PG8_SB(1, 1), cB + hstep + kstep, voffB);
    PG8_WAIT_V(6); PG8_BAR;
    for (;;) {
        const bool has_next = S.next(ui + 1, nxt);
        const char* nA = has_next ? (const char*)g.A + (size_t)nxt.pm * tstep + (size_t)nxt.kt0 * kstep : cA; const char* nB = has_next ? (const char*)g.Bt + (size_t)nxt.pn * tstep + (size_t)nxt.kt0 * kstep : cB;
        const int nt = cur.nkt;
        for (int t = 0; t < nt; t += 2) {
            const bool last = (t == nt - 2);
            const char* a1 = cA + (size_t)(t + 1) * kstep;
            const char* a2 = last ? nA : cA + (size_t)(t + 2) * kstep; const char* b2 = last ? nB : cB + (size_t)(t + 2) * kstep;
            const char* a3 = a2 + kstep; const char* b3 = b2 + kstep;
            if (last && has_next) S.a_ready(nxt);
            PG8_LDB(B0, 0, 0); PG8_SCHED; PG8_LDA(At, 0, 0); PG8_STAGE(PG8_SA(1, 1), a1 + hstep, voffA);
            PG8_WAIT_L(8); PG8_BAR; PG8_WAIT_L(0); PG8_MMA(0, 0, At, B0); PG8_BAR; PG8_SCHED;
            PG8_LDB(B1, 0, 1); PG8_STAGE(PG8_SB(0, 0), b2, voffB);
            PG8_BAR; PG8_WAIT_L(0); PG8_MMA(0, 1, At, B1); PG8_BAR;
            PG8_LDA(At, 0, 1); PG8_STAGE(PG8_SA(0, 0), a2, voffA);
            PG8_BAR; PG8_WAIT_L(0); PG8_MMA(1, 0, At, B0); PG8_BAR; PG8_SCHED;
            PG8_STAGE(PG8_SB(0, 1), b2 + hstep, voffB);
            PG8_WAIT_V(6); PG8_BAR; PG8_MMA(1, 1, At, B1); PG8_BAR;
            PG8_LDB(B0, 1, 0); PG8_SCHED; PG8_LDA(At, 1, 0); PG8_STAGE(PG8_SA(0, 1), a2 + hstep, voffA);
            PG8_WAIT_L(8); PG8_BAR; PG8_WAIT_L(0); PG8_MMA(0, 0, At, B0); PG8_BAR; PG8_SCHED;
            PG8_LDB(B1, 1, 1); PG8_STAGE(PG8_SB(1, 0), b3, voffB);
            PG8_BAR; PG8_WAIT_L(0); PG8_MMA(0, 1, At, B1); PG8_BAR;
            PG8_LDA(At, 1, 1); PG8_STAGE(PG8_SA(1, 0), a3, voffA);
            PG8_BAR; PG8_WAIT_L(0); PG8_MMA(1, 0, At, B0); PG8_BAR; PG8_SCHED;
            PG8_STAGE(PG8_SB(1, 1), b3 + hstep, voffB);
            PG8_WAIT_V(6); PG8_BAR; PG8_MMA(1, 1, At, B1); PG8_BAR;
        }
        if constexpr (!Epi::AFTER_DRAIN) { E(acc, cur, wr, wc, fr, fq); S.done(cur); }
        if (!has_next) break;
#pragma unroll
        for (int a = 0; a < 2; ++a)
#pragma unroll
            for (int b = 0; b < 2; ++b)
#pragma unroll
                for (int m = 0; m < 4; ++m)
#pragma unroll
                    for (int n = 0; n < 2; ++n) acc[a][b][m][n] = (f32x4){0.f, 0.f, 0.f, 0.f};
        cur = nxt; cA = nA; cB = nB; ++ui;
    }
    PG8_WAIT_V(0);
    if (wr == 0) PG8_BAR;
    PG8_BAR;
    if constexpr (Epi::AFTER_DRAIN) { E.fused(acc, cur, wr, wc, fr, fq, lds, wid, lane); S.done(cur); }
#undef PG8_SA
#undef PG8_SB
#undef PG8_STAGE
#undef PG8_LDA
#undef PG8_LDB
#undef PG8_MMA
#undef PG8_WAIT_V
#undef PG8_WAIT_L
#undef PG8_BAR
#undef PG8_SCHED
}
}

using pg8::bf16_t; using pg8::bf16x8; using pg8::f32x4; using pg8::u32x4;
#define LAS __attribute__((address_space(3)))
typedef unsigned u32x2 __attribute__((ext_vector_type(2)));

constexpr int DM = 1024, NB = 8, SEQ = 8192, DB = 32, DS = 32;
constexpr int MP = NB * SEQ, MS = DB * DS, MT = MP + MS;
constexpr int NPROJ = 2560, INCOLS = 2568, DFF = 2816;
constexpr int SCN = 16;
constexpr float ALPHA = 1.189207115002721f, KSCALE = 0.08838834764831845f, LN_EPS = 1e-5f;

constexpr size_t al256(size_t x) { return (x + 255) & ~(size_t)255; }
constexpr size_t WS_BAR = 0;
constexpr size_t WS_WIN = 16384;
constexpr size_t WS_WOUT = WS_WIN + al256((size_t)NPROJ * DM * 2);
constexpr size_t WS_WGU = WS_WOUT + al256((size_t)DM * DM * 2);
constexpr size_t WS_WDN = WS_WGU + al256((size_t)2 * DFF * DM * 2);
constexpr size_t WS_WPOOL = WS_WDN + al256((size_t)DM * DFF * 2);
constexpr size_t WS_BIAS = WS_WPOOL + al256((size_t)4 * 128 * 128 * 2);
constexpr size_t WS_GATES = WS_BIAS + al256((size_t)NPROJ * 4);
constexpr size_t WS_MTAB = WS_GATES + al256((size_t)MT * 8 * 4);
constexpr size_t WS_BTAB = WS_MTAB + al256((size_t)32 * 132 * 4);
constexpr size_t WS_GTAB = WS_BTAB + al256((size_t)32 * 128 * 4);
constexpr size_t WS_DST = WS_GTAB + al256((size_t)MT * 4 * 16);
constexpr size_t WS_DN = WS_DST + al256((size_t)224 * 16384 * 4);
constexpr size_t WS_H0 = WS_DN + al256((size_t)224 * 128 * 4);
constexpr size_t WS_PROJ = WS_H0 + al256((size_t)MT * DM * 2);
constexpr size_t WS_MIX = WS_PROJ + al256((size_t)MT * NPROJ * 2);
constexpr size_t WS_END = WS_MIX + al256((size_t)MT * DM * 2);
constexpr size_t WS_SLAB = WS_END;
constexpr size_t WS_END2 = WS_SLAB + (size_t)11 * 1024 * 1024 * 4;
constexpr size_t WS_R2 = WS_END2;
constexpr size_t WS_END3 = WS_R2 + al256((size_t)MT * DM * 2);
constexpr size_t WS_R1 = WS_PROJ;
constexpr size_t WS_ACT = WS_PROJ;
static_assert((size_t)MT * DFF * 2 <= WS_END - WS_PROJ, "act does not fit");

constexpr size_t O_Y = 0;
constexpr size_t O_POOLP = (size_t)MT * DM;
constexpr size_t O_CP = O_POOLP + (size_t)NB * 15 * 512;
constexpr size_t O_NP = O_CP + (size_t)NB * 4 * 16384;
constexpr size_t O_MP = O_NP + (size_t)NB * 4 * 128;
constexpr size_t O_POOLS = O_MP + (size_t)NB * 4;
constexpr size_t O_CS = O_POOLS + (size_t)DB * 15 * 512;
constexpr size_t O_NS = O_CS + (size_t)DB * 4 * 16384;
constexpr size_t O_MS = O_NS + (size_t)DB * 4 * 128;
constexpr size_t O_END = O_MS + (size_t)DB * 4;

struct Params { const float* in[21]; float* out; unsigned char* ws; };

__device__ __forceinline__ int fresh_tid() { int t = threadIdx.x; asm volatile("" : "+v"(t)); return t; }
__device__ __forceinline__ float bf2f(unsigned x) { return __uint_as_float(x << 16); }
__device__ __forceinline__ float bflo(unsigned w) { return __uint_as_float(w << 16); }
__device__ __forceinline__ float bfhi(unsigned w) { return __uint_as_float(w & 0xffff0000u); }
__device__ __forceinline__ unsigned pk2(float lo, float hi) { return pg8::cvt_pk_bf16(lo, hi); }
__device__ __forceinline__ float wave_sum(float v) {
#pragma unroll
    for (int o = 32; o; o >>= 1) v += __shfl_xor(v, o);
    return v; }
__device__ __forceinline__ float wave_max(float v) {
#pragma unroll
    for (int o = 32; o; o >>= 1) v = fmaxf(v, __shfl_xor(v, o));
    return v; }
__device__ __forceinline__ float scan_sum(float x, int lane) {
#pragma unroll
    for (int o = 1; o < 64; o <<= 1) { const float y = __shfl_up(x, o); if (lane >= o) x += y; }
    return x; }
__device__ __forceinline__ float scan_max(float x, int lane) {
#pragma unroll
    for (int o = 1; o < 64; o <<= 1) { const float y = __shfl_up(x, o); if (lane >= o) x = fmaxf(x, y); }
    return x; }
__device__ __forceinline__ float logsigmoid(float x) { return fminf(x, 0.f) - log1pf(expf(-fabsf(x))); }
__device__ __forceinline__ bf16x8 ldfrag(LAS const unsigned char* base, int row, int strideB, int kbyte) { return *(LAS const bf16x8*)(base + row * strideB + kbyte); }
#define LDS_BARRIER() do { asm volatile("s_waitcnt lgkmcnt(0)" ::: "memory"); __builtin_amdgcn_s_barrier(); asm volatile("" ::: "memory"); } while (0)
#define MFMA16(a, b, c) __builtin_amdgcn_mfma_f32_16x16x32_bf16((a), (b), (c), 0, 0, 0)

#define XB_TMO      128
#define XB_XCNT(j)  (256  + 64 * (j))
#define XB_XSUB(j)  (1280 + 64 * (j))
#define XB_XGEN(j)  (2304 + 64 * (j))
#define XB_TOP      3328
#define XB_TOPGEN   3392
#define XCD_BAR_WORDS 3456
#define XB_SPIN_CAP (1u << 18)
__device__ __forceinline__ unsigned xb_ld(unsigned* p)              { return __hip_atomic_load(p, __ATOMIC_RELAXED, __HIP_MEMORY_SCOPE_AGENT); }
__device__ __forceinline__ unsigned xb_add(unsigned* p, unsigned v) { return __hip_atomic_fetch_add(p, v, __ATOMIC_RELAXED, __HIP_MEMORY_SCOPE_AGENT); }
__device__ __forceinline__ unsigned xb_xcc_id() { return (unsigned)__builtin_amdgcn_s_getreg((3 << 11) | 20) & 0xFu; }
#define XB_SPIN(cond, bar) do { unsigned _sp = 0; while (cond) { __builtin_amdgcn_s_sleep(1); \
    if ((++_sp & 255u) == 0u) { if (xb_ld(&(bar)[XB_TMO])) break; if (_sp > XB_SPIN_CAP) { atomicAdd(&(bar)[XB_TMO], 1u); break; } } } } while (0)

struct XcdBarrier {
    unsigned* bar; unsigned x;
    volatile LAS unsigned* st;
};

__device__ __forceinline__ XcdBarrier xcd_barrier_post(unsigned* bar, volatile LAS unsigned* st) {
    XcdBarrier b; b.bar = bar; b.x = xb_xcc_id(); b.st = st;
    if (threadIdx.x == 0) (void)xb_add(&bar[XB_XCNT(b.x)], 1u);
    return b;
}
__device__ __forceinline__ void xcd_barrier_complete(unsigned* bar, unsigned x, unsigned& nloc, unsigned& nx) {
    const unsigned G = gridDim.x * gridDim.y * gridDim.z;
    unsigned sum, cnt, mine, sp = 0u;
    for (;;) {
        sum = 0u; cnt = 0u; mine = 0u;
#pragma unroll
        for (unsigned j = 0; j < 16; ++j) { const unsigned c = xb_ld(&bar[XB_XCNT(j)]); sum += c; cnt += (c > 0u) ? 1u : 0u; mine = (j == x) ? c : mine; }
        if (sum == G) break;
        __builtin_amdgcn_s_sleep(1);
        if ((++sp & 255u) == 0u) { if (xb_ld(&bar[XB_TMO])) break; if (sp > XB_SPIN_CAP) { atomicAdd(&bar[XB_TMO], 1u); break; } }
    }
    nloc = mine > 0u ? mine : 1u; nx = cnt > 0u ? cnt : 1u;
}

__device__ __forceinline__ void xcd_barrier(const XcdBarrier& b) {
    asm volatile("s_waitcnt vmcnt(0)" ::: "memory");
    __syncthreads();
    if (threadIdx.x == 0) {
        unsigned* bar = b.bar;
        __builtin_amdgcn_s_waitcnt(0);
        unsigned nloc = b.st[0], nx = b.st[1];
        if (nloc == 0u) { xcd_barrier_complete(bar, b.x, nloc, nx); b.st[0] = nloc; b.st[1] = nx; }
        const unsigned old = xb_add(&bar[XB_XSUB(b.x)], 1u);
        const unsigned gen = old / nloc;
        if (old + 1u == (gen + 1u) * nloc) {
            __builtin_amdgcn_fence(__ATOMIC_RELEASE, "agent");
            asm volatile("s_waitcnt vmcnt(0)" ::: "memory");
            const unsigned og = xb_add(&bar[XB_TOP], 1u);
            const unsigned tg = og / nx;
            if (og + 1u == (tg + 1u) * nx) xb_add(&bar[XB_TOPGEN], 1u);
            else XB_SPIN(xb_ld(&bar[XB_TOPGEN]) == tg, bar);
            __builtin_amdgcn_fence(__ATOMIC_ACQUIRE, "agent");
            xb_add(&bar[XB_XGEN(b.x)], 1u);
            asm volatile("s_waitcnt vmcnt(0)" ::: "memory");
        } else {
            XB_SPIN(xb_ld(&bar[XB_XGEN(b.x)]) == gen, bar);
            __builtin_amdgcn_fence(__ATOMIC_ACQUIRE, "agent");
            asm volatile("s_waitcnt vmcnt(0)" ::: "memory");
        }
    }
    __syncthreads();
}

struct SplitOrder {
    int nN, nP, S, nkt, G, c;
    __device__ __forceinline__ void init(int N, int Ktiles, int S_, int G_, int c_) { nN = N / 256; nP = 256 * nN; S = S_; nkt = Ktiles; G = G_; c = c_; }
    __device__ __forceinline__ bool next(int i, pg8::Unit& u) const {
        const long L = (long)i * G + c;
        if (L >= nP + 4 * nN * S) return false;
        int pm, pn, k0 = 0, kn = nkt;
        if (L < nP) { int wgid = (int)L; { const int q = nP / 8, xcd = wgid % 8, off = wgid / 8; wgid = xcd * q + off; }
            const int nig = 8 * nN, gid = wgid / nig, fm = gid * 8; pm = fm + ((wgid % nig) % 8); pn = (wgid % nig) / 8; }
        else { const int j = (int)(L - nP), su = j / S, sl = j - su * S; pm = 256 + su / nN; pn = su % nN; kn = nkt / S; k0 = sl * kn; }
        u.pm = pm; u.pn = pn; u.kt0 = k0; u.nkt = kn; return true;
    }
    __device__ __forceinline__ void a_ready(const pg8::Unit&) const {}
    __device__ __forceinline__ void done(const pg8::Unit&) const {}
};

struct EpiBf16B {
    static constexpr bool PERM = true, AFTER_DRAIN = false;
    bf16_t* O; int ldc; const float* bias;
    __device__ __forceinline__ void operator()(const f32x4 (&acc)[2][2][4][2], const pg8::Unit& u, int wr, int wc, int fr, int fq) const {
        const int row0 = u.pm * 256 + wr * 64 + fr, col0 = u.pn * 256 + wc * 32 + 8 * fq;
        f32x4 bv[2][2];
#pragma unroll
        for (int bj = 0; bj < 2; ++bj)
#pragma unroll
            for (int n = 0; n < 2; ++n) bv[bj][n] = *(const f32x4*)(bias + col0 + bj * 128 + 4 * n);
#pragma unroll
        for (int ai = 0; ai < 2; ++ai)
#pragma unroll
            for (int m = 0; m < 4; ++m) { bf16_t* rowp = O + (size_t)(row0 + ai * 128 + m * 16) * ldc + col0;
#pragma unroll
                for (int bj = 0; bj < 2; ++bj) { const f32x4 v0 = acc[ai][bj][m][0] + bv[bj][0], v1 = acc[ai][bj][m][1] + bv[bj][1];
                    u32x4 w; w.x = pk2(v0[0], v0[1]); w.y = pk2(v0[2], v0[3]); w.z = pk2(v1[0], v1[1]); w.w = pk2(v1[2], v1[3]);
                    *(u32x4*)(rowp + bj * 128) = w; } }
    }
};
struct EpiRes {
    static constexpr bool PERM = true, AFTER_DRAIN = false;
    const bf16_t* base; bf16_t* out; float* slab; int nkt_full;
    __device__ __forceinline__ void operator()(const f32x4 (&acc)[2][2][4][2], const pg8::Unit& u, int wr, int wc, int fr, int fq) const {
        const int row0 = u.pm * 256 + wr * 64 + fr, col0 = u.pn * 256 + wc * 32 + 8 * fq;
        if (u.nkt != nkt_full) {
            float* sp = slab + (size_t)(u.kt0 / u.nkt) * (1024 * 1024) + (size_t)(row0 - MP) * DM + col0;
#pragma unroll
            for (int ai = 0; ai < 2; ++ai)
#pragma unroll
                for (int m = 0; m < 4; ++m)
#pragma unroll
                    for (int bj = 0; bj < 2; ++bj)
#pragma unroll
                        for (int n = 0; n < 2; ++n) *(f32x4*)(sp + (size_t)(ai * 128 + m * 16) * DM + bj * 128 + 4 * n) = acc[ai][bj][m][n];
            return; }
        u32x4 bb[2][4][2];
#pragma unroll
        for (int ai = 0; ai < 2; ++ai)
#pragma unroll
            for (int m = 0; m < 4; ++m)
#pragma unroll
                for (int bj = 0; bj < 2; ++bj) bb[ai][m][bj] = *(const u32x4*)(base + (size_t)(row0 + ai * 128 + m * 16) * DM + col0 + bj * 128);
        asm volatile("" ::: "memory");
#pragma unroll
        for (int ai = 0; ai < 2; ++ai)
#pragma unroll
            for (int m = 0; m < 4; ++m) { const size_t off = (size_t)(row0 + ai * 128 + m * 16) * DM + col0;
#pragma unroll
                for (int bj = 0; bj < 2; ++bj) { const u32x4 b = bb[ai][m][bj]; const f32x4 a0 = acc[ai][bj][m][0], a1 = acc[ai][bj][m][1];
                    u32x4 w; w.x = pk2(ALPHA * bflo(b.x) + a0[0], ALPHA * bfhi(b.x) + a0[1]); w.y = pk2(ALPHA * bflo(b.y) + a0[2], ALPHA * bfhi(b.y) + a0[3]);
                    w.z = pk2(ALPHA * bflo(b.z) + a1[0], ALPHA * bfhi(b.z) + a1[1]); w.w = pk2(ALPHA * bflo(b.w) + a1[2], ALPHA * bfhi(b.w) + a1[3]);
                    *(u32x4*)(out + off + bj * 128) = w; } }
    }
};
__device__ __forceinline__ float fsigmoid(float x) { return __builtin_amdgcn_rcpf(1.0f + __expf(-x)); }
__device__ __forceinline__ float swiglu(float g, float u) { return g * u * fsigmoid(g); }
struct EpiSwiglu {
    static constexpr bool PERM = true, AFTER_DRAIN = false;
    bf16_t* O;
    __device__ __forceinline__ void operator()(const f32x4 (&acc)[2][2][4][2], const pg8::Unit& u, int wr, int wc, int fr, int fq) const {
        const int row0 = u.pm * 256 + wr * 64 + fr, col0 = u.pn * 128 + wc * 32 + 8 * fq;
#pragma unroll
        for (int ai = 0; ai < 2; ++ai)
#pragma unroll
            for (int m = 0; m < 4; ++m) { bf16_t* rowp = O + (size_t)(row0 + ai * 128 + m * 16) * DFF + col0;
                const f32x4 g0 = acc[ai][0][m][0], g1 = acc[ai][0][m][1], u0 = acc[ai][1][m][0], u1 = acc[ai][1][m][1];
                u32x4 w; w.x = pk2(swiglu(g0[0], u0[0]), swiglu(g0[1], u0[1])); w.y = pk2(swiglu(g0[2], u0[2]), swiglu(g0[3], u0[3]));
                w.z = pk2(swiglu(g1[0], u1[0]), swiglu(g1[1], u1[1])); w.w = pk2(swiglu(g1[2], u1[2]), swiglu(g1[3], u1[3]));
                *(u32x4*)rowp = w; }
    }
};

constexpr int TR_TILES = 640 + 256 + 704 + 704 + 704 + 16;
struct TileDesc { const float* src; bf16_t* dst; int ld, K, mode, k0, n0; };
__device__ __forceinline__ TileDesc tile_desc(const Params& p, int t) {
    TileDesc d; unsigned char* ws = p.ws;
    if (t < 640) { d.src = p.in[8]; d.ld = INCOLS; d.K = DM; d.mode = 3; d.dst = (bf16_t*)(ws + WS_WIN); }
    else if (t < 896) { t -= 640; d.src = p.in[13]; d.ld = DM; d.K = DM; d.mode = 0; d.dst = (bf16_t*)(ws + WS_WOUT); }
    else if (t < 1600) { t -= 896; d.src = p.in[16]; d.ld = DFF; d.K = DM; d.mode = 1; d.dst = (bf16_t*)(ws + WS_WGU); }
    else if (t < 2304) { t -= 1600; d.src = p.in[17]; d.ld = DFF; d.K = DM; d.mode = 2; d.dst = (bf16_t*)(ws + WS_WGU); }
    else if (t < 3008) { t -= 2304; d.src = p.in[18]; d.ld = DM; d.K = DFF; d.mode = 0; d.dst = (bf16_t*)(ws + WS_WDN); }
    else { t -= 3008; const int g = t >> 2; t &= 3; d.src = p.in[10] + g * 16384; d.ld = 128; d.K = 128; d.mode = 0; d.dst = (bf16_t*)(ws + WS_WPOOL) + g * 16384; }
    const int nkt = d.K >> 6; d.k0 = (t % nkt) * 64; d.n0 = (t / nkt) * 64; return d;
}

__device__ __forceinline__ void phase0(const Params& p, LAS unsigned char* lds) {
    const int tid = fresh_tid(), lane = tid & 63, wave = tid >> 6, G = gridDim.x, bx = blockIdx.x;
    unsigned char* ws = p.ws;
    LAS float* T = (LAS float*)lds;
    {
        const int r = tid >> 3, cs = (tid & 7) * 8;
        int t = bx; float4 a = make_float4(0.f, 0.f, 0.f, 0.f), b = a; TileDesc d = tile_desc(p, t < TR_TILES ? t : 0);
        if (t < TR_TILES) { const float* s = d.src + (size_t)(d.k0 + r) * d.ld + d.n0 + cs; a = *(const float4*)s; b = *(const float4*)(s + 4); }
#pragma unroll 1
        for (; t < TR_TILES; t += G) {
            { LAS float* q = T + r * 65 + cs; q[0] = a.x; q[1] = a.y; q[2] = a.z; q[3] = a.w; q[4] = b.x; q[5] = b.y; q[6] = b.z; q[7] = b.w; }
            const TileDesc dn = tile_desc(p, t + G < TR_TILES ? t + G : 0);
            if (t + G < TR_TILES) { const float* s = dn.src + (size_t)(dn.k0 + r) * dn.ld + dn.n0 + cs; a = *(const float4*)s; b = *(const float4*)(s + 4); }
            LDS_BARRIER();
            { const int n = tid >> 3, ks = (tid & 7) * 8, gn = d.n0 + n; float v[8];
#pragma unroll
              for (int i = 0; i < 8; ++i) v[i] = T[(ks + i) * 65 + n];
              const float sc = (d.mode == 3 && gn >= 1024 && gn < 1536) ? KSCALE : 1.0f;
              const int drow = (d.mode == 1) ? 256 * (gn >> 7) + (gn & 127) : (d.mode == 2) ? 256 * (gn >> 7) + 128 + (gn & 127) : gn;
              u32x4 w; w.x = pk2(v[0] * sc, v[1] * sc); w.y = pk2(v[2] * sc, v[3] * sc); w.z = pk2(v[4] * sc, v[5] * sc); w.w = pk2(v[6] * sc, v[7] * sc);
              *(u32x4*)(d.dst + (size_t)drow * d.K + d.k0 + ks) = w; }
            LDS_BARRIER();
            d = dn;
        }
    }
    { float* bs = (float*)(ws + WS_BIAS); const float* b_in = p.in[9];
      for (int i = bx * 512 + tid; i < NPROJ; i += G * 512) bs[i] = b_in[i] * ((i >= 1024 && i < 1536) ? KSCALE : 1.0f); }
    f32x4 wlo[4][4], whi[4][4];
    { const float* w_in = p.in[8];
#pragma unroll
      for (int i = 0; i < 4; ++i)
#pragma unroll
          for (int e = 0; e < 4; ++e) { const float* wp = w_in + (size_t)(i * 256 + lane * 4 + e) * INCOLS + NPROJ; wlo[i][e] = *(const f32x4*)wp; whi[i][e] = *(const f32x4*)(wp + 4); } }
    const float* lg = p.in[6]; const float* lb = p.in[7]; const float* b_in = p.in[9];
    bf16_t* h0 = (bf16_t*)(ws + WS_H0); float* gates = (float*)(ws + WS_GATES);
    const float gb_perm = lane < 8 ? b_in[NPROJ + (((lane & 1) << 2) | (lane & 2) | ((lane >> 2) & 1))] : 0.f;
    int row = bx * 8 + wave; float4 v[4];
    if (row < MT) { const float* x = row < MP ? p.in[0] + (size_t)row * DM : p.in[1] + (size_t)(row - MP) * DM;
#pragma unroll
        for (int i = 0; i < 4; ++i) v[i] = *(const float4*)(x + i * 256 + lane * 4); }
#pragma unroll 1
    for (; row < MT; row += G * 8) {
        const int nrow = row + G * 8; float4 nv[4];
        if (nrow < MT) { const float* x = nrow < MP ? p.in[0] + (size_t)nrow * DM : p.in[1] + (size_t)(nrow - MP) * DM;
#pragma unroll
            for (int i = 0; i < 4; ++i) nv[i] = *(const float4*)(x + i * 256 + lane * 4); }
        else {
#pragma unroll
            for (int i = 0; i < 4; ++i) nv[i] = make_float4(0.f, 0.f, 0.f, 0.f); }
        float s = 0.f;
#pragma unroll
        for (int i = 0; i < 4; ++i) s += (v[i].x + v[i].y) + (v[i].z + v[i].w);
        const float mu = wave_sum(s) * (1.0f / DM);
        float q = 0.f;
#pragma unroll
        for (int i = 0; i < 4; ++i) { v[i].x -= mu; v[i].y -= mu; v[i].z -= mu; v[i].w -= mu; q += (v[i].x * v[i].x + v[i].y * v[i].y) + (v[i].z * v[i].z + v[i].w * v[i].w); }
        const float rstd = rsqrtf(wave_sum(q) * (1.0f / DM) + LN_EPS);
        f32x4 glo = (f32x4){0.f, 0.f, 0.f, 0.f}, ghi = glo;
#pragma unroll
        for (int i = 0; i < 4; ++i) { const int c = i * 256 + lane * 4; const float4 gg = *(const float4*)(lg + c), bb = *(const float4*)(lb + c);
            float4 y; y.x = v[i].x * rstd * gg.x + bb.x; y.y = v[i].y * rstd * gg.y + bb.y; y.z = v[i].z * rstd * gg.z + bb.z; y.w = v[i].w * rstd * gg.w + bb.w;
            u32x2 w; w.x = pk2(y.x, y.y); w.y = pk2(y.z, y.w); *(u32x2*)(h0 + (size_t)row * DM + c) = w;
            glo += y.x * wlo[i][0] + y.y * wlo[i][1] + y.z * wlo[i][2] + y.w * wlo[i][3];
            ghi += y.x * whi[i][0] + y.y * whi[i][1] + y.z * whi[i][2] + y.w * whi[i][3]; }
        { const bool b0 = lane & 1, b1 = lane & 2, b2 = lane & 4;
          f32x4 k4, s4;
#pragma unroll
          for (int j = 0; j < 4; ++j) { k4[j] = b0 ? ghi[j] : glo[j]; s4[j] = b0 ? glo[j] : ghi[j]; }
#pragma unroll
          for (int j = 0; j < 4; ++j) k4[j] += __shfl_xor(s4[j], 1);
          float k2a = b1 ? k4[2] : k4[0], k2b = b1 ? k4[3] : k4[1];
          k2a += __shfl_xor(b1 ? k4[0] : k4[2], 2); k2b += __shfl_xor(b1 ? k4[1] : k4[3], 2);
          float k1 = b2 ? k2b : k2a; k1 += __shfl_xor(b2 ? k2a : k2b, 4);
          k1 += __shfl_xor(k1, 8); k1 += __shfl_xor(k1, 16); k1 += __shfl_xor(k1, 32);
          const int gidx = ((lane & 1) << 2) | (lane & 2) | ((lane >> 2) & 1);
          if (lane < 8) gates[(size_t)row * 8 + gidx] = k1 + gb_perm; }
#pragma unroll
        for (int i = 0; i < 4; ++i) v[i] = nv[i];
    }
}

__device__ __forceinline__ void gate_scan(const Params& p, LAS unsigned char* lds) {
    const int tid = fresh_tid(), lane = tid & 63, wave = tid >> 6, G = gridDim.x;
    const float* gates = (const float*)(p.ws + WS_GATES); float* mtab = (float*)(p.ws + WS_MTAB); float* btab = (float*)(p.ws + WS_BTAB);
    f32x4* gtab = (f32x4*)(p.ws + WS_GTAB);
    LAS float* sA = (LAS float*)lds; LAS float* sB = sA + 128; LAS float* sM = sA + 256;
    const int vb = (blockIdx.x + G - (64 % G)) % G;
    for (int chain = vb; chain < 32; chain += G) {
        const int batch = chain >> 2, head = chain & 3;
        float ig[16], bb[16];
#pragma unroll
        for (int k = 0; k < 16; ++k) { const size_t row = (size_t)batch * SEQ + (wave + 8 * k) * 64 + lane; ig[k] = gates[row * 8 + head]; bb[k] = gates[row * 8 + 4 + head]; }
#pragma unroll
        for (int k = 0; k < 16; ++k) { bb[k] = scan_sum(logsigmoid(bb[k]), lane); const float A = wave_max(ig[k] - bb[k]); const float bl = __shfl(bb[k], 63);
            if (lane == 0) { sA[wave + 8 * k] = A; sB[wave + 8 * k] = bl; } }
        __syncthreads();
        if (tid == 0) { float m = 0.f; mtab[chain * 132] = 0.f; sM[0] = 0.f;
            for (int c = 0; c < 128; ++c) { m = sB[c] + fmaxf(m, sA[c]); mtab[chain * 132 + c + 1] = m; sM[c + 1] = m; btab[chain * 128 + c] = sB[c]; }
            p.out[O_MP + chain] = m; }
        __syncthreads();
#pragma unroll
        for (int k = 0; k < 16; ++k) { const int c = wave + 8 * k; const size_t row = (size_t)batch * SEQ + c * 64 + lane;
            const float a = ig[k] - bb[k]; const float m_prev = sM[c]; const float M = fmaxf(m_prev, scan_max(a, lane));
            gtab[row * 4 + head] = (f32x4){a, M, expf(m_prev - M), expf(-(bb[k] + M))}; }
        __syncthreads();
    }
    const int vb2 = (blockIdx.x + G - (96 % G)) % G;
    for (int s = vb2 * 8 + wave; s < DB * 4; s += G * 8) {
        const int b_ = s >> 2, head = s & 3; const bool valid = lane < 32; const size_t row = (size_t)MP + b_ * 32 + (lane & 31);
        const float ig = gates[row * 8 + head], fg = gates[row * 8 + 4 + head]; const float m_prev = p.in[5][s];
        const float b = scan_sum(valid ? logsigmoid(fg) : 0.f, lane); const float a = valid ? ig - b : -1e30f;
        const float M = fmaxf(m_prev, scan_max(a, lane));
        if (valid) gtab[row * 4 + head] = (f32x4){a, M, expf(m_prev - M), expf(-(b + M))};
        if (lane == 31) p.out[O_MS + s] = b + M;
    }
}

constexpr int L_Q = 0, L_K = 17408, L_KW = 34816, L_V = 52224, L_CT = 69632, L_S = 104448, L_G = 113664, L_H = 116512;
constexpr int LDS_XB = 152000, LDS_TOTAL = 152064;
typedef short s16x4 __attribute__((ext_vector_type(4)));
__device__ __forceinline__ bf16x8 ldfrag_tr(LAS const unsigned char* base, int row0, int col0, int lane) {
    const int g = lane >> 4, q = (lane & 15) >> 2, pp = lane & 3;
    LAS const unsigned char* a = base + (row0 + 8 * g + q) * 272 + (col0 + 4 * pp) * 2;
    const s16x4 lo = __builtin_amdgcn_ds_read_tr16_b64_v4i16((LAS s16x4*)a);
    const s16x4 hi = __builtin_amdgcn_ds_read_tr16_b64_v4i16((LAS s16x4*)(a + 4 * 272));
    return __builtin_shufflevector(lo, hi, 0, 1, 2, 3, 4, 5, 6, 7);
}

template <bool FULL>
__device__ __forceinline__ void mlstm_run(const Params& p, LAS unsigned char* lds, f32x4 (&accC)[2][4], f32x4 (&accN)[2], int row0, int head, int nch, int L) {
    const int tid = fresh_tid(), lane = tid & 63, wave = __builtin_amdgcn_readfirstlane(tid >> 6), l15 = lane & 15, l4 = lane >> 4, st = wave & 3, tp = wave >> 2;
    const bf16_t* proj = (const bf16_t*)(p.ws + WS_PROJ); const f32x4* gtab = (const f32x4*)(p.ws + WS_GTAB);
    bf16_t* mix = (bf16_t*)(p.ws + WS_MIX);
    LAS unsigned short* sQ = (LAS unsigned short*)(lds + L_Q); LAS unsigned short* sK = (LAS unsigned short*)(lds + L_K);
    LAS unsigned short* sKW = (LAS unsigned short*)(lds + L_KW); LAS unsigned short* sV = (LAS unsigned short*)(lds + L_V);
    LAS unsigned short* sS = (LAS unsigned short*)(lds + L_S); LAS float* sH = (LAS float*)(lds + L_H);
    LAS float* gA = (LAS float*)(lds + L_G); LAS float* gM = gA + 64; LAS float* gDec = gA + 128; LAS float* gEinv = gA + 192; LAS float* gW = gA + 256;
    LAS float* gQn = gA + 320; LAS float* gDi = gA + 384; LAS float* gN = gA + 448; LAS float* scal = gA + 576; LAS float* gNg = gA + 584;
    const bf16x8 ones = (bf16x8){0x3F80, 0x3F80, 0x3F80, 0x3F80, 0x3F80, 0x3F80, 0x3F80, 0x3F80};
    const int tok0 = tid >> 4, dsg = tid & 15;
    const int orow = tid >> 3, oseg = tid & 7;
    u32x4 kq[2], kk[2], kv[2]; f32x4 pgt = (f32x4){0.f, 0.f, 0.f, 0.f}; float pa[2] = {-1e30f, -1e30f}, pml = 0.f;
    if (FULL && tid < 128) gNg[tid] = p.in[12][head * 128 + tid];
#pragma unroll
    for (int i = 0; i < 2; ++i) { const int tok = tok0 + 32 * i; const bool valid = tok < L; const u32x4 z = (u32x4){0u, 0u, 0u, 0u};
        const bf16_t* src = proj + (size_t)(row0 + tok) * NPROJ + head * 128 + dsg * 8;
        kk[i] = valid ? *(const u32x4*)(src + 1024) : z; kv[i] = valid ? *(const u32x4*)(src + 1536) : z;
        if (FULL) kq[i] = valid ? *(const u32x4*)(src + 512) : z; else kq[i] = z; }
    if (wave == 0 && lane < L) pgt = gtab[(size_t)(row0 + lane) * 4 + head];
    { const float* gf = (const float*)gtab; pml = gf[((size_t)(row0 + L - 1) * 4 + head) * 4 + 1];
#pragma unroll
      for (int i = 0; i < 2; ++i) { const int tok = tok0 + 32 * i; if (tok < L) pa[i] = gf[((size_t)(row0 + tok) * 4 + head) * 4]; } }
#pragma unroll 1
    for (int c = 0; c < nch; ++c) {
        const int r0 = row0 + c * 64;
        if (wave == 0) {
            const bool valid = lane < L; const float a = valid ? pgt[0] : -1e30f; const float Ml = __shfl(pgt[1], L - 1);
            gA[lane] = a; gM[lane] = valid ? pgt[1] : Ml; gDec[lane] = valid ? pgt[2] : 0.f; gEinv[lane] = valid ? pgt[3] : 1.f;
            if (lane == L - 1) scal[0] = pgt[2];
        }
        if (FULL) {
#pragma unroll
            for (int i = 0; i < 2; ++i)
#pragma unroll
                for (int n = 0; n < 4; ++n) { u32x2 w; w.x = pk2(accC[i][n][0], accC[i][n][1]); w.y = pk2(accC[i][n][2], accC[i][n][3]);
                    *(LAS u32x2*)(lds + L_CT + (64 * tp + 16 * n + l15) * 272 + (32 * st + 16 * i + 4 * l4) * 2) = w; }
            if (tp == 0 && l15 == 0) {
#pragma unroll
                for (int i = 0; i < 2; ++i) *(LAS f32x4*)(gN + 32 * st + 16 * i + 4 * l4) = accN[i]; }
        }
#pragma unroll
        for (int i = 0; i < 2; ++i) { const int tok = tok0 + 32 * i;
            if (FULL) { *(LAS u32x4*)(sQ + tok * 136 + dsg * 8) = kq[i]; *(LAS u32x4*)(sK + tok * 136 + dsg * 8) = kk[i]; }
            *(LAS u32x4*)(sV + tok * 136 + dsg * 8) = kv[i];
            const float w = __expf(pa[i] - pml); u32x4 o;
            o.x = pk2(bflo(kk[i].x) * w, bfhi(kk[i].x) * w); o.y = pk2(bflo(kk[i].y) * w, bfhi(kk[i].y) * w);
            o.z = pk2(bflo(kk[i].z) * w, bfhi(kk[i].z) * w); o.w = pk2(bflo(kk[i].w) * w, bfhi(kk[i].w) * w);
            *(LAS u32x4*)(sKW + tok * 136 + dsg * 8) = o; }
        LDS_BARRIER();
        if (c + 1 < nch) {
#pragma unroll
            for (int i = 0; i < 2; ++i) { const int tok = tok0 + 32 * i;
                const bf16_t* src = proj + (size_t)(r0 + 64 + tok) * NPROJ + head * 128 + dsg * 8;
                kk[i] = *(const u32x4*)(src + 1024); kv[i] = *(const u32x4*)(src + 1536);
                if (FULL) kq[i] = *(const u32x4*)(src + 512); }
            if (wave == 0) pgt = gtab[(size_t)(r0 + 64 + lane) * 4 + head];
            { const float* gf = (const float*)gtab; pml = gf[((size_t)(r0 + 64 + L - 1) * 4 + head) * 4 + 1];
#pragma unroll
              for (int i = 0; i < 2; ++i) pa[i] = gf[((size_t)(r0 + 64 + tok0 + 32 * i) * 4 + head) * 4]; }
        }
        f32x4 nacc[4];
#pragma unroll
        for (int n = 0; n < 4; ++n) nacc[n] = (f32x4){0.f, 0.f, 0.f, 0.f};
        if (FULL) {
            f32x4 sacc[2]; sacc[0] = (f32x4){0.f, 0.f, 0.f, 0.f}; sacc[1] = sacc[0];
#pragma unroll
            for (int ks = 0; ks < 4; ++ks) { const int kb = (32 * ks + 8 * l4) * 2;
                const bf16x8 a = ldfrag(lds + L_K, 16 * st + l15, 272, kb);
#pragma unroll
                for (int tt = 0; tt < 2; ++tt) { const bf16x8 b = ldfrag(lds + L_Q, 16 * (2 * tp + tt) + l15, 272, kb); sacc[tt] = MFMA16(a, b, sacc[tt]); } }
#pragma unroll
            for (int tt = 0; tt < 2; ++tt) { const int t = 16 * (2 * tp + tt) + l15; const float Mt = gM[t]; float dv[4];
#pragma unroll
                for (int j = 0; j < 4; ++j) { const int s = 16 * st + 4 * l4 + j; dv[j] = (s <= t) ? sacc[tt][j] * __expf(gA[s] - Mt) : 0.f; }
                u32x2 w; w.x = pk2(dv[0], dv[1]); w.y = pk2(dv[2], dv[3]); *(LAS u32x2*)(lds + L_S + t * 144 + (16 * st + 4 * l4) * 2) = w; }
#pragma unroll
            for (int ks = 0; ks < 4; ++ks) { const int kb = (32 * ks + 8 * l4) * 2;
                const bf16x8 a = ldfrag(lds + L_Q, 16 * st + l15, 272, kb);
#pragma unroll
                for (int n = 0; n < 4; ++n) { const bf16x8 b = ldfrag(lds + L_CT, 64 * tp + 16 * n + l15, 272, kb); nacc[n] = MFMA16(a, b, nacc[n]); } }
#pragma unroll
            for (int j = 0; j < 4; ++j) { const float dj = gDec[16 * st + 4 * l4 + j];
#pragma unroll
                for (int n = 0; n < 4; ++n) nacc[n][j] *= dj; }
            { float s = 0.f;
              const u32x4 q0 = *(LAS const u32x4*)(sQ + orow * 136 + oseg * 16), q1 = *(LAS const u32x4*)(sQ + orow * 136 + oseg * 16 + 8);
              const unsigned qw[8] = {q0.x, q0.y, q0.z, q0.w, q1.x, q1.y, q1.z, q1.w};
#pragma unroll
              for (int e = 0; e < 8; ++e) s += bflo(qw[e]) * gN[oseg * 16 + 2 * e] + bfhi(qw[e]) * gN[oseg * 16 + 2 * e + 1];
              s += __shfl_xor(s, 1); s += __shfl_xor(s, 2); s += __shfl_xor(s, 4);
              if (oseg == 0) gQn[orow] = s; }
        }
        if (FULL) LDS_BARRIER();
        if (FULL) {
            const u32x4 s0 = *(LAS const u32x4*)(sS + orow * 72 + oseg * 8);
            float s = (bflo(s0.x) + bfhi(s0.x)) + (bflo(s0.y) + bfhi(s0.y)) + (bflo(s0.z) + bfhi(s0.z)) + (bflo(s0.w) + bfhi(s0.w));
            s += __shfl_xor(s, 1); s += __shfl_xor(s, 2); s += __shfl_xor(s, 4);
            if (oseg == 0) { const float den = gDec[orow] * gQn[orow] + s; gDi[orow] = __builtin_amdgcn_rcpf(fmaxf(fabsf(den), gEinv[orow])); } }
        const float wsv = scal[0];
#pragma unroll
        for (int i = 0; i < 2; ++i) { accN[i] *= wsv;
#pragma unroll
            for (int n = 0; n < 4; ++n) accC[i][n] *= wsv; }
#pragma unroll
        for (int ks = 0; ks < 2; ++ks) { bf16x8 bv[4];
#pragma unroll
            for (int n = 0; n < 4; ++n) bv[n] = ldfrag_tr(lds + L_V, 32 * ks, 64 * tp + 16 * n, lane);
            if (FULL) { const bf16x8 a = ldfrag(lds + L_S, 16 * st + l15, 144, (32 * ks + 8 * l4) * 2);
#pragma unroll
                for (int n = 0; n < 4; ++n) nacc[n] = MFMA16(a, bv[n], nacc[n]); }
#pragma unroll
            for (int i = 0; i < 2; ++i) { const bf16x8 a = ldfrag_tr(lds + L_KW, 32 * ks, 32 * st + 16 * i, lane);
                accN[i] = MFMA16(a, ones, accN[i]);
#pragma unroll
                for (int n = 0; n < 4; ++n) accC[i][n] = MFMA16(a, bv[n], accC[i][n]); } }
        LDS_BARRIER();
        if (FULL) {
            u32x4 ow0 = (u32x4){0u, 0u, 0u, 0u}, ow1 = ow0;
            if (orow < L) { const bf16_t* op = proj + (size_t)(r0 + orow) * NPROJ + 2048 + head * 128 + oseg * 16; ow0 = *(const u32x4*)op; ow1 = *(const u32x4*)(op + 8); }
#pragma unroll
            for (int j = 0; j < 4; ++j) { const int t = 16 * st + 4 * l4 + j; const float di = gDi[t];
#pragma unroll
                for (int n = 0; n < 4; ++n) sH[t * 132 + 64 * tp + 16 * n + l15] = nacc[n][j] * di; }
            LDS_BARRIER();
            if (orow < L) {
                f32x4 x[4]; float s = 0.f;
#pragma unroll
                for (int e = 0; e < 4; ++e) { x[e] = *(LAS const f32x4*)(sH + orow * 132 + oseg * 16 + 4 * e); s += (x[e][0] + x[e][1]) + (x[e][2] + x[e][3]); }
                s += __shfl_xor(s, 1); s += __shfl_xor(s, 2); s += __shfl_xor(s, 4);
                const float mean = s * (1.0f / 128.0f); float q = 0.f;
#pragma unroll
                for (int e = 0; e < 4; ++e) { x[e] -= mean; q += (x[e][0] * x[e][0] + x[e][1] * x[e][1]) + (x[e][2] * x[e][2] + x[e][3] * x[e][3]); }
                q += __shfl_xor(q, 1); q += __shfl_xor(q, 2); q += __shfl_xor(q, 4);
                const float rstd = rsqrtf(q * (1.0f / 128.0f) + LN_EPS);
                const unsigned owv[8] = {ow0.x, ow0.y, ow0.z, ow0.w, ow1.x, ow1.y, ow1.z, ow1.w}; unsigned ov[8];
#pragma unroll
                for (int e = 0; e < 4; ++e) { const f32x4 g = *(LAS const f32x4*)(gNg + oseg * 16 + 4 * e);
                    const float y0 = x[e][0] * rstd * g[0] * fsigmoid(bflo(owv[2 * e])), y1 = x[e][1] * rstd * g[1] * fsigmoid(bfhi(owv[2 * e]));
                    const float y2 = x[e][2] * rstd * g[2] * fsigmoid(bflo(owv[2 * e + 1])), y3 = x[e][3] * rstd * g[3] * fsigmoid(bfhi(owv[2 * e + 1]));
                    ov[2 * e] = pk2(y0, y1); ov[2 * e + 1] = pk2(y2, y3); }
                bf16_t* mp = mix + (size_t)(r0 + orow) * DM + 512 + head * 128 + oseg * 16;
                *(u32x4*)mp = (u32x4){ov[0], ov[1], ov[2], ov[3]}; *(u32x4*)(mp + 8) = (u32x4){ov[4], ov[5], ov[6], ov[7]};
            }
        }
    }
    LDS_BARRIER();
}

constexpr int L_PW = 34816, L_PU = 69632;
template <int W>
__device__ __forceinline__ void pool_diff(LAS unsigned char* lds, bool sample, int tilepos0) {
    const int tid = fresh_tid(), co = tid & 15, t0 = (tid >> 4) * 4;
#pragma unroll 1
    for (int tt = 0; tt < 4; ++tt) {
        const int t = t0 + tt; const int sgi = sample ? (t >> 5) : 0, lt = sample ? (t & 31) : t;
        const int rowbase = sample ? sgi * 47 + 15 + lt : 15 + t;
        const int cnt = sample ? W : min(tilepos0 + t + 1, W);
        float sum[8];
#pragma unroll
        for (int e = 0; e < 8; ++e) sum[e] = 0.f;
        u32x4 x0 = (u32x4){0u, 0u, 0u, 0u};
#pragma unroll
        for (int j = 0; j < W; ++j) { const u32x4 r = *(LAS const u32x4*)(lds + L_PU + (rowbase - j) * 272 + co * 16); if (j == 0) x0 = r;
            sum[0] += bflo(r.x); sum[1] += bfhi(r.x); sum[2] += bflo(r.y); sum[3] += bfhi(r.y); sum[4] += bflo(r.z); sum[5] += bfhi(r.z); sum[6] += bflo(r.w); sum[7] += bfhi(r.w); }
        const float inv = 1.0f / (float)cnt;
        u32x4 w; w.x = pk2(sum[0] * inv - bflo(x0.x), sum[1] * inv - bfhi(x0.x)); w.y = pk2(sum[2] * inv - bflo(x0.y), sum[3] * inv - bfhi(x0.y));
        w.z = pk2(sum[4] * inv - bflo(x0.z), sum[5] * inv - bfhi(x0.z)); w.w = pk2(sum[6] * inv - bflo(x0.w), sum[7] * inv - bfhi(x0.w));
        *(LAS u32x4*)(lds + t * 272 + co * 16) = w; }
}

__device__ __forceinline__ void pool_fetch(const Params& p, int item, int tid, u32x4 (&pf)[6]) {
    const int g = item & 3, R0 = (item >> 2) * 128;
    const bf16_t* proj = (const bf16_t*)(p.ws + WS_PROJ); const float* hist = p.in[2];
    if (R0 < MP) {
        const int seqrow0 = (R0 / SEQ) * SEQ, tilepos0 = R0 - seqrow0;
        u32x4 raw[6];
#pragma unroll
        for (int i = 0; i < 6; ++i) { const int piece = tid + 512 * i, e = piece >> 4, seg = piece & 15; int pos = tilepos0 - 15 + (e < 143 ? e : 142); pos = pos < 0 ? 0 : pos;
            raw[i] = *(const u32x4*)(proj + (size_t)(seqrow0 + pos) * NPROJ + g * 128 + seg * 8); }
#pragma unroll
        for (int i = 0; i < 6; ++i) { const int piece = tid + 512 * i, e = piece >> 4; const bool valid = (e < 143) && (tilepos0 - 15 + e >= 0);
            pf[i] = valid ? raw[i] : (u32x4){0u, 0u, 0u, 0u}; }
    } else {
#pragma unroll
        for (int i = 0; i < 6; ++i) { const int piece = tid + 512 * i, e = piece >> 4, seg = piece & 15; u32x4 val = (u32x4){0u, 0u, 0u, 0u};
            if (e < 188) { const int sgi = e / 47, le = e - sgi * 47, b = ((R0 - MP) >> 5) + sgi;
                if (le < 15) { const float* hp = hist + ((size_t)b * 15 + le) * 512 + g * 128 + seg * 8; const float4 a = *(const float4*)hp, c4 = *(const float4*)(hp + 4);
                    val.x = pk2(a.x, a.y); val.y = pk2(a.z, a.w); val.z = pk2(c4.x, c4.y); val.w = pk2(c4.z, c4.w); }
                else val = *(const u32x4*)(proj + (size_t)(MP + b * 32 + le - 15) * NPROJ + g * 128 + seg * 8); }
            pf[i] = val; }
    }
}

__device__ __forceinline__ void pool_loop(const Params& p, LAS unsigned char* lds, int first, int stride, int end) {
    const int tid = fresh_tid(), lane = tid & 63, wave = __builtin_amdgcn_readfirstlane(tid >> 6), l15 = lane & 15, l4 = lane >> 4, st = wave & 3, tp = wave >> 2;
    bf16_t* mix = (bf16_t*)(p.ws + WS_MIX); const float* pscale = p.in[11];
    if (first >= end) return;
    u32x4 pf[6]; pool_fetch(p, first, tid, pf);
    int gw = -1;
#pragma unroll 1
    for (int item = first; item < end; item += stride) {
        const int g = item & 3, R0 = (item >> 2) * 128;
        const bool sample = R0 >= MP; const int tilepos0 = sample ? 0 : R0 - (R0 / SEQ) * SEQ;
        if (g != gw) { const bf16_t* Wp = (const bf16_t*)(p.ws + WS_WPOOL) + g * 16384; gw = g;
#pragma unroll
            for (int i = 0; i < 4; ++i) { const int piece = tid + 512 * i, row = piece >> 4, seg = piece & 15;
                *(LAS u32x4*)(lds + L_PW + row * 272 + seg * 16) = *(const u32x4*)(Wp + row * 128 + seg * 8); } }
#pragma unroll
        for (int i = 0; i < 6; ++i) { const int piece = tid + 512 * i, e = piece >> 4, seg = piece & 15; if (e < 188) *(LAS u32x4*)(lds + L_PU + e * 272 + seg * 16) = pf[i]; }
        LDS_BARRIER();
        if (item + stride < end) pool_fetch(p, item + stride, tid, pf);
        if (g == 0) pool_diff<2>(lds, sample, tilepos0); else if (g == 1) pool_diff<4>(lds, sample, tilepos0); else if (g == 2) pool_diff<8>(lds, sample, tilepos0); else pool_diff<16>(lds, sample, tilepos0);
        LDS_BARRIER();
        f32x4 acc[2][4];
#pragma unroll
        for (int i = 0; i < 2; ++i)
#pragma unroll
            for (int n = 0; n < 4; ++n) acc[i][n] = (f32x4){0.f, 0.f, 0.f, 0.f};
#pragma unroll
        for (int ks = 0; ks < 4; ++ks) { const int kb = (32 * ks + 8 * l4) * 2; bf16x8 bv[4];
#pragma unroll
            for (int n = 0; n < 4; ++n) bv[n] = ldfrag(lds, 64 * tp + 16 * n + l15, 272, kb);
#pragma unroll
            for (int i = 0; i < 2; ++i) { const bf16x8 a = ldfrag(lds + L_PW, 32 * st + 16 * i + l15, 272, kb);
#pragma unroll
                for (int n = 0; n < 4; ++n) acc[i][n] = MFMA16(a, bv[n], acc[i][n]); } }
        LDS_BARRIER();
#pragma unroll
        for (int i = 0; i < 2; ++i) { const int d0 = 32 * st + 16 * i + 4 * l4; const float4 ps = *(const float4*)(pscale + g * 128 + d0);
#pragma unroll
            for (int n = 0; n < 4; ++n) { const int t = 64 * tp + 16 * n + l15;
                u32x2 w; w.x = pk2(acc[i][n][0] * ps.x, acc[i][n][1] * ps.y); w.y = pk2(acc[i][n][2] * ps.z, acc[i][n][3] * ps.w);
                *(LAS u32x2*)(lds + t * 272 + d0 * 2) = w; } }
        LDS_BARRIER();
        { const int t = tid >> 2, sg = tid & 3; const u32x4 o0 = *(LAS const u32x4*)(lds + t * 272 + sg * 64), o1 = *(LAS const u32x4*)(lds + t * 272 + sg * 64 + 16),
            o2 = *(LAS const u32x4*)(lds + t * 272 + sg * 64 + 32), o3 = *(LAS const u32x4*)(lds + t * 272 + sg * 64 + 48);
          bf16_t* mp = mix + (size_t)(R0 + t) * DM + g * 128 + sg * 32; *(u32x4*)mp = o0; *(u32x4*)(mp + 8) = o1; *(u32x4*)(mp + 16) = o2; *(u32x4*)(mp + 24) = o3; }
    }
    LDS_BARRIER();
}

constexpr int N_S2 = 224, N_SMP = 128, N_POOL = (MT / 128) * 4;

__device__ __forceinline__ void phase2(const Params& p, LAS unsigned char* lds, int kinds) {
    const int tid = fresh_tid(), lane = tid & 63, wave = tid >> 6, l15 = lane & 15, l4 = lane >> 4, st = wave & 3, tp = wave >> 2;
    float* Dst = (float*)(p.ws + WS_DST); float* Dn = (float*)(p.ws + WS_DN); const float* mtab = (const float*)(p.ws + WS_MTAB);
    for (int it = blockIdx.x; it < N_S2 + N_SMP; it += gridDim.x) {
        if (it < N_S2) {
            if (!(kinds & 1)) continue;
            const int chain = it / 7, sc = it % 7, batch = chain >> 2, head = chain & 3;
            f32x4 accC[2][4], accN[2];
#pragma unroll
            for (int i = 0; i < 2; ++i) { accN[i] = (f32x4){0.f, 0.f, 0.f, 0.f};
#pragma unroll
                for (int n = 0; n < 4; ++n) accC[i][n] = (f32x4){0.f, 0.f, 0.f, 0.f}; }
            mlstm_run<false>(p, lds, accC, accN, batch * SEQ + sc * SCN * 64, head, SCN, 64);
            { float* dp = Dst + ((size_t)it * 512 + tid) * 32;
#pragma unroll
              for (int i = 0; i < 2; ++i)
#pragma unroll
                  for (int n = 0; n < 4; ++n) *(f32x4*)(dp + (i * 4 + n) * 4) = accC[i][n]; }
            if (tp == 0 && l15 == 0) {
#pragma unroll
                for (int i = 0; i < 2; ++i) *(f32x4*)(Dn + it * 128 + 32 * st + 16 * i + 4 * l4) = accN[i]; }
        } else {
            if (!(kinds & 2)) continue;
            const int s = it - N_S2, b = s >> 2, head = s & 3;
            const float* C0 = p.in[3] + (size_t)s * 16384; f32x4 accC[2][4], accN[2];
#pragma unroll
            for (int i = 0; i < 2; ++i) accN[i] = *(const f32x4*)(p.in[4] + s * 128 + 32 * st + 16 * i + 4 * l4);
#pragma unroll
            for (int i = 0; i < 2; ++i)
#pragma unroll
                for (int n = 0; n < 4; ++n)
#pragma unroll
                    for (int j = 0; j < 4; ++j) accC[i][n][j] = C0[(32 * st + 16 * i + 4 * l4 + j) * 128 + 64 * tp + 16 * n + l15];
            mlstm_run<true>(p, lds, accC, accN, MP + b * 32, head, 1, 32);
            float* Co = p.out + O_CS + (size_t)s * 16384;
#pragma unroll
            for (int i = 0; i < 2; ++i)
#pragma unroll
                for (int n = 0; n < 4; ++n)
#pragma unroll
                    for (int j = 0; j < 4; ++j) Co[(32 * st + 16 * i + 4 * l4 + j) * 128 + 64 * tp + 16 * n + l15] = accC[i][n][j];
            if (tp == 0 && l15 == 0) {
#pragma unroll
                for (int i = 0; i < 2; ++i) *(f32x4*)(p.out + O_NS + s * 128 + 32 * st + 16 * i + 4 * l4) = accN[i]; }
        }
    }
    if (kinds & 4) { const int G = gridDim.x; int first = blockIdx.x; while (first < N_S2 + N_SMP) first += G;
        pool_loop(p, lds, first - N_S2 - N_SMP, G, N_POOL); }
    const bf16_t* proj = (const bf16_t*)(p.ws + WS_PROJ);
    for (int idx = blockIdx.x * 512 + tid; idx < (NB + DB) * 15 * 512; idx += gridDim.x * 512) {
        if (idx < NB * 7680) { const int b = idx / 7680, rem = idx % 7680, i = rem >> 9, c = rem & 511;
            p.out[O_POOLP + idx] = bf2f(proj[(size_t)(b * SEQ + SEQ - 15 + i) * NPROJ + c]); }
        else { const int id2 = idx - NB * 7680, b = id2 / 7680, rem = id2 % 7680, i = rem >> 9, c = rem & 511;
            p.out[O_POOLS + id2] = bf2f(proj[(size_t)(MP + b * 32 + 17 + i) * NPROJ + c]); }
    }
}

__device__ __forceinline__ void phase3(const Params& p, LAS unsigned char* lds) {
    const int tid = fresh_tid(), lane = tid & 63, wave = tid >> 6, l15 = lane & 15, l4 = lane >> 4, st = wave & 3, tp = wave >> 2;
    const float* Dst = (const float*)(p.ws + WS_DST); const float* Dn = (const float*)(p.ws + WS_DN);
    const float* mtab = (const float*)(p.ws + WS_MTAB); const float* btab = (const float*)(p.ws + WS_BTAB);
    for (int it = blockIdx.x; it < 256; it += gridDim.x) {
        const int chain = it >> 3, sc = it & 7, batch = chain >> 2, head = chain & 3;
        f32x4 accC[2][4], accN[2];
#pragma unroll
        for (int i = 0; i < 2; ++i) { accN[i] = (f32x4){0.f, 0.f, 0.f, 0.f};
#pragma unroll
            for (int n = 0; n < 4; ++n) accC[i][n] = (f32x4){0.f, 0.f, 0.f, 0.f}; }
        f32x4 dC[2][4], dN[2];
        if (sc > 0) {
#pragma unroll
            for (int i = 0; i < 2; ++i) { dN[i] = *(const f32x4*)(Dn + (chain * 7) * 128 + 32 * st + 16 * i + 4 * l4);
#pragma unroll
                for (int n = 0; n < 4; ++n) dC[i][n] = *(const f32x4*)(Dst + ((size_t)(chain * 7) * 512 + tid) * 32 + (i * 4 + n) * 4); } }
#pragma unroll 1
        for (int j = 0; j < sc; ++j) {
            float Bs = 0.f;
            for (int c = 0; c < SCN; ++c) Bs += btab[chain * 128 + j * SCN + c];
            const float Wj = expf(Bs + mtab[chain * 132 + j * SCN] - mtab[chain * 132 + (j + 1) * SCN]);
#pragma unroll
            for (int i = 0; i < 2; ++i) { accN[i] = Wj * accN[i] + dN[i];
#pragma unroll
                for (int n = 0; n < 4; ++n) accC[i][n] = Wj * accC[i][n] + dC[i][n]; }
            if (j + 1 < sc) { const int item = chain * 7 + j + 1;
#pragma unroll
                for (int i = 0; i < 2; ++i) { dN[i] = *(const f32x4*)(Dn + item * 128 + 32 * st + 16 * i + 4 * l4);
#pragma unroll
                    for (int n = 0; n < 4; ++n) dC[i][n] = *(const f32x4*)(Dst + ((size_t)item * 512 + tid) * 32 + (i * 4 + n) * 4); } }
        }
        mlstm_run<true>(p, lds, accC, accN, batch * SEQ + sc * SCN * 64, head, SCN, 64);
        if (sc == 7) {
            const int t2 = fresh_tid(), l15b = t2 & 15, l4b = (t2 >> 4) & 3, stb = (t2 >> 6) & 3, tpb = t2 >> 8;
            float* Co = p.out + O_CP + (size_t)chain * 16384 + (32 * stb + 4 * l4b) * 128 + 64 * tpb + l15b;
#pragma unroll
            for (int i = 0; i < 2; ++i)
#pragma unroll
                for (int n = 0; n < 4; ++n)
#pragma unroll
                    for (int j = 0; j < 4; ++j) Co[(16 * i + j) * 128 + 16 * n] = accC[i][n][j];
            if (tpb == 0 && l15b == 0) {
#pragma unroll
                for (int i = 0; i < 2; ++i) *(f32x4*)(p.out + O_NP + chain * 128 + 32 * stb + 16 * i + 4 * l4b) = accN[i]; }
        }
    }
}

template <int S>
__device__ __forceinline__ void ln_load(const bf16_t* src, const float* slab, const bf16_t* hb, int row, int lane, float4 (&v)[4]) {
    if (row >= MP) {
#pragma unroll
        for (int i = 0; i < 4; ++i) { const int c = i * 256 + lane * 4; const u32x2 h2 = *(const u32x2*)(hb + (size_t)row * DM + c);
            const float* sp = slab + (size_t)(row - MP) * DM + c; float4 t[S];
#pragma unroll
            for (int sl = 0; sl < S; ++sl) t[sl] = *(const float4*)(sp + (size_t)sl * (1024 * 1024));
            float4 a = make_float4(ALPHA * bflo(h2.x), ALPHA * bfhi(h2.x), ALPHA * bflo(h2.y), ALPHA * bfhi(h2.y));
#pragma unroll
            for (int sl = 0; sl < S; ++sl) { a.x += t[sl].x; a.y += t[sl].y; a.z += t[sl].z; a.w += t[sl].w; }
            v[i] = a; }
    } else {
#pragma unroll
        for (int i = 0; i < 4; ++i) { const u32x2 r = *(const u32x2*)(src + (size_t)row * DM + i * 256 + lane * 4); v[i] = make_float4(bflo(r.x), bfhi(r.x), bflo(r.y), bfhi(r.y)); } }
}
template <bool TO_BF16, int S>
__device__ __forceinline__ void ln_rows(const bf16_t* src, const float* gam, const float* bet, bf16_t* ob, float* of, const float* slab, const bf16_t* hb) {
    const int tid = fresh_tid(), lane = tid & 63, wave = tid >> 6, stride = gridDim.x * 8;
    int row = blockIdx.x * 8 + wave; float4 v[4];
    if (row < MT) ln_load<S>(src, slab, hb, row, lane, v);
#pragma unroll 1
    for (; row < MT; row += stride) {
        const int nrow = row + stride; float4 nv[4];
        if (nrow < MT) ln_load<S>(src, slab, hb, nrow, lane, nv);
        else {
#pragma unroll
            for (int i = 0; i < 4; ++i) nv[i] = make_float4(0.f, 0.f, 0.f, 0.f); }
        float s = 0.f;
#pragma unroll
        for (int i = 0; i < 4; ++i) s += (v[i].x + v[i].y) + (v[i].z + v[i].w);
        const float mu = wave_sum(s) * (1.0f / DM); float q = 0.f;
#pragma unroll
        for (int i = 0; i < 4; ++i) { v[i].x -= mu; v[i].y -= mu; v[i].z -= mu; v[i].w -= mu; q += (v[i].x * v[i].x + v[i].y * v[i].y) + (v[i].z * v[i].z + v[i].w * v[i].w); }
        const float rstd = rsqrtf(wave_sum(q) * (1.0f / DM) + LN_EPS);
#pragma unroll
        for (int i = 0; i < 4; ++i) { const int c = i * 256 + lane * 4; const float4 gg = *(const float4*)(gam + c), bb = *(const float4*)(bet + c);
            float4 y; y.x = v[i].x * rstd * gg.x + bb.x; y.y = v[i].y * rstd * gg.y + bb.y; y.z = v[i].z * rstd * gg.z + bb.z; y.w = v[i].w * rstd * gg.w + bb.w;
            if (TO_BF16) { u32x2 w; w.x = pk2(y.x, y.y); w.y = pk2(y.z, y.w); *(u32x2*)(ob + (size_t)row * DM + c) = w; }
            else *(float4*)(of + (size_t)row * DM + c) = y; }
#pragma unroll
        for (int i = 0; i < 4; ++i) v[i] = nv[i];
    }
}

__global__ void __launch_bounds__(512) fwd_mega(Params p) {
    extern __shared__ __attribute__((aligned(16))) unsigned char smem[];
    LAS unsigned char* lds = (LAS unsigned char*)smem;
    cg::grid_group grid = cg::this_grid();
    volatile LAS unsigned* stw = (volatile LAS unsigned*)(lds + LDS_XB);
    if (threadIdx.x == 0) { stw[0] = 0u; stw[1] = 0u; }
    __syncthreads();
    const XcdBarrier xbar = xcd_barrier_post((unsigned*)(p.ws + WS_BAR), stw);
    unsigned char* ws = p.ws;
    bf16_t* h0 = (bf16_t*)(ws + WS_H0); bf16_t* proj = (bf16_t*)(ws + WS_PROJ); bf16_t* mix = (bf16_t*)(ws + WS_MIX); bf16_t* act = (bf16_t*)(ws + WS_ACT);
    float* slab = (float*)(ws + WS_SLAB);
    const int G = gridDim.x, bx = blockIdx.x;
#ifndef DBL
#define DBL 0
#endif
    if (DBL & 0x800) { for (int i = 0; i < 10; ++i) xcd_barrier(xbar); }
    if (DBL & 1) { phase0(p, lds); xcd_barrier(xbar); }
    phase0(p, lds);
    grid.sync();
    gate_scan(p, lds);
    for (int rep_ = 0; rep_ < ((DBL & 0x1000) ? 2 : 1); ++rep_)
    { if (rep_) xcd_barrier(xbar); pg8::Gemm g{h0, (const bf16_t*)(ws + WS_WIN), MT, NPROJ, DM}; SplitOrder S; S.init(NPROJ, DM / 64, 1, G, bx);
      EpiBf16B e{proj, NPROJ, (const float*)(ws + WS_BIAS)}; pg8::gemm_phase(lds, g, S, e); }
    xcd_barrier(xbar);
    if (DBL & 4) { phase2(p, lds, 15); xcd_barrier(xbar); }
    if (DBL & 0x200) { phase2(p, lds, 4); xcd_barrier(xbar); }
    if (DBL & 0x400) { phase2(p, lds, 1); xcd_barrier(xbar); }
    phase2(p, lds, 15);
    xcd_barrier(xbar);
    if (DBL & 8) { phase3(p, lds); xcd_barrier(xbar); }
    phase3(p, lds);
    xcd_barrier(xbar);
    for (int rep_ = 0; rep_ < ((DBL & 0x2000) ? 2 : 1); ++rep_)
    { if (rep_) xcd_barrier(xbar); pg8::Gemm g{mix, (const bf16_t*)(ws + WS_WOUT), MT, DM, DM}; SplitOrder S; S.init(DM, DM / 64, 4, G, bx);
      EpiRes e{h0, (bf16_t*)(ws + WS_R1), slab, DM / 64}; pg8::gemm_phase(lds, g, S, e); }
    xcd_barrier(xbar);
    if (DBL & 32) { ln_rows<true, 4>((const bf16_t*)(ws + WS_R1), p.in[14], p.in[15], h0, nullptr, slab, h0); xcd_barrier(xbar); }
    ln_rows<true, 4>((const bf16_t*)(ws + WS_R1), p.in[14], p.in[15], h0, nullptr, slab, h0);
    xcd_barrier(xbar);
    for (int rep_ = 0; rep_ < ((DBL & 0x4000) ? 2 : 1); ++rep_)
    { if (rep_) xcd_barrier(xbar); pg8::Gemm g{h0, (const bf16_t*)(ws + WS_WGU), MT, 2 * DFF, DM}; SplitOrder S; S.init(2 * DFF, DM / 64, 1, G, bx);
      EpiSwiglu e{act}; pg8::gemm_phase(lds, g, S, e); }
    xcd_barrier(xbar);
    for (int rep_ = 0; rep_ < ((DBL & 0x8000) ? 2 : 1); ++rep_)
    { if (rep_) xcd_barrier(xbar); pg8::Gemm g{act, (const bf16_t*)(ws + WS_WDN), MT, DM, DFF}; SplitOrder S; S.init(DM, DFF / 64, 11, G, bx);
      EpiRes e{h0, (bf16_t*)(ws + WS_R2), slab, DFF / 64}; pg8::gemm_phase(lds, g, S, e); }
    xcd_barrier(xbar);
    if (DBL & 0x10000) { ln_rows<false, 11>((const bf16_t*)(ws + WS_R2), p.in[19], p.in[20], nullptr, p.out + O_Y, slab, h0); xcd_barrier(xbar); }
    ln_rows<false, 11>((const bf16_t*)(ws + WS_R2), p.in[19], p.in[20], nullptr, p.out + O_Y, slab, h0);
}

extern "C" void kernel_launch(void* const* d_in, const int* in_sizes, int n_in, void* d_out, int out_size, void* d_ws, size_t ws_size, hipStream_t stream) {
    constexpr size_t kDynLds = LDS_TOTAL;
    static int grid_blocks = 0;
    if (!grid_blocks) {
        if (n_in != 21 || (size_t)out_size != O_END || ws_size < WS_END3) { fprintf(stderr, "kernel_launch: unexpected shapes: n_in %d out %d ws %zu (need %zu)\n", n_in, out_size, ws_size, (size_t)WS_END3); grid_blocks = -1; return; }
        int dev = 0, cus = 0, per_cu = 0;
        hipGetDevice(&dev);
        hipDeviceGetAttribute(&cus, hipDeviceAttributeMultiprocessorCount, dev);
        if (hipFuncSetAttribute((const void*)fwd_mega, hipFuncAttributeMaxDynamicSharedMemorySize, (int)kDynLds) != hipSuccess) { fprintf(stderr, "kernel_launch: hipFuncSetAttribute failed\n"); grid_blocks = -1; return; }
        if (hipOccupancyMaxActiveBlocksPerMultiprocessor(&per_cu, (const void*)fwd_mega, 512, kDynLds) != hipSuccess || per_cu < 1) { fprintf(stderr, "kernel_launch: occupancy query failed (%d)\n", per_cu); grid_blocks = -1; return; }
        if (per_cu > 1) per_cu = 1;
        grid_blocks = cus * per_cu;
    }
    if (grid_blocks < 0) return;
    if (hipMemsetAsync((char*)d_ws + WS_BAR, 0, XCD_BAR_WORDS * 4, stream) != hipSuccess) { fprintf(stderr, "kernel_launch: memset of the barrier words failed\n"); return; }
    Params p{};
    for (int i = 0; i < 21; ++i) p.in[i] = (const float*)d_in[i];
    p.out = (float*)d_out; p.ws = (unsigned char*)d_ws;
    void* args[] = {&p};
    hipError_t e = hipLaunchCooperativeKernel((const void*)fwd_mega, dim3(grid_blocks), dim3(512), args, kDynLds, stream);
    if (e != hipSuccess) fprintf(stderr, "cooperative launch failed: %s (grid %d)\n", hipGetErrorString(e), grid_blocks);
}
```

```cpp
#include <hip/hip_runtime.h>
#include <hip/hip_cooperative_groups.h>
#include <cstdio>
namespace cg = cooperative_groups;
namespace pg8 {
#define PG8_LAS __attribute__((address_space(3)))
typedef unsigned short bf16_t;
typedef short bf16x8 __attribute__((ext_vector_type(8)));
typedef float f32x4 __attribute__((ext_vector_type(4)));
typedef unsigned u32x4 __attribute__((ext_vector_type(4)));
constexpr int BM = 256, BK = 64, HALF = 128, HTB = HALF * BK * 2  , STAGE_BYTES = 8 * HTB, NXCD = 8, WGM = 8;

__host__ __device__ __forceinline__ int lds_byte(int r, int c) { const int st = (r >> 4) * 2 + (c >> 5), rr = r & 15, cc = c & 31, ob = rr * 64 + cc * 2; return st * 1024 + (ob ^ (((ob >> 9) & 1) << 5)); }
__host__ __device__ __forceinline__ void stage_rc(int b, int& R, int& C) { const int st = b / 1024, sb = b % 1024, swz = sb ^ (((sb >> 9) & 1) << 5); R = (st >> 1) * 16 + swz / 64; C = (st & 1) * 32 + (swz % 64) / 2; }
__host__ __device__ __forceinline__ int perm32(int rho) { const int n = rho >> 4, i = rho & 15; return 8 * (i >> 2) + 4 * n + (i & 3); }

struct Unit { int pm, pn, kt0, nkt; };
struct Gemm { const bf16_t* A; const bf16_t* Bt; int M, N, K; };
struct StaticOrder {
    int nM, nN, nwg, G, c;
    __host__ __device__ void init(int M, int N, int G_, int c_) { nM = M / BM; nN = N / BM; nwg = nM * nN; G = G_; c = c_; }
    __host__ __device__ bool next(int i, Unit& u) const {
        const long L = (long)i * G + c; if (L >= nwg) return false;
        int wgid = (int)L; { const int q = nwg / NXCD, r = nwg % NXCD, xcd = wgid % NXCD, off = wgid / NXCD; wgid = (xcd < r ? xcd * (q + 1) : r * (q + 1) + (xcd - r) * q) + off; }
        const int nig = WGM * nN, gid = wgid / nig, fm = gid * WGM, gsz = (nM - fm) < WGM ? (nM - fm) : WGM;
        u.pm = fm + ((wgid % nig) % gsz); u.pn = (wgid % nig) / gsz; u.kt0 = 0; u.nkt = 0; return true;
    }
    __device__ __forceinline__ void a_ready(const Unit&) const {}
    __device__ __forceinline__ void done(const Unit&) const {}
};
__device__ __forceinline__ unsigned cvt_pk_bf16(float lo, float hi) { unsigned r; asm volatile("v_cvt_pk_bf16_f32 %0, %1, %2" : "=v"(r) : "v"(lo), "v"(hi)); return r; }
template <class Epi, class Sched>
__device__ __forceinline__ void gemm_phase(PG8_LAS unsigned char* lds, const Gemm g, const Sched& S, const Epi& E) {
    int tid_ = threadIdx.x; asm volatile("" : "+v"(tid_)); const int tid = tid_, wid = __builtin_amdgcn_readfirstlane(tid >> 6), lane = tid & 63, wr = wid >> 2, wc = wid & 3, fr = lane & 15, fq = lane >> 4;
    const int K = g.K;
    unsigned voffA[2], voffB[2];
#pragma unroll
    for (int i = 0; i < 2; ++i) { int R, C; stage_rc(tid * 16 + i * 8192, R, C); const int Rb = Epi::PERM ? ((R & ~31) + perm32(R & 31)) : R;
        voffA[i] = (unsigned)(R * K + C) * 2u; voffB[i] = (unsigned)(Rb * K + C) * 2u; }
    const size_t kstep = (size_t)(BK * 2);
    const size_t hstep = (size_t)HALF * K * 2;
    const size_t tstep = 2 * hstep;
    const unsigned ldsw = (unsigned)wid * 1024u;
    const int aoff = lds_byte(wr * 64 + fr, fq * 8), boff = lds_byte(wc * 32 + fr, fq * 8);
#define PG8_SA(b, h) (((b) * 2 + (h)) * HTB)
#define PG8_SB(b, h) ((4 + (b) * 2 + (h)) * HTB)
#define PG8_STAGE(bufoff, gbase, voff) do { _Pragma("unroll") for (int _i = 0; _i < 2; ++_i) \
        __builtin_amdgcn_global_load_lds((const unsigned*)((const char*)(gbase) + (voff)[_i]), (PG8_LAS unsigned*)(lds + (bufoff) + ldsw + _i * 8192), 16, 0, 0); } while (0)
#define PG8_LDA(dst, b, h) do { _Pragma("unroll") for (int m = 0; m < 4; ++m) _Pragma("unroll") for (int k = 0; k < 2; ++k) dst[m][k] = *(const PG8_LAS bf16x8*)(lds + PG8_SA(b, h) + aoff + m * 2048 + k * 1024); } while (0)
#define PG8_LDB(dst, b, h) do { _Pragma("unroll") for (int n = 0; n < 2; ++n) _Pragma("unroll") for (int k = 0; k < 2; ++k) dst[n][k] = *(const PG8_LAS bf16x8*)(lds + PG8_SB(b, h) + boff + n * 2048 + k * 1024); } while (0)
#define PG8_MMA(ai, bj, At, Bt) do { __builtin_amdgcn_s_setprio(1); _Pragma("unroll") for (int m = 0; m < 4; ++m) _Pragma("unroll") for (int n = 0; n < 2; ++n) _Pragma("unroll") for (int k = 0; k < 2; ++k) \
        acc[ai][bj][m][n] = __builtin_amdgcn_mfma_f32_16x16x32_bf16(Bt[n][k], At[m][k], acc[ai][bj][m][n], 0, 0, 0); __builtin_amdgcn_s_setprio(0); } while (0)
#define PG8_WAIT_V(n) asm volatile("s_waitcnt vmcnt(" #n ")" ::: "memory")
#define PG8_WAIT_L(n) asm volatile("s_waitcnt lgkmcnt(" #n ")" ::: "memory")
#define PG8_BAR __builtin_amdgcn_s_barrier()
#define PG8_SCHED __builtin_amdgcn_sched_barrier(0)
    Unit cur, nxt; int ui = 0;
    if (!S.next(0, cur)) return;
    f32x4 acc[2][2][4][2];
#pragma unroll
    for (int a = 0; a < 2; ++a)
#pragma unroll
        for (int b = 0; b < 2; ++b)
#pragma unroll
            for (int m = 0; m < 4; ++m)
#pragma unroll
                for (int n = 0; n < 2; ++n) acc[a][b][m][n] = (f32x4){0.f, 0.f, 0.f, 0.f};
    bf16x8 At[4][2], B0[2][2], B1[2][2];
    const char* cA = (const char*)g.A + (size_t)cur.pm * tstep + (size_t)cur.kt0 * kstep; const char* cB = (const char*)g.Bt + (size_t)cur.pn * tstep + (size_t)cur.kt0 * kstep;
    S.a_ready(cur);
    PG8_STAGE(PG8_SB(0, 0), cB, voffB); PG8_STAGE(PG8_SA(0, 0), cA, voffA); PG8_STAGE(PG8_SB(0, 1), cB + hstep, voffB); PG8_STAGE(PG8_SA(0, 1), cA + hstep, voffA);
    if (wr == 1) PG8_BAR;
    PG8_WAIT_V(4); PG8_BAR;
    PG8_STAGE(PG8_SB(1, 0), cB + kstep, voffB); PG8_STAGE(PG8_SA(1, 0), cA + kstep, voffA); PG8_STAGE(PG8_SB(1, 1), cB + hstep + kstep, voffB);
    PG8_WAIT_V(6); PG8_BAR;
    for (;;) {
        const bool has_next = S.next(ui + 1, nxt);
        const char* nA = has_next ? (const char*)g.A + (size_t)nxt.pm * tstep + (size_t)nxt.kt0 * kstep : cA; const char* nB = has_next ? (const char*)g.Bt + (size_t)nxt.pn * tstep + (size_t)nxt.kt0 * kstep : cB;
        const int nt = cur.nkt;
        for (int t = 0; t < nt; t += 2) {
            const bool last = (t == nt - 2);
            const char* a1 = cA + (size_t)(t + 1) * kstep;
            const char* a2 = last ? nA : cA + (size_t)(t + 2) * kstep; const char* b2 = last ? nB : cB + (size_t)(t + 2) * kstep;
            const char* a3 = a2 + kstep; const char* b3 = b2 + kstep;
            if (last && has_next) S.a_ready(nxt);
            PG8_LDB(B0, 0, 0); PG8_SCHED; PG8_LDA(At, 0, 0); PG8_STAGE(PG8_SA(1, 1), a1 + hstep, voffA);
            PG8_WAIT_L(8); PG8_BAR; PG8_WAIT_L(0); PG8_MMA(0, 0, At, B0); PG8_BAR; PG8_SCHED;
            PG8_LDB(B1, 0, 1); PG8_STAGE(PG8_SB(0, 0), b2, voffB);
            PG8_BAR; PG8_WAIT_L(0); PG8_MMA(0, 1, At, B1); PG8_BAR;
            PG8_LDA(At, 0, 1); PG8_STAGE(PG8_SA(0, 0), a2, voffA);
            PG8_BAR; PG8_WAIT_L(0); PG8_MMA(1, 0, At, B0); PG8_BAR; PG8_SCHED;
            PG8_STAGE(PG8_SB(0, 1), b2 + hstep, voffB);
            PG8_WAIT_V(6); PG8_BAR; PG8_MMA(1, 1, At, B1); PG8_BAR;
            PG8_LDB(B0, 1, 0); PG8_SCHED; PG8_LDA(At, 1, 0); PG8_STAGE(PG8_SA(0, 1), a2 + hstep, voffA);
            PG8_WAIT_L(8); PG8_BAR; PG8_WAIT_L(0); PG8_MMA(0, 0, At, B0); PG8_BAR; PG8_SCHED;
            PG8_LDB(B1, 1, 1); PG8_STAGE(PG8_SB(1, 0), b3, voffB);
            PG8_BAR; PG8_WAIT_L(0); PG8_MMA(0, 1, At, B1); PG8_BAR;
            PG8_LDA(At, 1, 1); PG8_STAGE(PG8_SA(1, 0), a3, voffA);
            PG8_BAR; PG8_WAIT_L(0); PG8_MMA(1, 0, At, B0); PG8_BAR; PG8_SCHED;
            PG8_STAGE(PG8_SB(1, 1), b3 + hstep, voffB);
            PG8_WAIT_V(6); PG8_BAR; PG8_MMA(1, 1, At, B1); PG8_BAR;
        }
        if constexpr (!Epi::AFTER_DRAIN) { E(acc, cur, wr, wc, fr, fq); S.done(cur); }
        if (!has_next) break;
#pragma unroll
        for (int a = 0; a < 2; ++a)
#pragma unroll
            for (int b = 0; b < 2; ++b)
#pragma unroll
                for (int m = 0; m < 4; ++m)
#pragma unroll
                    for (int n = 0; n < 2; ++n) acc[a][b][m][n] = (f32x4){0.f, 0.f, 0.f, 0.f};
        cur = nxt; cA = nA; cB = nB; ++ui;
    }
    PG8_WAIT_V(0);
    if (wr == 0) PG8_BAR;
    PG8_BAR;
    if constexpr (Epi::AFTER_DRAIN) { E.fused(acc, cur, wr, wc, fr, fq, lds, wid, lane); S.done(cur); }
#undef PG8_SA
#undef PG8_SB
#undef PG8_STAGE
#undef PG8_LDA
#undef PG8_LDB
#undef PG8_MMA
#undef PG8_WAIT_V
#undef PG8_WAIT_L
#undef PG8_BAR
#undef PG8_SCHED
}
}

using pg8::bf16_t; using pg8::bf16x8; using pg8::f32x4; using pg8::u32x4;
#define LAS __attribute__((address_space(3)))
typedef unsigned u32x2 __attribute__((ext_vector_type(2)));

constexpr int DM = 1024, NB = 8, SEQ = 8192, DB = 32, DS = 32;
constexpr int MP = NB * SEQ, MS = DB * DS, MT = MP + MS;
constexpr int NPROJ = 2560, INCOLS = 2568, DFF = 2816;
constexpr int SCN = 16;
constexpr float ALPHA = 1.189207115002721f, KSCALE = 0.08838834764831845f, LN_EPS = 1e-5f;

constexpr size_t al256(size_t x) { return (x + 255) & ~(size_t)255; }
constexpr size_t WS_BAR = 0;
constexpr size_t WS_WIN = 16384;
constexpr size_t WS_WOUT = WS_WIN + al256((size_t)NPROJ * DM * 2);
constexpr size_t WS_WGU = WS_WOUT + al256((size_t)DM * DM * 2);
constexpr size_t WS_WDN = WS_WGU + al256((size_t)2 * DFF * DM * 2);
constexpr size_t WS_WPOOL = WS_WDN + al256((size_t)DM * DFF * 2);
constexpr size_t WS_BIAS = WS_WPOOL + al256((size_t)4 * 128 * 128 * 2);
constexpr size_t WS_GATES = WS_BIAS + al256((size_t)NPROJ * 4);
constexpr size_t WS_MTAB = WS_GATES + al256((size_t)MT * 8 * 4);
constexpr size_t WS_BTAB = WS_MTAB + al256((size_t)32 * 132 * 4);
constexpr size_t WS_GTAB = WS_BTAB + al256((size_t)32 * 128 * 4);
constexpr size_t WS_DST = WS_GTAB + al256((size_t)MT * 4 * 16);
constexpr size_t WS_DN = WS_DST + al256((size_t)224 * 16384 * 4);
constexpr size_t WS_H0 = WS_DN + al256((size_t)224 * 128 * 4);
constexpr size_t WS_PROJ = WS_H0 + al256((size_t)MT * DM * 2);
constexpr size_t WS_MIX = WS_PROJ + al256((size_t)MT * NPROJ * 2);
constexpr size_t WS_END = WS_MIX + al256((size_t)MT * DM * 2);
constexpr size_t WS_SLAB = WS_END;
constexpr size_t WS_END2 = WS_SLAB + (size_t)11 * 1024 * 1024 * 4;
constexpr size_t WS_R2 = WS_END2;
constexpr size_t WS_END3 = WS_R2 + al256((size_t)MT * DM * 2);
constexpr size_t WS_R1 = WS_PROJ;
constexpr size_t WS_ACT = WS_PROJ;
static_assert((size_t)MT * DFF * 2 <= WS_END - WS_PROJ, "act does not fit");

constexpr size_t O_Y = 0;
constexpr size_t O_POOLP = (size_t)MT * DM;
constexpr size_t O_CP = O_POOLP + (size_t)NB * 15 * 512;
constexpr size_t O_NP = O_CP + (size_t)NB * 4 * 16384;
constexpr size_t O_MP = O_NP + (size_t)NB * 4 * 128;
constexpr size_t O_POOLS = O_MP + (size_t)NB * 4;
constexpr size_t O_CS = O_POOLS + (size_t)DB * 15 * 512;
constexpr size_t O_NS = O_CS + (size_t)DB * 4 * 16384;
constexpr size_t O_MS = O_NS + (size_t)DB * 4 * 128;
constexpr size_t O_END = O_MS + (size_t)DB * 4;

struct Params { const float* in[21]; float* out; unsigned char* ws; };

__device__ __forceinline__ int fresh_tid() { int t = threadIdx.x; asm volatile("" : "+v"(t)); return t; }
__device__ __forceinline__ float bf2f(unsigned x) { return __uint_as_float(x << 16); }
__device__ __forceinline__ float bflo(unsigned w) { return __uint_as_float(w << 16); }
__device__ __forceinline__ float bfhi(unsigned w) { return __uint_as_float(w & 0xffff0000u); }
__device__ __forceinline__ unsigned pk2(float lo, float hi) { return pg8::cvt_pk_bf16(lo, hi); }
__device__ __forceinline__ float wave_sum(float v) {
#pragma unroll
    for (int o = 32; o; o >>= 1) v += __shfl_xor(v, o);
    return v; }
__device__ __forceinline__ float wave_max(float v) {
#pragma unroll
    for (int o = 32; o; o >>= 1) v = fmaxf(v, __shfl_xor(v, o));
    return v; }
__device__ __forceinline__ float scan_sum(float x, int lane) {
#pragma unroll
    for (int o = 1; o < 64; o <<= 1) { const float y = __shfl_up(x, o); if (lane >= o) x += y; }
    return x; }
__device__ __forceinline__ float scan_max(float x, int lane) {
#pragma unroll
    for (int o = 1; o < 64; o <<= 1) { const float y = __shfl_up(x, o); if (lane >= o) x = fmaxf(x, y); }
    return x; }
__device__ __forceinline__ float logsigmoid(float x) { return fminf(x, 0.f) - log1pf(expf(-fabsf(x))); }
__device__ __forceinline__ bf16x8 ldfrag(LAS const unsigned char* base, int row, int strideB, int kbyte) { return *(LAS const bf16x8*)(base + row * strideB + kbyte); }
#define LDS_BARRIER() do { asm volatile("s_waitcnt lgkmcnt(0)" ::: "memory"); __builtin_amdgcn_s_barrier(); asm volatile("" ::: "memory"); } while (0)
#define MFMA16(a, b, c) __builtin_amdgcn_mfma_f32_16x16x32_bf16((a), (b), (c), 0, 0, 0)

#define XB_TMO      128
#define XB_XCNT(j)  (256  + 64 * (j))
#define XB_XSUB(j)  (1280 + 64 * (j))
#define XB_XGEN(j)  (2304 + 64 * (j))
#define XB_TOP      3328
#define XB_TOPGEN   3392
#define XCD_BAR_WORDS 3456
#define XB_SPIN_CAP (1u << 18)
__device__ __forceinline__ unsigned xb_ld(unsigned* p)              { return __hip_atomic_load(p, __ATOMIC_RELAXED, __HIP_MEMORY_SCOPE_AGENT); }
__device__ __forceinline__ unsigned xb_add(unsigned* p, unsigned v) { return __hip_atomic_fetch_add(p, v, __ATOMIC_RELAXED, __HIP_MEMORY_SCOPE_AGENT); }
__device__ __forceinline__ unsigned xb_xcc_id() { return (unsigned)__builtin_amdgcn_s_getreg((3 << 11) | 20) & 0xFu; }
#define XB_SPIN(cond, bar) do { unsigned _sp = 0; while (cond) { __builtin_amdgcn_s_sleep(1); \
    if ((++_sp & 255u) == 0u) { if (xb_ld(&(bar)[XB_TMO])) break; if (_sp > XB_SPIN_CAP) { atomicAdd(&(bar)[XB_TMO], 1u); break; } } } } while (0)

struct XcdBarrier {
    unsigned* bar; unsigned x;
    volatile LAS unsigned* st;
};

__device__ __forceinline__ XcdBarrier xcd_barrier_post(unsigned* bar, volatile LAS unsigned* st) {
    XcdBarrier b; b.bar = bar; b.x = xb_xcc_id(); b.st = st;
    if (threadIdx.x == 0) (void)xb_add(&bar[XB_XCNT(b.x)], 1u);
    return b;
}
__device__ __forceinline__ void xcd_barrier_complete(unsigned* bar, unsigned x, unsigned& nloc, unsigned& nx) {
    const unsigned G = gridDim.x * gridDim.y * gridDim.z;
    unsigned sum, cnt, mine, sp = 0u;
    for (;;) {
        sum = 0u; cnt = 0u; mine = 0u;
#pragma unroll
        for (unsigned j = 0; j < 16; ++j) { const unsigned c = xb_ld(&bar[XB_XCNT(j)]); sum += c; cnt += (c > 0u) ? 1u : 0u; mine = (j == x) ? c : mine; }
        if (sum == G) break;
        __builtin_amdgcn_s_sleep(1);
        if ((++sp & 255u) == 0u) { if (xb_ld(&bar[XB_TMO])) break; if (sp > XB_SPIN_CAP) { atomicAdd(&bar[XB_TMO], 1u); break; } }
    }
    nloc = mine > 0u ? mine : 1u; nx = cnt > 0u ? cnt : 1u;
}

__device__ __forceinline__ void xcd_barrier(const XcdBarrier& b) {
    asm volatile("s_waitcnt vmcnt(0)" ::: "memory");
    __syncthreads();
    if (threadIdx.x == 0) {
        unsigned* bar = b.bar;
        __builtin_amdgcn_s_waitcnt(0);
        unsigned nloc = b.st[0], nx = b.st[1];
        if (nloc == 0u) { xcd_barrier_complete(bar, b.x, nloc, nx); b.st[0] = nloc; b.st[1] = nx; }
        const unsigned old = xb_add(&bar[XB_XSUB(b.x)], 1u);
        const unsigned gen = old / nloc;
        if (old + 1u == (gen + 1u) * nloc) {
            __builtin_amdgcn_fence(__ATOMIC_RELEASE, "agent");
            asm volatile("s_waitcnt vmcnt(0)" ::: "memory");
            const unsigned og = xb_add(&bar[XB_TOP], 1u);
            const unsigned tg = og / nx;
            if (og + 1u == (tg + 1u) * nx) xb_add(&bar[XB_TOPGEN], 1u);
            else XB_SPIN(xb_ld(&bar[XB_TOPGEN]) == tg, bar);
            __builtin_amdgcn_fence(__ATOMIC_ACQUIRE, "agent");
            xb_add(&bar[XB_XGEN(b.x)], 1u);
            asm volatile("s_waitcnt vmcnt(0)" ::: "memory");
        } else {
            XB_SPIN(xb_ld(&bar[XB_XGEN(b.x)]) == gen, bar);
            __builtin_amdgcn_fence(__ATOMIC_ACQUIRE, "agent");
            asm volatile("s_waitcnt vmcnt(0)" ::: "memory");
        }
    }
    __syncthreads();
}

struct SplitOrder {
    int nN, nP, S, nkt, G, c;
    __device__ __forceinline__ void init(int N, int Ktiles, int S_, int G_, int c_) { nN = N / 256; nP = 256 * nN; S = S_; nkt = Ktiles; G = G_; c = c_; }
    __device__ __forceinline__ bool next(int i, pg8::Unit& u) const {
        const long L = (long)i * G + c;
        if (L >= nP + 4 * nN * S) return false;
        int pm, pn, k0 = 0, kn = nkt;
        if (L < nP) { int wgid = (int)L; { const int q = nP / 8, xcd = wgid % 8, off = wgid / 8; wgid = xcd * q + off; }
            const int nig = 8 * nN, gid = wgid / nig, fm = gid * 8; pm = fm + ((wgid % nig) % 8); pn = (wgid % nig) / 8; }
        else { const int j = (int)(L - nP), su = j / S, sl = j - su * S; pm = 256 + su / nN; pn = su % nN; kn = nkt / S; k0 = sl * kn; }
        u.pm = pm; u.pn = pn; u.kt0 = k0; u.nkt = kn; return true;
    }
    __device__ __forceinline__ void a_ready(const pg8::Unit&) const {}
    __device__ __forceinline__ void done(const pg8::Unit&) const {}
};

struct EpiBf16B {
    static constexpr bool PERM = true, AFTER_DRAIN = false;
    bf16_t* O; int ldc; const float* bias;
    __device__ __forceinline__ void operator()(const f32x4 (&acc)[2][2][4][2], const pg8::Unit& u, int wr, int wc, int fr, int fq) const {
        const int row0 = u.pm * 256 + wr * 64 + fr, col0 = u.pn * 256 + wc * 32 + 8 * fq;
        f32x4 bv[2][2];
#pragma unroll
        for (int bj = 0; bj < 2; ++bj)
#pragma unroll
            for (int n = 0; n < 2; ++n) bv[bj][n] = *(const f32x4*)(bias + col0 + bj * 128 + 4 * n);
#pragma unroll
        for (int ai = 0; ai < 2; ++ai)
#pragma unroll
            for (int m = 0; m < 4; ++m) { bf16_t* rowp = O + (size_t)(row0 + ai * 128 + m * 16) * ldc + col0;
#pragma unroll
                for (int bj = 0; bj < 2; ++bj) { const f32x4 v0 = acc[ai][bj][m][0] + bv[bj][0], v1 = acc[ai][bj][m][1] + bv[bj][1];
                    u32x4 w; w.x = pk2(v0[0], v0[1]); w.y = pk2(v0[2], v0[3]); w.z = pk2(v1[0], v1[1]); w.w = pk2(v1[2], v1[3]);
                    *(u32x4*)(rowp + bj * 128) = w; } }
    }
};
struct EpiRes {
    static constexpr bool PERM = true, AFTER_DRAIN = false;
    const bf16_t* base; bf16_t* out; float* slab; int nkt_full;
    __device__ __forceinline__ void operator()(const f32x4 (&acc)[2][2][4][2], const pg8::Unit& u, int wr, int wc, int fr, int fq) const {
        const int row0 = u.pm * 256 + wr * 64 + fr, col0 = u.pn * 256 + wc * 32 + 8 * fq;
        if (u.nkt != nkt_full) {
            float* sp = slab + (size_t)(u.kt0 / u.nkt) * (1024 * 1024) + (size_t)(row0 - MP) * DM + col0;
#pragma unroll
            for (int ai = 0; ai < 2; ++ai)
#pragma unroll
                for (int m = 0; m < 4; ++m)
#pragma unroll
                    for (int bj = 0; bj < 2; ++bj)
#pragma unroll
                        for (int n = 0; n < 2; ++n) *(f32x4*)(sp + (size_t)(ai * 128 + m * 16) * DM + bj * 128 + 4 * n) = acc[ai][bj][m][n];
            return; }
        u32x4 bb[2][4][2];
#pragma unroll
        for (int ai = 0; ai < 2; ++ai)
#pragma unroll
            for (int m = 0; m < 4; ++m)
#pragma unroll
                for (int bj = 0; bj < 2; ++bj) bb[ai][m][bj] = *(const u32x4*)(base + (size_t)(row0 + ai * 128 + m * 16) * DM + col0 + bj * 128);
        asm volatile("" ::: "memory");
#pragma unroll
        for (int ai = 0; ai < 2; ++ai)
#pragma unroll
            for (int m = 0; m < 4; ++m) { const size_t off = (size_t)(row0 + ai * 128 + m * 16) * DM + col0;
#pragma unroll
                for (int bj = 0; bj < 2; ++bj) { const u32x4 b = bb[ai][m][bj]; const f32x4 a0 = acc[ai][bj][m][0], a1 = acc[ai][bj][m][1];
                    u32x4 w; w.x = pk2(ALPHA * bflo(b.x) + a0[0], ALPHA * bfhi(b.x) + a0[1]); w.y = pk2(ALPHA * bflo(b.y) + a0[2], ALPHA * bfhi(b.y) + a0[3]);
                    w.z = pk2(ALPHA * bflo(b.z) + a1[0], ALPHA * bfhi(b.z) + a1[1]); w.w = pk2(ALPHA * bflo(b.w) + a1[2], ALPHA * bfhi(b.w) + a1[3]);
                    *(u32x4*)(out + off + bj * 128) = w; } }
    }
};
__device__ __forceinline__ float fsigmoid(float x) { return __builtin_amdgcn_rcpf(1.0f + __expf(-x)); }
__device__ __forceinline__ float swiglu(float g, float u) { return g * u * fsigmoid(g); }
struct EpiSwiglu {
    static constexpr bool PERM = true, AFTER_DRAIN = false;
    bf16_t* O;
    __device__ __forceinline__ void operator()(const f32x4 (&acc)[2][2][4][2], const pg8::Unit& u, int wr, int wc, int fr, int fq) const {
        const int row0 = u.pm * 256 + wr * 64 + fr, col0 = u.pn * 128 + wc * 32 + 8 * fq;
#pragma unroll
        for (int ai = 0; ai < 2; ++ai)
#pragma unroll
            for (int m = 0; m < 4; ++m) { bf16_t* rowp = O + (size_t)(row0 + ai * 128 + m * 16) * DFF + col0;
                const f32x4 g0 = acc[ai][0][m][0], g1 = acc[ai][0][m][1], u0 = acc[ai][1][m][0], u1 = acc[ai][1][m][1];
                u32x4 w; w.x = pk2(swiglu(g0[0], u0[0]), swiglu(g0[1], u0[1])); w.y = pk2(swiglu(g0[2], u0[2]), swiglu(g0[3], u0[3]));
                w.z = pk2(swiglu(g1[0], u1[0]), swiglu(g1[1], u1[1])); w.w = pk2(swiglu(g1[2], u1[2]), swiglu(g1[3], u1[3]));
                *(u32x4*)rowp = w; }
    }
};

constexpr int TR_TILES = 640 + 256 + 704 + 704 + 704 + 16;
struct TileDesc { const float* src; bf16_t* dst; int ld, K, mode, k0, n0; };
__device__ __forceinline__ TileDesc tile_desc(const Params& p, int t) {
    TileDesc d; unsigned char* ws = p.ws;
    if (t < 640) { d.src = p.in[8]; d.ld = INCOLS; d.K = DM; d.mode = 3; d.dst = (bf16_t*)(ws + WS_WIN); }
    else if (t < 896) { t -= 640; d.src = p.in[13]; d.ld = DM; d.K = DM; d.mode = 0; d.dst = (bf16_t*)(ws + WS_WOUT); }
    else if (t < 1600) { t -= 896; d.src = p.in[16]; d.ld = DFF; d.K = DM; d.mode = 1; d.dst = (bf16_t*)(ws + WS_WGU); }
    else if (t < 2304) { t -= 1600; d.src = p.in[17]; d.ld = DFF; d.K = DM; d.mode = 2; d.dst = (bf16_t*)(ws + WS_WGU); }
    else if (t < 3008) { t -= 2304; d.src = p.in[18]; d.ld = DM; d.K = DFF; d.mode = 0; d.dst = (bf16_t*)(ws + WS_WDN); }
    else { t -= 3008; const int g = t >> 2; t &= 3; d.src = p.in[10] + g * 16384; d.ld = 128; d.K = 128; d.mode = 0; d.dst = (bf16_t*)(ws + WS_WPOOL) + g * 16384; }
    const int nkt = d.K >> 6; d.k0 = (t % nkt) * 64; d.n0 = (t / nkt) * 64; return d;
}

__device__ __forceinline__ void phase0(const Params& p, LAS unsigned char* lds) {
    const int tid = fresh_tid(), lane = tid & 63, wave = tid >> 6, G = gridDim.x, bx = blockIdx.x;
    unsigned char* ws = p.ws;
    LAS float* T = (LAS float*)lds;
    {
        const int r = tid >> 3, cs = (tid & 7) * 8;
        int t = bx; float4 a = make_float4(0.f, 0.f, 0.f, 0.f), b = a; TileDesc d = tile_desc(p, t < TR_TILES ? t : 0);
        if (t < TR_TILES) { const float* s = d.src + (size_t)(d.k0 + r) * d.ld + d.n0 + cs; a = *(const float4*)s; b = *(const float4*)(s + 4); }
#pragma unroll 1
        for (; t < TR_TILES; t += G) {
            { LAS float* q = T + r * 65 + cs; q[0] = a.x; q[1] = a.y; q[2] = a.z; q[3] = a.w; q[4] = b.x; q[5] = b.y; q[6] = b.z; q[7] = b.w; }
            const TileDesc dn = tile_desc(p, t + G < TR_TILES ? t + G : 0);
            if (t + G < TR_TILES) { const float* s = dn.src + (size_t)(dn.k0 + r) * dn.ld + dn.n0 + cs; a = *(const float4*)s; b = *(const float4*)(s + 4); }
            LDS_BARRIER();
            { const int n = tid >> 3, ks = (tid & 7) * 8, gn = d.n0 + n; float v[8];
#pragma unroll
              for (int i = 0; i < 8; ++i) v[i] = T[(ks + i) * 65 + n];
              const float sc = (d.mode == 3 && gn >= 1024 && gn < 1536) ? KSCALE : 1.0f;
              const int drow = (d.mode == 1) ? 256 * (gn >> 7) + (gn & 127) : (d.mode == 2) ? 256 * (gn >> 7) + 128 + (gn & 127) : gn;
              u32x4 w; w.x = pk2(v[0] * sc, v[1] * sc); w.y = pk2(v[2] * sc, v[3] * sc); w.z = pk2(v[4] * sc, v[5] * sc); w.w = pk2(v[6] * sc, v[7] * sc);
              *(u32x4*)(d.dst + (size_t)drow * d.K + d.k0 + ks) = w; }
            LDS_BARRIER();
            d = dn;
        }
    }
    { float* bs = (float*)(ws + WS_BIAS); const float* b_in = p.in[9];
      for (int i = bx * 512 + tid; i < NPROJ; i += G * 512) bs[i] = b_in[i] * ((i >= 1024 && i < 1536) ? KSCALE : 1.0f); }
    f32x4 wlo[4][4], whi[4][4];
    { const float* w_in = p.in[8];
#pragma unroll
      for (int i = 0; i < 4; ++i)
#pragma unroll
          for (int e = 0; e < 4; ++e) { const float* wp = w_in + (size_t)(i * 256 + lane * 4 + e) * INCOLS + NPROJ; wlo[i][e] = *(const f32x4*)wp; whi[i][e] = *(const f32x4*)(wp + 4); } }
    const float* lg = p.in[6]; const float* lb = p.in[7]; const float* b_in = p.in[9];
    bf16_t* h0 = (bf16_t*)(ws + WS_H0); float* gates = (float*)(ws + WS_GATES);
    const float gb_perm = lane < 8 ? b_in[NPROJ + (((lane & 1) << 2) | (lane & 2) | ((lane >> 2) & 1))] : 0.f;
    int row = bx * 8 + wave; float4 v[4];
    if (row < MT) { const float* x = row < MP ? p.in[0] + (size_t)row * DM : p.in[1] + (size_t)(row - MP) * DM;
#pragma unroll
        for (int i = 0; i < 4; ++i) v[i] = *(const float4*)(x + i * 256 + lane * 4); }
#pragma unroll 1
    for (; row < MT; row += G * 8) {
        const int nrow = row + G * 8; float4 nv[4];
        if (nrow < MT) { const float* x = nrow < MP ? p.in[0] + (size_t)nrow * DM : p.in[1] + (size_t)(nrow - MP) * DM;
#pragma unroll
            for (int i = 0; i < 4; ++i) nv[i] = *(const float4*)(x + i * 256 + lane * 4); }
        else {
#pragma unroll
            for (int i = 0; i < 4; ++i) nv[i] = make_float4(0.f, 0.f, 0.f, 0.f); }
        float s = 0.f;
#pragma unroll
        for (int i = 0; i < 4; ++i) s += (v[i].x + v[i].y) + (v[i].z + v[i].w);
        const float mu = wave_sum(s) * (1.0f / DM);
        float q = 0.f;
#pragma unroll
        for (int i = 0; i < 4; ++i) { v[i].x -= mu; v[i].y -= mu; v[i].z -= mu; v[i].w -= mu; q += (v[i].x * v[i].x + v[i].y * v[i].y) + (v[i].z * v[i].z + v[i].w * v[i].w); }
        const float rstd = rsqrtf(wave_sum(q) * (1.0f / DM) + LN_EPS);
        f32x4 glo = (f32x4){0.f, 0.f, 0.f, 0.f}, ghi = glo;
#pragma unroll
        for (int i = 0; i < 4; ++i) { const int c = i * 256 + lane * 4; const float4 gg = *(const float4*)(lg + c), bb = *(const float4*)(lb + c);
            float4 y; y.x = v[i].x * rstd * gg.x + bb.x; y.y = v[i].y * rstd * gg.y + bb.y; y.z = v[i].z * rstd * gg.z + bb.z; y.w = v[i].w * rstd * gg.w + bb.w;
            u32x2 w; w.x = pk2(y.x, y.y); w.y = pk2(y.z, y.w); *(u32x2*)(h0 + (size_t)row * DM + c) = w;
            glo += y.x * wlo[i][0] + y.y * wlo[i][1] + y.z * wlo[i][2] + y.w * wlo[i][3];
            ghi += y.x * whi[i][0] + y.y * whi[i][1] + y.z * whi[i][2] + y.w * whi[i][3]; }
        { const bool b0 = lane & 1, b1 = lane & 2, b2 = lane & 4;
          f32x4 k4, s4;
#pragma unroll
          for (int j = 0; j < 4; ++j) { k4[j] = b0 ? ghi[j] : glo[j]; s4[j] = b0 ? glo[j] : ghi[j]; }
#pragma unroll
          for (int j = 0; j < 4; ++j) k4[j] += __shfl_xor(s4[j], 1);
          float k2a = b1 ? k4[2] : k4[0], k2b = b1 ? k4[3] : k4[1];
          k2a += __shfl_xor(b1 ? k4[0] : k4[2], 2); k2b += __shfl_xor(b1 ? k4[1] : k4[3], 2);
          float k1 = b2 ? k2b : k2a; k1 += __shfl_xor(b2 ? k2a : k2b, 4);
          k1 += __shfl_xor(k1, 8); k1 += __shfl_xor(k1, 16); k1 += __shfl_xor(k1, 32);
          const int gidx = ((lane & 1) << 2) | (lane & 2) | ((lane >> 2) & 1);
          if (lane < 8) gates[(size_t)row * 8 + gidx] = k1 + gb_perm; }
#pragma unroll
        for (int i = 0; i < 4; ++i) v[i] = nv[i];
    }
}

__device__ __forceinline__ void gate_scan(const Params& p, LAS unsigned char* lds) {
    const int tid = fresh_tid(), lane = tid & 63, wave = tid >> 6, G = gridDim.x;
    const float* gates = (const float*)(p.ws + WS_GATES); float* mtab = (float*)(p.ws + WS_MTAB); float* btab = (float*)(p.ws + WS_BTAB);
    f32x4* gtab = (f32x4*)(p.ws + WS_GTAB);
    LAS float* sA = (LAS float*)lds; LAS float* sB = sA + 128; LAS float* sM = sA + 256;
    const int vb = (blockIdx.x + G - (64 % G)) % G;
    for (int chain = vb; chain < 32; chain += G) {
        const int batch = chain >> 2, head = chain & 3;
        float ig[16], bb[16];
#pragma unroll
        for (int k = 0; k < 16; ++k) { const size_t row = (size_t)batch * SEQ + (wave + 8 * k) * 64 + lane; ig[k] = gates[row * 8 + head]; bb[k] = gates[row * 8 + 4 + head]; }
#pragma unroll
        for (int k = 0; k < 16; ++k) { bb[k] = scan_sum(logsigmoid(bb[k]), lane); const float A = wave_max(ig[k] - bb[k]); const float bl = __shfl(bb[k], 63);
            if (lane == 0) { sA[wave + 8 * k] = A; sB[wave + 8 * k] = bl; } }
        __syncthreads();
        if (tid == 0) { float m = 0.f; mtab[chain * 132] = 0.f; sM[0] = 0.f;
            for (int c = 0; c < 128; ++c) { m = sB[c] + fmaxf(m, sA[c]); mtab[chain * 132 + c + 1] = m; sM[c + 1] = m; btab[chain * 128 + c] = sB[c]; }
            p.out[O_MP + chain] = m; }
        __syncthreads();
#pragma unroll
        for (int k = 0; k < 16; ++k) { const int c = wave + 8 * k; const size_t row = (size_t)batch * SEQ + c * 64 + lane;
            const float a = ig[k] - bb[k]; const float m_prev = sM[c]; const float M = fmaxf(m_prev, scan_max(a, lane));
            gtab[row * 4 + head] = (f32x4){a, M, expf(m_prev - M), expf(-(bb[k] + M))}; }
        __syncthreads();
    }
    const int vb2 = (blockIdx.x + G - (96 % G)) % G;
    for (int s = vb2 * 8 + wave; s < DB * 4; s += G * 8) {
        const int b_ = s >> 2, head = s & 3; const bool valid = lane < 32; const size_t row = (size_t)MP + b_ * 32 + (lane & 31);
        const float ig = gates[row * 8 + head], fg = gates[row * 8 + 4 + head]; const float m_prev = p.in[5][s];
        const float b = scan_sum(valid ? logsigmoid(fg) : 0.f, lane); const float a = valid ? ig - b : -1e30f;
        const float M = fmaxf(m_prev, scan_max(a, lane));
        if (valid) gtab[row * 4 + head] = (f32x4){a, M, expf(m_prev - M), expf(-(b + M))};
        if (lane == 31) p.out[O_MS + s] = b + M;
    }
}

constexpr int L_Q = 0, L_K = 17408, L_KW = 34816, L_V = 52224, L_CT = 69632, L_S = 104448, L_G = 113664, L_H = 116512;
constexpr int LDS_XB = 152000, LDS_TOTAL = 152064;
typedef short s16x4 __attribute__((ext_vector_type(4)));
__device__ __forceinline__ bf16x8 ldfrag_tr(LAS const unsigned char* base, int row0, int col0, int lane) {
    const int g = lane >> 4, q = (lane & 15) >> 2, pp = lane & 3;
    LAS const unsigned char* a = base + (row0 + 8 * g + q) * 272 + (col0 + 4 * pp) * 2;
    const s16x4 lo = __builtin_amdgcn_ds_read_tr16_b64_v4i16((LAS s16x4*)a);
    const s16x4 hi = __builtin_amdgcn_ds_read_tr16_b64_v4i16((LAS s16x4*)(a + 4 * 272));
    return __builtin_shufflevector(lo, hi, 0, 1, 2, 3, 4, 5, 6, 7);
}

template <bool FULL>
__device__ __forceinline__ void mlstm_run(const Params& p, LAS unsigned char* lds, f32x4 (&accC)[2][4], f32x4 (&accN)[2], int row0, int head, int nch, int L) {
    const int tid = fresh_tid(), lane = tid & 63, wave = __builtin_amdgcn_readfirstlane(tid >> 6), l15 = lane & 15, l4 = lane >> 4, st = wave & 3, tp = wave >> 2;
    const bf16_t* proj = (const bf16_t*)(p.ws + WS_PROJ); const f32x4* gtab = (const f32x4*)(p.ws + WS_GTAB);
    bf16_t* mix = (bf16_t*)(p.ws + WS_MIX);
    LAS unsigned short* sQ = (LAS unsigned short*)(lds + L_Q); LAS unsigned short* sK = (LAS unsigned short*)(lds + L_K);
    LAS unsigned short* sKW = (LAS unsigned short*)(lds + L_KW); LAS unsigned short* sV = (LAS unsigned short*)(lds + L_V);
    LAS unsigned short* sS = (LAS unsigned short*)(lds + L_S); LAS float* sH = (LAS float*)(lds + L_H);
    LAS float* gA = (LAS float*)(lds + L_G); LAS float* gM = gA + 64; LAS float* gDec = gA + 128; LAS float* gEinv = gA + 192; LAS float* gW = gA + 256;
    LAS float* gQn = gA + 320; LAS float* gDi = gA + 384; LAS float* gN = gA + 448; LAS float* scal = gA + 576; LAS float* gNg = gA + 584;
    const bf16x8 ones = (bf16x8){0x3F80, 0x3F80, 0x3F80, 0x3F80, 0x3F80, 0x3F80, 0x3F80, 0x3F80};
    const int tok0 = tid >> 4, dsg = tid & 15;
    const int orow = tid >> 3, oseg = tid & 7;
    u32x4 kq[2], kk[2], kv[2]; f32x4 pgt = (f32x4){0.f, 0.f, 0.f, 0.f}; float pa[2] = {-1e30f, -1e30f}, pml = 0.f;
    if (FULL && tid < 128) gNg[tid] = p.in[12][head * 128 + tid];
#pragma unroll
    for (int i = 0; i < 2; ++i) { const int tok = tok0 + 32 * i; const bool valid = tok < L; const u32x4 z = (u32x4){0u, 0u, 0u, 0u};
        const bf16_t* src = proj + (size_t)(row0 + tok) * NPROJ + head * 128 + dsg * 8;
        kk[i] = valid ? *(const u32x4*)(src + 1024) : z; kv[i] = valid ? *(const u32x4*)(src + 1536) : z;
        if (FULL) kq[i] = valid ? *(const u32x4*)(src + 512) : z; else kq[i] = z; }
    if (wave == 0 && lane < L) pgt = gtab[(size_t)(row0 + lane) * 4 + head];
    { const float* gf = (const float*)gtab; pml = gf[((size_t)(row0 + L - 1) * 4 + head) * 4 + 1];
#pragma unroll
      for (int i = 0; i < 2; ++i) { const int tok = tok0 + 32 * i; if (tok < L) pa[i] = gf[((size_t)(row0 + tok) * 4 + head) * 4]; } }
#pragma unroll 1
    for (int c = 0; c < nch; ++c) {
        const int r0 = row0 + c * 64;
        if (wave == 0) {
            const bool valid = lane < L; const float a = valid ? pgt[0] : -1e30f; const float Ml = __shfl(pgt[1], L - 1);
            gA[lane] = a; gM[lane] = valid ? pgt[1] : Ml; gDec[lane] = valid ? pgt[2] : 0.f; gEinv[lane] = valid ? pgt[3] : 1.f;
            if (lane == L - 1) scal[0] = pgt[2];
        }
        if (FULL) {
#pragma unroll
            for (int i = 0; i < 2; ++i)
#pragma unroll
                for (int n = 0; n < 4; ++n) { u32x2 w; w.x = pk2(accC[i][n][0], accC[i][n][1]); w.y = pk2(accC[i][n][2], accC[i][n][3]);
                    *(LAS u32x2*)(lds + L_CT + (64 * tp + 16 * n + l15) * 272 + (32 * st + 16 * i + 4 * l4) * 2) = w; }
            if (tp == 0 && l15 == 0) {
#pragma unroll
                for (int i = 0; i < 2; ++i) *(LAS f32x4*)(gN + 32 * st + 16 * i + 4 * l4) = accN[i]; }
        }
#pragma unroll
        for (int i = 0; i < 2; ++i) { const int tok = tok0 + 32 * i;
            if (FULL) { *(LAS u32x4*)(sQ + tok * 136 + dsg * 8) = kq[i]; *(LAS u32x4*)(sK + tok * 136 + dsg * 8) = kk[i]; }
            *(LAS u32x4*)(sV + tok * 136 + dsg * 8) = kv[i];
            const float w = __expf(pa[i] - pml); u32x4 o;
            o.x = pk2(bflo(kk[i].x) * w, bfhi(kk[i].x) * w); o.y = pk2(bflo(kk[i].y) * w, bfhi(kk[i].y) * w);
            o.z = pk2(bflo(kk[i].z) * w, bfhi(kk[i].z) * w); o.w = pk2(bflo(kk[i].w) * w, bfhi(kk[i].w) * w);
            *(LAS u32x4*)(sKW + tok * 136 + dsg * 8) = o; }
        LDS_BARRIER();
        if (c + 1 < nch) {
#pragma unroll
            for (int i = 0; i < 2; ++i) { const int tok = tok0 + 32 * i;
                const bf16_t* src = proj + (size_t)(r0 + 64 + tok) * NPROJ + head * 128 + dsg * 8;
                kk[i] = *(const u32x4*)(src + 1024); kv[i] = *(const u32x4*)(src + 1536);
                if (FULL) kq[i] = *(const u32x4*)(src + 512); }
            if (wave == 0) pgt = gtab[(size_t)(r0 + 64 + lane) * 4 + head];
            { const float* gf = (const float*)gtab; pml = gf[((size_t)(r0 + 64 + L - 1) * 4 + head) * 4 + 1];
#pragma unroll
              for (int i = 0; i < 2; ++i) pa[i] = gf[((size_t)(r0 + 64 + tok0 + 32 * i) * 4 + head) * 4]; }
        }
        f32x4 nacc[4];
#pragma unroll
        for (int n = 0; n < 4; ++n) nacc[n] = (f32x4){0.f, 0.f, 0.f, 0.f};
        if (FULL) {
            f32x4 sacc[2]; sacc[0] = (f32x4){0.f, 0.f, 0.f, 0.f}; sacc[1] = sacc[0];
#pragma unroll
            for (int ks = 0; ks < 4; ++ks) { const int kb = (32 * ks + 8 * l4) * 2;
                const bf16x8 a = ldfrag(lds + L_K, 16 * st + l15, 272, kb);
#pragma unroll
                for (int tt = 0; tt < 2; ++tt) { const bf16x8 b = ldfrag(lds + L_Q, 16 * (2 * tp + tt) + l15, 272, kb); sacc[tt] = MFMA16(a, b, sacc[tt]); } }
#pragma unroll
            for (int tt = 0; tt < 2; ++tt) { const int t = 16 * (2 * tp + tt) + l15; const float Mt = gM[t]; float dv[4];
#pragma unroll
                for (int j = 0; j < 4; ++j) { const int s = 16 * st + 4 * l4 + j; dv[j] = (s <= t) ? sacc[tt][j] * __expf(gA[s] - Mt) : 0.f; }
                u32x2 w; w.x = pk2(dv[0], dv[1]); w.y = pk2(dv[2], dv[3]); *(LAS u32x2*)(lds + L_S + t * 144 + (16 * st + 4 * l4) * 2) = w; }
#pragma unroll
            for (int ks = 0; ks < 4; ++ks) { const int kb = (32 * ks + 8 * l4) * 2;
                const bf16x8 a = ldfrag(lds + L_Q, 16 * st + l15, 272, kb);
#pragma unroll
                for (int n = 0; n < 4; ++n) { const bf16x8 b = ldfrag(lds + L_CT, 64 * tp + 16 * n + l15, 272, kb); nacc[n] = MFMA16(a, b, nacc[n]); } }
#pragma unroll
            for (int j = 0; j < 4; ++j) { const float dj = gDec[16 * st + 4 * l4 + j];
#pragma unroll
                for (int n = 0; n < 4; ++n) nacc[n][j] *= dj; }
            { float s = 0.f;
              const u32x4 q0 = *(LAS const u32x4*)(sQ + orow * 136 + oseg * 16), q1 = *(LAS const u32x4*)(sQ + orow * 136 + oseg * 16 + 8);
              const unsigned qw[8] = {q0.x, q0.y, q0.z, q0.w, q1.x, q1.y, q1.z, q1.w};
#pragma unroll
              for (int e = 0; e < 8; ++e) s += bflo(qw[e]) * gN[oseg * 16 + 2 * e] + bfhi(qw[e]) * gN[oseg * 16 + 2 * e + 1];
              s += __shfl_xor(s, 1); s += __shfl_xor(s, 2); s += __shfl_xor(s, 4);
              if (oseg == 0) gQn[orow] = s; }
        }
        if (FULL) LDS_BARRIER();
        if (FULL) {
            const u32x4 s0 = *(LAS const u32x4*)(sS + orow * 72 + oseg * 8);
            float s = (bflo(s0.x) + bfhi(s0.x)) + (bflo(s0.y) + bfhi(s0.y)) + (bflo(s0.z) + bfhi(s0.z)) + (bflo(s0.w) + bfhi(s0.w));
            s += __shfl_xor(s, 1); s += __shfl_xor(s, 2); s += __shfl_xor(s, 4);
            if (oseg == 0) { const float den = gDec[orow] * gQn[orow] + s; gDi[orow] = __builtin_amdgcn_rcpf(fmaxf(fabsf(den), gEinv[orow])); } }
        const float wsv = scal[0];
#pragma unroll
        for (int i = 0; i < 2; ++i) { accN[i] *= wsv;
#pragma unroll
            for (int n = 0; n < 4; ++n) accC[i][n] *= wsv; }
#pragma unroll
        for (int ks = 0; ks < 2; ++ks) { bf16x8 bv[4];
#pragma unroll
            for (int n = 0; n < 4; ++n) bv[n] = ldfrag_tr(lds + L_V, 32 * ks, 64 * tp + 16 * n, lane);
            if (FULL) { const bf16x8 a = ldfrag(lds + L_S, 16 * st + l15, 144, (32 * ks + 8 * l4) * 2);
#pragma unroll
                for (int n = 0; n < 4; ++n) nacc[n] = MFMA16(a, bv[n], nacc[n]); }
#pragma unroll
            for (int i = 0; i < 2; ++i) { const bf16x8 a = ldfrag_tr(lds + L_KW, 32 * ks, 32 * st + 16 * i, lane);
                accN[i] = MFMA16(a, ones, accN[i]);
#pragma unroll
                for (int n = 0; n < 4; ++n) accC[i][n] = MFMA16(a, bv[n], accC[i][n]); } }
        LDS_BARRIER();
        if (FULL) {
            u32x4 ow0 = (u32x4){0u, 0u, 0u, 0u}, ow1 = ow0;
            if (orow < L) { const bf16_t* op = proj + (size_t)(r0 + orow) * NPROJ + 2048 + head * 128 + oseg * 16; ow0 = *(const u32x4*)op; ow1 = *(const u32x4*)(op + 8); }
#pragma unroll
            for (int j = 0; j < 4; ++j) { const int t = 16 * st + 4 * l4 + j; const float di = gDi[t];
#pragma unroll
                for (int n = 0; n < 4; ++n) sH[t * 132 + 64 * tp + 16 * n + l15] = nacc[n][j] * di; }
            LDS_BARRIER();
            if (orow < L) {
                f32x4 x[4]; float s = 0.f;
#pragma unroll
                for (int e = 0; e < 4; ++e) { x[e] = *(LAS const f32x4*)(sH + orow * 132 + oseg * 16 + 4 * e); s += (x[e][0] + x[e][1]) + (x[e][2] + x[e][3]); }
                s += __shfl_xor(s, 1); s += __shfl_xor(s, 2); s += __shfl_xor(s, 4);
                const float mean = s * (1.0f / 128.0f); float q = 0.f;
#pragma unroll
                for (int e = 0; e < 4; ++e) { x[e] -= mean; q += (x[e][0] * x[e][0] + x[e][1] * x[e][1]) + (x[e][2] * x[e][2] + x[e][3] * x[e][3]); }
                q += __shfl_xor(q, 1); q += __shfl_xor(q, 2); q += __shfl_xor(q, 4);
                const float rstd = rsqrtf(q * (1.0f / 128.0f) + LN_EPS);
                const unsigned owv[8] = {ow0.x, ow0.y, ow0.z, ow0.w, ow1.x, ow1.y, ow1.z, ow1.w}; unsigned ov[8];
#pragma unroll
                for (int e = 0; e < 4; ++e) { const f32x4 g = *(LAS const f32x4*)(gNg + oseg * 16 + 4 * e);
                    const float y0 = x[e][0] * rstd * g[0] * fsigmoid(bflo(owv[2 * e])), y1 = x[e][1] * rstd * g[1] * fsigmoid(bfhi(owv[2 * e]));
                    const float y2 = x[e][2] * rstd * g[2] * fsigmoid(bflo(owv[2 * e + 1])), y3 = x[e][3] * rstd * g[3] * fsigmoid(bfhi(owv[2 * e + 1]));
                    ov[2 * e] = pk2(y0, y1); ov[2 * e + 1] = pk2(y2, y3); }
                bf16_t* mp = mix + (size_t)(r0 + orow) * DM + 512 + head * 128 + oseg * 16;
                *(u32x4*)mp = (u32x4){ov[0], ov[1], ov[2], ov[3]}; *(u32x4*)(mp + 8) = (u32x4){ov[4], ov[5], ov[6], ov[7]};
            }
        }
    }
    LDS_BARRIER();
}

constexpr int L_PW = 34816, L_PU = 69632;
template <int W>
__device__ __forceinline__ void pool_diff(LAS unsigned char* lds, bool sample, int tilepos0) {
    const int tid = fresh_tid(), co = tid & 15, t0 = (tid >> 4) * 4;
    const int rb0 = sample ? (t0 >> 5) * 47 + 15 + (t0 & 31) : 15 + t0;
    LAS const unsigned char* up = lds + L_PU + co * 16;
    float sum[8];
#pragma unroll
    for (int e = 0; e < 8; ++e) sum[e] = 0.f;
    u32x4 xc = (u32x4){0u, 0u, 0u, 0u};
#pragma unroll
    for (int j = 0; j < W; ++j) { const u32x4 r = *(LAS const u32x4*)(up + (rb0 - j) * 272); if (j == 0) xc = r;
        sum[0] += bflo(r.x); sum[1] += bfhi(r.x); sum[2] += bflo(r.y); sum[3] += bfhi(r.y); sum[4] += bflo(r.z); sum[5] += bfhi(r.z); sum[6] += bflo(r.w); sum[7] += bfhi(r.w); }
#pragma unroll
    for (int tt = 0; tt < 4; ++tt) {
        if (tt > 0) { const u32x4 rn = *(LAS const u32x4*)(up + (rb0 + tt) * 272), ro = *(LAS const u32x4*)(up + (rb0 + tt - W) * 272); xc = rn;
            sum[0] += bflo(rn.x) - bflo(ro.x); sum[1] += bfhi(rn.x) - bfhi(ro.x); sum[2] += bflo(rn.y) - bflo(ro.y); sum[3] += bfhi(rn.y) - bfhi(ro.y);
            sum[4] += bflo(rn.z) - bflo(ro.z); sum[5] += bfhi(rn.z) - bfhi(ro.z); sum[6] += bflo(rn.w) - bflo(ro.w); sum[7] += bfhi(rn.w) - bfhi(ro.w); }
        const int cnt = sample ? W : min(tilepos0 + t0 + tt + 1, W); const float inv = 1.0f / (float)cnt;
        u32x4 w; w.x = pk2(sum[0] * inv - bflo(xc.x), sum[1] * inv - bfhi(xc.x)); w.y = pk2(sum[2] * inv - bflo(xc.y), sum[3] * inv - bfhi(xc.y));
        w.z = pk2(sum[4] * inv - bflo(xc.z), sum[5] * inv - bfhi(xc.z)); w.w = pk2(sum[6] * inv - bflo(xc.w), sum[7] * inv - bfhi(xc.w));
        *(LAS u32x4*)(lds + (t0 + tt) * 272 + co * 16) = w; }
}

__device__ __forceinline__ void pool_fetch(const Params& p, int item, int tid, u32x4 (&pf)[6]) {
    const int g = item & 3, R0 = (item >> 2) * 128;
    const bf16_t* proj = (const bf16_t*)(p.ws + WS_PROJ); const float* hist = p.in[2];
    if (R0 < MP) {
        const int seqrow0 = (R0 / SEQ) * SEQ, tilepos0 = R0 - seqrow0;
        u32x4 raw[6];
#pragma unroll
        for (int i = 0; i < 6; ++i) { const int piece = tid + 512 * i, e = piece >> 4, seg = piece & 15; int pos = tilepos0 - 15 + (e < 143 ? e : 142); pos = pos < 0 ? 0 : pos;
            raw[i] = *(const u32x4*)(proj + (size_t)(seqrow0 + pos) * NPROJ + g * 128 + seg * 8); }
#pragma unroll
        for (int i = 0; i < 6; ++i) pf[i] = raw[i];
    } else {
#pragma unroll
        for (int i = 0; i < 6; ++i) { const int piece = tid + 512 * i, e = piece >> 4, seg = piece & 15; u32x4 val = (u32x4){0u, 0u, 0u, 0u};
            if (e < 188) { const int sgi = e / 47, le = e - sgi * 47, b = ((R0 - MP) >> 5) + sgi;
                if (le < 15) { const float* hp = hist + ((size_t)b * 15 + le) * 512 + g * 128 + seg * 8; const float4 a = *(const float4*)hp, c4 = *(const float4*)(hp + 4);
                    val.x = pk2(a.x, a.y); val.y = pk2(a.z, a.w); val.z = pk2(c4.x, c4.y); val.w = pk2(c4.z, c4.w); }
                else val = *(const u32x4*)(proj + (size_t)(MP + b * 32 + le - 15) * NPROJ + g * 128 + seg * 8); }
            pf[i] = val; }
    }
}

__device__ __forceinline__ void pool_loop(const Params& p, LAS unsigned char* lds, int first, int stride, int end) {
    const int tid = fresh_tid(), lane = tid & 63, wave = __builtin_amdgcn_readfirstlane(tid >> 6), l15 = lane & 15, l4 = lane >> 4, st = wave & 3, tp = wave >> 2;
    bf16_t* mix = (bf16_t*)(p.ws + WS_MIX); const float* pscale = p.in[11];
    if (first >= end) return;
    u32x4 pf[6]; pool_fetch(p, first, tid, pf);
    int gw = -1;
#pragma unroll 1
    for (int item = first; item < end; item += stride) {
        const int g = item & 3, R0 = (item >> 2) * 128;
        const bool sample = R0 >= MP; const int tilepos0 = sample ? 0 : R0 - (R0 / SEQ) * SEQ;
        if (g != gw) { const bf16_t* Wp = (const bf16_t*)(p.ws + WS_WPOOL) + g * 16384; gw = g;
#pragma unroll
            for (int i = 0; i < 4; ++i) { const int piece = tid + 512 * i, row = piece >> 4, seg = piece & 15;
                *(LAS u32x4*)(lds + L_PW + row * 272 + seg * 16) = *(const u32x4*)(Wp + row * 128 + seg * 8); } }
#pragma unroll
        for (int i = 0; i < 6; ++i) { const int piece = tid + 512 * i, e = piece >> 4, seg = piece & 15; const bool keep = sample || ((e < 143) && (tilepos0 - 15 + e >= 0));
            if (e < 188) *(LAS u32x4*)(lds + L_PU + e * 272 + seg * 16) = keep ? pf[i] : (u32x4){0u, 0u, 0u, 0u}; }
        LDS_BARRIER();
        if (item + stride < end) pool_fetch(p, item + stride, tid, pf);
        if (g == 0) pool_diff<2>(lds, sample, tilepos0); else if (g == 1) pool_diff<4>(lds, sample, tilepos0); else if (g == 2) pool_diff<8>(lds, sample, tilepos0); else pool_diff<16>(lds, sample, tilepos0);
        LDS_BARRIER();
        f32x4 acc[2][4];
#pragma unroll
        for (int i = 0; i < 2; ++i)
#pragma unroll
            for (int n = 0; n < 4; ++n) acc[i][n] = (f32x4){0.f, 0.f, 0.f, 0.f};
#pragma unroll
        for (int ks = 0; ks < 4; ++ks) { const int kb = (32 * ks + 8 * l4) * 2; bf16x8 bv[4];
#pragma unroll
            for (int n = 0; n < 4; ++n) bv[n] = ldfrag(lds, 64 * tp + 16 * n + l15, 272, kb);
#pragma unroll
            for (int i = 0; i < 2; ++i) { const bf16x8 a = ldfrag(lds + L_PW, 32 * st + 16 * i + l15, 272, kb);
#pragma unroll
                for (int n = 0; n < 4; ++n) acc[i][n] = MFMA16(a, bv[n], acc[i][n]); } }
        LDS_BARRIER();
#pragma unroll
        for (int i = 0; i < 2; ++i) { const int d0 = 32 * st + 16 * i + 4 * l4; const float4 ps = *(const float4*)(pscale + g * 128 + d0);
#pragma unroll
            for (int n = 0; n < 4; ++n) { const int t = 64 * tp + 16 * n + l15;
                u32x2 w; w.x = pk2(acc[i][n][0] * ps.x, acc[i][n][1] * ps.y); w.y = pk2(acc[i][n][2] * ps.z, acc[i][n][3] * ps.w);
                *(LAS u32x2*)(lds + t * 272 + d0 * 2) = w; } }
        LDS_BARRIER();
        { const int t = tid >> 2, sg = tid & 3; const u32x4 o0 = *(LAS const u32x4*)(lds + t * 272 + sg * 64), o1 = *(LAS const u32x4*)(lds + t * 272 + sg * 64 + 16),
            o2 = *(LAS const u32x4*)(lds + t * 272 + sg * 64 + 32), o3 = *(LAS const u32x4*)(lds + t * 272 + sg * 64 + 48);
          bf16_t* mp = mix + (size_t)(R0 + t) * DM + g * 128 + sg * 32; *(u32x4*)mp = o0; *(u32x4*)(mp + 8) = o1; *(u32x4*)(mp + 16) = o2; *(u32x4*)(mp + 24) = o3; }
    }
    LDS_BARRIER();
}

constexpr int N_S2 = 224, N_SMP = 128, N_POOL = (MT / 128) * 4;

__device__ __forceinline__ void phase2(const Params& p, LAS unsigned char* lds, int kinds) {
    const int tid = fresh_tid(), lane = tid & 63, wave = tid >> 6, l15 = lane & 15, l4 = lane >> 4, st = wave & 3, tp = wave >> 2;
    float* Dst = (float*)(p.ws + WS_DST); float* Dn = (float*)(p.ws + WS_DN); const float* mtab = (const float*)(p.ws + WS_MTAB);
    const int step2 = (gridDim.x == 256) ? (blockIdx.x < N_S2 ? (1 << 20) : 32) : (int)gridDim.x;
    for (int it = blockIdx.x; it < N_S2 + N_SMP; it += step2) {
        if (it < N_S2) {
            if (!(kinds & 1)) continue;
            const int chain = it / 7, sc = it % 7, batch = chain >> 2, head = chain & 3;
            f32x4 accC[2][4], accN[2];
#pragma unroll
            for (int i = 0; i < 2; ++i) { accN[i] = (f32x4){0.f, 0.f, 0.f, 0.f};
#pragma unroll
                for (int n = 0; n < 4; ++n) accC[i][n] = (f32x4){0.f, 0.f, 0.f, 0.f}; }
            mlstm_run<false>(p, lds, accC, accN, batch * SEQ + sc * SCN * 64, head, SCN, 64);
            { float* dp = Dst + ((size_t)it * 512 + tid) * 32;
#pragma unroll
              for (int i = 0; i < 2; ++i)
#pragma unroll
                  for (int n = 0; n < 4; ++n) *(f32x4*)(dp + (i * 4 + n) * 4) = accC[i][n]; }
            if (tp == 0 && l15 == 0) {
#pragma unroll
                for (int i = 0; i < 2; ++i) *(f32x4*)(Dn + it * 128 + 32 * st + 16 * i + 4 * l4) = accN[i]; }
        } else {
            if (!(kinds & 2)) continue;
            const int s = it - N_S2, b = s >> 2, head = s & 3;
            const float* C0 = p.in[3] + (size_t)s * 16384; f32x4 accC[2][4], accN[2];
#pragma unroll
            for (int i = 0; i < 2; ++i) accN[i] = *(const f32x4*)(p.in[4] + s * 128 + 32 * st + 16 * i + 4 * l4);
#pragma unroll
            for (int i = 0; i < 2; ++i)
#pragma unroll
                for (int n = 0; n < 4; ++n)
#pragma unroll
                    for (int j = 0; j < 4; ++j) accC[i][n][j] = C0[(32 * st + 16 * i + 4 * l4 + j) * 128 + 64 * tp + 16 * n + l15];
            mlstm_run<true>(p, lds, accC, accN, MP + b * 32, head, 1, 32);
            float* Co = p.out + O_CS + (size_t)s * 16384;
#pragma unroll
            for (int i = 0; i < 2; ++i)
#pragma unroll
                for (int n = 0; n < 4; ++n)
#pragma unroll
                    for (int j = 0; j < 4; ++j) Co[(32 * st + 16 * i + 4 * l4 + j) * 128 + 64 * tp + 16 * n + l15] = accC[i][n][j];
            if (tp == 0 && l15 == 0) {
#pragma unroll
                for (int i = 0; i < 2; ++i) *(f32x4*)(p.out + O_NS + s * 128 + 32 * st + 16 * i + 4 * l4) = accN[i]; }
        }
    }
    if (kinds & 4) { const int G = gridDim.x; int first = blockIdx.x; while (first < N_S2 + N_SMP) first += G;
        pool_loop(p, lds, first - N_S2 - N_SMP, G, N_POOL); }
    const bf16_t* proj = (const bf16_t*)(p.ws + WS_PROJ);
    for (int idx = blockIdx.x * 512 + tid; idx < (NB + DB) * 15 * 512; idx += gridDim.x * 512) {
        if (idx < NB * 7680) { const int b = idx / 7680, rem = idx % 7680, i = rem >> 9, c = rem & 511;
            p.out[O_POOLP + idx] = bf2f(proj[(size_t)(b * SEQ + SEQ - 15 + i) * NPROJ + c]); }
        else { const int id2 = idx - NB * 7680, b = id2 / 7680, rem = id2 % 7680, i = rem >> 9, c = rem & 511;
            p.out[O_POOLS + id2] = bf2f(proj[(size_t)(MP + b * 32 + 17 + i) * NPROJ + c]); }
    }
}

__device__ __forceinline__ void phase3(const Params& p, LAS unsigned char* lds) {
    const int tid = fresh_tid(), lane = tid & 63, wave = tid >> 6, l15 = lane & 15, l4 = lane >> 4, st = wave & 3, tp = wave >> 2;
    const float* Dst = (const float*)(p.ws + WS_DST); const float* Dn = (const float*)(p.ws + WS_DN);
    const float* mtab = (const float*)(p.ws + WS_MTAB); const float* btab = (const float*)(p.ws + WS_BTAB);
    for (int it = blockIdx.x; it < 256; it += gridDim.x) {
        const int chain = it >> 3, sc = it & 7, batch = chain >> 2, head = chain & 3;
        f32x4 accC[2][4], accN[2];
#pragma unroll
        for (int i = 0; i < 2; ++i) { accN[i] = (f32x4){0.f, 0.f, 0.f, 0.f};
#pragma unroll
            for (int n = 0; n < 4; ++n) accC[i][n] = (f32x4){0.f, 0.f, 0.f, 0.f}; }
        f32x4 dC[2][4], dN[2];
        if (sc > 0) {
#pragma unroll
            for (int i = 0; i < 2; ++i) { dN[i] = *(const f32x4*)(Dn + (chain * 7) * 128 + 32 * st + 16 * i + 4 * l4);
#pragma unroll
                for (int n = 0; n < 4; ++n) dC[i][n] = *(const f32x4*)(Dst + ((size_t)(chain * 7) * 512 + tid) * 32 + (i * 4 + n) * 4); } }
#pragma unroll 1
        for (int j = 0; j < sc; ++j) {
            float Bs = 0.f;
            for (int c = 0; c < SCN; ++c) Bs += btab[chain * 128 + j * SCN + c];
            const float Wj = expf(Bs + mtab[chain * 132 + j * SCN] - mtab[chain * 132 + (j + 1) * SCN]);
#pragma unroll
            for (int i = 0; i < 2; ++i) { accN[i] = Wj * accN[i] + dN[i];
#pragma unroll
                for (int n = 0; n < 4; ++n) accC[i][n] = Wj * accC[i][n] + dC[i][n]; }
            if (j + 1 < sc) { const int item = chain * 7 + j + 1;
#pragma unroll
                for (int i = 0; i < 2; ++i) { dN[i] = *(const f32x4*)(Dn + item * 128 + 32 * st + 16 * i + 4 * l4);
#pragma unroll
                    for (int n = 0; n < 4; ++n) dC[i][n] = *(const f32x4*)(Dst + ((size_t)item * 512 + tid) * 32 + (i * 4 + n) * 4); } }
        }
        mlstm_run<true>(p, lds, accC, accN, batch * SEQ + sc * SCN * 64, head, SCN, 64);
        if (sc == 7) {
            const int t2 = fresh_tid(), l15b = t2 & 15, l4b = (t2 >> 4) & 3, stb = (t2 >> 6) & 3, tpb = t2 >> 8;
            float* Co = p.out + O_CP + (size_t)chain * 16384 + (32 * stb + 4 * l4b) * 128 + 64 * tpb + l15b;
#pragma unroll
            for (int i = 0; i < 2; ++i)
#pragma unroll
                for (int n = 0; n < 4; ++n)
#pragma unroll
                    for (int j = 0; j < 4; ++j) Co[(16 * i + j) * 128 + 16 * n] = accC[i][n][j];
            if (tpb == 0 && l15b == 0) {
#pragma unroll
                for (int i = 0; i < 2; ++i) *(f32x4*)(p.out + O_NP + chain * 128 + 32 * stb + 16 * i + 4 * l4b) = accN[i]; }
        }
    }
}

template <int S>
__device__ __forceinline__ void ln_load(const bf16_t* src, const float* slab, const bf16_t* hb, int row, int lane, float4 (&v)[4]) {
    if (row >= MP) {
#pragma unroll
        for (int i = 0; i < 4; ++i) { const int c = i * 256 + lane * 4; const u32x2 h2 = *(const u32x2*)(hb + (size_t)row * DM + c);
            const float* sp = slab + (size_t)(row - MP) * DM + c; float4 t[S];
#pragma unroll
            for (int sl = 0; sl < S; ++sl) t[sl] = *(const float4*)(sp + (size_t)sl * (1024 * 1024));
            float4 a = make_float4(ALPHA * bflo(h2.x), ALPHA * bfhi(h2.x), ALPHA * bflo(h2.y), ALPHA * bfhi(h2.y));
#pragma unroll
            for (int sl = 0; sl < S; ++sl) { a.x += t[sl].x; a.y += t[sl].y; a.z += t[sl].z; a.w += t[sl].w; }
            v[i] = a; }
    } else {
#pragma unroll
        for (int i = 0; i < 4; ++i) { const u32x2 r = *(const u32x2*)(src + (size_t)row * DM + i * 256 + lane * 4); v[i] = make_float4(bflo(r.x), bfhi(r.x), bflo(r.y), bfhi(r.y)); } }
}
template <bool TO_BF16, int S>
__device__ __forceinline__ void ln_rows(const bf16_t* src, const float* gam, const float* bet, bf16_t* ob, float* of, const float* slab, const bf16_t* hb) {
    const int tid = fresh_tid(), lane = tid & 63, wave = tid >> 6, stride = gridDim.x * 8;
    int row = blockIdx.x * 8 + wave; float4 v[4];
    if (row < MT) ln_load<S>(src, slab, hb, row, lane, v);
#pragma unroll 1
    for (; row < MT; row += stride) {
        const int nrow = row + stride; float4 nv[4];
        if (nrow < MT) ln_load<S>(src, slab, hb, nrow, lane, nv);
        else {
#pragma unroll
            for (int i = 0; i < 4; ++i) nv[i] = make_float4(0.f, 0.f, 0.f, 0.f); }
        float s = 0.f;
#pragma unroll
        for (int i = 0; i < 4; ++i) s += (v[i].x + v[i].y) + (v[i].z + v[i].w);
        const float mu = wave_sum(s) * (1.0f / DM); float q = 0.f;
#pragma unroll
        for (int i = 0; i < 4; ++i) { v[i].x -= mu; v[i].y -= mu; v[i].z -= mu; v[i].w -= mu; q += (v[i].x * v[i].x + v[i].y * v[i].y) + (v[i].z * v[i].z + v[i].w * v[i].w); }
        const float rstd = rsqrtf(wave_sum(q) * (1.0f / DM) + LN_EPS);
#pragma unroll
        for (int i = 0; i < 4; ++i) { const int c = i * 256 + lane * 4; const float4 gg = *(const float4*)(gam + c), bb = *(const float4*)(bet + c);
            float4 y; y.x = v[i].x * rstd * gg.x + bb.x; y.y = v[i].y * rstd * gg.y + bb.y; y.z = v[i].z * rstd * gg.z + bb.z; y.w = v[i].w * rstd * gg.w + bb.w;
            if (TO_BF16) { u32x2 w; w.x = pk2(y.x, y.y); w.y = pk2(y.z, y.w); *(u32x2*)(ob + (size_t)row * DM + c) = w; }
            else *(float4*)(of + (size_t)row * DM + c) = y; }
#pragma unroll
        for (int i = 0; i < 4; ++i) v[i] = nv[i];
    }
}

__global__ void __launch_bounds__(512) fwd_mega(Params p) {
    extern __shared__ __attribute__((aligned(16))) unsigned char smem[];
    LAS unsigned char* lds = (LAS unsigned char*)smem;
    cg::grid_group grid = cg::this_grid();
    volatile LAS unsigned* stw = (volatile LAS unsigned*)(lds + LDS_XB);
    if (threadIdx.x == 0) { stw[0] = 0u; stw[1] = 0u; }
    __syncthreads();
    const XcdBarrier xbar = xcd_barrier_post((unsigned*)(p.ws + WS_BAR), stw);
    unsigned char* ws = p.ws;
    bf16_t* h0 = (bf16_t*)(ws + WS_H0); bf16_t* proj = (bf16_t*)(ws + WS_PROJ); bf16_t* mix = (bf16_t*)(ws + WS_MIX); bf16_t* act = (bf16_t*)(ws + WS_ACT);
    float* slab = (float*)(ws + WS_SLAB);
    const int G = gridDim.x, bx = blockIdx.x;
#ifndef DBL
#define DBL 0
#endif
    if (DBL & 0x800) { for (int i = 0; i < 10; ++i) xcd_barrier(xbar); }
    if (DBL & 1) { phase0(p, lds); xcd_barrier(xbar); }
    phase0(p, lds);
    grid.sync();
    gate_scan(p, lds);
    for (int rep_ = 0; rep_ < ((DBL & 0x1000) ? 2 : 1); ++rep_)
    { if (rep_) xcd_barrier(xbar); pg8::Gemm g{h0, (const bf16_t*)(ws + WS_WIN), MT, NPROJ, DM}; SplitOrder S; S.init(NPROJ, DM / 64, 1, G, bx);
      EpiBf16B e{proj, NPROJ, (const float*)(ws + WS_BIAS)}; pg8::gemm_phase(lds, g, S, e); }
    xcd_barrier(xbar);
    if (DBL & 4) { phase2(p, lds, 15); xcd_barrier(xbar); }
    if (DBL & 0x200) { phase2(p, lds, 4); xcd_barrier(xbar); }
    if (DBL & 0x400) { phase2(p, lds, 1); xcd_barrier(xbar); }
    phase2(p, lds, 15);
    xcd_barrier(xbar);
    if (DBL & 8) { phase3(p, lds); xcd_barrier(xbar); }
    phase3(p, lds);
    xcd_barrier(xbar);
    for (int rep_ = 0; rep_ < ((DBL & 0x2000) ? 2 : 1); ++rep_)
    { if (rep_) xcd_barrier(xbar); pg8::Gemm g{mix, (const bf16_t*)(ws + WS_WOUT), MT, DM, DM}; SplitOrder S; S.init(DM, DM / 64, 4, G, bx);
      EpiRes e{h0, (bf16_t*)(ws + WS_R1), slab, DM / 64}; pg8::gemm_phase(lds, g, S, e); }
    xcd_barrier(xbar);
    if (DBL & 32) { ln_rows<true, 4>((const bf16_t*)(ws + WS_R1), p.in[14], p.in[15], h0, nullptr, slab, h0); xcd_barrier(xbar); }
    ln_rows<true, 4>((const bf16_t*)(ws + WS_R1), p.in[14], p.in[15], h0, nullptr, slab, h0);
    xcd_barrier(xbar);
    for (int rep_ = 0; rep_ < ((DBL & 0x4000) ? 2 : 1); ++rep_)
    { if (rep_) xcd_barrier(xbar); pg8::Gemm g{h0, (const bf16_t*)(ws + WS_WGU), MT, 2 * DFF, DM}; SplitOrder S; S.init(2 * DFF, DM / 64, 1, G, bx);
      EpiSwiglu e{act}; pg8::gemm_phase(lds, g, S, e); }
    xcd_barrier(xbar);
    for (int rep_ = 0; rep_ < ((DBL & 0x8000) ? 2 : 1); ++rep_)
    { if (rep_) xcd_barrier(xbar); pg8::Gemm g{act, (const bf16_t*)(ws + WS_WDN), MT, DM, DFF}; SplitOrder S; S.init(DM, DFF / 64, 11, G, bx);
      EpiRes e{h0, (bf16_t*)(ws + WS_R2), slab, DFF / 64}; pg8::gemm_phase(lds, g, S, e); }
    xcd_barrier(xbar);
    if (DBL & 0x10000) { ln_rows<false, 11>((const bf16_t*)(ws + WS_R2), p.in[19], p.in[20], nullptr, p.out + O_Y, slab, h0); xcd_barrier(xbar); }
    ln_rows<false, 11>((const bf16_t*)(ws + WS_R2), p.in[19], p.in[20], nullptr, p.out + O_Y, slab, h0);
}

extern "C" void kernel_launch(void* const* d_in, const int* in_sizes, int n_in, void* d_out, int out_size, void* d_ws, size_t ws_size, hipStream_t stream) {
    constexpr size_t kDynLds = LDS_TOTAL;
    static int grid_blocks = 0;
    if (!grid_blocks) {
        if (n_in != 21 || (size_t)out_size != O_END || ws_size < WS_END3) { fprintf(stderr, "kernel_launch: unexpected shapes: n_in %d out %d ws %zu (need %zu)\n", n_in, out_size, ws_size, (size_t)WS_END3); grid_blocks = -1; return; }
        int dev = 0, cus = 0, per_cu = 0;
        hipGetDevice(&dev);
        hipDeviceGetAttribute(&cus, hipDeviceAttributeMultiprocessorCount, dev);
        if (hipFuncSetAttribute((const void*)fwd_mega, hipFuncAttributeMaxDynamicSharedMemorySize, (int)kDynLds) != hipSuccess) { fprintf(stderr, "kernel_launch: hipFuncSetAttribute failed\n"); grid_blocks = -1; return; }
        if (hipOccupancyMaxActiveBlocksPerMultiprocessor(&per_cu, (const void*)fwd_mega, 512, kDynLds) != hipSuccess || per_cu < 1) { fprintf(stderr, "kernel_launch: occupancy query failed (%d)\n", per_cu); grid_blocks = -1; return; }
        if (per_cu > 1) per_cu = 1;
        grid_blocks = cus * per_cu;
    }
    if (grid_blocks < 0) return;
    if (hipMemsetAsync((char*)d_ws + WS_BAR, 0, XCD_BAR_WORDS * 4, stream) != hipSuccess) { fprintf(stderr, "kernel_launch: memset of the barrier words failed\n"); return; }
    Params p{};
    for (int i = 0; i < 21; ++i) p.in[i] = (const float*)d_in[i];
    p.out = (float*)d_out; p.ws = (unsigned char*)d_ws;
    void* args[] = {&p};
    hipError_t e = hipLaunchCooperativeKernel((const void*)fwd_mega, dim3(grid_blocks), dim3(512), args, kDynLds, stream);
    if (e != hipSuccess) fprintf(stderr, "cooperative launch failed: %s (grid %d)\n", hipGetErrorString(e), grid_blocks);
}
```

```cpp
#include <hip/hip_runtime.h>
#include <hip/hip_cooperative_groups.h>
#include <cstdio>
namespace cg = cooperative_groups;
namespace pg8 {
#define PG8_LAS __attribute__((address_space(3)))
typedef unsigned short bf16_t;
typedef short bf16x8 __attribute__((ext_vector_type(8)));
typedef float f32x4 __attribute__((ext_vector_type(4)));
typedef unsigned u32x4 __attribute__((ext_vector_type(4)));
typedef int i32x4 __attribute__((ext_vector_type(4)));
typedef int i32x8 __attribute__((ext_vector_type(8)));
constexpr int BM = 256, BK = 64, HALF = 128, HTB = HALF * BK * 2  , STAGE_BYTES = 8 * HTB, NXCD = 8, WGM = 8;

__host__ __device__ __forceinline__ int lds_byte(int r, int c) { const int st = (r >> 4) * 2 + (c >> 5), rr = r & 15, cc = c & 31, ob = rr * 64 + cc * 2; return st * 1024 + (ob ^ (((ob >> 9) & 1) << 5)); }
__host__ __device__ __forceinline__ void stage_rc(int b, int& R, int& C) { const int st = b / 1024, sb = b % 1024, swz = sb ^ (((sb >> 9) & 1) << 5); R = (st >> 1) * 16 + swz / 64; C = (st & 1) * 32 + (swz % 64) / 2; }
__host__ __device__ __forceinline__ int perm32(int rho) { const int n = rho >> 4, i = rho & 15; return 8 * (i >> 2) + 4 * n + (i & 3); }

struct Unit { int pm, pn, kt0, nkt; };
struct Gemm { const bf16_t* A; const bf16_t* Bt; int M, N, K; };
struct StaticOrder {
    int nM, nN, nwg, G, c;
    __host__ __device__ void init(int M, int N, int G_, int c_) { nM = M / BM; nN = N / BM; nwg = nM * nN; G = G_; c = c_; }
    __host__ __device__ bool next(int i, Unit& u) const {
        const long L = (long)i * G + c; if (L >= nwg) return false;
        int wgid = (int)L; { const int q = nwg / NXCD, r = nwg % NXCD, xcd = wgid % NXCD, off = wgid / NXCD; wgid = (xcd < r ? xcd * (q + 1) : r * (q + 1) + (xcd - r) * q) + off; }
        const int nig = WGM * nN, gid = wgid / nig, fm = gid * WGM, gsz = (nM - fm) < WGM ? (nM - fm) : WGM;
        u.pm = fm + ((wgid % nig) % gsz); u.pn = (wgid % nig) / gsz; u.kt0 = 0; u.nkt = 0; return true;
    }
    __device__ __forceinline__ void a_ready(const Unit&) const {}
    __device__ __forceinline__ void done(const Unit&) const {}
};
__device__ __forceinline__ unsigned cvt_pk_bf16(float lo, float hi) { unsigned r; asm volatile("v_cvt_pk_bf16_f32 %0, %1, %2" : "=v"(r) : "v"(lo), "v"(hi)); return r; }
template <class Epi, class Sched, bool FP8 = false>
__device__ __forceinline__ void gemm_phase(PG8_LAS unsigned char* lds, const Gemm g, const Sched& S, const Epi& E) {
    int tid_ = threadIdx.x; asm volatile("" : "+v"(tid_)); const int tid = tid_, wid = __builtin_amdgcn_readfirstlane(tid >> 6), lane = tid & 63, wr = wid >> 2, wc = wid & 3, fr = lane & 15, fq = lane >> 4;
    const int K = g.K;
    unsigned voffA[2], voffB[2];
#pragma unroll
    for (int i = 0; i < 2; ++i) { int R, C; stage_rc(tid * 16 + i * 8192, R, C); const int Rb = Epi::PERM ? ((R & ~31) + perm32(R & 31)) : R;
        voffA[i] = (unsigned)(R * K + C) * 2u; voffB[i] = (unsigned)(Rb * K + C) * 2u; }
    const size_t kstep = (size_t)(BK * 2);
    const size_t hstep = (size_t)HALF * K * 2;
    const size_t tstep = 2 * hstep;
    const unsigned ldsw = (unsigned)wid * 1024u;
    const int aoff = FP8 ? lds_byte(wr * 64 + fr, fq * 16) : lds_byte(wr * 64 + fr, fq * 8), boff = FP8 ? lds_byte(wc * 32 + fr, fq * 16) : lds_byte(wc * 32 + fr, fq * 8);
#define PG8_SA(b, h) (((b) * 2 + (h)) * HTB)
#define PG8_SB(b, h) ((4 + (b) * 2 + (h)) * HTB)
#define PG8_STAGE(bufoff, gbase, voff) do { _Pragma("unroll") for (int _i = 0; _i < 2; ++_i) \
        __builtin_amdgcn_global_load_lds((const unsigned*)((const char*)(gbase) + (voff)[_i]), (PG8_LAS unsigned*)(lds + (bufoff) + ldsw + _i * 8192), 16, 0, 0); } while (0)
#define PG8_LDA(dst, dst8, b, h) do { if constexpr (FP8) { _Pragma("unroll") for (int m = 0; m < 4; ++m) { dst8[m].lo = *(const PG8_LAS i32x4*)(lds + PG8_SA(b, h) + aoff + m * 2048); dst8[m].hi = *(const PG8_LAS i32x4*)(lds + PG8_SA(b, h) + aoff + m * 2048 + 16); } } \
    else { _Pragma("unroll") for (int m = 0; m < 4; ++m) _Pragma("unroll") for (int k = 0; k < 2; ++k) dst[m][k] = *(const PG8_LAS bf16x8*)(lds + PG8_SA(b, h) + aoff + m * 2048 + k * 1024); } } while (0)
#define PG8_LDB(dst, dst8, b, h) do { if constexpr (FP8) { _Pragma("unroll") for (int n = 0; n < 2; ++n) { dst8[n].lo = *(const PG8_LAS i32x4*)(lds + PG8_SB(b, h) + boff + n * 2048); dst8[n].hi = *(const PG8_LAS i32x4*)(lds + PG8_SB(b, h) + boff + n * 2048 + 16); } } \
    else { _Pragma("unroll") for (int n = 0; n < 2; ++n) _Pragma("unroll") for (int k = 0; k < 2; ++k) dst[n][k] = *(const PG8_LAS bf16x8*)(lds + PG8_SB(b, h) + boff + n * 2048 + k * 1024); } } while (0)
#define PG8_MMA(ai, bj, At, Bt, At8, Bt8) do { __builtin_amdgcn_s_setprio(1); \
    if constexpr (FP8) { _Pragma("unroll") for (int m = 0; m < 4; ++m) _Pragma("unroll") for (int n = 0; n < 2; ++n) \
        asm volatile("v_mfma_scale_f32_16x16x128_f8f6f4 %0, %1, %2, %0, %3, %3 op_sel_hi:[0,0,0]" : "+v"(acc[ai][bj][m][n]) : "v"(Bt8[n]), "v"(At8[m]), "v"(sc1_)); } \
    else { _Pragma("unroll") for (int m = 0; m < 4; ++m) _Pragma("unroll") for (int n = 0; n < 2; ++n) _Pragma("unroll") for (int k = 0; k < 2; ++k) \
        acc[ai][bj][m][n] = __builtin_amdgcn_mfma_f32_16x16x32_bf16(Bt[n][k], At[m][k], acc[ai][bj][m][n], 0, 0, 0); } \
    __builtin_amdgcn_s_setprio(0); } while (0)
#define PG8_WAIT_V(n) asm volatile("s_waitcnt vmcnt(" #n ")" ::: "memory")
#define PG8_WAIT_L(n) asm volatile("s_waitcnt lgkmcnt(" #n ")" ::: "memory")
#define PG8_BAR __builtin_amdgcn_s_barrier()
#define PG8_SCHED __builtin_amdgcn_sched_barrier(0)
    Unit cur, nxt; int ui = 0;
    if (!S.next(0, cur)) return;
    f32x4 acc[2][2][4][2];
#pragma unroll
    for (int a = 0; a < 2; ++a)
#pragma unroll
        for (int b = 0; b < 2; ++b)
#pragma unroll
            for (int m = 0; m < 4; ++m)
#pragma unroll
                for (int n = 0; n < 2; ++n) acc[a][b][m][n] = (f32x4){0.f, 0.f, 0.f, 0.f};
    bf16x8 At[4][2], B0[2][2], B1[2][2]; i32x8 At8[4], B08[2], B18[2]; const int sc1_ = 0x7f7f7f7f;
    const char* cA = (const char*)g.A + (size_t)cur.pm * tstep + (size_t)cur.kt0 * kstep; const char* cB = (const char*)g.Bt + (size_t)cur.pn * tstep + (size_t)cur.kt0 * kstep;
    S.a_ready(cur);
    PG8_STAGE(PG8_SB(0, 0), cB, voffB); PG8_STAGE(PG8_SA(0, 0), cA, voffA); PG8_STAGE(PG8_SB(0, 1), cB + hstep, voffB); PG8_STAGE(PG8_SA(0, 1), cA + hstep, voffA);
    if (wr == 1) PG8_BAR;
    PG8_WAIT_V(4); PG8_BAR;
    PG8_STAGE(PG8_SB(1, 0), cB + kstep, voffB); PG8_STAGE(PG8_SA(1, 0), cA + kstep, voffA); PG8_STAGE(PG8_SB(1, 1), cB + hstep + kstep, voffB);
    PG8_WAIT_V(6); PG8_BAR;
    for (;;) {
        const bool has_next = S.next(ui + 1, nxt);
        const char* nA = has_next ? (const char*)g.A + (size_t)nxt.pm * tstep + (size_t)nxt.kt0 * kstep : cA; const char* nB = has_next ? (const char*)g.Bt + (size_t)nxt.pn * tstep + (size_t)nxt.kt0 * kstep : cB;
        const int nt = cur.nkt;
        for (int t = 0; t < nt; t += 2) {
            const bool last = (t == nt - 2);
            const char* a1 = cA + (size_t)(t + 1) * kstep;
            const char* a2 = last ? nA : cA + (size_t)(t + 2) * kstep; const char* b2 = last ? nB : cB + (size_t)(t + 2) * kstep;
            const char* a3 = a2 + kstep; const char* b3 = b2 + kstep;
            if (last && has_next) S.a_ready(nxt);
            PG8_LDB(B0, B08, 0, 0); PG8_SCHED; PG8_LDA(At, At8, 0, 0); PG8_STAGE(PG8_SA(1, 1), a1 + hstep, voffA);
            PG8_WAIT_L(8); PG8_BAR; PG8_WAIT_L(0); PG8_MMA(0, 0, At, B0, At8, B08); PG8_BAR; PG8_SCHED;
            PG8_LDB(B1, B18, 0, 1); PG8_STAGE(PG8_SB(0, 0), b2, voffB);
            PG8_BAR; PG8_WAIT_L(0); PG8_MMA(0, 1, At, B1, At8, B18); PG8_BAR;
            PG8_LDA(At, At8, 0, 1); PG8_STAGE(PG8_SA(0, 0), a2, voffA);
            PG8_BAR; PG8_WAIT_L(0); PG8_MMA(1, 0, At, B0, At8, B08); PG8_BAR; PG8_SCHED;
            PG8_STAGE(PG8_SB(0, 1), b2 + hstep, voffB);
            PG8_WAIT_V(6); PG8_BAR; PG8_MMA(1, 1, At, B1, At8, B18); PG8_BAR;
            PG8_LDB(B0, B08, 1, 0); PG8_SCHED; PG8_LDA(At, At8, 1, 0); PG8_STAGE(PG8_SA(0, 1), a2 + hstep, voffA);
            PG8_WAIT_L(8); PG8_BAR; PG8_WAIT_L(0); PG8_MMA(0, 0, At, B0, At8, B08); PG8_BAR; PG8_SCHED;
            PG8_LDB(B1, B18, 1, 1); PG8_STAGE(PG8_SB(1, 0), b3, voffB);
            PG8_BAR; PG8_WAIT_L(0); PG8_MMA(0, 1, At, B1, At8, B18); PG8_BAR;
            PG8_LDA(At, At8, 1, 1); PG8_STAGE(PG8_SA(1, 0), a3, voffA);
            PG8_BAR; PG8_WAIT_L(0); PG8_MMA(1, 0, At, B0, At8, B08); PG8_BAR; PG8_SCHED;
            PG8_STAGE(PG8_SB(1, 1), b3 + hstep, voffB);
            PG8_WAIT_V(6); PG8_BAR; PG8_MMA(1, 1, At, B1, At8, B18); PG8_BAR;
        }
        if constexpr (FP8) { asm volatile("s_nop 15\n\ts_nop 15" ::: "memory"); }
        if constexpr (!Epi::AFTER_DRAIN) { E(acc, cur, wr, wc, fr, fq); S.done(cur); }
        if (!has_next) break;
#pragma unroll
        for (int a = 0; a < 2; ++a)
#pragma unroll
            for (int b = 0; b < 2; ++b)
#pragma unroll
                for (int m = 0; m < 4; ++m)
#pragma unroll
                    for (int n = 0; n < 2; ++n) acc[a][b][m][n] = (f32x4){0.f, 0.f, 0.f, 0.f};
        cur = nxt; cA = nA; cB = nB; ++ui;
    }
    PG8_WAIT_V(0);
    if (wr == 0) PG8_BAR;
    PG8_BAR;
    if constexpr (Epi::AFTER_DRAIN) { E.fused(acc, cur, wr, wc, fr, fq, lds, wid, lane); S.done(cur); }
#undef PG8_SA
#undef PG8_SB
#undef PG8_STAGE
#undef PG8_LDA
#undef PG8_LDB
#undef PG8_MMA
#undef PG8_WAIT_V
#undef PG8_WAIT_L
#undef PG8_BAR
#undef PG8_SCHED
}
}

using pg8::bf16_t; using pg8::bf16x8; using pg8::f32x4; using pg8::u32x4;
#define LAS __attribute__((address_space(3)))
typedef unsigned u32x2 __attribute__((ext_vector_type(2)));

constexpr int DM = 1024, NB = 8, SEQ = 8192, DB = 32, DS = 32;
constexpr int MP = NB * SEQ, MS = DB * DS, MT = MP + MS;
constexpr int NPROJ = 2560, INCOLS = 2568, DFF = 2816;
constexpr int SCN = 16;
constexpr float ALPHA = 1.189207115002721f, KSCALE = 0.08838834764831845f, LN_EPS = 1e-5f;

constexpr size_t al256(size_t x) { return (x + 255) & ~(size_t)255; }
constexpr size_t WS_BAR = 0;
constexpr size_t WS_WIN = 16384;
constexpr size_t WS_WOUT = WS_WIN + al256((size_t)NPROJ * DM * 2);
constexpr size_t WS_WGU = WS_WOUT + al256((size_t)DM * DM * 2);
constexpr size_t WS_WDN = WS_WGU + al256((size_t)2 * DFF * DM * 2);
constexpr size_t WS_WPOOL = WS_WDN + al256((size_t)DM * DFF * 2);
constexpr size_t WS_BIAS = WS_WPOOL + al256((size_t)4 * 128 * 128 * 2);
constexpr size_t WS_GATES = WS_BIAS + al256((size_t)NPROJ * 4);
constexpr size_t WS_MTAB = WS_GATES + al256((size_t)MT * 8 * 4);
constexpr size_t WS_BTAB = WS_MTAB + al256((size_t)32 * 132 * 4);
constexpr size_t WS_GTAB = WS_BTAB + al256((size_t)32 * 128 * 4);
constexpr size_t WS_DST = WS_GTAB + al256((size_t)MT * 4 * 16);
constexpr size_t WS_DN = WS_DST + al256((size_t)224 * 16384 * 4);
constexpr size_t WS_H0 = WS_DN + al256((size_t)224 * 128 * 4);
constexpr size_t WS_PROJ = WS_H0 + al256((size_t)MT * DM * 2);
constexpr size_t WS_MIX = WS_PROJ + al256((size_t)MT * NPROJ * 2);
constexpr size_t WS_END = WS_MIX + al256((size_t)MT * DM * 2);
constexpr size_t WS_SLAB = WS_END;
constexpr size_t WS_END2 = WS_SLAB + (size_t)11 * 1024 * 1024 * 4;
constexpr size_t WS_R2 = WS_END2;
constexpr size_t WS_END3 = WS_R2 + al256((size_t)MT * DM * 2);
constexpr size_t WS_H8 = WS_MIX + ((size_t)64 << 20);
constexpr float W8_SCALE = 32.0f;
constexpr size_t WS_R1 = WS_PROJ;
constexpr size_t WS_ACT = WS_PROJ;
static_assert((size_t)MT * DFF * 2 <= WS_END - WS_PROJ, "act does not fit");
static_assert(WS_PROJ + (size_t)MT * DFF * 2 <= WS_MIX + ((size_t)64 << 20) && WS_MIX + ((size_t)64 << 20) + (size_t)MT * DM <= WS_END, "h8 placement");

constexpr size_t O_Y = 0;
constexpr size_t O_POOLP = (size_t)MT * DM;
constexpr size_t O_CP = O_POOLP + (size_t)NB * 15 * 512;
constexpr size_t O_NP = O_CP + (size_t)NB * 4 * 16384;
constexpr size_t O_MP = O_NP + (size_t)NB * 4 * 128;
constexpr size_t O_POOLS = O_MP + (size_t)NB * 4;
constexpr size_t O_CS = O_POOLS + (size_t)DB * 15 * 512;
constexpr size_t O_NS = O_CS + (size_t)DB * 4 * 16384;
constexpr size_t O_MS = O_NS + (size_t)DB * 4 * 128;
constexpr size_t O_END = O_MS + (size_t)DB * 4;

struct Params { const float* in[21]; float* out; unsigned char* ws; };

__device__ __forceinline__ int fresh_tid() { int t = threadIdx.x; asm volatile("" : "+v"(t)); return t; }
__device__ __forceinline__ float bf2f(unsigned x) { return __uint_as_float(x << 16); }
__device__ __forceinline__ float bflo(unsigned w) { return __uint_as_float(w << 16); }
__device__ __forceinline__ float bfhi(unsigned w) { return __uint_as_float(w & 0xffff0000u); }
__device__ __forceinline__ unsigned pk2(float lo, float hi) { return pg8::cvt_pk_bf16(lo, hi); }
__device__ __forceinline__ unsigned pk4_fp8(float a, float b, float c, float d) { int r = __builtin_amdgcn_cvt_pk_fp8_f32(a, b, 0, false); r = __builtin_amdgcn_cvt_pk_fp8_f32(c, d, r, true); return (unsigned)r; }
__device__ __forceinline__ float wave_sum(float v) {
#pragma unroll
    for (int o = 32; o; o >>= 1) v += __shfl_xor(v, o);
    return v; }
__device__ __forceinline__ float wave_max(float v) {
#pragma unroll
    for (int o = 32; o; o >>= 1) v = fmaxf(v, __shfl_xor(v, o));
    return v; }
__device__ __forceinline__ float scan_sum(float x, int lane) {
#pragma unroll
    for (int o = 1; o < 64; o <<= 1) { const float y = __shfl_up(x, o); if (lane >= o) x += y; }
    return x; }
__device__ __forceinline__ float scan_max(float x, int lane) {
#pragma unroll
    for (int o = 1; o < 64; o <<= 1) { const float y = __shfl_up(x, o); if (lane >= o) x = fmaxf(x, y); }
    return x; }
__device__ __forceinline__ float logsigmoid(float x) { return fminf(x, 0.f) - log1pf(expf(-fabsf(x))); }
__device__ __forceinline__ bf16x8 ldfrag(LAS const unsigned char* base, int row, int strideB, int kbyte) { return *(LAS const bf16x8*)(base + row * strideB + kbyte); }
#define LDS_BARRIER() do { asm volatile("s_waitcnt lgkmcnt(0)" ::: "memory"); __builtin_amdgcn_s_barrier(); asm volatile("" ::: "memory"); } while (0)
#define MFMA16(a, b, c) __builtin_amdgcn_mfma_f32_16x16x32_bf16((a), (b), (c), 0, 0, 0)

#define XB_TMO      128
#define XB_XCNT(j)  (256  + 64 * (j))
#define XB_XSUB(j)  (1280 + 64 * (j))
#define XB_XGEN(j)  (2304 + 64 * (j))
#define XB_TOP      3328
#define XB_TOPGEN   3392
#define XCD_BAR_WORDS 3456
#define XB_SPIN_CAP (1u << 18)
__device__ __forceinline__ unsigned xb_ld(unsigned* p)              { return __hip_atomic_load(p, __ATOMIC_RELAXED, __HIP_MEMORY_SCOPE_AGENT); }
__device__ __forceinline__ unsigned xb_add(unsigned* p, unsigned v) { return __hip_atomic_fetch_add(p, v, __ATOMIC_RELAXED, __HIP_MEMORY_SCOPE_AGENT); }
__device__ __forceinline__ unsigned xb_xcc_id() { return (unsigned)__builtin_amdgcn_s_getreg((3 << 11) | 20) & 0xFu; }
#define XB_SPIN(cond, bar) do { unsigned _sp = 0; while (cond) { __builtin_amdgcn_s_sleep(1); \
    if ((++_sp & 255u) == 0u) { if (xb_ld(&(bar)[XB_TMO])) break; if (_sp > XB_SPIN_CAP) { atomicAdd(&(bar)[XB_TMO], 1u); break; } } } } while (0)

struct XcdBarrier {
    unsigned* bar; unsigned x;
    volatile LAS unsigned* st;
};

__device__ __forceinline__ XcdBarrier xcd_barrier_post(unsigned* bar, volatile LAS unsigned* st) {
    XcdBarrier b; b.bar = bar; b.x = xb_xcc_id(); b.st = st;
    if (threadIdx.x == 0) (void)xb_add(&bar[XB_XCNT(b.x)], 1u);
    return b;
}
__device__ __forceinline__ void xcd_barrier_complete(unsigned* bar, unsigned x, unsigned& nloc, unsigned& nx) {
    const unsigned G = gridDim.x * gridDim.y * gridDim.z;
    unsigned sum, cnt, mine, sp = 0u;
    for (;;) {
        sum = 0u; cnt = 0u; mine = 0u;
#pragma unroll
        for (unsigned j = 0; j < 16; ++j) { const unsigned c = xb_ld(&bar[XB_XCNT(j)]); sum += c; cnt += (c > 0u) ? 1u : 0u; mine = (j == x) ? c : mine; }
        if (sum == G) break;
        __builtin_amdgcn_s_sleep(1);
        if ((++sp & 255u) == 0u) { if (xb_ld(&bar[XB_TMO])) break; if (sp > XB_SPIN_CAP) { atomicAdd(&bar[XB_TMO], 1u); break; } }
    }
    nloc = mine > 0u ? mine : 1u; nx = cnt > 0u ? cnt : 1u;
}

__device__ __forceinline__ void xcd_barrier(const XcdBarrier& b) {
    asm volatile("s_waitcnt vmcnt(0)" ::: "memory");
    __syncthreads();
    if (threadIdx.x == 0) {
        unsigned* bar = b.bar;
        __builtin_amdgcn_s_waitcnt(0);
        unsigned nloc = b.st[0], nx = b.st[1];
        if (nloc == 0u) { xcd_barrier_complete(bar, b.x, nloc, nx); b.st[0] = nloc; b.st[1] = nx; }
        const unsigned old = xb_add(&bar[XB_XSUB(b.x)], 1u);
        const unsigned gen = old / nloc;
        if (old + 1u == (gen + 1u) * nloc) {
            __builtin_amdgcn_fence(__ATOMIC_RELEASE, "agent");
            asm volatile("s_waitcnt vmcnt(0)" ::: "memory");
            const unsigned og = xb_add(&bar[XB_TOP], 1u);
            const unsigned tg = og / nx;
            if (og + 1u == (tg + 1u) * nx) xb_add(&bar[XB_TOPGEN], 1u);
            else XB_SPIN(xb_ld(&bar[XB_TOPGEN]) == tg, bar);
            __builtin_amdgcn_fence(__ATOMIC_ACQUIRE, "agent");
            xb_add(&bar[XB_XGEN(b.x)], 1u);
            asm volatile("s_waitcnt vmcnt(0)" ::: "memory");
        } else {
            XB_SPIN(xb_ld(&bar[XB_XGEN(b.x)]) == gen, bar);
            __builtin_amdgcn_fence(__ATOMIC_ACQUIRE, "agent");
            asm volatile("s_waitcnt vmcnt(0)" ::: "memory");
        }
    }
    __syncthreads();
}

struct SplitOrder {
    int nN, nP, S, nkt, G, c;
    __device__ __forceinline__ void init(int N, int Ktiles, int S_, int G_, int c_) { nN = N / 256; nP = 256 * nN; S = S_; nkt = Ktiles; G = G_; c = c_; }
    __device__ __forceinline__ bool next(int i, pg8::Unit& u) const {
        const long L = (long)i * G + c;
        if (L >= nP + 4 * nN * S) return false;
        int pm, pn, k0 = 0, kn = nkt;
        if (L < nP) { int wgid = (int)L; { const int q = nP / 8, xcd = wgid % 8, off = wgid / 8; wgid = xcd * q + off; }
            const int nig = 8 * nN, gid = wgid / nig, fm = gid * 8; pm = fm + ((wgid % nig) % 8); pn = (wgid % nig) / 8; }
        else { const int j = (int)(L - nP), su = j / S, sl = j - su * S; pm = 256 + su / nN; pn = su % nN; kn = nkt / S; k0 = sl * kn; }
        u.pm = pm; u.pn = pn; u.kt0 = k0; u.nkt = kn; return true;
    }
    __device__ __forceinline__ void a_ready(const pg8::Unit&) const {}
    __device__ __forceinline__ void done(const pg8::Unit&) const {}
};

struct EpiBf16B {
    static constexpr bool PERM = true, AFTER_DRAIN = false;
    bf16_t* O; int ldc; const float* bias;
    __device__ __forceinline__ void operator()(const f32x4 (&acc)[2][2][4][2], const pg8::Unit& u, int wr, int wc, int fr, int fq) const {
        const int row0 = u.pm * 256 + wr * 64 + fr, col0 = u.pn * 256 + wc * 32 + 8 * fq;
        f32x4 bv[2][2];
#pragma unroll
        for (int bj = 0; bj < 2; ++bj)
#pragma unroll
            for (int n = 0; n < 2; ++n) bv[bj][n] = *(const f32x4*)(bias + col0 + bj * 128 + 4 * n);
#pragma unroll
        for (int ai = 0; ai < 2; ++ai)
#pragma unroll
            for (int m = 0; m < 4; ++m) { bf16_t* rowp = O + (size_t)(row0 + ai * 128 + m * 16) * ldc + col0;
#pragma unroll
                for (int bj = 0; bj < 2; ++bj) { const f32x4 v0 = acc[ai][bj][m][0] + bv[bj][0], v1 = acc[ai][bj][m][1] + bv[bj][1];
                    u32x4 w; w.x = pk2(v0[0], v0[1]); w.y = pk2(v0[2], v0[3]); w.z = pk2(v1[0], v1[1]); w.w = pk2(v1[2], v1[3]);
                    *(u32x4*)(rowp + bj * 128) = w; } }
    }
};
struct EpiRes {
    static constexpr bool PERM = true, AFTER_DRAIN = false;
    const bf16_t* base; bf16_t* out; float* slab; int nkt_full;
    __device__ __forceinline__ void operator()(const f32x4 (&acc)[2][2][4][2], const pg8::Unit& u, int wr, int wc, int fr, int fq) const {
        const int row0 = u.pm * 256 + wr * 64 + fr, col0 = u.pn * 256 + wc * 32 + 8 * fq;
        if (u.nkt != nkt_full) {
            float* sp = slab + (size_t)(u.kt0 / u.nkt) * (1024 * 1024) + (size_t)(row0 - MP) * DM + col0;
#pragma unroll
            for (int ai = 0; ai < 2; ++ai)
#pragma unroll
                for (int m = 0; m < 4; ++m)
#pragma unroll
                    for (int bj = 0; bj < 2; ++bj)
#pragma unroll
                        for (int n = 0; n < 2; ++n) *(f32x4*)(sp + (size_t)(ai * 128 + m * 16) * DM + bj * 128 + 4 * n) = acc[ai][bj][m][n];
            return; }
        u32x4 bb[2][4][2];
#pragma unroll
        for (int ai = 0; ai < 2; ++ai)
#pragma unroll
            for (int m = 0; m < 4; ++m)
#pragma unroll
                for (int bj = 0; bj < 2; ++bj) bb[ai][m][bj] = *(const u32x4*)(base + (size_t)(row0 + ai * 128 + m * 16) * DM + col0 + bj * 128);
        asm volatile("" ::: "memory");
#pragma unroll
        for (int ai = 0; ai < 2; ++ai)
#pragma unroll
            for (int m = 0; m < 4; ++m) { const size_t off = (size_t)(row0 + ai * 128 + m * 16) * DM + col0;
#pragma unroll
                for (int bj = 0; bj < 2; ++bj) { const u32x4 b = bb[ai][m][bj]; const f32x4 a0 = acc[ai][bj][m][0], a1 = acc[ai][bj][m][1];
                    u32x4 w; w.x = pk2(ALPHA * bflo(b.x) + a0[0], ALPHA * bfhi(b.x) + a0[1]); w.y = pk2(ALPHA * bflo(b.y) + a0[2], ALPHA * bfhi(b.y) + a0[3]);
                    w.z = pk2(ALPHA * bflo(b.z) + a1[0], ALPHA * bfhi(b.z) + a1[1]); w.w = pk2(ALPHA * bflo(b.w) + a1[2], ALPHA * bfhi(b.w) + a1[3]);
                    *(u32x4*)(out + off + bj * 128) = w; } }
    }
};
__device__ __forceinline__ float fsigmoid(float x) { return __builtin_amdgcn_rcpf(1.0f + __expf(-x)); }
__device__ __forceinline__ float swiglu(float g, float u) { return g * u * fsigmoid(g); }
struct EpiSwiglu {
    static constexpr bool PERM = true, AFTER_DRAIN = false;
    bf16_t* O; float sc;
    __device__ __forceinline__ void operator()(const f32x4 (&acc)[2][2][4][2], const pg8::Unit& u, int wr, int wc, int fr, int fq) const {
        const int row0 = u.pm * 256 + wr * 64 + fr, col0 = u.pn * 128 + wc * 32 + 8 * fq;
#pragma unroll
        for (int ai = 0; ai < 2; ++ai)
#pragma unroll
            for (int m = 0; m < 4; ++m) { bf16_t* rowp = O + (size_t)(row0 + ai * 128 + m * 16) * DFF + col0;
                const f32x4 g0 = acc[ai][0][m][0] * sc, g1 = acc[ai][0][m][1] * sc, u0 = acc[ai][1][m][0] * sc, u1 = acc[ai][1][m][1] * sc;
                u32x4 w; w.x = pk2(swiglu(g0[0], u0[0]), swiglu(g0[1], u0[1])); w.y = pk2(swiglu(g0[2], u0[2]), swiglu(g0[3], u0[3]));
                w.z = pk2(swiglu(g1[0], u1[0]), swiglu(g1[1], u1[1])); w.w = pk2(swiglu(g1[2], u1[2]), swiglu(g1[3], u1[3]));
                *(u32x4*)rowp = w; }
    }
};

constexpr int TR_TILES = 640 + 256 + 704 + 704 + 704 + 16;
struct TileDesc { const float* src; bf16_t* dst; int ld, K, mode, k0, n0; };
__device__ __forceinline__ TileDesc tile_desc(const Params& p, int t) {
    TileDesc d; unsigned char* ws = p.ws;
    if (t < 640) { d.src = p.in[8]; d.ld = INCOLS; d.K = DM; d.mode = 3; d.dst = (bf16_t*)(ws + WS_WIN); }
    else if (t < 896) { t -= 640; d.src = p.in[13]; d.ld = DM; d.K = DM; d.mode = 0; d.dst = (bf16_t*)(ws + WS_WOUT); }
    else if (t < 1600) { t -= 896; d.src = p.in[16]; d.ld = DFF; d.K = DM; d.mode = 1; d.dst = (bf16_t*)(ws + WS_WGU); }
    else if (t < 2304) { t -= 1600; d.src = p.in[17]; d.ld = DFF; d.K = DM; d.mode = 2; d.dst = (bf16_t*)(ws + WS_WGU); }
    else if (t < 3008) { t -= 2304; d.src = p.in[18]; d.ld = DM; d.K = DFF; d.mode = 0; d.dst = (bf16_t*)(ws + WS_WDN); }
    else { t -= 3008; const int g = t >> 2; t &= 3; d.src = p.in[10] + g * 16384; d.ld = 128; d.K = 128; d.mode = 0; d.dst = (bf16_t*)(ws + WS_WPOOL) + g * 16384; }
    const int nkt = d.K >> 6; d.k0 = (t % nkt) * 64; d.n0 = (t / nkt) * 64; return d;
}

__device__ __forceinline__ void phase0(const Params& p, LAS unsigned char* lds) {
    const int tid = fresh_tid(), lane = tid & 63, wave = tid >> 6, G = gridDim.x, bx = blockIdx.x;
    unsigned char* ws = p.ws;
    LAS float* T = (LAS float*)lds;
    {
        const int r = tid >> 3, cs = (tid & 7) * 8;
        int t = bx; float4 a = make_float4(0.f, 0.f, 0.f, 0.f), b = a; TileDesc d = tile_desc(p, t < TR_TILES ? t : 0);
        if (t < TR_TILES) { const float* s = d.src + (size_t)(d.k0 + r) * d.ld + d.n0 + cs; a = *(const float4*)s; b = *(const float4*)(s + 4); }
#pragma unroll 1
        for (; t < TR_TILES; t += G) {
            { LAS float* q = T + r * 65 + cs; q[0] = a.x; q[1] = a.y; q[2] = a.z; q[3] = a.w; q[4] = b.x; q[5] = b.y; q[6] = b.z; q[7] = b.w; }
            const TileDesc dn = tile_desc(p, t + G < TR_TILES ? t + G : 0);
            if (t + G < TR_TILES) { const float* s = dn.src + (size_t)(dn.k0 + r) * dn.ld + dn.n0 + cs; a = *(const float4*)s; b = *(const float4*)(s + 4); }
            LDS_BARRIER();
            { const int n = tid >> 3, ks = (tid & 7) * 8, gn = d.n0 + n; float v[8];
#pragma unroll
              for (int i = 0; i < 8; ++i) v[i] = T[(ks + i) * 65 + n];
              const float sc = (d.mode == 3 && gn >= 1024 && gn < 1536) ? KSCALE : 1.0f;
              const int drow = (d.mode == 1) ? 256 * (gn >> 7) + (gn & 127) : (d.mode == 2) ? 256 * (gn >> 7) + 128 + (gn & 127) : gn;
              if (d.mode == 1 || d.mode == 2) {
                  u32x2 w8; w8.x = pk4_fp8(v[0] * W8_SCALE, v[1] * W8_SCALE, v[2] * W8_SCALE, v[3] * W8_SCALE); w8.y = pk4_fp8(v[4] * W8_SCALE, v[5] * W8_SCALE, v[6] * W8_SCALE, v[7] * W8_SCALE);
                  *(u32x2*)((unsigned char*)d.dst + (size_t)drow * d.K + d.k0 + ks) = w8; }
              else { u32x4 w; w.x = pk2(v[0] * sc, v[1] * sc); w.y = pk2(v[2] * sc, v[3] * sc); w.z = pk2(v[4] * sc, v[5] * sc); w.w = pk2(v[6] * sc, v[7] * sc);
                  *(u32x4*)(d.dst + (size_t)drow * d.K + d.k0 + ks) = w; } }
            LDS_BARRIER();
            d = dn;
        }
    }
    { float* bs = (float*)(ws + WS_BIAS); const float* b_in = p.in[9];
      for (int i = bx * 512 + tid; i < NPROJ; i += G * 512) bs[i] = b_in[i] * ((i >= 1024 && i < 1536) ? KSCALE : 1.0f); }
    f32x4 wlo[4][4], whi[4][4];
    { const float* w_in = p.in[8];
#pragma unroll
      for (int i = 0; i < 4; ++i)
#pragma unroll
          for (int e = 0; e < 4; ++e) { const float* wp = w_in + (size_t)(i * 256 + lane * 4 + e) * INCOLS + NPROJ; wlo[i][e] = *(const f32x4*)wp; whi[i][e] = *(const f32x4*)(wp + 4); } }
    const float* lg = p.in[6]; const float* lb = p.in[7]; const float* b_in = p.in[9];
    bf16_t* h0 = (bf16_t*)(ws + WS_H0); float* gates = (float*)(ws + WS_GATES);
    const float gb_perm = lane < 8 ? b_in[NPROJ + (((lane & 1) << 2) | (lane & 2) | ((lane >> 2) & 1))] : 0.f;
    int row = bx * 8 + wave; float4 v[4];
    if (row < MT) { const float* x = row < MP ? p.in[0] + (size_t)row * DM : p.in[1] + (size_t)(row - MP) * DM;
#pragma unroll
        for (int i = 0; i < 4; ++i) v[i] = *(const float4*)(x + i * 256 + lane * 4); }
#pragma unroll 1
    for (; row < MT; row += G * 8) {
        const int nrow = row + G * 8; float4 nv[4];
        if (nrow < MT) { const float* x = nrow < MP ? p.in[0] + (size_t)nrow * DM : p.in[1] + (size_t)(nrow - MP) * DM;
#pragma unroll
            for (int i = 0; i < 4; ++i) nv[i] = *(const float4*)(x + i * 256 + lane * 4); }
        else {
#pragma unroll
            for (int i = 0; i < 4; ++i) nv[i] = make_float4(0.f, 0.f, 0.f, 0.f); }
        float s = 0.f;
#pragma unroll
        for (int i = 0; i < 4; ++i) s += (v[i].x + v[i].y) + (v[i].z + v[i].w);
        const float mu = wave_sum(s) * (1.0f / DM);
        float q = 0.f;
#pragma unroll
        for (int i = 0; i < 4; ++i) { v[i].x -= mu; v[i].y -= mu; v[i].z -= mu; v[i].w -= mu; q += (v[i].x * v[i].x + v[i].y * v[i].y) + (v[i].z * v[i].z + v[i].w * v[i].w); }
        const float rstd = rsqrtf(wave_sum(q) * (1.0f / DM) + LN_EPS);
        f32x4 glo = (f32x4){0.f, 0.f, 0.f, 0.f}, ghi = glo;
#pragma unroll
        for (int i = 0; i < 4; ++i) { const int c = i * 256 + lane * 4; const float4 gg = *(const float4*)(lg + c), bb = *(const float4*)(lb + c);
            float4 y; y.x = v[i].x * rstd * gg.x + bb.x; y.y = v[i].y * rstd * gg.y + bb.y; y.z = v[i].z * rstd * gg.z + bb.z; y.w = v[i].w * rstd * gg.w + bb.w;
            u32x2 w; w.x = pk2(y.x, y.y); w.y = pk2(y.z, y.w); *(u32x2*)(h0 + (size_t)row * DM + c) = w;
            glo += y.x * wlo[i][0] + y.y * wlo[i][1] + y.z * wlo[i][2] + y.w * wlo[i][3];
            ghi += y.x * whi[i][0] + y.y * whi[i][1] + y.z * whi[i][2] + y.w * whi[i][3]; }
        { const bool b0 = lane & 1, b1 = lane & 2, b2 = lane & 4;
          f32x4 k4, s4;
#pragma unroll
          for (int j = 0; j < 4; ++j) { k4[j] = b0 ? ghi[j] : glo[j]; s4[j] = b0 ? glo[j] : ghi[j]; }
#pragma unroll
          for (int j = 0; j < 4; ++j) k4[j] += __shfl_xor(s4[j], 1);
          float k2a = b1 ? k4[2] : k4[0], k2b = b1 ? k4[3] : k4[1];
          k2a += __shfl_xor(b1 ? k4[0] : k4[2], 2); k2b += __shfl_xor(b1 ? k4[1] : k4[3], 2);
          float k1 = b2 ? k2b : k2a; k1 += __shfl_xor(b2 ? k2a : k2b, 4);
          k1 += __shfl_xor(k1, 8); k1 += __shfl_xor(k1, 16); k1 += __shfl_xor(k1, 32);
          const int gidx = ((lane & 1) << 2) | (lane & 2) | ((lane >> 2) & 1);
          if (lane < 8) gates[(size_t)row * 8 + gidx] = k1 + gb_perm; }
#pragma unroll
        for (int i = 0; i < 4; ++i) v[i] = nv[i];
    }
}

__device__ __forceinline__ void gate_scan(const Params& p, LAS unsigned char* lds) {
    const int tid = fresh_tid(), lane = tid & 63, wave = tid >> 6, G = gridDim.x;
    const float* gates = (const float*)(p.ws + WS_GATES); float* mtab = (float*)(p.ws + WS_MTAB); float* btab = (float*)(p.ws + WS_BTAB);
    f32x4* gtab = (f32x4*)(p.ws + WS_GTAB);
    LAS float* sA = (LAS float*)lds; LAS float* sB = sA + 128; LAS float* sM = sA + 256;
    const int vb = (blockIdx.x + G - (64 % G)) % G;
    for (int chain = vb; chain < 32; chain += G) {
        const int batch = chain >> 2, head = chain & 3;
        float ig[16], bb[16];
#pragma unroll
        for (int k = 0; k < 16; ++k) { const size_t row = (size_t)batch * SEQ + (wave + 8 * k) * 64 + lane; ig[k] = gates[row * 8 + head]; bb[k] = gates[row * 8 + 4 + head]; }
#pragma unroll
        for (int k = 0; k < 16; ++k) { bb[k] = scan_sum(logsigmoid(bb[k]), lane); const float A = wave_max(ig[k] - bb[k]); const float bl = __shfl(bb[k], 63);
            if (lane == 0) { sA[wave + 8 * k] = A; sB[wave + 8 * k] = bl; } }
        __syncthreads();
        if (tid == 0) { float m = 0.f; mtab[chain * 132] = 0.f; sM[0] = 0.f;
            for (int c = 0; c < 128; ++c) { m = sB[c] + fmaxf(m, sA[c]); mtab[chain * 132 + c + 1] = m; sM[c + 1] = m; btab[chain * 128 + c] = sB[c]; }
            p.out[O_MP + chain] = m; }
        __syncthreads();
#pragma unroll
        for (int k = 0; k < 16; ++k) { const int c = wave + 8 * k; const size_t row = (size_t)batch * SEQ + c * 64 + lane;
            const float a = ig[k] - bb[k]; const float m_prev = sM[c]; const float M = fmaxf(m_prev, scan_max(a, lane));
            gtab[row * 4 + head] = (f32x4){a, M, expf(m_prev - M), expf(-(bb[k] + M))}; }
        __syncthreads();
    }
    const int vb2 = (blockIdx.x + G - (96 % G)) % G;
    for (int s = vb2 * 8 + wave; s < DB * 4; s += G * 8) {
        const int b_ = s >> 2, head = s & 3; const bool valid = lane < 32; const size_t row = (size_t)MP + b_ * 32 + (lane & 31);
        const float ig = gates[row * 8 + head], fg = gates[row * 8 + 4 + head]; const float m_prev = p.in[5][s];
        const float b = scan_sum(valid ? logsigmoid(fg) : 0.f, lane); const float a = valid ? ig - b : -1e30f;
        const float M = fmaxf(m_prev, scan_max(a, lane));
        if (valid) gtab[row * 4 + head] = (f32x4){a, M, expf(m_prev - M), expf(-(b + M))};
        if (lane == 31) p.out[O_MS + s] = b + M;
    }
}

constexpr int L_Q = 0, L_K = 17408, L_KW = 34816, L_V = 52224, L_CT = 69632, L_S = 104448, L_G = 113664, L_H = 116512;
constexpr int LDS_XB = 152000, LDS_TOTAL = 152064;
typedef short s16x4 __attribute__((ext_vector_type(4)));
__device__ __forceinline__ bf16x8 ldfrag_tr(LAS const unsigned char* base, int row0, int col0, int lane) {
    const int g = lane >> 4, q = (lane & 15) >> 2, pp = lane & 3;
    LAS const unsigned char* a = base + (row0 + 8 * g + q) * 272 + (col0 + 4 * pp) * 2;
    const s16x4 lo = __builtin_amdgcn_ds_read_tr16_b64_v4i16((LAS s16x4*)a);
    const s16x4 hi = __builtin_amdgcn_ds_read_tr16_b64_v4i16((LAS s16x4*)(a + 4 * 272));
    return __builtin_shufflevector(lo, hi, 0, 1, 2, 3, 4, 5, 6, 7);
}

template <bool FULL>
__device__ __forceinline__ void mlstm_run(const Params& p, LAS unsigned char* lds, f32x4 (&accC)[2][4], f32x4 (&accN)[2], int row0, int head, int nch, int L) {
    const int tid = fresh_tid(), lane = tid & 63, wave = __builtin_amdgcn_readfirstlane(tid >> 6), l15 = lane & 15, l4 = lane >> 4, st = wave & 3, tp = wave >> 2;
    const bf16_t* proj = (const bf16_t*)(p.ws + WS_PROJ); const f32x4* gtab = (const f32x4*)(p.ws + WS_GTAB);
    bf16_t* mix = (bf16_t*)(p.ws + WS_MIX);
    LAS unsigned short* sQ = (LAS unsigned short*)(lds + L_Q); LAS unsigned short* sK = (LAS unsigned short*)(lds + L_K);
    LAS unsigned short* sKW = (LAS unsigned short*)(lds + L_KW); LAS unsigned short* sV = (LAS unsigned short*)(lds + L_V);
    LAS unsigned short* sS = (LAS unsigned short*)(lds + L_S); LAS float* sH = (LAS float*)(lds + L_H);
    LAS float* gA = (LAS float*)(lds + L_G); LAS float* gM = gA + 64; LAS float* gDec = gA + 128; LAS float* gEinv = gA + 192; LAS float* gW = gA + 256;
    LAS float* gQn = gA + 320; LAS float* gDi = gA + 384; LAS float* gN = gA + 448; LAS float* scal = gA + 576; LAS float* gNg = gA + 584;
    const bf16x8 ones = (bf16x8){0x3F80, 0x3F80, 0x3F80, 0x3F80, 0x3F80, 0x3F80, 0x3F80, 0x3F80};
    const int tok0 = tid >> 4, dsg = tid & 15;
    const int orow = tid >> 3, oseg = tid & 7;
    u32x4 kq[2], kk[2], kv[2]; f32x4 pgt = (f32x4){0.f, 0.f, 0.f, 0.f}; float pa[2] = {-1e30f, -1e30f}, pml = 0.f;
    if (FULL && tid < 128) gNg[tid] = p.in[12][head * 128 + tid];
#pragma unroll
    for (int i = 0; i < 2; ++i) { const int tok = tok0 + 32 * i; const bool valid = tok < L; const u32x4 z = (u32x4){0u, 0u, 0u, 0u};
        const bf16_t* src = proj + (size_t)(row0 + tok) * NPROJ + head * 128 + dsg * 8;
        kk[i] = valid ? *(const u32x4*)(src + 1024) : z; kv[i] = valid ? *(const u32x4*)(src + 1536) : z;
        if (FULL) kq[i] = valid ? *(const u32x4*)(src + 512) : z; else kq[i] = z; }
    if (wave == 0 && lane < L) pgt = gtab[(size_t)(row0 + lane) * 4 + head];
    { const float* gf = (const float*)gtab; pml = gf[((size_t)(row0 + L - 1) * 4 + head) * 4 + 1];
#pragma unroll
      for (int i = 0; i < 2; ++i) { const int tok = tok0 + 32 * i; if (tok < L) pa[i] = gf[((size_t)(row0 + tok) * 4 + head) * 4]; } }
#pragma unroll 1
    for (int c = 0; c < nch; ++c) {
        const int r0 = row0 + c * 64;
        if (wave == 0) {
            const bool valid = lane < L; const float a = valid ? pgt[0] : -1e30f; const float Ml = __shfl(pgt[1], L - 1);
            gA[lane] = a; gM[lane] = valid ? pgt[1] : Ml; gDec[lane] = valid ? pgt[2] : 0.f; gEinv[lane] = valid ? pgt[3] : 1.f;
            if (lane == L - 1) scal[0] = pgt[2];
        }
        if (FULL) {
#pragma unroll
            for (int i = 0; i < 2; ++i)
#pragma unroll
                for (int n = 0; n < 4; ++n) { u32x2 w; w.x = pk2(accC[i][n][0], accC[i][n][1]); w.y = pk2(accC[i][n][2], accC[i][n][3]);
                    *(LAS u32x2*)(lds + L_CT + (64 * tp + 16 * n + l15) * 272 + (32 * st + 16 * i + 4 * l4) * 2) = w; }
            if (tp == 0 && l15 == 0) {
#pragma unroll
                for (int i = 0; i < 2; ++i) *(LAS f32x4*)(gN + 32 * st + 16 * i + 4 * l4) = accN[i]; }
        }
#pragma unroll
        for (int i = 0; i < 2; ++i) { const int tok = tok0 + 32 * i;
            if (FULL) { *(LAS u32x4*)(sQ + tok * 136 + dsg * 8) = kq[i]; *(LAS u32x4*)(sK + tok * 136 + dsg * 8) = kk[i]; }
            *(LAS u32x4*)(sV + tok * 136 + dsg * 8) = kv[i];
            const float w = __expf(pa[i] - pml); u32x4 o;
            o.x = pk2(bflo(kk[i].x) * w, bfhi(kk[i].x) * w); o.y = pk2(bflo(kk[i].y) * w, bfhi(kk[i].y) * w);
            o.z = pk2(bflo(kk[i].z) * w, bfhi(kk[i].z) * w); o.w = pk2(bflo(kk[i].w) * w, bfhi(kk[i].w) * w);
            *(LAS u32x4*)(sKW + tok * 136 + dsg * 8) = o; }
        LDS_BARRIER();
        if (c + 1 < nch) {
#pragma unroll
            for (int i = 0; i < 2; ++i) { const int tok = tok0 + 32 * i;
                const bf16_t* src = proj + (size_t)(r0 + 64 + tok) * NPROJ + head * 128 + dsg * 8;
                kk[i] = *(const u32x4*)(src + 1024); kv[i] = *(const u32x4*)(src + 1536);
                if (FULL) kq[i] = *(const u32x4*)(src + 512); }
            if (wave == 0) pgt = gtab[(size_t)(r0 + 64 + lane) * 4 + head];
            { const float* gf = (const float*)gtab; pml = gf[((size_t)(r0 + 64 + L - 1) * 4 + head) * 4 + 1];
#pragma unroll
              for (int i = 0; i < 2; ++i) pa[i] = gf[((size_t)(r0 + 64 + tok0 + 32 * i) * 4 + head) * 4]; }
        }
        f32x4 nacc[4];
#pragma unroll
        for (int n = 0; n < 4; ++n) nacc[n] = (f32x4){0.f, 0.f, 0.f, 0.f};
        if (FULL) {
            f32x4 sacc[2]; sacc[0] = (f32x4){0.f, 0.f, 0.f, 0.f}; sacc[1] = sacc[0];
#pragma unroll
            for (int ks = 0; ks < 4; ++ks) { const int kb = (32 * ks + 8 * l4) * 2;
                const bf16x8 a = ldfrag(lds + L_K, 16 * st + l15, 272, kb);
#pragma unroll
                for (int tt = 0; tt < 2; ++tt) { const bf16x8 b = ldfrag(lds + L_Q, 16 * (2 * tp + tt) + l15, 272, kb); sacc[tt] = MFMA16(a, b, sacc[tt]); } }
#pragma unroll
            for (int tt = 0; tt < 2; ++tt) { const int t = 16 * (2 * tp + tt) + l15; const float Mt = gM[t]; float dv[4];
#pragma unroll
                for (int j = 0; j < 4; ++j) { const int s = 16 * st + 4 * l4 + j; dv[j] = (s <= t) ? sacc[tt][j] * __expf(gA[s] - Mt) : 0.f; }
                u32x2 w; w.x = pk2(dv[0], dv[1]); w.y = pk2(dv[2], dv[3]); *(LAS u32x2*)(lds + L_S + t * 144 + (16 * st + 4 * l4) * 2) = w; }
#pragma unroll
            for (int ks = 0; ks < 4; ++ks) { const int kb = (32 * ks + 8 * l4) * 2;
                const bf16x8 a = ldfrag(lds + L_Q, 16 * st + l15, 272, kb);
#pragma unroll
                for (int n = 0; n < 4; ++n) { const bf16x8 b = ldfrag(lds + L_CT, 64 * tp + 16 * n + l15, 272, kb); nacc[n] = MFMA16(a, b, nacc[n]); } }
#pragma unroll
            for (int j = 0; j < 4; ++j) { const float dj = gDec[16 * st + 4 * l4 + j];
#pragma unroll
                for (int n = 0; n < 4; ++n) nacc[n][j] *= dj; }
            { float s = 0.f;
              const u32x4 q0 = *(LAS const u32x4*)(sQ + orow * 136 + oseg * 16), q1 = *(LAS const u32x4*)(sQ + orow * 136 + oseg * 16 + 8);
              const unsigned qw[8] = {q0.x, q0.y, q0.z, q0.w, q1.x, q1.y, q1.z, q1.w};
#pragma unroll
              for (int e = 0; e < 8; ++e) s += bflo(qw[e]) * gN[oseg * 16 + 2 * e] + bfhi(qw[e]) * gN[oseg * 16 + 2 * e + 1];
              s += __shfl_xor(s, 1); s += __shfl_xor(s, 2); s += __shfl_xor(s, 4);
              if (oseg == 0) gQn[orow] = s; }
        }
        if (FULL) LDS_BARRIER();
        if (FULL) {
            const u32x4 s0 = *(LAS const u32x4*)(sS + orow * 72 + oseg * 8);
            float s = (bflo(s0.x) + bfhi(s0.x)) + (bflo(s0.y) + bfhi(s0.y)) + (bflo(s0.z) + bfhi(s0.z)) + (bflo(s0.w) + bfhi(s0.w));
            s += __shfl_xor(s, 1); s += __shfl_xor(s, 2); s += __shfl_xor(s, 4);
            if (oseg == 0) { const float den = gDec[orow] * gQn[orow] + s; gDi[orow] = __builtin_amdgcn_rcpf(fmaxf(fabsf(den), gEinv[orow])); } }
        const float wsv = scal[0];
#pragma unroll
        for (int i = 0; i < 2; ++i) { accN[i] *= wsv;
#pragma unroll
            for (int n = 0; n < 4; ++n) accC[i][n] *= wsv; }
#pragma unroll
        for (int ks = 0; ks < 2; ++ks) { bf16x8 bv[4];
#pragma unroll
            for (int n = 0; n < 4; ++n) bv[n] = ldfrag_tr(lds + L_V, 32 * ks, 64 * tp + 16 * n, lane);
            if (FULL) { const bf16x8 a = ldfrag(lds + L_S, 16 * st + l15, 144, (32 * ks + 8 * l4) * 2);
#pragma unroll
                for (int n = 0; n < 4; ++n) nacc[n] = MFMA16(a, bv[n], nacc[n]); }
#pragma unroll
            for (int i = 0; i < 2; ++i) { const bf16x8 a = ldfrag_tr(lds + L_KW, 32 * ks, 32 * st + 16 * i, lane);
                accN[i] = MFMA16(a, ones, accN[i]);
#pragma unroll
                for (int n = 0; n < 4; ++n) accC[i][n] = MFMA16(a, bv[n], accC[i][n]); } }
        LDS_BARRIER();
        if (FULL) {
            u32x4 ow0 = (u32x4){0u, 0u, 0u, 0u}, ow1 = ow0;
            if (orow < L) { const bf16_t* op = proj + (size_t)(r0 + orow) * NPROJ + 2048 + head * 128 + oseg * 16; ow0 = *(const u32x4*)op; ow1 = *(const u32x4*)(op + 8); }
#pragma unroll
            for (int j = 0; j < 4; ++j) { const int t = 16 * st + 4 * l4 + j; const float di = gDi[t];
#pragma unroll
                for (int n = 0; n < 4; ++n) sH[t * 132 + 64 * tp + 16 * n + l15] = nacc[n][j] * di; }
            LDS_BARRIER();
            if (orow < L) {
                f32x4 x[4]; float s = 0.f;
#pragma unroll
                for (int e = 0; e < 4; ++e) { x[e] = *(LAS const f32x4*)(sH + orow * 132 + oseg * 16 + 4 * e); s += (x[e][0] + x[e][1]) + (x[e][2] + x[e][3]); }
                s += __shfl_xor(s, 1); s += __shfl_xor(s, 2); s += __shfl_xor(s, 4);
                const float mean = s * (1.0f / 128.0f); float q = 0.f;
#pragma unroll
                for (int e = 0; e < 4; ++e) { x[e] -= mean; q += (x[e][0] * x[e][0] + x[e][1] * x[e][1]) + (x[e][2] * x[e][2] + x[e][3] * x[e][3]); }
                q += __shfl_xor(q, 1); q += __shfl_xor(q, 2); q += __shfl_xor(q, 4);
                const float rstd = rsqrtf(q * (1.0f / 128.0f) + LN_EPS);
                const unsigned owv[8] = {ow0.x, ow0.y, ow0.z, ow0.w, ow1.x, ow1.y, ow1.z, ow1.w}; unsigned ov[8];
#pragma unroll
                for (int e = 0; e < 4; ++e) { const f32x4 g = *(LAS const f32x4*)(gNg + oseg * 16 + 4 * e);
                    const float y0 = x[e][0] * rstd * g[0] * fsigmoid(bflo(owv[2 * e])), y1 = x[e][1] * rstd * g[1] * fsigmoid(bfhi(owv[2 * e]));
                    const float y2 = x[e][2] * rstd * g[2] * fsigmoid(bflo(owv[2 * e + 1])), y3 = x[e][3] * rstd * g[3] * fsigmoid(bfhi(owv[2 * e + 1]));
                    ov[2 * e] = pk2(y0, y1); ov[2 * e + 1] = pk2(y2, y3); }
                bf16_t* mp = mix + (size_t)(r0 + orow) * DM + 512 + head * 128 + oseg * 16;
                *(u32x4*)mp = (u32x4){ov[0], ov[1], ov[2], ov[3]}; *(u32x4*)(mp + 8) = (u32x4){ov[4], ov[5], ov[6], ov[7]};
            }
        }
    }
    LDS_BARRIER();
}

constexpr int L_PW = 34816, L_PU = 69632;
template <int W>
__device__ __forceinline__ void pool_diff(LAS unsigned char* lds, bool sample, int tilepos0) {
    const int tid = fresh_tid(), co = tid & 15, t0 = (tid >> 4) * 4;
    const int rb0 = sample ? (t0 >> 5) * 47 + 15 + (t0 & 31) : 15 + t0;
    LAS const unsigned char* up = lds + L_PU + co * 16;
    float sum[8];
#pragma unroll
    for (int e = 0; e < 8; ++e) sum[e] = 0.f;
    u32x4 xc = (u32x4){0u, 0u, 0u, 0u};
#pragma unroll
    for (int j = 0; j < W; ++j) { const u32x4 r = *(LAS const u32x4*)(up + (rb0 - j) * 272); if (j == 0) xc = r;
        sum[0] += bflo(r.x); sum[1] += bfhi(r.x); sum[2] += bflo(r.y); sum[3] += bfhi(r.y); sum[4] += bflo(r.z); sum[5] += bfhi(r.z); sum[6] += bflo(r.w); sum[7] += bfhi(r.w); }
#pragma unroll
    for (int tt = 0; tt < 4; ++tt) {
        if (tt > 0) { const u32x4 rn = *(LAS const u32x4*)(up + (rb0 + tt) * 272), ro = *(LAS const u32x4*)(up + (rb0 + tt - W) * 272); xc = rn;
            sum[0] += bflo(rn.x) - bflo(ro.x); sum[1] += bfhi(rn.x) - bfhi(ro.x); sum[2] += bflo(rn.y) - bflo(ro.y); sum[3] += bfhi(rn.y) - bfhi(ro.y);
            sum[4] += bflo(rn.z) - bflo(ro.z); sum[5] += bfhi(rn.z) - bfhi(ro.z); sum[6] += bflo(rn.w) - bflo(ro.w); sum[7] += bfhi(rn.w) - bfhi(ro.w); }
        const int cnt = sample ? W : min(tilepos0 + t0 + tt + 1, W); const float inv = 1.0f / (float)cnt;
        u32x4 w; w.x = pk2(sum[0] * inv - bflo(xc.x), sum[1] * inv - bfhi(xc.x)); w.y = pk2(sum[2] * inv - bflo(xc.y), sum[3] * inv - bfhi(xc.y));
        w.z = pk2(sum[4] * inv - bflo(xc.z), sum[5] * inv - bfhi(xc.z)); w.w = pk2(sum[6] * inv - bflo(xc.w), sum[7] * inv - bfhi(xc.w));
        *(LAS u32x4*)(lds + (t0 + tt) * 272 + co * 16) = w; }
}

__device__ __forceinline__ void pool_fetch(const Params& p, int item, int tid, u32x4 (&pf)[6]) {
    const int g = item & 3, R0 = (item >> 2) * 128;
    const bf16_t* proj = (const bf16_t*)(p.ws + WS_PROJ); const float* hist = p.in[2];
    if (R0 < MP) {
        const int seqrow0 = (R0 / SEQ) * SEQ, tilepos0 = R0 - seqrow0;
        u32x4 raw[6];
#pragma unroll
        for (int i = 0; i < 6; ++i) { const int piece = tid + 512 * i, e = piece >> 4, seg = piece & 15; int pos = tilepos0 - 15 + (e < 143 ? e : 142); pos = pos < 0 ? 0 : pos;
            raw[i] = *(const u32x4*)(proj + (size_t)(seqrow0 + pos) * NPROJ + g * 128 + seg * 8); }
#pragma unroll
        for (int i = 0; i < 6; ++i) pf[i] = raw[i];
    } else {
#pragma unroll
        for (int i = 0; i < 6; ++i) { const int piece = tid + 512 * i, e = piece >> 4, seg = piece & 15; u32x4 val = (u32x4){0u, 0u, 0u, 0u};
            if (e < 188) { const int sgi = e / 47, le = e - sgi * 47, b = ((R0 - MP) >> 5) + sgi;
                if (le < 15) { const float* hp = hist + ((size_t)b * 15 + le) * 512 + g * 128 + seg * 8; const float4 a = *(const float4*)hp, c4 = *(const float4*)(hp + 4);
                    val.x = pk2(a.x, a.y); val.y = pk2(a.z, a.w); val.z = pk2(c4.x, c4.y); val.w = pk2(c4.z, c4.w); }
                else val = *(const u32x4*)(proj + (size_t)(MP + b * 32 + le - 15) * NPROJ + g * 128 + seg * 8); }
            pf[i] = val; }
    }
}

__device__ __forceinline__ void pool_loop(const Params& p, LAS unsigned char* lds, int first, int stride, int end) {
    const int tid = fresh_tid(), lane = tid & 63, wave = __builtin_amdgcn_readfirstlane(tid >> 6), l15 = lane & 15, l4 = lane >> 4, st = wave & 3, tp = wave >> 2;
    bf16_t* mix = (bf16_t*)(p.ws + WS_MIX); const float* pscale = p.in[11];
    if (first >= end) return;
    u32x4 pf[6]; pool_fetch(p, first, tid, pf);
    int gw = -1;
#pragma unroll 1
    for (int item = first; item < end; item += stride) {
        const int g = item & 3, R0 = (item >> 2) * 128;
        const bool sample = R0 >= MP; const int tilepos0 = sample ? 0 : R0 - (R0 / SEQ) * SEQ;
        if (g != gw) { const bf16_t* Wp = (const bf16_t*)(p.ws + WS_WPOOL) + g * 16384; gw = g;
#pragma unroll
            for (int i = 0; i < 4; ++i) { const int piece = tid + 512 * i, row = piece >> 4, seg = piece & 15;
                *(LAS u32x4*)(lds + L_PW + row * 272 + seg * 16) = *(const u32x4*)(Wp + row * 128 + seg * 8); } }
#pragma unroll
        for (int i = 0; i < 6; ++i) { const int piece = tid + 512 * i, e = piece >> 4, seg = piece & 15; const bool keep = sample || ((e < 143) && (tilepos0 - 15 + e >= 0));
            if (e < 188) *(LAS u32x4*)(lds + L_PU + e * 272 + seg * 16) = keep ? pf[i] : (u32x4){0u, 0u, 0u, 0u}; }
        LDS_BARRIER();
        if (item + stride < end) pool_fetch(p, item + stride, tid, pf);
        if (g == 0) pool_diff<2>(lds, sample, tilepos0); else if (g == 1) pool_diff<4>(lds, sample, tilepos0); else if (g == 2) pool_diff<8>(lds, sample, tilepos0); else pool_diff<16>(lds, sample, tilepos0);
        LDS_BARRIER();
        f32x4 acc[2][4];
#pragma unroll
        for (int i = 0; i < 2; ++i)
#pragma unroll
            for (int n = 0; n < 4; ++n) acc[i][n] = (f32x4){0.f, 0.f, 0.f, 0.f};
#pragma unroll
        for (int ks = 0; ks < 4; ++ks) { const int kb = (32 * ks + 8 * l4) * 2; bf16x8 bv[4];
#pragma unroll
            for (int n = 0; n < 4; ++n) bv[n] = ldfrag(lds, 64 * tp + 16 * n + l15, 272, kb);
#pragma unroll
            for (int i = 0; i < 2; ++i) { const bf16x8 a = ldfrag(lds + L_PW, 32 * st + 16 * i + l15, 272, kb);
#pragma unroll
                for (int n = 0; n < 4; ++n) acc[i][n] = MFMA16(a, bv[n], acc[i][n]); } }
        LDS_BARRIER();
#pragma unroll
        for (int i = 0; i < 2; ++i) { const int d0 = 32 * st + 16 * i + 4 * l4; const float4 ps = *(const float4*)(pscale + g * 128 + d0);
#pragma unroll
            for (int n = 0; n < 4; ++n) { const int t = 64 * tp + 16 * n + l15;
                u32x2 w; w.x = pk2(acc[i][n][0] * ps.x, acc[i][n][1] * ps.y); w.y = pk2(acc[i][n][2] * ps.z, acc[i][n][3] * ps.w);
                *(LAS u32x2*)(lds + t * 272 + d0 * 2) = w; } }
        LDS_BARRIER();
        { const int t = tid >> 2, sg = tid & 3; const u32x4 o0 = *(LAS const u32x4*)(lds + t * 272 + sg * 64), o1 = *(LAS const u32x4*)(lds + t * 272 + sg * 64 + 16),
            o2 = *(LAS const u32x4*)(lds + t * 272 + sg * 64 + 32), o3 = *(LAS const u32x4*)(lds + t * 272 + sg * 64 + 48);
          bf16_t* mp = mix + (size_t)(R0 + t) * DM + g * 128 + sg * 32; *(u32x4*)mp = o0; *(u32x4*)(mp + 8) = o1; *(u32x4*)(mp + 16) = o2; *(u32x4*)(mp + 24) = o3; }
    }
    LDS_BARRIER();
}

constexpr int N_S2 = 224, N_SMP = 128, N_POOL = (MT / 128) * 4;

__device__ __forceinline__ void phase2(const Params& p, LAS unsigned char* lds, int kinds) {
    const int tid = fresh_tid(), lane = tid & 63, wave = tid >> 6, l15 = lane & 15, l4 = lane >> 4, st = wave & 3, tp = wave >> 2;
    float* Dst = (float*)(p.ws + WS_DST); float* Dn = (float*)(p.ws + WS_DN); const float* mtab = (const float*)(p.ws + WS_MTAB);
    const int step2 = (gridDim.x == 256) ? (blockIdx.x < N_S2 ? (1 << 20) : 32) : (int)gridDim.x;
    for (int it = blockIdx.x; it < N_S2 + N_SMP; it += step2) {
        if (it < N_S2) {
            if (!(kinds & 1)) continue;
            const int chain = it / 7, sc = it % 7, batch = chain >> 2, head = chain & 3;
            f32x4 accC[2][4], accN[2];
#pragma unroll
            for (int i = 0; i < 2; ++i) { accN[i] = (f32x4){0.f, 0.f, 0.f, 0.f};
#pragma unroll
                for (int n = 0; n < 4; ++n) accC[i][n] = (f32x4){0.f, 0.f, 0.f, 0.f}; }
            mlstm_run<false>(p, lds, accC, accN, batch * SEQ + sc * SCN * 64, head, SCN, 64);
            { float* dp = Dst + ((size_t)it * 512 + tid) * 32;
#pragma unroll
              for (int i = 0; i < 2; ++i)
#pragma unroll
                  for (int n = 0; n < 4; ++n) *(f32x4*)(dp + (i * 4 + n) * 4) = accC[i][n]; }
            if (tp == 0 && l15 == 0) {
#pragma unroll
                for (int i = 0; i < 2; ++i) *(f32x4*)(Dn + it * 128 + 32 * st + 16 * i + 4 * l4) = accN[i]; }
        } else {
            if (!(kinds & 2)) continue;
            const int s = it - N_S2, b = s >> 2, head = s & 3;
            const float* C0 = p.in[3] + (size_t)s * 16384; f32x4 accC[2][4], accN[2];
#pragma unroll
            for (int i = 0; i < 2; ++i) accN[i] = *(const f32x4*)(p.in[4] + s * 128 + 32 * st + 16 * i + 4 * l4);
#pragma unroll
            for (int i = 0; i < 2; ++i)
#pragma unroll
                for (int n = 0; n < 4; ++n)
#pragma unroll
                    for (int j = 0; j < 4; ++j) accC[i][n][j] = C0[(32 * st + 16 * i + 4 * l4 + j) * 128 + 64 * tp + 16 * n + l15];
            mlstm_run<true>(p, lds, accC, accN, MP + b * 32, head, 1, 32);
            float* Co = p.out + O_CS + (size_t)s * 16384;
#pragma unroll
            for (int i = 0; i < 2; ++i)
#pragma unroll
                for (int n = 0; n < 4; ++n)
#pragma unroll
                    for (int j = 0; j < 4; ++j) Co[(32 * st + 16 * i + 4 * l4 + j) * 128 + 64 * tp + 16 * n + l15] = accC[i][n][j];
            if (tp == 0 && l15 == 0) {
#pragma unroll
                for (int i = 0; i < 2; ++i) *(f32x4*)(p.out + O_NS + s * 128 + 32 * st + 16 * i + 4 * l4) = accN[i]; }
        }
    }
    if (kinds & 4) { const int G = gridDim.x; int first = blockIdx.x; while (first < N_S2 + N_SMP) first += G;
        pool_loop(p, lds, first - N_S2 - N_SMP, G, N_POOL); }
    const bf16_t* proj = (const bf16_t*)(p.ws + WS_PROJ);
    for (int idx = blockIdx.x * 512 + tid; idx < (NB + DB) * 15 * 512; idx += gridDim.x * 512) {
        if (idx < NB * 7680) { const int b = idx / 7680, rem = idx % 7680, i = rem >> 9, c = rem & 511;
            p.out[O_POOLP + idx] = bf2f(proj[(size_t)(b * SEQ + SEQ - 15 + i) * NPROJ + c]); }
        else { const int id2 = idx - NB * 7680, b = id2 / 7680, rem = id2 % 7680, i = rem >> 9, c = rem & 511;
            p.out[O_POOLS + id2] = bf2f(proj[(size_t)(MP + b * 32 + 17 + i) * NPROJ + c]); }
    }
}

__device__ __forceinline__ void phase3(const Params& p, LAS unsigned char* lds) {
    const int tid = fresh_tid(), lane = tid & 63, wave = tid >> 6, l15 = lane & 15, l4 = lane >> 4, st = wave & 3, tp = wave >> 2;
    const float* Dst = (const float*)(p.ws + WS_DST); const float* Dn = (const float*)(p.ws + WS_DN);
    const float* mtab = (const float*)(p.ws + WS_MTAB); const float* btab = (const float*)(p.ws + WS_BTAB);
    for (int it = blockIdx.x; it < 256; it += gridDim.x) {
        const int chain = it >> 3, sc = it & 7, batch = chain >> 2, head = chain & 3;
        f32x4 accC[2][4], accN[2];
#pragma unroll
        for (int i = 0; i < 2; ++i) { accN[i] = (f32x4){0.f, 0.f, 0.f, 0.f};
#pragma unroll
            for (int n = 0; n < 4; ++n) accC[i][n] = (f32x4){0.f, 0.f, 0.f, 0.f}; }
        f32x4 dC[2][4], dN[2];
        if (sc > 0) {
#pragma unroll
            for (int i = 0; i < 2; ++i) { dN[i] = *(const f32x4*)(Dn + (chain * 7) * 128 + 32 * st + 16 * i + 4 * l4);
#pragma unroll
                for (int n = 0; n < 4; ++n) dC[i][n] = *(const f32x4*)(Dst + ((size_t)(chain * 7) * 512 + tid) * 32 + (i * 4 + n) * 4); } }
#pragma unroll 1
        for (int j = 0; j < sc; ++j) {
            float Bs = 0.f;
            for (int c = 0; c < SCN; ++c) Bs += btab[chain * 128 + j * SCN + c];
            const float Wj = expf(Bs + mtab[chain * 132 + j * SCN] - mtab[chain * 132 + (j + 1) * SCN]);
#pragma unroll
            for (int i = 0; i < 2; ++i) { accN[i] = Wj * accN[i] + dN[i];
#pragma unroll
                for (int n = 0; n < 4; ++n) accC[i][n] = Wj * accC[i][n] + dC[i][n]; }
            if (j + 1 < sc) { const int item = chain * 7 + j + 1;
#pragma unroll
                for (int i = 0; i < 2; ++i) { dN[i] = *(const f32x4*)(Dn + item * 128 + 32 * st + 16 * i + 4 * l4);
#pragma unroll
                    for (int n = 0; n < 4; ++n) dC[i][n] = *(const f32x4*)(Dst + ((size_t)item * 512 + tid) * 32 + (i * 4 + n) * 4); } }
        }
        mlstm_run<true>(p, lds, accC, accN, batch * SEQ + sc * SCN * 64, head, SCN, 64);
        if (sc == 7) {
            const int t2 = fresh_tid(), l15b = t2 & 15, l4b = (t2 >> 4) & 3, stb = (t2 >> 6) & 3, tpb = t2 >> 8;
            float* Co = p.out + O_CP + (size_t)chain * 16384 + (32 * stb + 4 * l4b) * 128 + 64 * tpb + l15b;
#pragma unroll
            for (int i = 0; i < 2; ++i)
#pragma unroll
                for (int n = 0; n < 4; ++n)
#pragma unroll
                    for (int j = 0; j < 4; ++j) Co[(16 * i + j) * 128 + 16 * n] = accC[i][n][j];
            if (tpb == 0 && l15b == 0) {
#pragma unroll
                for (int i = 0; i < 2; ++i) *(f32x4*)(p.out + O_NP + chain * 128 + 32 * stb + 16 * i + 4 * l4b) = accN[i]; }
        }
    }
}

template <int S>
__device__ __forceinline__ void ln_load(const bf16_t* src, const float* slab, const bf16_t* hb, int row, int lane, float4 (&v)[4]) {
    if (row >= MP) {
#pragma unroll
        for (int i = 0; i < 4; ++i) { const int c = i * 256 + lane * 4; const u32x2 h2 = *(const u32x2*)(hb + (size_t)row * DM + c);
            const float* sp = slab + (size_t)(row - MP) * DM + c; float4 t[S];
#pragma unroll
            for (int sl = 0; sl < S; ++sl) t[sl] = *(const float4*)(sp + (size_t)sl * (1024 * 1024));
            float4 a = make_float4(ALPHA * bflo(h2.x), ALPHA * bfhi(h2.x), ALPHA * bflo(h2.y), ALPHA * bfhi(h2.y));
#pragma unroll
            for (int sl = 0; sl < S; ++sl) { a.x += t[sl].x; a.y += t[sl].y; a.z += t[sl].z; a.w += t[sl].w; }
            v[i] = a; }
    } else {
#pragma unroll
        for (int i = 0; i < 4; ++i) { const u32x2 r = *(const u32x2*)(src + (size_t)row * DM + i * 256 + lane * 4); v[i] = make_float4(bflo(r.x), bfhi(r.x), bflo(r.y), bfhi(r.y)); } }
}
template <bool TO_BF16, int S>
__device__ __forceinline__ void ln_rows(const bf16_t* src, const float* gam, const float* bet, bf16_t* ob, float* of, const float* slab, const bf16_t* hb, unsigned char* o8) {
    const int tid = fresh_tid(), lane = tid & 63, wave = tid >> 6, stride = gridDim.x * 8;
    int row = blockIdx.x * 8 + wave; float4 v[4];
    if (row < MT) ln_load<S>(src, slab, hb, row, lane, v);
#pragma unroll 1
    for (; row < MT; row += stride) {
        const int nrow = row + stride; float4 nv[4];
        if (nrow < MT) ln_load<S>(src, slab, hb, nrow, lane, nv);
        else {
#pragma unroll
            for (int i = 0; i < 4; ++i) nv[i] = make_float4(0.f, 0.f, 0.f, 0.f); }
        float s = 0.f;
#pragma unroll
        for (int i = 0; i < 4; ++i) s += (v[i].x + v[i].y) + (v[i].z + v[i].w);
        const float mu = wave_sum(s) * (1.0f / DM); float q = 0.f;
#pragma unroll
        for (int i = 0; i < 4; ++i) { v[i].x -= mu; v[i].y -= mu; v[i].z -= mu; v[i].w -= mu; q += (v[i].x * v[i].x + v[i].y * v[i].y) + (v[i].z * v[i].z + v[i].w * v[i].w); }
        const float rstd = rsqrtf(wave_sum(q) * (1.0f / DM) + LN_EPS);
#pragma unroll
        for (int i = 0; i < 4; ++i) { const int c = i * 256 + lane * 4; const float4 gg = *(const float4*)(gam + c), bb = *(const float4*)(bet + c);
            float4 y; y.x = v[i].x * rstd * gg.x + bb.x; y.y = v[i].y * rstd * gg.y + bb.y; y.z = v[i].z * rstd * gg.z + bb.z; y.w = v[i].w * rstd * gg.w + bb.w;
            if (TO_BF16) { u32x2 w; w.x = pk2(y.x, y.y); w.y = pk2(y.z, y.w); *(u32x2*)(ob + (size_t)row * DM + c) = w; *(unsigned*)(o8 + (size_t)row * DM + c) = pk4_fp8(y.x, y.y, y.z, y.w); }
            else *(float4*)(of + (size_t)row * DM + c) = y; }
#pragma unroll
        for (int i = 0; i < 4; ++i) v[i] = nv[i];
    }
}

__global__ void __launch_bounds__(512) fwd_mega(Params p) {
    extern __shared__ __attribute__((aligned(16))) unsigned char smem[];
    LAS unsigned char* lds = (LAS unsigned char*)smem;
    cg::grid_group grid = cg::this_grid();
    volatile LAS unsigned* stw = (volatile LAS unsigned*)(lds + LDS_XB);
    if (threadIdx.x == 0) { stw[0] = 0u; stw[1] = 0u; }
    __syncthreads();
    const XcdBarrier xbar = xcd_barrier_post((unsigned*)(p.ws + WS_BAR), stw);
    unsigned char* ws = p.ws;
    bf16_t* h0 = (bf16_t*)(ws + WS_H0); bf16_t* proj = (bf16_t*)(ws + WS_PROJ); bf16_t* mix = (bf16_t*)(ws + WS_MIX); bf16_t* act = (bf16_t*)(ws + WS_ACT);
    float* slab = (float*)(ws + WS_SLAB);
    const int G = gridDim.x, bx = blockIdx.x;
#ifndef DBL
#define DBL 0
#endif
    if (DBL & 0x800) { for (int i = 0; i < 10; ++i) xcd_barrier(xbar); }
    if (DBL & 1) { phase0(p, lds); xcd_barrier(xbar); }
    phase0(p, lds);
    grid.sync();
    gate_scan(p, lds);
    for (int rep_ = 0; rep_ < ((DBL & 0x1000) ? 2 : 1); ++rep_)
    { if (rep_) xcd_barrier(xbar); pg8::Gemm g{h0, (const bf16_t*)(ws + WS_WIN), MT, NPROJ, DM}; SplitOrder S; S.init(NPROJ, DM / 64, 1, G, bx);
      EpiBf16B e{proj, NPROJ, (const float*)(ws + WS_BIAS)}; pg8::gemm_phase(lds, g, S, e); }
    xcd_barrier(xbar);
    if (DBL & 4) { phase2(p, lds, 15); xcd_barrier(xbar); }
    if (DBL & 0x200) { phase2(p, lds, 4); xcd_barrier(xbar); }
    if (DBL & 0x400) { phase2(p, lds, 1); xcd_barrier(xbar); }
    phase2(p, lds, 15);
    xcd_barrier(xbar);
    if (DBL & 8) { phase3(p, lds); xcd_barrier(xbar); }
    phase3(p, lds);
    xcd_barrier(xbar);
    for (int rep_ = 0; rep_ < ((DBL & 0x2000) ? 2 : 1); ++rep_)
    { if (rep_) xcd_barrier(xbar); pg8::Gemm g{mix, (const bf16_t*)(ws + WS_WOUT), MT, DM, DM}; SplitOrder S; S.init(DM, DM / 64, 4, G, bx);
      EpiRes e{h0, (bf16_t*)(ws + WS_R1), slab, DM / 64}; pg8::gemm_phase(lds, g, S, e); }
    xcd_barrier(xbar);
    if (DBL & 32) { ln_rows<true, 4>((const bf16_t*)(ws + WS_R1), p.in[14], p.in[15], h0, nullptr, slab, h0, ws + WS_H8); xcd_barrier(xbar); }
    ln_rows<true, 4>((const bf16_t*)(ws + WS_R1), p.in[14], p.in[15], h0, nullptr, slab, h0, ws + WS_H8);
    xcd_barrier(xbar);
    for (int rep_ = 0; rep_ < ((DBL & 0x4000) ? 2 : 1); ++rep_)
    { if (rep_) xcd_barrier(xbar);
#ifdef STAGGER
      if (bx & 1) { for (int q = 0; q < STAGGER; ++q) __builtin_amdgcn_s_sleep(127); }
#endif
      pg8::Gemm g{(const bf16_t*)(ws + WS_H8), (const bf16_t*)(ws + WS_WGU), MT, 2 * DFF, DM / 2}; SplitOrder S; S.init(2 * DFF, DM / 128, 1, G, bx);
      EpiSwiglu e{act, 1.0f / W8_SCALE}; pg8::gemm_phase<EpiSwiglu, SplitOrder, true>(lds, g, S, e); }
    xcd_barrier(xbar);
    for (int rep_ = 0; rep_ < ((DBL & 0x8000) ? 2 : 1); ++rep_)
    { if (rep_) xcd_barrier(xbar); pg8::Gemm g{act, (const bf16_t*)(ws + WS_WDN), MT, DM, DFF}; SplitOrder S; S.init(DM, DFF / 64, 11, G, bx);
      EpiRes e{h0, (bf16_t*)(ws + WS_R2), slab, DFF / 64}; pg8::gemm_phase(lds, g, S, e); }
    xcd_barrier(xbar);
    if (DBL & 0x10000) { ln_rows<false, 11>((const bf16_t*)(ws + WS_R2), p.in[19], p.in[20], nullptr, p.out + O_Y, slab, h0, nullptr); xcd_barrier(xbar); }
    ln_rows<false, 11>((const bf16_t*)(ws + WS_R2), p.in[19], p.in[20], nullptr, p.out + O_Y, slab, h0, nullptr);
}

extern "C" void kernel_launch(void* const* d_in, const int* in_sizes, int n_in, void* d_out, int out_size, void* d_ws, size_t ws_size, hipStream_t stream) {
    constexpr size_t kDynLds = LDS_TOTAL;
    static int grid_blocks = 0;
    if (!grid_blocks) {
        if (n_in != 21 || (size_t)out_size != O_END || ws_size < WS_END3) { fprintf(stderr, "kernel_launch: unexpected shapes: n_in %d out %d ws %zu (need %zu)\n", n_in, out_size, ws_size, (size_t)WS_END3); grid_blocks = -1; return; }
        int dev = 0, cus = 0, per_cu = 0;
        hipGetDevice(&dev);
        hipDeviceGetAttribute(&cus, hipDeviceAttributeMultiprocessorCount, dev);
        if (hipFuncSetAttribute((const void*)fwd_mega, hipFuncAttributeMaxDynamicSharedMemorySize, (int)kDynLds) != hipSuccess) { fprintf(stderr, "kernel_launch: hipFuncSetAttribute failed\n"); grid_blocks = -1; return; }
        if (hipOccupancyMaxActiveBlocksPerMultiprocessor(&per_cu, (const void*)fwd_mega, 512, kDynLds) != hipSuccess || per_cu < 1) { fprintf(stderr, "kernel_launch: occupancy query failed (%d)\n", per_cu); grid_blocks = -1; return; }
        if (per_cu > 1) per_cu = 1;
        grid_blocks = cus * per_cu;
    }
    if (grid_blocks < 0) return;
    if (hipMemsetAsync((char*)d_ws + WS_BAR, 0, XCD_BAR_WORDS * 4, stream) != hipSuccess) { fprintf(stderr, "kernel_launch: memset of the barrier words failed\n"); return; }
    Params p{};
    for (int i = 0; i < 21; ++i) p.in[i] = (const float*)d_in[i];
    p.out = (float*)d_out; p.ws = (unsigned char*)d_ws;
    void* args[] = {&p};
    hipError_t e = hipLaunchCooperativeKernel((const void*)fwd_mega, dim3(grid_blocks), dim3(512), args, kDynLds, stream);
    if (e != hipSuccess) fprintf(stderr, "cooperative launch failed: %s (grid %d)\n", hipGetErrorString(e), grid_blocks);
}
```

```cpp
#include <hip/hip_runtime.h>
#include <hip/hip_cooperative_groups.h>
#include <cstdio>
namespace cg = cooperative_groups;
namespace pg8 {
#define PG8_LAS __attribute__((address_space(3)))
typedef unsigned short bf16_t;
typedef short bf16x8 __attribute__((ext_vector_type(8)));
typedef float f32x4 __attribute__((ext_vector_type(4)));
typedef unsigned u32x4 __attribute__((ext_vector_type(4)));
typedef int i32x4 __attribute__((ext_vector_type(4)));
typedef int i32x8 __attribute__((ext_vector_type(8)));
constexpr int BM = 256, BK = 64, HALF = 128, HTB = HALF * BK * 2  , STAGE_BYTES = 8 * HTB, NXCD = 8, WGM = 8;

__host__ __device__ __forceinline__ int lds_byte(int r, int c) { const int st = (r >> 4) * 2 + (c >> 5), rr = r & 15, cc = c & 31, ob = rr * 64 + cc * 2; return st * 1024 + (ob ^ (((ob >> 9) & 1) << 5)); }
__host__ __device__ __forceinline__ void stage_rc(int b, int& R, int& C) { const int st = b / 1024, sb = b % 1024, swz = sb ^ (((sb >> 9) & 1) << 5); R = (st >> 1) * 16 + swz / 64; C = (st & 1) * 32 + (swz % 64) / 2; }
__host__ __device__ __forceinline__ int perm32(int rho) { const int n = rho >> 4, i = rho & 15; return 8 * (i >> 2) + 4 * n + (i & 3); }

struct Unit { int pm, pn, kt0, nkt; };
struct Gemm { const bf16_t* A; const bf16_t* Bt; int M, N, K; };
struct StaticOrder {
    int nM, nN, nwg, G, c;
    __host__ __device__ void init(int M, int N, int G_, int c_) { nM = M / BM; nN = N / BM; nwg = nM * nN; G = G_; c = c_; }
    __host__ __device__ bool next(int i, Unit& u) const {
        const long L = (long)i * G + c; if (L >= nwg) return false;
        int wgid = (int)L; { const int q = nwg / NXCD, r = nwg % NXCD, xcd = wgid % NXCD, off = wgid / NXCD; wgid = (xcd < r ? xcd * (q + 1) : r * (q + 1) + (xcd - r) * q) + off; }
        const int nig = WGM * nN, gid = wgid / nig, fm = gid * WGM, gsz = (nM - fm) < WGM ? (nM - fm) : WGM;
        u.pm = fm + ((wgid % nig) % gsz); u.pn = (wgid % nig) / gsz; u.kt0 = 0; u.nkt = 0; return true;
    }
    __device__ __forceinline__ void a_ready(const Unit&) const {}
    __device__ __forceinline__ void done(const Unit&) const {}
};
__device__ __forceinline__ unsigned cvt_pk_bf16(float lo, float hi) { unsigned r; asm volatile("v_cvt_pk_bf16_f32 %0, %1, %2" : "=v"(r) : "v"(lo), "v"(hi)); return r; }
template <class Epi, class Sched, bool FP8 = false>
__device__ __forceinline__ void gemm_phase(PG8_LAS unsigned char* lds, const Gemm g, const Sched& S, const Epi& E) {
    int tid_ = threadIdx.x; asm volatile("" : "+v"(tid_)); const int tid = tid_, wid = __builtin_amdgcn_readfirstlane(tid >> 6), lane = tid & 63, wr = wid >> 2, wc = wid & 3, fr = lane & 15, fq = lane >> 4;
    const int K = g.K;
    unsigned voffA[2], voffB[2];
#pragma unroll
    for (int i = 0; i < 2; ++i) { int R, C; stage_rc(tid * 16 + i * 8192, R, C); const int Rb = Epi::PERM ? ((R & ~31) + perm32(R & 31)) : R;
        voffA[i] = (unsigned)(R * K + C) * 2u; voffB[i] = (unsigned)(Rb * K + C) * 2u; }
    const size_t kstep = (size_t)(BK * 2);
    const size_t hstep = (size_t)HALF * K * 2;
    const size_t tstep = 2 * hstep;
    const unsigned ldsw = (unsigned)wid * 1024u;
    const int aoff = FP8 ? lds_byte(wr * 64 + fr, fq * 16) : lds_byte(wr * 64 + fr, fq * 8), boff = FP8 ? lds_byte(wc * 32 + fr, fq * 16) : lds_byte(wc * 32 + fr, fq * 8);
#define PG8_SA(b, h) (((b) * 2 + (h)) * HTB)
#define PG8_SB(b, h) ((4 + (b) * 2 + (h)) * HTB)
#define PG8_STAGE(bufoff, gbase, voff) do { _Pragma("unroll") for (int _i = 0; _i < 2; ++_i) \
        __builtin_amdgcn_global_load_lds((const unsigned*)((const char*)(gbase) + (voff)[_i]), (PG8_LAS unsigned*)(lds + (bufoff) + ldsw + _i * 8192), 16, 0, 0); } while (0)
#define PG8_LDA(dst, dst8, b, h) do { if constexpr (FP8) { _Pragma("unroll") for (int m = 0; m < 4; ++m) { dst8[m].lo = *(const PG8_LAS i32x4*)(lds + PG8_SA(b, h) + aoff + m * 2048); dst8[m].hi = *(const PG8_LAS i32x4*)(lds + PG8_SA(b, h) + aoff + m * 2048 + 16); } } \
    else { _Pragma("unroll") for (int m = 0; m < 4; ++m) _Pragma("unroll") for (int k = 0; k < 2; ++k) dst[m][k] = *(const PG8_LAS bf16x8*)(lds + PG8_SA(b, h) + aoff + m * 2048 + k * 1024); } } while (0)
#define PG8_LDB(dst, dst8, b, h) do { if constexpr (FP8) { _Pragma("unroll") for (int n = 0; n < 2; ++n) { dst8[n].lo = *(const PG8_LAS i32x4*)(lds + PG8_SB(b, h) + boff + n * 2048); dst8[n].hi = *(const PG8_LAS i32x4*)(lds + PG8_SB(b, h) + boff + n * 2048 + 16); } } \
    else { _Pragma("unroll") for (int n = 0; n < 2; ++n) _Pragma("unroll") for (int k = 0; k < 2; ++k) dst[n][k] = *(const PG8_LAS bf16x8*)(lds + PG8_SB(b, h) + boff + n * 2048 + k * 1024); } } while (0)
#define PG8_MMA(ai, bj, At, Bt, At8, Bt8) do { __builtin_amdgcn_s_setprio(1); \
    if constexpr (FP8) { _Pragma("unroll") for (int m = 0; m < 4; ++m) _Pragma("unroll") for (int n = 0; n < 2; ++n) \
        asm volatile("v_mfma_scale_f32_16x16x128_f8f6f4 %0, %1, %2, %0, %3, %3 op_sel_hi:[0,0,0]" : "+v"(acc[ai][bj][m][n]) : "v"(Bt8[n]), "v"(At8[m]), "v"(sc1_)); } \
    else { _Pragma("unroll") for (int m = 0; m < 4; ++m) _Pragma("unroll") for (int n = 0; n < 2; ++n) _Pragma("unroll") for (int k = 0; k < 2; ++k) \
        acc[ai][bj][m][n] = __builtin_amdgcn_mfma_f32_16x16x32_bf16(Bt[n][k], At[m][k], acc[ai][bj][m][n], 0, 0, 0); } \
    __builtin_amdgcn_s_setprio(0); } while (0)
#define PG8_WAIT_V(n) asm volatile("s_waitcnt vmcnt(" #n ")" ::: "memory")
#define PG8_WAIT_L(n) asm volatile("s_waitcnt lgkmcnt(" #n ")" ::: "memory")
#define PG8_BAR __builtin_amdgcn_s_barrier()
#define PG8_SCHED __builtin_amdgcn_sched_barrier(0)
    Unit cur, nxt; int ui = 0;
    if (!S.next(0, cur)) return;
    f32x4 acc[2][2][4][2];
#pragma unroll
    for (int a = 0; a < 2; ++a)
#pragma unroll
        for (int b = 0; b < 2; ++b)
#pragma unroll
            for (int m = 0; m < 4; ++m)
#pragma unroll
                for (int n = 0; n < 2; ++n) acc[a][b][m][n] = (f32x4){0.f, 0.f, 0.f, 0.f};
    bf16x8 At[4][2], B0[2][2], B1[2][2]; i32x8 At8[4], B08[2], B18[2]; const int sc1_ = 0x7f7f7f7f;
    const char* cA = (const char*)g.A + (size_t)cur.pm * tstep + (size_t)cur.kt0 * kstep; const char* cB = (const char*)g.Bt + (size_t)cur.pn * tstep + (size_t)cur.kt0 * kstep;
    S.a_ready(cur);
    PG8_STAGE(PG8_SB(0, 0), cB, voffB); PG8_STAGE(PG8_SA(0, 0), cA, voffA); PG8_STAGE(PG8_SB(0, 1), cB + hstep, voffB); PG8_STAGE(PG8_SA(0, 1), cA + hstep, voffA);
    if (wr == 1) PG8_BAR;
    PG8_WAIT_V(4); PG8_BAR;
    PG8_STAGE(PG8_SB(1, 0), cB + kstep, voffB); PG8_STAGE(PG8_SA(1, 0), cA + kstep, voffA); PG8_STAGE(PG8_SB(1, 1), cB + hstep + kstep, voffB);
    PG8_WAIT_V(6); PG8_BAR;
    for (;;) {
        const bool has_next = S.next(ui + 1, nxt);
        const char* nA = has_next ? (const char*)g.A + (size_t)nxt.pm * tstep + (size_t)nxt.kt0 * kstep : cA; const char* nB = has_next ? (const char*)g.Bt + (size_t)nxt.pn * tstep + (size_t)nxt.kt0 * kstep : cB;
        const int nt = cur.nkt;
        for (int t = 0; t < nt; t += 2) {
            const bool last = (t == nt - 2);
            const char* a1 = cA + (size_t)(t + 1) * kstep;
            const char* a2 = last ? nA : cA + (size_t)(t + 2) * kstep; const char* b2 = last ? nB : cB + (size_t)(t + 2) * kstep;
            const char* a3 = a2 + kstep; const char* b3 = b2 + kstep;
            if (last && has_next) S.a_ready(nxt);
            PG8_LDB(B0, B08, 0, 0); PG8_SCHED; PG8_LDA(At, At8, 0, 0); PG8_STAGE(PG8_SA(1, 1), a1 + hstep, voffA);
            PG8_WAIT_L(8); PG8_BAR; PG8_WAIT_L(0); PG8_MMA(0, 0, At, B0, At8, B08); PG8_BAR; PG8_SCHED;
            PG8_LDB(B1, B18, 0, 1); PG8_STAGE(PG8_SB(0, 0), b2, voffB);
            PG8_BAR; PG8_WAIT_L(0); PG8_MMA(0, 1, At, B1, At8, B18); PG8_BAR;
            PG8_LDA(At, At8, 0, 1); PG8_STAGE(PG8_SA(0, 0), a2, voffA);
            PG8_BAR; PG8_WAIT_L(0); PG8_MMA(1, 0, At, B0, At8, B08); PG8_BAR; PG8_SCHED;
            PG8_STAGE(PG8_SB(0, 1), b2 + hstep, voffB);
            PG8_WAIT_V(6); PG8_BAR; PG8_MMA(1, 1, At, B1, At8, B18); PG8_BAR;
            PG8_LDB(B0, B08, 1, 0); PG8_SCHED; PG8_LDA(At, At8, 1, 0); PG8_STAGE(PG8_SA(0, 1), a2 + hstep, voffA);
            PG8_WAIT_L(8); PG8_BAR; PG8_WAIT_L(0); PG8_MMA(0, 0, At, B0, At8, B08); PG8_BAR; PG8_SCHED;
            PG8_LDB(B1, B18, 1, 1); PG8_STAGE(PG8_SB(1, 0), b3, voffB);
            PG8_BAR; PG8_WAIT_L(0); PG8_MMA(0, 1, At, B1, At8, B18); PG8_BAR;
            PG8_LDA(At, At8, 1, 1); PG8_STAGE(PG8_SA(1, 0), a3, voffA);
            PG8_BAR; PG8_WAIT_L(0); PG8_MMA(1, 0, At, B0, At8, B08); PG8_BAR; PG8_SCHED;
            PG8_STAGE(PG8_SB(1, 1), b3 + hstep, voffB);
            PG8_WAIT_V(6); PG8_BAR; PG8_MMA(1, 1, At, B1, At8, B18); PG8_BAR;
        }
        if constexpr (FP8) { asm volatile("s_nop 15\n\ts_nop 15" ::: "memory"); }
        if constexpr (!Epi::AFTER_DRAIN) { E(acc, cur, wr, wc, fr, fq); S.done(cur); }
#ifdef EPI2X
        if constexpr (FP8) { asm volatile("" ::: "memory"); E(acc, cur, wr, wc, fr, fq); }
#endif
        if (!has_next) break;
#pragma unroll
        for (int a = 0; a < 2; ++a)
#pragma unroll
            for (int b = 0; b < 2; ++b)
#pragma unroll
                for (int m = 0; m < 4; ++m)
#pragma unroll
                    for (int n = 0; n < 2; ++n) acc[a][b][m][n] = (f32x4){0.f, 0.f, 0.f, 0.f};
        cur = nxt; cA = nA; cB = nB; ++ui;
    }
    PG8_WAIT_V(0);
    if (wr == 0) PG8_BAR;
    PG8_BAR;
    if constexpr (Epi::AFTER_DRAIN) { E.fused(acc, cur, wr, wc, fr, fq, lds, wid, lane); S.done(cur); }
#undef PG8_SA
#undef PG8_SB
#undef PG8_STAGE
#undef PG8_LDA
#undef PG8_LDB
#undef PG8_MMA
#undef PG8_WAIT_V
#undef PG8_WAIT_L
#undef PG8_BAR
#undef PG8_SCHED
}
}

using pg8::bf16_t; using pg8::bf16x8; using pg8::f32x4; using pg8::u32x4;
#define LAS __attribute__((address_space(3)))
typedef unsigned u32x2 __attribute__((ext_vector_type(2)));

constexpr int DM = 1024, NB = 8, SEQ = 8192, DB = 32, DS = 32;
constexpr int MP = NB * SEQ, MS = DB * DS, MT = MP + MS;
constexpr int NPROJ = 2560, INCOLS = 2568, DFF = 2816;
constexpr int SCN = 16;
constexpr float ALPHA = 1.189207115002721f, KSCALE = 0.08838834764831845f, LN_EPS = 1e-5f;

constexpr size_t al256(size_t x) { return (x + 255) & ~(size_t)255; }
constexpr size_t WS_BAR = 0;
constexpr size_t WS_WIN = 16384;
constexpr size_t WS_WOUT = WS_WIN + al256((size_t)NPROJ * DM * 2);
constexpr size_t WS_WGU = WS_WOUT + al256((size_t)DM * DM * 2);
constexpr size_t WS_WDN = WS_WGU + al256((size_t)2 * DFF * DM * 2);
constexpr size_t WS_WPOOL = WS_WDN + al256((size_t)DM * DFF * 2);
constexpr size_t WS_BIAS = WS_WPOOL + al256((size_t)4 * 128 * 128 * 2);
constexpr size_t WS_GATES = WS_BIAS + al256((size_t)NPROJ * 4);
constexpr size_t WS_MTAB = WS_GATES + al256((size_t)MT * 8 * 4);
constexpr size_t WS_BTAB = WS_MTAB + al256((size_t)32 * 132 * 4);
constexpr size_t WS_GTAB = WS_BTAB + al256((size_t)32 * 128 * 4);
constexpr size_t WS_DST = WS_GTAB + al256((size_t)MT * 4 * 16);
constexpr size_t WS_DN = WS_DST + al256((size_t)224 * 16384 * 4);
constexpr size_t WS_H0 = WS_DN + al256((size_t)224 * 128 * 4);
constexpr size_t WS_PROJ = WS_H0 + al256((size_t)MT * DM * 2);
constexpr size_t WS_MIX = WS_PROJ + al256((size_t)MT * NPROJ * 2);
constexpr size_t WS_END = WS_MIX + al256((size_t)MT * DM * 2);
constexpr size_t WS_SLAB = WS_END;
constexpr size_t WS_END2 = WS_SLAB + (size_t)11 * 1024 * 1024 * 4;
constexpr size_t WS_R2 = WS_END2;
constexpr size_t WS_END3 = WS_R2 + al256((size_t)MT * DM * 2);
constexpr size_t WS_H8 = WS_MIX + ((size_t)64 << 20);
constexpr float W8_SCALE = 32.0f;
constexpr size_t WS_R1 = WS_PROJ;
constexpr size_t WS_ACT = WS_PROJ;
static_assert((size_t)MT * DFF * 2 <= WS_END - WS_PROJ, "act does not fit");
static_assert(WS_PROJ + (size_t)MT * DFF * 2 <= WS_MIX + ((size_t)64 << 20) && WS_MIX + ((size_t)64 << 20) + (size_t)MT * DM <= WS_END, "h8 placement");

constexpr size_t O_Y = 0;
constexpr size_t O_POOLP = (size_t)MT * DM;
constexpr size_t O_CP = O_POOLP + (size_t)NB * 15 * 512;
constexpr size_t O_NP = O_CP + (size_t)NB * 4 * 16384;
constexpr size_t O_MP = O_NP + (size_t)NB * 4 * 128;
constexpr size_t O_POOLS = O_MP + (size_t)NB * 4;
constexpr size_t O_CS = O_POOLS + (size_t)DB * 15 * 512;
constexpr size_t O_NS = O_CS + (size_t)DB * 4 * 16384;
constexpr size_t O_MS = O_NS + (size_t)DB * 4 * 128;
constexpr size_t O_END = O_MS + (size_t)DB * 4;

struct Params { const float* in[21]; float* out; unsigned char* ws; };

__device__ __forceinline__ int fresh_tid() { int t = threadIdx.x; asm volatile("" : "+v"(t)); return t; }
__device__ __forceinline__ float bf2f(unsigned x) { return __uint_as_float(x << 16); }
__device__ __forceinline__ float bflo(unsigned w) { return __uint_as_float(w << 16); }
__device__ __forceinline__ float bfhi(unsigned w) { return __uint_as_float(w & 0xffff0000u); }
__device__ __forceinline__ unsigned pk2(float lo, float hi) { return pg8::cvt_pk_bf16(lo, hi); }
__device__ __forceinline__ unsigned pk4_fp8(float a, float b, float c, float d) { int r = __builtin_amdgcn_cvt_pk_fp8_f32(a, b, 0, false); r = __builtin_amdgcn_cvt_pk_fp8_f32(c, d, r, true); return (unsigned)r; }
__device__ __forceinline__ float wave_sum(float v) {
#pragma unroll
    for (int o = 32; o; o >>= 1) v += __shfl_xor(v, o);
    return v; }
__device__ __forceinline__ float wave_max(float v) {
#pragma unroll
    for (int o = 32; o; o >>= 1) v = fmaxf(v, __shfl_xor(v, o));
    return v; }
__device__ __forceinline__ float scan_sum(float x, int lane) {
#pragma unroll
    for (int o = 1; o < 64; o <<= 1) { const float y = __shfl_up(x, o); if (lane >= o) x += y; }
    return x; }
__device__ __forceinline__ float scan_max(float x, int lane) {
#pragma unroll
    for (int o = 1; o < 64; o <<= 1) { const float y = __shfl_up(x, o); if (lane >= o) x = fmaxf(x, y); }
    return x; }
__device__ __forceinline__ float logsigmoid(float x) { return fminf(x, 0.f) - log1pf(expf(-fabsf(x))); }
__device__ __forceinline__ bf16x8 ldfrag(LAS const unsigned char* base, int row, int strideB, int kbyte) { return *(LAS const bf16x8*)(base + row * strideB + kbyte); }
#define LDS_BARRIER() do { asm volatile("s_waitcnt lgkmcnt(0)" ::: "memory"); __builtin_amdgcn_s_barrier(); asm volatile("" ::: "memory"); } while (0)
#define MFMA16(a, b, c) __builtin_amdgcn_mfma_f32_16x16x32_bf16((a), (b), (c), 0, 0, 0)

#define XB_TMO      128
#define XB_XCNT(j)  (256  + 64 * (j))
#define XB_XSUB(j)  (1280 + 64 * (j))
#define XB_XGEN(j)  (2304 + 64 * (j))
#define XB_TOP      3328
#define XB_TOPGEN   3392
#define XCD_BAR_WORDS 3456
#define XB_SPIN_CAP (1u << 18)
__device__ __forceinline__ unsigned xb_ld(unsigned* p)              { return __hip_atomic_load(p, __ATOMIC_RELAXED, __HIP_MEMORY_SCOPE_AGENT); }
__device__ __forceinline__ unsigned xb_add(unsigned* p, unsigned v) { return __hip_atomic_fetch_add(p, v, __ATOMIC_RELAXED, __HIP_MEMORY_SCOPE_AGENT); }
__device__ __forceinline__ unsigned xb_xcc_id() { return (unsigned)__builtin_amdgcn_s_getreg((3 << 11) | 20) & 0xFu; }
#define XB_SPIN(cond, bar) do { unsigned _sp = 0; while (cond) { __builtin_amdgcn_s_sleep(1); \
    if ((++_sp & 255u) == 0u) { if (xb_ld(&(bar)[XB_TMO])) break; if (_sp > XB_SPIN_CAP) { atomicAdd(&(bar)[XB_TMO], 1u); break; } } } } while (0)

struct XcdBarrier {
    unsigned* bar; unsigned x;
    volatile LAS unsigned* st;
};

__device__ __forceinline__ XcdBarrier xcd_barrier_post(unsigned* bar, volatile LAS unsigned* st) {
    XcdBarrier b; b.bar = bar; b.x = xb_xcc_id(); b.st = st;
    if (threadIdx.x == 0) (void)xb_add(&bar[XB_XCNT(b.x)], 1u);
    return b;
}
__device__ __forceinline__ void xcd_barrier_complete(unsigned* bar, unsigned x, unsigned& nloc, unsigned& nx) {
    const unsigned G = gridDim.x * gridDim.y * gridDim.z;
    unsigned sum, cnt, mine, sp = 0u;
    for (;;) {
        sum = 0u; cnt = 0u; mine = 0u;
#pragma unroll
        for (unsigned j = 0; j < 16; ++j) { const unsigned c = xb_ld(&bar[XB_XCNT(j)]); sum += c; cnt += (c > 0u) ? 1u : 0u; mine = (j == x) ? c : mine; }
        if (sum == G) break;
        __builtin_amdgcn_s_sleep(1);
        if ((++sp & 255u) == 0u) { if (xb_ld(&bar[XB_TMO])) break; if (sp > XB_SPIN_CAP) { atomicAdd(&bar[XB_TMO], 1u); break; } }
    }
    nloc = mine > 0u ? mine : 1u; nx = cnt > 0u ? cnt : 1u;
}

__device__ __forceinline__ void xcd_barrier(const XcdBarrier& b) {
    asm volatile("s_waitcnt vmcnt(0)" ::: "memory");
    __syncthreads();
    if (threadIdx.x == 0) {
        unsigned* bar = b.bar;
        __builtin_amdgcn_s_waitcnt(0);
        unsigned nloc = b.st[0], nx = b.st[1];
        if (nloc == 0u) { xcd_barrier_complete(bar, b.x, nloc, nx); b.st[0] = nloc; b.st[1] = nx; }
        const unsigned old = xb_add(&bar[XB_XSUB(b.x)], 1u);
        const unsigned gen = old / nloc;
        if (old + 1u == (gen + 1u) * nloc) {
            __builtin_amdgcn_fence(__ATOMIC_RELEASE, "agent");
            asm volatile("s_waitcnt vmcnt(0)" ::: "memory");
            const unsigned og = xb_add(&bar[XB_TOP], 1u);
            const unsigned tg = og / nx;
            if (og + 1u == (tg + 1u) * nx) xb_add(&bar[XB_TOPGEN], 1u);
            else XB_SPIN(xb_ld(&bar[XB_TOPGEN]) == tg, bar);
            __builtin_amdgcn_fence(__ATOMIC_ACQUIRE, "agent");
            xb_add(&bar[XB_XGEN(b.x)], 1u);
            asm volatile("s_waitcnt vmcnt(0)" ::: "memory");
        } else {
            XB_SPIN(xb_ld(&bar[XB_XGEN(b.x)]) == gen, bar);
            __builtin_amdgcn_fence(__ATOMIC_ACQUIRE, "agent");
            asm volatile("s_waitcnt vmcnt(0)" ::: "memory");
        }
    }
    __syncthreads();
}

struct SplitOrder {
    int nN, nP, S, nkt, G, c;
    __device__ __forceinline__ void init(int N, int Ktiles, int S_, int G_, int c_) { nN = N / 256; nP = 256 * nN; S = S_; nkt = Ktiles; G = G_; c = c_; }
    __device__ __forceinline__ bool next(int i, pg8::Unit& u) const {
        const long L = (long)i * G + c;
        if (L >= nP + 4 * nN * S) return false;
        int pm, pn, k0 = 0, kn = nkt;
        if (L < nP) { int wgid = (int)L; { const int q = nP / 8, xcd = wgid % 8, off = wgid / 8; wgid = xcd * q + off; }
            const int nig = 8 * nN, gid = wgid / nig, fm = gid * 8; pm = fm + ((wgid % nig) % 8); pn = (wgid % nig) / 8; }
        else { const int j = (int)(L - nP), su = j / S, sl = j - su * S; pm = 256 + su / nN; pn = su % nN; kn = nkt / S; k0 = sl * kn; }
        u.pm = pm; u.pn = pn; u.kt0 = k0; u.nkt = kn; return true;
    }
    __device__ __forceinline__ void a_ready(const pg8::Unit&) const {}
    __device__ __forceinline__ void done(const pg8::Unit&) const {}
};

struct EpiBf16B {
    static constexpr bool PERM = true, AFTER_DRAIN = false;
    bf16_t* O; int ldc; const float* bias;
    __device__ __forceinline__ void operator()(const f32x4 (&acc)[2][2][4][2], const pg8::Unit& u, int wr, int wc, int fr, int fq) const {
        const int row0 = u.pm * 256 + wr * 64 + fr, col0 = u.pn * 256 + wc * 32 + 8 * fq;
        f32x4 bv[2][2];
#pragma unroll
        for (int bj = 0; bj < 2; ++bj)
#pragma unroll
            for (int n = 0; n < 2; ++n) bv[bj][n] = *(const f32x4*)(bias + col0 + bj * 128 + 4 * n);
#pragma unroll
        for (int ai = 0; ai < 2; ++ai)
#pragma unroll
            for (int m = 0; m < 4; ++m) { bf16_t* rowp = O + (size_t)(row0 + ai * 128 + m * 16) * ldc + col0;
#pragma unroll
                for (int bj = 0; bj < 2; ++bj) { const f32x4 v0 = acc[ai][bj][m][0] + bv[bj][0], v1 = acc[ai][bj][m][1] + bv[bj][1];
                    u32x4 w; w.x = pk2(v0[0], v0[1]); w.y = pk2(v0[2], v0[3]); w.z = pk2(v1[0], v1[1]); w.w = pk2(v1[2], v1[3]);
                    *(u32x4*)(rowp + bj * 128) = w; } }
    }
};
struct EpiRes {
    static constexpr bool PERM = true, AFTER_DRAIN = false;
    const bf16_t* base; bf16_t* out; float* slab; int nkt_full;
    __device__ __forceinline__ void operator()(const f32x4 (&acc)[2][2][4][2], const pg8::Unit& u, int wr, int wc, int fr, int fq) const {
        const int row0 = u.pm * 256 + wr * 64 + fr, col0 = u.pn * 256 + wc * 32 + 8 * fq;
        if (u.nkt != nkt_full) {
            float* sp = slab + (size_t)(u.kt0 / u.nkt) * (1024 * 1024) + (size_t)(row0 - MP) * DM + col0;
#pragma unroll
            for (int ai = 0; ai < 2; ++ai)
#pragma unroll
                for (int m = 0; m < 4; ++m)
#pragma unroll
                    for (int bj = 0; bj < 2; ++bj)
#pragma unroll
                        for (int n = 0; n < 2; ++n) *(f32x4*)(sp + (size_t)(ai * 128 + m * 16) * DM + bj * 128 + 4 * n) = acc[ai][bj][m][n];
            return; }
        u32x4 bb[2][4][2];
#pragma unroll
        for (int ai = 0; ai < 2; ++ai)
#pragma unroll
            for (int m = 0; m < 4; ++m)
#pragma unroll
                for (int bj = 0; bj < 2; ++bj) bb[ai][m][bj] = *(const u32x4*)(base + (size_t)(row0 + ai * 128 + m * 16) * DM + col0 + bj * 128);
        asm volatile("" ::: "memory");
#pragma unroll
        for (int ai = 0; ai < 2; ++ai)
#pragma unroll
            for (int m = 0; m < 4; ++m) { const size_t off = (size_t)(row0 + ai * 128 + m * 16) * DM + col0;
#pragma unroll
                for (int bj = 0; bj < 2; ++bj) { const u32x4 b = bb[ai][m][bj]; const f32x4 a0 = acc[ai][bj][m][0], a1 = acc[ai][bj][m][1];
                    u32x4 w; w.x = pk2(ALPHA * bflo(b.x) + a0[0], ALPHA * bfhi(b.x) + a0[1]); w.y = pk2(ALPHA * bflo(b.y) + a0[2], ALPHA * bfhi(b.y) + a0[3]);
                    w.z = pk2(ALPHA * bflo(b.z) + a1[0], ALPHA * bfhi(b.z) + a1[1]); w.w = pk2(ALPHA * bflo(b.w) + a1[2], ALPHA * bfhi(b.w) + a1[3]);
                    *(u32x4*)(out + off + bj * 128) = w; } }
    }
};
__device__ __forceinline__ float fsigmoid(float x) { return __builtin_amdgcn_rcpf(1.0f + __expf(-x)); }
__device__ __forceinline__ float swiglu(float g, float u) { return g * u * fsigmoid(g); }
struct EpiSwiglu {
    static constexpr bool PERM = true, AFTER_DRAIN = false;
    bf16_t* O; float sc;
    __device__ __forceinline__ void operator()(const f32x4 (&acc)[2][2][4][2], const pg8::Unit& u, int wr, int wc, int fr, int fq) const {
        const int row0 = u.pm * 256 + wr * 64 + fr, col0 = u.pn * 128 + wc * 32 + 8 * fq;
#pragma unroll
        for (int ai = 0; ai < 2; ++ai)
#pragma unroll
            for (int m = 0; m < 4; ++m) { bf16_t* rowp = O + (size_t)(row0 + ai * 128 + m * 16) * DFF + col0;
                const f32x4 g0 = acc[ai][0][m][0] * sc, g1 = acc[ai][0][m][1] * sc, u0 = acc[ai][1][m][0] * sc, u1 = acc[ai][1][m][1] * sc;
                u32x4 w; w.x = pk2(swiglu(g0[0], u0[0]), swiglu(g0[1], u0[1])); w.y = pk2(swiglu(g0[2], u0[2]), swiglu(g0[3], u0[3]));
                w.z = pk2(swiglu(g1[0], u1[0]), swiglu(g1[1], u1[1])); w.w = pk2(swiglu(g1[2], u1[2]), swiglu(g1[3], u1[3]));
                *(u32x4*)rowp = w; }
    }
};

constexpr int TR_TILES = 640 + 256 + 704 + 704 + 704 + 16;
struct TileDesc { const float* src; bf16_t* dst; int ld, K, mode, k0, n0; };
__device__ __forceinline__ TileDesc tile_desc(const Params& p, int t) {
    TileDesc d; unsigned char* ws = p.ws;
    if (t < 640) { d.src = p.in[8]; d.ld = INCOLS; d.K = DM; d.mode = 3; d.dst = (bf16_t*)(ws + WS_WIN); }
    else if (t < 896) { t -= 640; d.src = p.in[13]; d.ld = DM; d.K = DM; d.mode = 0; d.dst = (bf16_t*)(ws + WS_WOUT); }
    else if (t < 1600) { t -= 896; d.src = p.in[16]; d.ld = DFF; d.K = DM; d.mode = 1; d.dst = (bf16_t*)(ws + WS_WGU); }
    else if (t < 2304) { t -= 1600; d.src = p.in[17]; d.ld = DFF; d.K = DM; d.mode = 2; d.dst = (bf16_t*)(ws + WS_WGU); }
    else if (t < 3008) { t -= 2304; d.src = p.in[18]; d.ld = DM; d.K = DFF; d.mode = 0; d.dst = (bf16_t*)(ws + WS_WDN); }
    else { t -= 3008; const int g = t >> 2; t &= 3; d.src = p.in[10] + g * 16384; d.ld = 128; d.K = 128; d.mode = 0; d.dst = (bf16_t*)(ws + WS_WPOOL) + g * 16384; }
    const int nkt = d.K >> 6; d.k0 = (t % nkt) * 64; d.n0 = (t / nkt) * 64; return d;
}

__device__ __forceinline__ void phase0(const Params& p, LAS unsigned char* lds) {
    const int tid = fresh_tid(), lane = tid & 63, wave = tid >> 6, G = gridDim.x, bx = blockIdx.x;
    unsigned char* ws = p.ws;
    LAS float* T = (LAS float*)lds;
    {
        const int r = tid >> 3, cs = (tid & 7) * 8;
        int t = bx; float4 a = make_float4(0.f, 0.f, 0.f, 0.f), b = a; TileDesc d = tile_desc(p, t < TR_TILES ? t : 0);
        if (t < TR_TILES) { const float* s = d.src + (size_t)(d.k0 + r) * d.ld + d.n0 + cs; a = *(const float4*)s; b = *(const float4*)(s + 4); }
#pragma unroll 1
        for (; t < TR_TILES; t += G) {
            { LAS float* q = T + r * 65 + cs; q[0] = a.x; q[1] = a.y; q[2] = a.z; q[3] = a.w; q[4] = b.x; q[5] = b.y; q[6] = b.z; q[7] = b.w; }
            const TileDesc dn = tile_desc(p, t + G < TR_TILES ? t + G : 0);
            if (t + G < TR_TILES) { const float* s = dn.src + (size_t)(dn.k0 + r) * dn.ld + dn.n0 + cs; a = *(const float4*)s; b = *(const float4*)(s + 4); }
            LDS_BARRIER();
            { const int n = tid >> 3, ks = (tid & 7) * 8, gn = d.n0 + n; float v[8];
#pragma unroll
              for (int i = 0; i < 8; ++i) v[i] = T[(ks + i) * 65 + n];
              const float sc = (d.mode == 3 && gn >= 1024 && gn < 1536) ? KSCALE : 1.0f;
              const int drow = (d.mode == 1) ? 256 * (gn >> 7) + (gn & 127) : (d.mode == 2) ? 256 * (gn >> 7) + 128 + (gn & 127) : gn;
              if (d.mode == 1 || d.mode == 2) {
                  u32x2 w8; w8.x = pk4_fp8(v[0] * W8_SCALE, v[1] * W8_SCALE, v[2] * W8_SCALE, v[3] * W8_SCALE); w8.y = pk4_fp8(v[4] * W8_SCALE, v[5] * W8_SCALE, v[6] * W8_SCALE, v[7] * W8_SCALE);
                  *(u32x2*)((unsigned char*)d.dst + (size_t)drow * d.K + d.k0 + ks) = w8; }
              else { u32x4 w; w.x = pk2(v[0] * sc, v[1] * sc); w.y = pk2(v[2] * sc, v[3] * sc); w.z = pk2(v[4] * sc, v[5] * sc); w.w = pk2(v[6] * sc, v[7] * sc);
                  *(u32x4*)(d.dst + (size_t)drow * d.K + d.k0 + ks) = w; } }
            LDS_BARRIER();
            d = dn;
        }
    }
    { float* bs = (float*)(ws + WS_BIAS); const float* b_in = p.in[9];
      for (int i = bx * 512 + tid; i < NPROJ; i += G * 512) bs[i] = b_in[i] * ((i >= 1024 && i < 1536) ? KSCALE : 1.0f); }
    f32x4 wlo[4][4], whi[4][4];
    { const float* w_in = p.in[8];
#pragma unroll
      for (int i = 0; i < 4; ++i)
#pragma unroll
          for (int e = 0; e < 4; ++e) { const float* wp = w_in + (size_t)(i * 256 + lane * 4 + e) * INCOLS + NPROJ; wlo[i][e] = *(const f32x4*)wp; whi[i][e] = *(const f32x4*)(wp + 4); } }
    const float* lg = p.in[6]; const float* lb = p.in[7]; const float* b_in = p.in[9];
    bf16_t* h0 = (bf16_t*)(ws + WS_H0); float* gates = (float*)(ws + WS_GATES);
    const float gb_perm = lane < 8 ? b_in[NPROJ + (((lane & 1) << 2) | (lane & 2) | ((lane >> 2) & 1))] : 0.f;
    int row = bx * 8 + wave; float4 v[4];
    if (row < MT) { const float* x = row < MP ? p.in[0] + (size_t)row * DM : p.in[1] + (size_t)(row - MP) * DM;
#pragma unroll
        for (int i = 0; i < 4; ++i) v[i] = *(const float4*)(x + i * 256 + lane * 4); }
#pragma unroll 1
    for (; row < MT; row += G * 8) {
        const int nrow = row + G * 8; float4 nv[4];
        if (nrow < MT) { const float* x = nrow < MP ? p.in[0] + (size_t)nrow * DM : p.in[1] + (size_t)(nrow - MP) * DM;
#pragma unroll
            for (int i = 0; i < 4; ++i) nv[i] = *(const float4*)(x + i * 256 + lane * 4); }
        else {
#pragma unroll
            for (int i = 0; i < 4; ++i) nv[i] = make_float4(0.f, 0.f, 0.f, 0.f); }
        float s = 0.f;
#pragma unroll
        for (int i = 0; i < 4; ++i) s += (v[i].x + v[i].y) + (v[i].z + v[i].w);
        const float mu = wave_sum(s) * (1.0f / DM);
        float q = 0.f;
#pragma unroll
        for (int i = 0; i < 4; ++i) { v[i].x -= mu; v[i].y -= mu; v[i].z -= mu; v[i].w -= mu; q += (v[i].x * v[i].x + v[i].y * v[i].y) + (v[i].z * v[i].z + v[i].w * v[i].w); }
        const float rstd = rsqrtf(wave_sum(q) * (1.0f / DM) + LN_EPS);
        f32x4 glo = (f32x4){0.f, 0.f, 0.f, 0.f}, ghi = glo;
#pragma unroll
        for (int i = 0; i < 4; ++i) { const int c = i * 256 + lane * 4; const float4 gg = *(const float4*)(lg + c), bb = *(const float4*)(lb + c);
            float4 y; y.x = v[i].x * rstd * gg.x + bb.x; y.y = v[i].y * rstd * gg.y + bb.y; y.z = v[i].z * rstd * gg.z + bb.z; y.w = v[i].w * rstd * gg.w + bb.w;
            u32x2 w; w.x = pk2(y.x, y.y); w.y = pk2(y.z, y.w); *(u32x2*)(h0 + (size_t)row * DM + c) = w;
            glo += y.x * wlo[i][0] + y.y * wlo[i][1] + y.z * wlo[i][2] + y.w * wlo[i][3];
            ghi += y.x * whi[i][0] + y.y * whi[i][1] + y.z * whi[i][2] + y.w * whi[i][3]; }
        { const bool b0 = lane & 1, b1 = lane & 2, b2 = lane & 4;
          f32x4 k4, s4;
#pragma unroll
          for (int j = 0; j < 4; ++j) { k4[j] = b0 ? ghi[j] : glo[j]; s4[j] = b0 ? glo[j] : ghi[j]; }
#pragma unroll
          for (int j = 0; j < 4; ++j) k4[j] += __shfl_xor(s4[j], 1);
          float k2a = b1 ? k4[2] : k4[0], k2b = b1 ? k4[3] : k4[1];
          k2a += __shfl_xor(b1 ? k4[0] : k4[2], 2); k2b += __shfl_xor(b1 ? k4[1] : k4[3], 2);
          float k1 = b2 ? k2b : k2a; k1 += __shfl_xor(b2 ? k2a : k2b, 4);
          k1 += __shfl_xor(k1, 8); k1 += __shfl_xor(k1, 16); k1 += __shfl_xor(k1, 32);
          const int gidx = ((lane & 1) << 2) | (lane & 2) | ((lane >> 2) & 1);
          if (lane < 8) gates[(size_t)row * 8 + gidx] = k1 + gb_perm; }
#pragma unroll
        for (int i = 0; i < 4; ++i) v[i] = nv[i];
    }
}

__device__ __forceinline__ void gate_scan(const Params& p, LAS unsigned char* lds) {
    const int tid = fresh_tid(), lane = tid & 63, wave = tid >> 6, G = gridDim.x;
    const float* gates = (const float*)(p.ws + WS_GATES); float* mtab = (float*)(p.ws + WS_MTAB); float* btab = (float*)(p.ws + WS_BTAB);
    f32x4* gtab = (f32x4*)(p.ws + WS_GTAB);
    LAS float* sA = (LAS float*)lds; LAS float* sB = sA + 128; LAS float* sM = sA + 256;
    const int vb = (blockIdx.x + G - (64 % G)) % G;
    for (int chain = vb; chain < 32; chain += G) {
        const int batch = chain >> 2, head = chain & 3;
        float ig[16], bb[16];
#pragma unroll
        for (int k = 0; k < 16; ++k) { const size_t row = (size_t)batch * SEQ + (wave + 8 * k) * 64 + lane; ig[k] = gates[row * 8 + head]; bb[k] = gates[row * 8 + 4 + head]; }
#pragma unroll
        for (int k = 0; k < 16; ++k) { bb[k] = scan_sum(logsigmoid(bb[k]), lane); const float A = wave_max(ig[k] - bb[k]); const float bl = __shfl(bb[k], 63);
            if (lane == 0) { sA[wave + 8 * k] = A; sB[wave + 8 * k] = bl; } }
        __syncthreads();
        if (tid == 0) { float m = 0.f; mtab[chain * 132] = 0.f; sM[0] = 0.f;
            for (int c = 0; c < 128; ++c) { m = sB[c] + fmaxf(m, sA[c]); mtab[chain * 132 + c + 1] = m; sM[c + 1] = m; btab[chain * 128 + c] = sB[c]; }
            p.out[O_MP + chain] = m; }
        __syncthreads();
#pragma unroll
        for (int k = 0; k < 16; ++k) { const int c = wave + 8 * k; const size_t row = (size_t)batch * SEQ + c * 64 + lane;
            const float a = ig[k] - bb[k]; const float m_prev = sM[c]; const float M = fmaxf(m_prev, scan_max(a, lane));
            gtab[row * 4 + head] = (f32x4){a, M, expf(m_prev - M), expf(-(bb[k] + M))}; }
        __syncthreads();
    }
    const int vb2 = (blockIdx.x + G - (96 % G)) % G;
    for (int s = vb2 * 8 + wave; s < DB * 4; s += G * 8) {
        const int b_ = s >> 2, head = s & 3; const bool valid = lane < 32; const size_t row = (size_t)MP + b_ * 32 + (lane & 31);
        const float ig = gates[row * 8 + head], fg = gates[row * 8 + 4 + head]; const float m_prev = p.in[5][s];
        const float b = scan_sum(valid ? logsigmoid(fg) : 0.f, lane); const float a = valid ? ig - b : -1e30f;
        const float M = fmaxf(m_prev, scan_max(a, lane));
        if (valid) gtab[row * 4 + head] = (f32x4){a, M, expf(m_prev - M), expf(-(b + M))};
        if (lane == 31) p.out[O_MS + s] = b + M;
    }
}

constexpr int L_Q = 0, L_K = 17408, L_KW = 34816, L_V = 52224, L_CT = 69632, L_S = 104448, L_G = 113664, L_H = 116512;
constexpr int LDS_XB = 152000, LDS_TOTAL = 152064;
typedef short s16x4 __attribute__((ext_vector_type(4)));
__device__ __forceinline__ bf16x8 ldfrag_tr(LAS const unsigned char* base, int row0, int col0, int lane) {
    const int g = lane >> 4, q = (lane & 15) >> 2, pp = lane & 3;
    LAS const unsigned char* a = base + (row0 + 8 * g + q) * 272 + (col0 + 4 * pp) * 2;
    const s16x4 lo = __builtin_amdgcn_ds_read_tr16_b64_v4i16((LAS s16x4*)a);
    const s16x4 hi = __builtin_amdgcn_ds_read_tr16_b64_v4i16((LAS s16x4*)(a + 4 * 272));
    return __builtin_shufflevector(lo, hi, 0, 1, 2, 3, 4, 5, 6, 7);
}

template <bool FULL>
__device__ __forceinline__ void mlstm_run(const Params& p, LAS unsigned char* lds, f32x4 (&accC)[2][4], f32x4 (&accN)[2], int row0, int head, int nch, int L) {
    const int tid = fresh_tid(), lane = tid & 63, wave = __builtin_amdgcn_readfirstlane(tid >> 6), l15 = lane & 15, l4 = lane >> 4, st = wave & 3, tp = wave >> 2;
    const bf16_t* proj = (const bf16_t*)(p.ws + WS_PROJ); const f32x4* gtab = (const f32x4*)(p.ws + WS_GTAB);
    bf16_t* mix = (bf16_t*)(p.ws + WS_MIX);
    LAS unsigned short* sQ = (LAS unsigned short*)(lds + L_Q); LAS unsigned short* sK = (LAS unsigned short*)(lds + L_K);
    LAS unsigned short* sKW = (LAS unsigned short*)(lds + L_KW); LAS unsigned short* sV = (LAS unsigned short*)(lds + L_V);
    LAS unsigned short* sS = (LAS unsigned short*)(lds + L_S); LAS float* sH = (LAS float*)(lds + L_H);
    LAS float* gA = (LAS float*)(lds + L_G); LAS float* gM = gA + 64; LAS float* gDec = gA + 128; LAS float* gEinv = gA + 192; LAS float* gW = gA + 256;
    LAS float* gQn = gA + 320; LAS float* gDi = gA + 384; LAS float* gN = gA + 448; LAS float* scal = gA + 576; LAS float* gNg = gA + 584;
    const bf16x8 ones = (bf16x8){0x3F80, 0x3F80, 0x3F80, 0x3F80, 0x3F80, 0x3F80, 0x3F80, 0x3F80};
    const int tok0 = tid >> 4, dsg = tid & 15;
    const int orow = tid >> 3, oseg = tid & 7;
    u32x4 kq[2], kk[2], kv[2]; f32x4 pgt = (f32x4){0.f, 0.f, 0.f, 0.f}; float pa[2] = {-1e30f, -1e30f}, pml = 0.f;
    if (FULL && tid < 128) gNg[tid] = p.in[12][head * 128 + tid];
#pragma unroll
    for (int i = 0; i < 2; ++i) { const int tok = tok0 + 32 * i; const bool valid = tok < L; const u32x4 z = (u32x4){0u, 0u, 0u, 0u};
        const bf16_t* src = proj + (size_t)(row0 + tok) * NPROJ + head * 128 + dsg * 8;
        kk[i] = valid ? *(const u32x4*)(src + 1024) : z; kv[i] = valid ? *(const u32x4*)(src + 1536) : z;
        if (FULL) kq[i] = valid ? *(const u32x4*)(src + 512) : z; else kq[i] = z; }
    if (wave == 0 && lane < L) pgt = gtab[(size_t)(row0 + lane) * 4 + head];
    { const float* gf = (const float*)gtab; pml = gf[((size_t)(row0 + L - 1) * 4 + head) * 4 + 1];
#pragma unroll
      for (int i = 0; i < 2; ++i) { const int tok = tok0 + 32 * i; if (tok < L) pa[i] = gf[((size_t)(row0 + tok) * 4 + head) * 4]; } }
#pragma unroll 1
    for (int c = 0; c < nch; ++c) {
        const int r0 = row0 + c * 64;
        if (wave == 0) {
            const bool valid = lane < L; const float a = valid ? pgt[0] : -1e30f; const float Ml = __shfl(pgt[1], L - 1);
            gA[lane] = a; gM[lane] = valid ? pgt[1] : Ml; gDec[lane] = valid ? pgt[2] : 0.f; gEinv[lane] = valid ? pgt[3] : 1.f;
            if (lane == L - 1) scal[0] = pgt[2];
        }
        if (FULL) {
#pragma unroll
            for (int i = 0; i < 2; ++i)
#pragma unroll
                for (int n = 0; n < 4; ++n) { u32x2 w; w.x = pk2(accC[i][n][0], accC[i][n][1]); w.y = pk2(accC[i][n][2], accC[i][n][3]);
                    *(LAS u32x2*)(lds + L_CT + (64 * tp + 16 * n + l15) * 272 + (32 * st + 16 * i + 4 * l4) * 2) = w; }
            if (tp == 0 && l15 == 0) {
#pragma unroll
                for (int i = 0; i < 2; ++i) *(LAS f32x4*)(gN + 32 * st + 16 * i + 4 * l4) = accN[i]; }
        }
#pragma unroll
        for (int i = 0; i < 2; ++i) { const int tok = tok0 + 32 * i;
            if (FULL) { *(LAS u32x4*)(sQ + tok * 136 + dsg * 8) = kq[i]; *(LAS u32x4*)(sK + tok * 136 + dsg * 8) = kk[i]; }
            *(LAS u32x4*)(sV + tok * 136 + dsg * 8) = kv[i];
            const float w = __expf(pa[i] - pml); u32x4 o;
            o.x = pk2(bflo(kk[i].x) * w, bfhi(kk[i].x) * w); o.y = pk2(bflo(kk[i].y) * w, bfhi(kk[i].y) * w);
            o.z = pk2(bflo(kk[i].z) * w, bfhi(kk[i].z) * w); o.w = pk2(bflo(kk[i].w) * w, bfhi(kk[i].w) * w);
            *(LAS u32x4*)(sKW + tok * 136 + dsg * 8) = o; }
        LDS_BARRIER();
        if (c + 1 < nch) {
#pragma unroll
            for (int i = 0; i < 2; ++i) { const int tok = tok0 + 32 * i;
                const bf16_t* src = proj + (size_t)(r0 + 64 + tok) * NPROJ + head * 128 + dsg * 8;
                kk[i] = *(const u32x4*)(src + 1024); kv[i] = *(const u32x4*)(src + 1536);
                if (FULL) kq[i] = *(const u32x4*)(src + 512); }
            if (wave == 0) pgt = gtab[(size_t)(r0 + 64 + lane) * 4 + head];
            { const float* gf = (const float*)gtab; pml = gf[((size_t)(r0 + 64 + L - 1) * 4 + head) * 4 + 1];
#pragma unroll
              for (int i = 0; i < 2; ++i) pa[i] = gf[((size_t)(r0 + 64 + tok0 + 32 * i) * 4 + head) * 4]; }
        }
        u32x4 ow0 = (u32x4){0u, 0u, 0u, 0u}, ow1 = ow0;
        if (FULL && orow < L) { const bf16_t* op = proj + (size_t)(r0 + orow) * NPROJ + 2048 + head * 128 + oseg * 16; ow0 = *(const u32x4*)op; ow1 = *(const u32x4*)(op + 8); }
        f32x4 nacc[4];
#pragma unroll
        for (int n = 0; n < 4; ++n) nacc[n] = (f32x4){0.f, 0.f, 0.f, 0.f};
        if (FULL) {
            f32x4 sacc[2]; sacc[0] = (f32x4){0.f, 0.f, 0.f, 0.f}; sacc[1] = sacc[0];
#pragma unroll
            for (int ks = 0; ks < 4; ++ks) { const int kb = (32 * ks + 8 * l4) * 2;
                const bf16x8 a = ldfrag(lds + L_K, 16 * st + l15, 272, kb);
#pragma unroll
                for (int tt = 0; tt < 2; ++tt) { const bf16x8 b = ldfrag(lds + L_Q, 16 * (2 * tp + tt) + l15, 272, kb); sacc[tt] = MFMA16(a, b, sacc[tt]); } }
#pragma unroll
            for (int tt = 0; tt < 2; ++tt) { const int t = 16 * (2 * tp + tt) + l15; const float Mt = gM[t]; float dv[4];
#pragma unroll
                for (int j = 0; j < 4; ++j) { const int s = 16 * st + 4 * l4 + j; dv[j] = (s <= t) ? sacc[tt][j] * __expf(gA[s] - Mt) : 0.f; }
                u32x2 w; w.x = pk2(dv[0], dv[1]); w.y = pk2(dv[2], dv[3]); *(LAS u32x2*)(lds + L_S + t * 144 + (16 * st + 4 * l4) * 2) = w; }
#pragma unroll
            for (int ks = 0; ks < 4; ++ks) { const int kb = (32 * ks + 8 * l4) * 2;
                const bf16x8 a = ldfrag(lds + L_Q, 16 * st + l15, 272, kb);
#pragma unroll
                for (int n = 0; n < 4; ++n) { const bf16x8 b = ldfrag(lds + L_CT, 64 * tp + 16 * n + l15, 272, kb); nacc[n] = MFMA16(a, b, nacc[n]); } }
#pragma unroll
            for (int j = 0; j < 4; ++j) { const float dj = gDec[16 * st + 4 * l4 + j];
#pragma unroll
                for (int n = 0; n < 4; ++n) nacc[n][j] *= dj; }
            { float s = 0.f;
              const u32x4 q0 = *(LAS const u32x4*)(sQ + orow * 136 + oseg * 16), q1 = *(LAS const u32x4*)(sQ + orow * 136 + oseg * 16 + 8);
              const unsigned qw[8] = {q0.x, q0.y, q0.z, q0.w, q1.x, q1.y, q1.z, q1.w};
#pragma unroll
              for (int e = 0; e < 8; ++e) s += bflo(qw[e]) * gN[oseg * 16 + 2 * e] + bfhi(qw[e]) * gN[oseg * 16 + 2 * e + 1];
              s += __shfl_xor(s, 1); s += __shfl_xor(s, 2); s += __shfl_xor(s, 4);
              if (oseg == 0) gQn[orow] = s; }
        }
        if (FULL) LDS_BARRIER();
        if (FULL) {
            const u32x4 s0 = *(LAS const u32x4*)(sS + orow * 72 + oseg * 8);
            float s = (bflo(s0.x) + bfhi(s0.x)) + (bflo(s0.y) + bfhi(s0.y)) + (bflo(s0.z) + bfhi(s0.z)) + (bflo(s0.w) + bfhi(s0.w));
            s += __shfl_xor(s, 1); s += __shfl_xor(s, 2); s += __shfl_xor(s, 4);
            if (oseg == 0) { const float den = gDec[orow] * gQn[orow] + s; gDi[orow] = __builtin_amdgcn_rcpf(fmaxf(fabsf(den), gEinv[orow])); } }
        const float wsv = scal[0];
#pragma unroll
        for (int i = 0; i < 2; ++i) { accN[i] *= wsv;
#pragma unroll
            for (int n = 0; n < 4; ++n) accC[i][n] *= wsv; }
#pragma unroll
        for (int ks = 0; ks < 2; ++ks) { bf16x8 bv[4];
#pragma unroll
            for (int n = 0; n < 4; ++n) bv[n] = ldfrag_tr(lds + L_V, 32 * ks, 64 * tp + 16 * n, lane);
            if (FULL) { const bf16x8 a = ldfrag(lds + L_S, 16 * st + l15, 144, (32 * ks + 8 * l4) * 2);
#pragma unroll
                for (int n = 0; n < 4; ++n) nacc[n] = MFMA16(a, bv[n], nacc[n]); }
#pragma unroll
            for (int i = 0; i < 2; ++i) { const bf16x8 a = ldfrag_tr(lds + L_KW, 32 * ks, 32 * st + 16 * i, lane);
                accN[i] = MFMA16(a, ones, accN[i]);
#pragma unroll
                for (int n = 0; n < 4; ++n) accC[i][n] = MFMA16(a, bv[n], accC[i][n]); } }
        LDS_BARRIER();
        if (FULL) {
#pragma unroll
            for (int j = 0; j < 4; ++j) { const int t = 16 * st + 4 * l4 + j; const float di = gDi[t];
#pragma unroll
                for (int n = 0; n < 4; ++n) sH[t * 132 + 64 * tp + 16 * n + l15] = nacc[n][j] * di; }
            LDS_BARRIER();
            if (orow < L) {
                f32x4 x[4]; float s = 0.f;
#pragma unroll
                for (int e = 0; e < 4; ++e) { x[e] = *(LAS const f32x4*)(sH + orow * 132 + oseg * 16 + 4 * e); s += (x[e][0] + x[e][1]) + (x[e][2] + x[e][3]); }
                s += __shfl_xor(s, 1); s += __shfl_xor(s, 2); s += __shfl_xor(s, 4);
                const float mean = s * (1.0f / 128.0f); float q = 0.f;
#pragma unroll
                for (int e = 0; e < 4; ++e) { x[e] -= mean; q += (x[e][0] * x[e][0] + x[e][1] * x[e][1]) + (x[e][2] * x[e][2] + x[e][3] * x[e][3]); }
                q += __shfl_xor(q, 1); q += __shfl_xor(q, 2); q += __shfl_xor(q, 4);
                const float rstd = rsqrtf(q * (1.0f / 128.0f) + LN_EPS);
                const unsigned owv[8] = {ow0.x, ow0.y, ow0.z, ow0.w, ow1.x, ow1.y, ow1.z, ow1.w}; unsigned ov[8];
#pragma unroll
                for (int e = 0; e < 4; ++e) { const f32x4 g = *(LAS const f32x4*)(gNg + oseg * 16 + 4 * e);
                    const float y0 = x[e][0] * rstd * g[0] * fsigmoid(bflo(owv[2 * e])), y1 = x[e][1] * rstd * g[1] * fsigmoid(bfhi(owv[2 * e]));
                    const float y2 = x[e][2] * rstd * g[2] * fsigmoid(bflo(owv[2 * e + 1])), y3 = x[e][3] * rstd * g[3] * fsigmoid(bfhi(owv[2 * e + 1]));
                    ov[2 * e] = pk2(y0, y1); ov[2 * e + 1] = pk2(y2, y3); }
                bf16_t* mp = mix + (size_t)(r0 + orow) * DM + 512 + head * 128 + oseg * 16;
                *(u32x4*)mp = (u32x4){ov[0], ov[1], ov[2], ov[3]}; *(u32x4*)(mp + 8) = (u32x4){ov[4], ov[5], ov[6], ov[7]};
            }
        }
    }
    LDS_BARRIER();
}

constexpr int L_PW = 34816, L_PU = 69632;
template <int W>
__device__ __forceinline__ void pool_diff(LAS unsigned char* lds, bool sample, int tilepos0) {
    const int tid = fresh_tid(), co = tid & 15, t0 = (tid >> 4) * 4;
    const int rb0 = sample ? (t0 >> 5) * 47 + 15 + (t0 & 31) : 15 + t0;
    LAS const unsigned char* up = lds + L_PU + co * 16;
    float sum[8];
#pragma unroll
    for (int e = 0; e < 8; ++e) sum[e] = 0.f;
    u32x4 xc = (u32x4){0u, 0u, 0u, 0u};
#pragma unroll
    for (int j = 0; j < W; ++j) { const u32x4 r = *(LAS const u32x4*)(up + (rb0 - j) * 272); if (j == 0) xc = r;
        sum[0] += bflo(r.x); sum[1] += bfhi(r.x); sum[2] += bflo(r.y); sum[3] += bfhi(r.y); sum[4] += bflo(r.z); sum[5] += bfhi(r.z); sum[6] += bflo(r.w); sum[7] += bfhi(r.w); }
#pragma unroll
    for (int tt = 0; tt < 4; ++tt) {
        if (tt > 0) { const u32x4 rn = *(LAS const u32x4*)(up + (rb0 + tt) * 272), ro = *(LAS const u32x4*)(up + (rb0 + tt - W) * 272); xc = rn;
            sum[0] += bflo(rn.x) - bflo(ro.x); sum[1] += bfhi(rn.x) - bfhi(ro.x); sum[2] += bflo(rn.y) - bflo(ro.y); sum[3] += bfhi(rn.y) - bfhi(ro.y);
            sum[4] += bflo(rn.z) - bflo(ro.z); sum[5] += bfhi(rn.z) - bfhi(ro.z); sum[6] += bflo(rn.w) - bflo(ro.w); sum[7] += bfhi(rn.w) - bfhi(ro.w); }
        const int cnt = sample ? W : min(tilepos0 + t0 + tt + 1, W); const float inv = 1.0f / (float)cnt;
        u32x4 w; w.x = pk2(sum[0] * inv - bflo(xc.x), sum[1] * inv - bfhi(xc.x)); w.y = pk2(sum[2] * inv - bflo(xc.y), sum[3] * inv - bfhi(xc.y));
        w.z = pk2(sum[4] * inv - bflo(xc.z), sum[5] * inv - bfhi(xc.z)); w.w = pk2(sum[6] * inv - bflo(xc.w), sum[7] * inv - bfhi(xc.w));
        *(LAS u32x4*)(lds + (t0 + tt) * 272 + co * 16) = w; }
}

__device__ __forceinline__ void pool_fetch(const Params& p, int item, int tid, u32x4 (&pf)[6]) {
    const int g = item & 3, R0 = (item >> 2) * 128;
    const bf16_t* proj = (const bf16_t*)(p.ws + WS_PROJ); const float* hist = p.in[2];
    if (R0 < MP) {
        const int seqrow0 = (R0 / SEQ) * SEQ, tilepos0 = R0 - seqrow0;
        u32x4 raw[6];
#pragma unroll
        for (int i = 0; i < 6; ++i) { const int piece = tid + 512 * i, e = piece >> 4, seg = piece & 15; int pos = tilepos0 - 15 + (e < 143 ? e : 142); pos = pos < 0 ? 0 : pos;
            raw[i] = *(const u32x4*)(proj + (size_t)(seqrow0 + pos) * NPROJ + g * 128 + seg * 8); }
#pragma unroll
        for (int i = 0; i < 6; ++i) pf[i] = raw[i];
    } else {
#pragma unroll
        for (int i = 0; i < 6; ++i) { const int piece = tid + 512 * i, e = piece >> 4, seg = piece & 15; u32x4 val = (u32x4){0u, 0u, 0u, 0u};
            if (e < 188) { const int sgi = e / 47, le = e - sgi * 47, b = ((R0 - MP) >> 5) + sgi;
                if (le < 15) { const float* hp = hist + ((size_t)b * 15 + le) * 512 + g * 128 + seg * 8; const float4 a = *(const float4*)hp, c4 = *(const float4*)(hp + 4);
                    val.x = pk2(a.x, a.y); val.y = pk2(a.z, a.w); val.z = pk2(c4.x, c4.y); val.w = pk2(c4.z, c4.w); }
                else val = *(const u32x4*)(proj + (size_t)(MP + b * 32 + le - 15) * NPROJ + g * 128 + seg * 8); }
            pf[i] = val; }
    }
}

__device__ __forceinline__ void pool_loop(const Params& p, LAS unsigned char* lds, int first, int stride, int end) {
    const int tid = fresh_tid(), lane = tid & 63, wave = __builtin_amdgcn_readfirstlane(tid >> 6), l15 = lane & 15, l4 = lane >> 4, st = wave & 3, tp = wave >> 2;
    bf16_t* mix = (bf16_t*)(p.ws + WS_MIX); const float* pscale = p.in[11];
    if (first >= end) return;
    u32x4 pf[6]; pool_fetch(p, first, tid, pf);
    int gw = -1;
#pragma unroll 1
    for (int item = first; item < end; item += stride) {
        const int g = item & 3, R0 = (item >> 2) * 128;
        const bool sample = R0 >= MP; const int tilepos0 = sample ? 0 : R0 - (R0 / SEQ) * SEQ;
        if (g != gw) { const bf16_t* Wp = (const bf16_t*)(p.ws + WS_WPOOL) + g * 16384; gw = g;
#pragma unroll
            for (int i = 0; i < 4; ++i) { const int piece = tid + 512 * i, row = piece >> 4, seg = piece & 15;
                *(LAS u32x4*)(lds + L_PW + row * 272 + seg * 16) = *(const u32x4*)(Wp + row * 128 + seg * 8); } }
#pragma unroll
        for (int i = 0; i < 6; ++i) { const int piece = tid + 512 * i, e = piece >> 4, seg = piece & 15; const bool keep = sample || ((e < 143) && (tilepos0 - 15 + e >= 0));
            if (e < 188) *(LAS u32x4*)(lds + L_PU + e * 272 + seg * 16) = keep ? pf[i] : (u32x4){0u, 0u, 0u, 0u}; }
        LDS_BARRIER();
        if (item + stride < end) pool_fetch(p, item + stride, tid, pf);
        if (g == 0) pool_diff<2>(lds, sample, tilepos0); else if (g == 1) pool_diff<4>(lds, sample, tilepos0); else if (g == 2) pool_diff<8>(lds, sample, tilepos0); else pool_diff<16>(lds, sample, tilepos0);
        LDS_BARRIER();
        f32x4 acc[2][4];
#pragma unroll
        for (int i = 0; i < 2; ++i)
#pragma unroll
            for (int n = 0; n < 4; ++n) acc[i][n] = (f32x4){0.f, 0.f, 0.f, 0.f};
#pragma unroll
        for (int ks = 0; ks < 4; ++ks) { const int kb = (32 * ks + 8 * l4) * 2; bf16x8 bv[4];
#pragma unroll
            for (int n = 0; n < 4; ++n) bv[n] = ldfrag(lds, 64 * tp + 16 * n + l15, 272, kb);
#pragma unroll
            for (int i = 0; i < 2; ++i) { const bf16x8 a = ldfrag(lds + L_PW, 32 * st + 16 * i + l15, 272, kb);
#pragma unroll
                for (int n = 0; n < 4; ++n) acc[i][n] = MFMA16(a, bv[n], acc[i][n]); } }
        LDS_BARRIER();
#pragma unroll
        for (int i = 0; i < 2; ++i) { const int d0 = 32 * st + 16 * i + 4 * l4; const float4 ps = *(const float4*)(pscale + g * 128 + d0);
#pragma unroll
            for (int n = 0; n < 4; ++n) { const int t = 64 * tp + 16 * n + l15;
                u32x2 w; w.x = pk2(acc[i][n][0] * ps.x, acc[i][n][1] * ps.y); w.y = pk2(acc[i][n][2] * ps.z, acc[i][n][3] * ps.w);
                *(LAS u32x2*)(lds + t * 272 + d0 * 2) = w; } }
        LDS_BARRIER();
        { const int t = tid >> 2, sg = tid & 3; const u32x4 o0 = *(LAS const u32x4*)(lds + t * 272 + sg * 64), o1 = *(LAS const u32x4*)(lds + t * 272 + sg * 64 + 16),
            o2 = *(LAS const u32x4*)(lds + t * 272 + sg * 64 + 32), o3 = *(LAS const u32x4*)(lds + t * 272 + sg * 64 + 48);
          bf16_t* mp = mix + (size_t)(R0 + t) * DM + g * 128 + sg * 32; *(u32x4*)mp = o0; *(u32x4*)(mp + 8) = o1; *(u32x4*)(mp + 16) = o2; *(u32x4*)(mp + 24) = o3; }
    }
    LDS_BARRIER();
}

constexpr int N_S2 = 224, N_SMP = 128, N_POOL = (MT / 128) * 4;

__device__ __forceinline__ void phase2(const Params& p, LAS unsigned char* lds, int kinds) {
    const int tid = fresh_tid(), lane = tid & 63, wave = tid >> 6, l15 = lane & 15, l4 = lane >> 4, st = wave & 3, tp = wave >> 2;
    float* Dst = (float*)(p.ws + WS_DST); float* Dn = (float*)(p.ws + WS_DN); const float* mtab = (const float*)(p.ws + WS_MTAB);
    const int step2 = (gridDim.x == 256) ? (blockIdx.x < N_S2 ? (1 << 20) : 32) : (int)gridDim.x;
    for (int it = blockIdx.x; it < N_S2 + N_SMP; it += step2) {
        if (it < N_S2) {
            if (!(kinds & 1)) continue;
            const int chain = it / 7, sc = it % 7, batch = chain >> 2, head = chain & 3;
            f32x4 accC[2][4], accN[2];
#pragma unroll
            for (int i = 0; i < 2; ++i) { accN[i] = (f32x4){0.f, 0.f, 0.f, 0.f};
#pragma unroll
                for (int n = 0; n < 4; ++n) accC[i][n] = (f32x4){0.f, 0.f, 0.f, 0.f}; }
            mlstm_run<false>(p, lds, accC, accN, batch * SEQ + sc * SCN * 64, head, SCN, 64);
            { float* dp = Dst + ((size_t)it * 512 + tid) * 32;
#pragma unroll
              for (int i = 0; i < 2; ++i)
#pragma unroll
                  for (int n = 0; n < 4; ++n) *(f32x4*)(dp + (i * 4 + n) * 4) = accC[i][n]; }
            if (tp == 0 && l15 == 0) {
#pragma unroll
                for (int i = 0; i < 2; ++i) *(f32x4*)(Dn + it * 128 + 32 * st + 16 * i + 4 * l4) = accN[i]; }
        } else {
            if (!(kinds & 2)) continue;
            const int s = it - N_S2, b = s >> 2, head = s & 3;
            const float* C0 = p.in[3] + (size_t)s * 16384; f32x4 accC[2][4], accN[2];
#pragma unroll
            for (int i = 0; i < 2; ++i) accN[i] = *(const f32x4*)(p.in[4] + s * 128 + 32 * st + 16 * i + 4 * l4);
#pragma unroll
            for (int i = 0; i < 2; ++i)
#pragma unroll
                for (int n = 0; n < 4; ++n)
#pragma unroll
                    for (int j = 0; j < 4; ++j) accC[i][n][j] = C0[(32 * st + 16 * i + 4 * l4 + j) * 128 + 64 * tp + 16 * n + l15];
            mlstm_run<true>(p, lds, accC, accN, MP + b * 32, head, 1, 32);
            float* Co = p.out + O_CS + (size_t)s * 16384;
#pragma unroll
            for (int i = 0; i < 2; ++i)
#pragma unroll
                for (int n = 0; n < 4; ++n)
#pragma unroll
                    for (int j = 0; j < 4; ++j) Co[(32 * st + 16 * i + 4 * l4 + j) * 128 + 64 * tp + 16 * n + l15] = accC[i][n][j];
            if (tp == 0 && l15 == 0) {
#pragma unroll
                for (int i = 0; i < 2; ++i) *(f32x4*)(p.out + O_NS + s * 128 + 32 * st + 16 * i + 4 * l4) = accN[i]; }
        }
    }
    if (kinds & 4) { const int G = gridDim.x; int first = blockIdx.x; while (first < N_S2 + N_SMP) first += G;
        pool_loop(p, lds, first - N_S2 - N_SMP, G, N_POOL); }
    const bf16_t* proj = (const bf16_t*)(p.ws + WS_PROJ);
    for (int idx = blockIdx.x * 512 + tid; idx < (NB + DB) * 15 * 512; idx += gridDim.x * 512) {
        if (idx < NB * 7680) { const int b = idx / 7680, rem = idx % 7680, i = rem >> 9, c = rem & 511;
            p.out[O_POOLP + idx] = bf2f(proj[(size_t)(b * SEQ + SEQ - 15 + i) * NPROJ + c]); }
        else { const int id2 = idx - NB * 7680, b = id2 / 7680, rem = id2 % 7680, i = rem >> 9, c = rem & 511;
            p.out[O_POOLS + id2] = bf2f(proj[(size_t)(MP + b * 32 + 17 + i) * NPROJ + c]); }
    }
}

__device__ __forceinline__ void phase3(const Params& p, LAS unsigned char* lds) {
    const int tid = fresh_tid(), lane = tid & 63, wave = tid >> 6, l15 = lane & 15, l4 = lane >> 4, st = wave & 3, tp = wave >> 2;
    const float* Dst = (const float*)(p.ws + WS_DST); const float* Dn = (const float*)(p.ws + WS_DN);
    const float* mtab = (const float*)(p.ws + WS_MTAB); const float* btab = (const float*)(p.ws + WS_BTAB);
    for (int it = blockIdx.x; it < 256; it += gridDim.x) {
        const int chain = it >> 3, sc = it & 7, batch = chain >> 2, head = chain & 3;
        f32x4 accC[2][4], accN[2];
#pragma unroll
        for (int i = 0; i < 2; ++i) { accN[i] = (f32x4){0.f, 0.f, 0.f, 0.f};
#pragma unroll
            for (int n = 0; n < 4; ++n) accC[i][n] = (f32x4){0.f, 0.f, 0.f, 0.f}; }
        f32x4 dC[2][4], dN[2];
        if (sc > 0) {
#pragma unroll
            for (int i = 0; i < 2; ++i) { dN[i] = *(const f32x4*)(Dn + (chain * 7) * 128 + 32 * st + 16 * i + 4 * l4);
#pragma unroll
                for (int n = 0; n < 4; ++n) dC[i][n] = *(const f32x4*)(Dst + ((size_t)(chain * 7) * 512 + tid) * 32 + (i * 4 + n) * 4); } }
#pragma unroll 1
        for (int j = 0; j < sc; ++j) {
            float Bs = 0.f;
            for (int c = 0; c < SCN; ++c) Bs += btab[chain * 128 + j * SCN + c];
            const float Wj = expf(Bs + mtab[chain * 132 + j * SCN] - mtab[chain * 132 + (j + 1) * SCN]);
#pragma unroll
            for (int i = 0; i < 2; ++i) { accN[i] = Wj * accN[i] + dN[i];
#pragma unroll
                for (int n = 0; n < 4; ++n) accC[i][n] = Wj * accC[i][n] + dC[i][n]; }
            if (j + 1 < sc) { const int item = chain * 7 + j + 1;
#pragma unroll
                for (int i = 0; i < 2; ++i) { dN[i] = *(const f32x4*)(Dn + item * 128 + 32 * st + 16 * i + 4 * l4);
#pragma unroll
                    for (int n = 0; n < 4; ++n) dC[i][n] = *(const f32x4*)(Dst + ((size_t)item * 512 + tid) * 32 + (i * 4 + n) * 4); } }
        }
        mlstm_run<true>(p, lds, accC, accN, batch * SEQ + sc * SCN * 64, head, SCN, 64);
        if (sc == 7) {
            const int t2 = fresh_tid(), l15b = t2 & 15, l4b = (t2 >> 4) & 3, stb = (t2 >> 6) & 3, tpb = t2 >> 8;
            float* Co = p.out + O_CP + (size_t)chain * 16384 + (32 * stb + 4 * l4b) * 128 + 64 * tpb + l15b;
#pragma unroll
            for (int i = 0; i < 2; ++i)
#pragma unroll
                for (int n = 0; n < 4; ++n)
#pragma unroll
                    for (int j = 0; j < 4; ++j) Co[(16 * i + j) * 128 + 16 * n] = accC[i][n][j];
            if (tpb == 0 && l15b == 0) {
#pragma unroll
                for (int i = 0; i < 2; ++i) *(f32x4*)(p.out + O_NP + chain * 128 + 32 * stb + 16 * i + 4 * l4b) = accN[i]; }
        }
    }
}

template <int S>
__device__ __forceinline__ void ln_load(const bf16_t* src, const float* slab, const bf16_t* hb, int row, int lane, float4 (&v)[4]) {
    if (row >= MP) {
#pragma unroll
        for (int i = 0; i < 4; ++i) { const int c = i * 256 + lane * 4; const u32x2 h2 = *(const u32x2*)(hb + (size_t)row * DM + c);
            const float* sp = slab + (size_t)(row - MP) * DM + c; float4 t[S];
#pragma unroll
            for (int sl = 0; sl < S; ++sl) t[sl] = *(const float4*)(sp + (size_t)sl * (1024 * 1024));
            float4 a = make_float4(ALPHA * bflo(h2.x), ALPHA * bfhi(h2.x), ALPHA * bflo(h2.y), ALPHA * bfhi(h2.y));
#pragma unroll
            for (int sl = 0; sl < S; ++sl) { a.x += t[sl].x; a.y += t[sl].y; a.z += t[sl].z; a.w += t[sl].w; }
            v[i] = a; }
    } else {
#pragma unroll
        for (int i = 0; i < 4; ++i) { const u32x2 r = *(const u32x2*)(src + (size_t)row * DM + i * 256 + lane * 4); v[i] = make_float4(bflo(r.x), bfhi(r.x), bflo(r.y), bfhi(r.y)); } }
}
template <bool TO_BF16, int S>
__device__ __forceinline__ void ln_rows(const bf16_t* src, const float* gam, const float* bet, bf16_t* ob, float* of, const float* slab, const bf16_t* hb, unsigned char* o8) {
    const int tid = fresh_tid(), lane = tid & 63, wave = tid >> 6, stride = gridDim.x * 8;
    int row = blockIdx.x * 8 + wave; float4 v[4];
    if (row < MT) ln_load<S>(src, slab, hb, row, lane, v);
#pragma unroll 1
    for (; row < MT; row += stride) {
        const int nrow = row + stride; float4 nv[4];
        if (nrow < MT) ln_load<S>(src, slab, hb, nrow, lane, nv);
        else {
#pragma unroll
            for (int i = 0; i < 4; ++i) nv[i] = make_float4(0.f, 0.f, 0.f, 0.f); }
        float s = 0.f;
#pragma unroll
        for (int i = 0; i < 4; ++i) s += (v[i].x + v[i].y) + (v[i].z + v[i].w);
        const float mu = wave_sum(s) * (1.0f / DM); float q = 0.f;
#pragma unroll
        for (int i = 0; i < 4; ++i) { v[i].x -= mu; v[i].y -= mu; v[i].z -= mu; v[i].w -= mu; q += (v[i].x * v[i].x + v[i].y * v[i].y) + (v[i].z * v[i].z + v[i].w * v[i].w); }
        const float rstd = rsqrtf(wave_sum(q) * (1.0f / DM) + LN_EPS);
#pragma unroll
        for (int i = 0; i < 4; ++i) { const int c = i * 256 + lane * 4; const float4 gg = *(const float4*)(gam + c), bb = *(const float4*)(bet + c);
            float4 y; y.x = v[i].x * rstd * gg.x + bb.x; y.y = v[i].y * rstd * gg.y + bb.y; y.z = v[i].z * rstd * gg.z + bb.z; y.w = v[i].w * rstd * gg.w + bb.w;
            if (TO_BF16) { u32x2 w; w.x = pk2(y.x, y.y); w.y = pk2(y.z, y.w); *(u32x2*)(ob + (size_t)row * DM + c) = w; *(unsigned*)(o8 + (size_t)row * DM + c) = pk4_fp8(y.x, y.y, y.z, y.w); }
            else *(float4*)(of + (size_t)row * DM + c) = y; }
#pragma unroll
        for (int i = 0; i < 4; ++i) v[i] = nv[i];
    }
}

__global__ void __launch_bounds__(512) fwd_mega(Params p) {
    extern __shared__ __attribute__((aligned(16))) unsigned char smem[];
    LAS unsigned char* lds = (LAS unsigned char*)smem;
    cg::grid_group grid = cg::this_grid();
    volatile LAS unsigned* stw = (volatile LAS unsigned*)(lds + LDS_XB);
    if (threadIdx.x == 0) { stw[0] = 0u; stw[1] = 0u; }
    __syncthreads();
    const XcdBarrier xbar = xcd_barrier_post((unsigned*)(p.ws + WS_BAR), stw);
    unsigned char* ws = p.ws;
    bf16_t* h0 = (bf16_t*)(ws + WS_H0); bf16_t* proj = (bf16_t*)(ws + WS_PROJ); bf16_t* mix = (bf16_t*)(ws + WS_MIX); bf16_t* act = (bf16_t*)(ws + WS_ACT);
    float* slab = (float*)(ws + WS_SLAB);
    const int G = gridDim.x, bx = blockIdx.x;
#ifndef DBL
#define DBL 0
#endif
    if (DBL & 0x800) { for (int i = 0; i < 10; ++i) xcd_barrier(xbar); }
    if (DBL & 1) { phase0(p, lds); xcd_barrier(xbar); }
    phase0(p, lds);
    grid.sync();
    gate_scan(p, lds);
    for (int rep_ = 0; rep_ < ((DBL & 0x1000) ? 2 : 1); ++rep_)
    { if (rep_) xcd_barrier(xbar); pg8::Gemm g{h0, (const bf16_t*)(ws + WS_WIN), MT, NPROJ, DM}; SplitOrder S; S.init(NPROJ, DM / 64, 1, G, bx);
      EpiBf16B e{proj, NPROJ, (const float*)(ws + WS_BIAS)}; pg8::gemm_phase(lds, g, S, e); }
    xcd_barrier(xbar);
    if (DBL & 4) { phase2(p, lds, 15); xcd_barrier(xbar); }
    if (DBL & 0x200) { phase2(p, lds, 4); xcd_barrier(xbar); }
    if (DBL & 0x400) { phase2(p, lds, 1); xcd_barrier(xbar); }
    phase2(p, lds, 15);
    xcd_barrier(xbar);
    if (DBL & 8) { phase3(p, lds); xcd_barrier(xbar); }
    phase3(p, lds);
    xcd_barrier(xbar);
    for (int rep_ = 0; rep_ < ((DBL & 0x2000) ? 2 : 1); ++rep_)
    { if (rep_) xcd_barrier(xbar); pg8::Gemm g{mix, (const bf16_t*)(ws + WS_WOUT), MT, DM, DM}; SplitOrder S; S.init(DM, DM / 64, 4, G, bx);
      EpiRes e{h0, (bf16_t*)(ws + WS_R1), slab, DM / 64}; pg8::gemm_phase(lds, g, S, e); }
    xcd_barrier(xbar);
    if (DBL & 32) { ln_rows<true, 4>((const bf16_t*)(ws + WS_R1), p.in[14], p.in[15], h0, nullptr, slab, h0, ws + WS_H8); xcd_barrier(xbar); }
    ln_rows<true, 4>((const bf16_t*)(ws + WS_R1), p.in[14], p.in[15], h0, nullptr, slab, h0, ws + WS_H8);
    xcd_barrier(xbar);
    for (int rep_ = 0; rep_ < ((DBL & 0x4000) ? 2 : 1); ++rep_)
    { if (rep_) xcd_barrier(xbar);
#ifdef STAGGER
      if (bx & 1) { for (int q = 0; q < STAGGER; ++q) __builtin_amdgcn_s_sleep(127); }
#endif
      pg8::Gemm g{(const bf16_t*)(ws + WS_H8), (const bf16_t*)(ws + WS_WGU), MT, 2 * DFF, DM / 2}; SplitOrder S; S.init(2 * DFF, DM / 128, 1, G, bx);
      EpiSwiglu e{act, 1.0f / W8_SCALE}; pg8::gemm_phase<EpiSwiglu, SplitOrder, true>(lds, g, S, e); }
    xcd_barrier(xbar);
    for (int rep_ = 0; rep_ < ((DBL & 0x8000) ? 2 : 1); ++rep_)
    { if (rep_) xcd_barrier(xbar); pg8::Gemm g{act, (const bf16_t*)(ws + WS_WDN), MT, DM, DFF}; SplitOrder S; S.init(DM, DFF / 64, 11, G, bx);
      EpiRes e{h0, (bf16_t*)(ws + WS_R2), slab, DFF / 64}; pg8::gemm_phase(lds, g, S, e); }
    xcd_barrier(xbar);
    if (DBL & 0x10000) { ln_rows<false, 11>((const bf16_t*)(ws + WS_R2), p.in[19], p.in[20], nullptr, p.out + O_Y, slab, h0, nullptr); xcd_barrier(xbar); }
    ln_rows<false, 11>((const bf16_t*)(ws + WS_R2), p.in[19], p.in[20], nullptr, p.out + O_Y, slab, h0, nullptr);
}

extern "C" void kernel_launch(void* const* d_in, const int* in_sizes, int n_in, void* d_out, int out_size, void* d_ws, size_t ws_size, hipStream_t stream) {
    constexpr size_t kDynLds = LDS_TOTAL;
    static int grid_blocks = 0;
    if (!grid_blocks) {
        if (n_in != 21 || (size_t)out_size != O_END || ws_size < WS_END3) { fprintf(stderr, "kernel_launch: unexpected shapes: n_in %d out %d ws %zu (need %zu)\n", n_in, out_size, ws_size, (size_t)WS_END3); grid_blocks = -1; return; }
        int dev = 0, cus = 0, per_cu = 0;
        hipGetDevice(&dev);
        hipDeviceGetAttribute(&cus, hipDeviceAttributeMultiprocessorCount, dev);
        if (hipFuncSetAttribute((const void*)fwd_mega, hipFuncAttributeMaxDynamicSharedMemorySize, (int)kDynLds) != hipSuccess) { fprintf(stderr, "kernel_launch: hipFuncSetAttribute failed\n"); grid_blocks = -1; return; }
        if (hipOccupancyMaxActiveBlocksPerMultiprocessor(&per_cu, (const void*)fwd_mega, 512, kDynLds) != hipSuccess || per_cu < 1) { fprintf(stderr, "kernel_launch: occupancy query failed (%d)\n", per_cu); grid_blocks = -1; return; }
        if (per_cu > 1) per_cu = 1;
        grid_blocks = cus * per_cu;
    }
    if (grid_blocks < 0) return;
    if (hipMemsetAsync((char*)d_ws + WS_BAR, 0, XCD_BAR_WORDS * 4, stream) != hipSuccess) { fprintf(stderr, "kernel_launch: memset of the barrier words failed\n"); return; }
    Params p{};
    for (int i = 0; i < 21; ++i) p.in[i] = (const float*)d_in[i];
    p.out = (float*)d_out; p.ws = (unsigned char*)d_ws;
    void* args[] = {&p};
    hipError_t e = hipLaunchCooperativeKernel((const void*)fwd_mega, dim3(grid_blocks), dim3(512), args, kDynLds, stream);
    if (e != hipSuccess) fprintf(stderr, "cooperative launch failed: %s (grid %d)\n", hipGetErrorString(e), grid_blocks);
}
```
